# Optimizing an MI355X kernel written in HIP

```python
import jax
import jax.numpy as jnp
from jax import lax
import numpy as np

D_MODEL = 1024
BATCH = 8
SEQ = 2048
DEPTH = 2

GRID_W = 64
CTX_LEN = 256
D_LRU = 512
N_LRU_HEADS = 8
LRU_HEAD_DIM = D_LRU // N_LRU_HEADS
CONV_W = 4
CONV_LEFT = 2
LRU_C = 8.0
D_POOL = 512
POOL_WINDOWS = (2, 4, 8, 16)
N_POOL_GROUPS = len(POOL_WINDOWS)
POOL_GROUP_DIM = D_POOL // N_POOL_GROUPS
D_IN = 2 * D_LRU + D_POOL
D_MIX = D_LRU + D_POOL
N_EXPERTS = 32
TOP_K = 4
D_EXPERT = D_MODEL
SWIGLU_LIMIT = 7.0
SWIGLU_ALPHA = 1.702
LN_EPS = 1e-5

kernel_name = 'hybrid_lru_pool_moe_dit'


def layer_norm(x, g=None, b=None):
    xf = x.astype(jnp.float32)
    mu = jnp.mean(xf, axis=-1, keepdims=True)
    var = jnp.mean(jnp.square(xf - mu), axis=-1, keepdims=True)
    y = (xf - mu) * lax.rsqrt(var + LN_EPS)
    if g is not None:
        y = y * g.astype(jnp.float32) + b.astype(jnp.float32)
    return y.astype(x.dtype)


def modulate(x, shift, scale):
    return x * (1 + scale) + shift


def grid_sincos(rows, cols, d):
    quarter = d // 4
    omega = 1.0 / (10000.0 ** (jnp.arange(quarter, dtype=jnp.float32) / quarter))

    def emb1d(n):
        ang = jnp.arange(n, dtype=jnp.float32)[:, None] * omega[None, :]
        return jnp.concatenate([jnp.sin(ang), jnp.cos(ang)], axis=-1)

    er = jnp.broadcast_to(emb1d(rows)[:, None, :], (rows, cols, d // 2))
    ec = jnp.broadcast_to(emb1d(cols)[None, :, :], (rows, cols, d // 2))
    return jnp.concatenate([er, ec], axis=-1).reshape(rows * cols, d)


def conv_centred(u, w, b):
    L = u.shape[1]
    up = jnp.pad(u, ((0, 0), (CONV_LEFT, CONV_W - 1 - CONV_LEFT), (0, 0)))
    y = b
    for k in range(CONV_W):
        y = y + up[:, k:k + L, :] * w[k]
    return y


def block_diag(u, w, b):
    B, L, _ = u.shape
    uh = u.reshape(B, L, N_LRU_HEADS, LRU_HEAD_DIM)
    return jnp.einsum('blhi,hij->blhj', uh, w).reshape(B, L, D_LRU) + b


def lru_coeffs(u, wa, ba, wx, bx, lam):
    uf = u.astype(jnp.float32)
    r = jax.nn.sigmoid(block_diag(uf, wa.astype(jnp.float32), ba.astype(jnp.float32)))
    i = jax.nn.sigmoid(block_diag(uf, wx.astype(jnp.float32), bx.astype(jnp.float32)))
    log_a = -LRU_C * r * jax.nn.softplus(-lam.astype(jnp.float32))
    a = jnp.exp(log_a)
    bterm = jnp.sqrt(-jnp.expm1(2.0 * log_a)) * (i * uf)
    return a, bterm


def _combine(e1, e2):
    a1, b1 = e1
    a2, b2 = e2
    return a1 * a2, a2 * b1 + b2


def linear_scan(a, bterm, h0, reverse):
    edge = -1 if reverse else 0
    bterm = bterm.at[:, edge].add(a[:, edge] * h0)
    _, h = lax.associative_scan(_combine, (a, bterm), reverse=reverse, axis=1)
    return h


def rglru_bidir(uc, ul, ga_w, ga_b, gx_w, gx_b, lam):
    hc_dirs = []
    hl_sum = None
    for d, rev in enumerate((False, True)):
        a, bt = lru_coeffs(uc, ga_w[d], ga_b[d], gx_w[d], gx_b[d], lam[d])
        h_c = linear_scan(a, bt, jnp.zeros_like(a[:, 0]), rev)
        h_end = h_c[:, 0] if rev else h_c[:, -1]
        a, bt = lru_coeffs(ul, ga_w[d], ga_b[d], gx_w[d], gx_b[d], lam[d])
        h_l = linear_scan(a, bt, h_end, rev)
        hc_dirs.append(h_c)
        hl_sum = h_l if hl_sum is None else hl_sum + h_l
    return hc_dirs, hl_sum


def multiscale_pool(u, w, b, scale, grid_w):
    B, L, _ = u.shape
    t = jnp.arange(L)
    if grid_w is None:
        seg_lo, seg_hi = 0, L
    else:
        seg_lo = (t // grid_w) * grid_w
        seg_hi = seg_lo + grid_w
    uf = u.astype(jnp.float32)
    prefix = jnp.pad(jnp.cumsum(uf, axis=1), ((0, 0), (1, 0), (0, 0)))
    diffs = []
    for g, win in enumerate(POOL_WINDOWS):
        lo = jnp.maximum(t - win // 2, seg_lo)
        hi = jnp.minimum(t + win // 2, seg_hi)
        sl = slice(g * POOL_GROUP_DIM, (g + 1) * POOL_GROUP_DIM)
        pg = prefix[:, :, sl]
        cnt = (hi - lo).astype(jnp.float32)[None, :, None]
        diffs.append((pg[:, hi] - pg[:, lo]) / cnt - uf[:, :, sl])
    dmat = jnp.stack(diffs, axis=2)
    y = jnp.einsum('blgi,gij->blgj', dmat, w.astype(jnp.float32)).reshape(B, L, D_POOL)
    y = (y + b.astype(jnp.float32)) * scale.astype(jnp.float32)
    return y.astype(u.dtype)


def token_mixer(hl, hc, w_in, conv_w, conv_b, ga_w, ga_b, gx_w, gx_b, lam,
                pool_w, pool_b, pool_scale, w_out, with_ctx_out):
    zl = hl @ w_in
    zc = hc @ w_in
    xr_l, y_l, xp_l = jnp.split(zl, [D_LRU, 2 * D_LRU], axis=-1)
    xr_c, y_c, xp_c = jnp.split(zc, [D_LRU, 2 * D_LRU], axis=-1)
    ul = conv_centred(xr_l, conv_w, conv_b)
    uc = conv_centred(xr_c, conv_w, conv_b)
    hc_dirs, hr_l = rglru_bidir(uc, ul, ga_w, ga_b, gx_w, gx_b, lam)
    lat = jnp.concatenate(
        [hr_l.astype(hl.dtype) * jax.nn.gelu(y_l),
         multiscale_pool(xp_l, pool_w, pool_b, pool_scale, GRID_W)], axis=-1) @ w_out
    if not with_ctx_out:
        return lat, None
    hr_c = (hc_dirs[0] + hc_dirs[1]).astype(hc.dtype)
    ctx_out = jnp.concatenate(
        [hr_c * jax.nn.gelu(y_c),
         multiscale_pool(xp_c, pool_w, pool_b, pool_scale, None)], axis=-1) @ w_out
    return lat, ctx_out


def moe_ffn(h, router_w, router_b, w1, b1, w2, b2):
    logits = (h @ router_w + router_b).astype(jnp.float32)
    top_v, top_i = lax.top_k(logits, TOP_K)
    top_p = jax.nn.softmax(top_v, axis=-1)
    gates = jnp.sum(jax.nn.one_hot(top_i, N_EXPERTS, dtype=jnp.float32) * top_p[..., None],
                    axis=1).astype(h.dtype)
    out = jnp.zeros_like(h)
    for e in range(N_EXPERTS):
        gu = h @ w1[e] + b1[e]
        glu = jnp.minimum(gu[:, :D_EXPERT], SWIGLU_LIMIT)
        lin = jnp.clip(gu[:, D_EXPERT:], -SWIGLU_LIMIT, SWIGLU_LIMIT)
        act = glu * jax.nn.sigmoid(SWIGLU_ALPHA * glu) * (lin + 1)
        out = out + gates[:, e:e + 1] * (act @ w2[e] + b2[e])
    return out


def setup_inputs(seed: int = 0) -> dict:
    key = jax.random.key(seed)
    ks = iter(jax.random.split(key, 40))

    def nrm(shape, s):
        return jax.random.normal(next(ks), shape, jnp.float32) * s

    beta = (8.0 * DEPTH) ** -0.25
    u = jax.random.uniform(next(ks), (DEPTH, 2, D_LRU), jnp.float32, 0.9, 0.999)
    s = u ** (1.0 / LRU_C)
    lru_lambda = jnp.log(s) - jnp.log1p(-s)
    return {
        'x': nrm((BATCH, SEQ, D_MODEL), 1.0),
        'c': nrm((BATCH, D_MODEL), 1.0),
        'ctx': nrm((BATCH, CTX_LEN, D_MODEL), 1.0),
        'c_ctx': nrm((D_MODEL,), 1.0),
        'w_mod': nrm((DEPTH, D_MODEL, 6 * D_MODEL), D_MODEL ** -0.5),
        'b_mod': nrm((DEPTH, 6 * D_MODEL), 0.01),
        'w_in': nrm((DEPTH, D_MODEL, D_IN), D_MODEL ** -0.5),
        'conv_w': nrm((DEPTH, CONV_W, D_LRU), CONV_W ** -0.5),
        'conv_b': nrm((DEPTH, D_LRU), 0.01),
        'gate_a_w': nrm((DEPTH, 2, N_LRU_HEADS, LRU_HEAD_DIM, LRU_HEAD_DIM), LRU_HEAD_DIM ** -0.5),
        'gate_a_b': nrm((DEPTH, 2, D_LRU), 0.01),
        'gate_x_w': nrm((DEPTH, 2, N_LRU_HEADS, LRU_HEAD_DIM, LRU_HEAD_DIM), LRU_HEAD_DIM ** -0.5),
        'gate_x_b': nrm((DEPTH, 2, D_LRU), 0.01),
        'lru_lambda': lru_lambda,
        'pool_w': nrm((DEPTH, N_POOL_GROUPS, POOL_GROUP_DIM, POOL_GROUP_DIM), POOL_GROUP_DIM ** -0.5),
        'pool_b': nrm((DEPTH, D_POOL), 0.01),
        'pool_scale': 1.0 + nrm((DEPTH, D_POOL), 0.02),
        'w_out': nrm((DEPTH, D_MIX, D_MODEL), beta * D_MIX ** -0.5),
        'ln1_g': 1.0 + nrm((DEPTH, D_MODEL), 0.02),
        'ln1_b': nrm((DEPTH, D_MODEL), 0.02),
        'router_w': nrm((DEPTH, D_MODEL, N_EXPERTS), D_MODEL ** -0.5),
        'router_b': nrm((DEPTH, N_EXPERTS), 0.01),
        'exp_w1': nrm((DEPTH, N_EXPERTS, D_MODEL, 2 * D_EXPERT), D_MODEL ** -0.5),
        'exp_b1': nrm((DEPTH, N_EXPERTS, 2 * D_EXPERT), 0.01),
        'exp_w2': nrm((DEPTH, N_EXPERTS, D_EXPERT, D_MODEL), beta * D_EXPERT ** -0.5),
        'exp_b2': nrm((DEPTH, N_EXPERTS, D_MODEL), 0.01),
        'ln2_g': 1.0 + nrm((DEPTH, D_MODEL), 0.02),
        'ln2_b': nrm((DEPTH, D_MODEL), 0.02),
    }


def reference(x, c, ctx, c_ctx, w_mod, b_mod, w_in, conv_w, conv_b, gate_a_w, gate_a_b,
              gate_x_w, gate_x_b, lru_lambda, pool_w, pool_b, pool_scale, w_out, ln1_g, ln1_b,
              router_w, router_b, exp_w1, exp_b1, exp_w2, exp_b2, ln2_g, ln2_b):
    B, S, D = x.shape
    ROWS = S // GRID_W
    alpha = (2.0 * DEPTH) ** 0.25
    xl = layer_norm(x + grid_sincos(ROWS, GRID_W, D).astype(x.dtype))
    xc = layer_norm(ctx)
    silu_c = jax.nn.silu(c)
    silu_cc = jax.nn.silu(c_ctx)
    for l in range(DEPTH):
        with_ctx = l < DEPTH - 1
        mod_l = silu_c @ w_mod[l] + b_mod[l]
        mod_c = silu_cc @ w_mod[l] + b_mod[l]
        sh1_l, sc1_l, g1_l, sh2_l, sc2_l, g2_l = jnp.split(mod_l[:, None, :], 6, axis=-1)
        sh1_c, sc1_c, g1_c, sh2_c, sc2_c, g2_c = jnp.split(mod_c, 6, axis=-1)

        ml, mc = token_mixer(modulate(xl, sh1_l, sc1_l), modulate(xc, sh1_c, sc1_c),
                             w_in[l], conv_w[l], conv_b[l], gate_a_w[l], gate_a_b[l],
                             gate_x_w[l], gate_x_b[l], lru_lambda[l], pool_w[l], pool_b[l],
                             pool_scale[l], w_out[l], with_ctx)
        xl = layer_norm(alpha * xl + g1_l * ml, ln1_g[l], ln1_b[l])
        hl2 = modulate(xl, sh2_l, sc2_l).reshape(-1, D)
        if with_ctx:
            xc = layer_norm(alpha * xc + g1_c * mc, ln1_g[l], ln1_b[l])
            hc2 = modulate(xc, sh2_c, sc2_c).reshape(-1, D)
            tokens = jnp.concatenate([hl2, hc2], axis=0)
        else:
            tokens = hl2

        f = moe_ffn(tokens, router_w[l], router_b[l], exp_w1[l], exp_b1[l], exp_w2[l], exp_b2[l])
        xl = layer_norm(alpha * xl + g2_l * f[:B * S].reshape(B, S, D), ln2_g[l], ln2_b[l])
        if with_ctx:
            fc = f[B * S:].reshape(B, -1, D)
            xc = layer_norm(alpha * xc + g2_c * fc, ln2_g[l], ln2_b[l])
    return xl
```

```cpp
#include <hip/hip_runtime.h>
#include <cstdio>
#include <cstdint>

constexpr int NB = 8, SEQ = 2048, D = 1024, CTXL = 256, DEPTH = 2;
constexpr int TL = NB * SEQ;
constexpr int TC = NB * CTXL;
constexpr int TT = TL + TC;
constexpr int DLRU = 512, DPOOL = 512, DIN = 1536, NH = 8, HD = 64;
constexpr int NE = 32, TOPK = 4, DF = 1024;
constexpr int GRIDW = 64;
constexpr float LN_EPS = 1e-5f;
constexpr float ALPHA = 1.41421356237309515f;
constexpr int MAXROWS = 81920;

enum { I_X = 0, I_C, I_CTX, I_CCTX, I_WMOD, I_BMOD, I_WIN, I_CONVW, I_CONVB, I_GAW, I_GAB, I_GXW, I_GXB, I_LAM, I_POOLW, I_POOLB, I_POOLS,
       I_WOUT, I_LN1G, I_LN1B, I_RW, I_RB, I_W1, I_B1, I_W2, I_B2, I_LN2G, I_LN2B, N_IN };

constexpr size_t MiB = 1u << 20;
constexpr size_t WS_CTL = 0, CTL_BYTES = 1 * MiB;
constexpr size_t WS_MOD = 1 * MiB;
constexpr size_t WS_POS = 2 * MiB;
constexpr size_t WS_TOPE = 3 * MiB;
constexpr size_t WS_SLOT = 3 * MiB + 512 * 1024;
constexpr size_t WS_ROWTOK = 4 * MiB;
constexpr size_t WS_ROWGATE = 7 * MiB;
constexpr size_t WS_AGG = 10 * MiB;
constexpr size_t WS_WIN = 16 * MiB, WS_WOUT = 23 * MiB, WS_WG = 28 * MiB, WS_WP = 29 * MiB;
constexpr size_t WS_W1T = 32 * MiB, WS_W2T = 288 * MiB;
constexpr size_t WS_XL = 416 * MiB;
constexpr size_t WS_H = 488 * MiB;
constexpr size_t WS_Z = 524 * MiB;
constexpr size_t WS_MIX = 578 * MiB;
constexpr size_t WS_Y1 = 614 * MiB;
constexpr size_t WS_ACT = 650 * MiB;
constexpr size_t WS_Y2 = 810 * MiB;
constexpr size_t WS_U = 970 * MiB;
constexpr size_t WS_AA = 1006 * MiB;
constexpr size_t WS_BB = 1078 * MiB;
constexpr size_t WS_HS = 1150 * MiB;
constexpr size_t WS_DD = 1186 * MiB;
constexpr size_t WS_END = 1222 * MiB;
constexpr int CW_CNT = 64;

typedef unsigned short bf16;
typedef float f32x4 __attribute__((ext_vector_type(4)));
typedef unsigned u32x2 __attribute__((ext_vector_type(2)));
typedef unsigned u32x4 __attribute__((ext_vector_type(4)));

__device__ __forceinline__ float bf2f(bf16 v) { return __uint_as_float(((unsigned)v) << 16); }
__device__ __forceinline__ unsigned f2bf(float f) { unsigned u = __float_as_uint(f); return (u + 0x7fffu + ((u >> 16) & 1u)) >> 16; }
__device__ __forceinline__ unsigned pk2(float lo, float hi) { return f2bf(lo) | (f2bf(hi) << 16); }
__device__ __forceinline__ float wave_sum(float v) {
#pragma unroll
    for (int o = 1; o < 64; o <<= 1) v += __shfl_xor(v, o);
    return v;
}
__device__ __forceinline__ float sigmoidf_(float x) { return 1.0f / (1.0f + __expf(-x)); }
__device__ __forceinline__ float gelu_tanh(float x) {
    const float u = 0.7978845608028654f * (x + 0.044715f * x * x * x);
    const float t = 1.0f - 2.0f / (__expf(2.0f * u) + 1.0f);
    return 0.5f * x * (1.0f + t);
}

struct P {
    const float* in[N_IN];
    float* out;
    unsigned char* ws;
    int l;
    int pad;
};

__device__ __forceinline__ int mod_row(int tok) { return tok < TL ? (tok >> 11) : NB; }

__global__ void __launch_bounds__(256) k_pos(P p) {
    float* POS = (float*)(p.ws + WS_POS);
    const int i = blockIdx.x * 256 + threadIdx.x;
    if (i >= 64 * 512) return;
    const int n = i / 512, j = i % 512, q = j % 256;
    const float omega = 1.0f / powf(10000.0f, (float)q / 256.0f);
    const float ang = (float)n * omega;
    POS[i] = j < 256 ? sinf(ang) : cosf(ang);
}

__global__ void __launch_bounds__(512) k_mod(P p) {
    __shared__ float sl[9 * 1024];
    __shared__ float part[16][9][32];
    const int tid = threadIdx.x;
    const float* c = p.in[I_C]; const float* cc = p.in[I_CCTX];
    for (int i = tid; i < 9 * 1024; i += 512) { const float v = i < 8192 ? c[i] : cc[i - 8192]; sl[i] = v / (1.0f + __expf(-v)); }
    __syncthreads();
    float* MOD = (float*)(p.ws + WS_MOD);
    for (int u = blockIdx.x; u < 2 * 192; u += gridDim.x) {
        const int l = u / 192, n0 = (u % 192) * 32;
        const float* W = p.in[I_WMOD] + (size_t)l * 1024 * 6144;
        const int col = tid & 31, ks = tid >> 5;
        float acc[9];
#pragma unroll
        for (int r = 0; r < 9; ++r) acc[r] = 0.f;
#pragma unroll 8
        for (int kk = 0; kk < 64; ++kk) {
            const int k = ks * 64 + kk;
            const float w = W[(size_t)k * 6144 + n0 + col];
#pragma unroll
            for (int r = 0; r < 9; ++r) acc[r] += sl[r * 1024 + k] * w;
        }
#pragma unroll
        for (int r = 0; r < 9; ++r) part[ks][r][col] = acc[r];
        __syncthreads();
        if (tid < 9 * 32) {
            const int r = tid / 32, cl = tid % 32; float s = 0.f;
#pragma unroll
            for (int q = 0; q < 16; ++q) s += part[q][r][cl];
            MOD[((size_t)l * 9 + r) * 6144 + n0 + cl] = s + p.in[I_BMOD][(size_t)l * 6144 + n0 + cl];
        }
        __syncthreads();
    }
}

__device__ __forceinline__ void ln_stats(const f32x4 (&v)[4], float& mean, float& rstd) {
    float s = 0.f;
#pragma unroll
    for (int j = 0; j < 4; ++j) s += (v[j].x + v[j].y) + (v[j].z + v[j].w);
    mean = wave_sum(s) * (1.f / D);
    float s2 = 0.f;
#pragma unroll
    for (int j = 0; j < 4; ++j) { const f32x4 d = v[j] - mean; s2 += (d.x * d.x + d.y * d.y) + (d.z * d.z + d.w * d.w); }
    rstd = 1.0f / sqrtf(wave_sum(s2) * (1.f / D) + LN_EPS);
}
__device__ __forceinline__ void store_bf16_row(bf16* row, int lane, const f32x4 (&h)[4]) {
    u32x2* o = (u32x2*)row + lane;
#pragma unroll
    for (int j = 0; j < 4; ++j) { u32x2 w; w.x = pk2(h[j].x, h[j].y); w.y = pk2(h[j].z, h[j].w); o[64 * j] = w; }
}

__global__ void __launch_bounds__(512) k_entry(P p) {
    const int lane = threadIdx.x & 63, gw = blockIdx.x * 8 + (threadIdx.x >> 6), ngw = gridDim.x * 8;
    const float* POS = (const float*)(p.ws + WS_POS);
    const float* MOD = (const float*)(p.ws + WS_MOD);
    float* XL = (float*)(p.ws + WS_XL); bf16* H = (bf16*)(p.ws + WS_H);
    for (int tok = gw; tok < TT; tok += ngw) {
        const float* src = tok < TL ? p.in[I_X] + (size_t)tok * D : p.in[I_CTX] + (size_t)(tok - TL) * D;
        f32x4 v[4];
#pragma unroll
        for (int j = 0; j < 4; ++j) v[j] = ((const f32x4*)src)[lane + 64 * j];
        if (tok < TL) {
            const int s = tok & (SEQ - 1), pr = s / GRIDW, pc = s % GRIDW;
#pragma unroll
            for (int j = 0; j < 4; ++j) {
                const float* ps = POS + (size_t)(j < 2 ? pr : pc) * 512 + (4 * lane + 256 * (j & 1));
                v[j] += *(const f32x4*)ps;
            }
        }
        float mean, rstd; ln_stats(v, mean, rstd);
        const float* m = MOD + (size_t)mod_row(tok) * 6144;
        f32x4 h[4];
#pragma unroll
        for (int j = 0; j < 4; ++j) {
            v[j] = (v[j] - mean) * rstd;
            ((f32x4*)(XL + (size_t)tok * D))[lane + 64 * j] = v[j];
            const f32x4 sh = ((const f32x4*)m)[lane + 64 * j], sc = ((const f32x4*)(m + 1024))[lane + 64 * j];
            h[j] = v[j] * (sc + 1.0f) + sh;
        }
        store_bf16_row(H + (size_t)tok * D, lane, h);
    }
}

struct NG {
    const bf16* A; const float* W; const float* bias; bf16* C; const int* cnt; const int* rowtok; const float* rowgate;
    int lda, ldw, ldc, M, N, K, pad;
};
__device__ __forceinline__ int pad256(int c) { return (c + 255) & ~255; }
template <int MODE> __global__ void __launch_bounds__(256) k_gemm_naive(NG g) {
    __shared__ float As[16][65];
    __shared__ float Bs[16][64];
    __shared__ float Bs2[MODE == 1 ? 16 : 1][64];
    const int tid = threadIdx.x, tx = tid & 15, ty = tid >> 4;
    const int e = blockIdx.z;
    int M = g.M, off = 0;
    const float* W = g.W; const float* bias = g.bias;
    if (MODE != 0) {
        M = g.cnt[e];
        for (int q = 0; q < e; ++q) off += pad256(g.cnt[q]);
        W += (size_t)e * g.K * g.ldw; bias += (size_t)e * g.ldw;
    }
    const int m0 = blockIdx.y * 64, n0 = blockIdx.x * 64;
    if (m0 >= M) return;
    float acc[4][4], acc2[4][4];
#pragma unroll
    for (int i = 0; i < 4; ++i)
#pragma unroll
        for (int j = 0; j < 4; ++j) { acc[i][j] = 0.f; acc2[i][j] = 0.f; }
    const int ar = tid >> 2, ak = (tid & 3) * 4;
    int arow = m0 + ar; const bool avalid = arow < M;
    size_t abase;
    if (MODE == 1) abase = (size_t)(avalid ? g.rowtok[(size_t)e * TT + arow] : 0) * g.lda;
    else if (MODE == 2) abase = (size_t)(off + arow) * g.lda;
    else abase = (size_t)(avalid ? arow : 0) * g.lda;
    const int bk = tid >> 4, bn = (tid & 15) * 4;
    for (int k0 = 0; k0 < g.K; k0 += 16) {
        {
            const u32x2 raw = *(const u32x2*)(g.A + abase + k0 + ak);
            As[ak + 0][ar] = avalid ? __uint_as_float(raw.x << 16) : 0.f; As[ak + 1][ar] = avalid ? __uint_as_float(raw.x & 0xffff0000u) : 0.f;
            As[ak + 2][ar] = avalid ? __uint_as_float(raw.y << 16) : 0.f; As[ak + 3][ar] = avalid ? __uint_as_float(raw.y & 0xffff0000u) : 0.f;
            const f32x4 b = *(const f32x4*)(W + (size_t)(k0 + bk) * g.ldw + n0 + bn);
            Bs[bk][bn] = b.x; Bs[bk][bn + 1] = b.y; Bs[bk][bn + 2] = b.z; Bs[bk][bn + 3] = b.w;
            if (MODE == 1) { const f32x4 b2 = *(const f32x4*)(W + (size_t)(k0 + bk) * g.ldw + DF + n0 + bn);
                Bs2[bk][bn] = b2.x; Bs2[bk][bn + 1] = b2.y; Bs2[bk][bn + 2] = b2.z; Bs2[bk][bn + 3] = b2.w; }
        }
        __syncthreads();
#pragma unroll
        for (int kk = 0; kk < 16; ++kk) {
            float a[4], b[4], b2[4];
#pragma unroll
            for (int i = 0; i < 4; ++i) a[i] = As[kk][ty * 4 + i];
#pragma unroll
            for (int j = 0; j < 4; ++j) { b[j] = Bs[kk][tx * 4 + j]; if (MODE == 1) b2[j] = Bs2[kk][tx * 4 + j]; }
#pragma unroll
            for (int i = 0; i < 4; ++i)
#pragma unroll
                for (int j = 0; j < 4; ++j) { acc[i][j] += a[i] * b[j]; if (MODE == 1) acc2[i][j] += a[i] * b2[j]; }
        }
        __syncthreads();
    }
#pragma unroll
    for (int i = 0; i < 4; ++i) {
        const int m = m0 + ty * 4 + i; if (m >= M) continue;
        const int n = n0 + tx * 4;
        float o[4];
        if (MODE == 0) {
#pragma unroll
            for (int j = 0; j < 4; ++j) o[j] = acc[i][j];
        } else if (MODE == 1) {
#pragma unroll
            for (int j = 0; j < 4; ++j) {
                const float gl = fminf(acc[i][j] + bias[n + j], 7.0f);
                const float li = fminf(fmaxf(acc2[i][j] + bias[DF + n + j], -7.0f), 7.0f);
                o[j] = gl * sigmoidf_(1.702f * gl) * (li + 1.0f);
            }
        } else {
            const float gt = g.rowgate[(size_t)e * TT + m];
#pragma unroll
            for (int j = 0; j < 4; ++j) o[j] = (acc[i][j] + bias[n + j]) * gt;
        }
        u32x2 w; w.x = pk2(o[0], o[1]); w.y = pk2(o[2], o[3]);
        *(u32x2*)(g.C + (size_t)((MODE == 0 ? 0 : off) + m) * g.ldc + n) = w;
    }
}

__device__ __forceinline__ void tok_seq(int tok, int& base, int& len, int& t) {
    if (tok < TL) { base = tok & ~(SEQ - 1); len = SEQ; t = tok & (SEQ - 1); }
    else { const int q = tok - TL; base = TL + (q & ~(CTXL - 1)); len = CTXL; t = q & (CTXL - 1); }
}
__global__ void __launch_bounds__(256) k_conv(P p) {
    const int l = p.l;
    const bf16* Z = (const bf16*)(p.ws + WS_Z); float* U = (float*)(p.ws + WS_U);
    const float* cw = p.in[I_CONVW] + (size_t)l * 4 * DLRU; const float* cb = p.in[I_CONVB] + (size_t)l * DLRU;
    const size_t i = (size_t)blockIdx.x * 256 + threadIdx.x;
    if (i >= (size_t)TT * DLRU) return;
    const int tok = (int)(i / DLRU), ch = (int)(i % DLRU);
    int base, len, t; tok_seq(tok, base, len, t);
    float y = cb[ch];
#pragma unroll
    for (int k = 0; k < 4; ++k) { const int tt = t + k - 2; if (tt >= 0 && tt < len) y += bf2f(Z[(size_t)(base + tt) * DIN + ch]) * cw[k * DLRU + ch]; }
    U[i] = y;
}
__device__ __forceinline__ float softplusf_(float x) { return x > 20.f ? x : log1pf(expf(x)); }
__global__ void __launch_bounds__(256) k_gates(P p) {
    const int l = p.l;
    const float* U = (const float*)(p.ws + WS_U);
    float* AA = (float*)(p.ws + WS_AA); float* BB = (float*)(p.ws + WS_BB);
    const size_t i = (size_t)blockIdx.x * 256 + threadIdx.x;
    if (i >= (size_t)TT * DLRU) return;
    const int tok = (int)(i / DLRU), ch = (int)(i % DLRU), h = ch / HD, j = ch % HD;
    const float* ur = U + (size_t)tok * DLRU + h * HD;
    const float u = U[i];
#pragma unroll
    for (int d = 0; d < 2; ++d) {
        const float* wa = p.in[I_GAW] + ((size_t)(l * 2 + d) * NH + h) * HD * HD + j;
        const float* wx = p.in[I_GXW] + ((size_t)(l * 2 + d) * NH + h) * HD * HD + j;
        float pr = p.in[I_GAB][(size_t)(l * 2 + d) * DLRU + ch], pi = p.in[I_GXB][(size_t)(l * 2 + d) * DLRU + ch];
        for (int q = 0; q < HD; ++q) { const float uv = ur[q]; pr += uv * wa[q * HD]; pi += uv * wx[q * HD]; }
        const float r = 1.0f / (1.0f + expf(-pr)), ig = 1.0f / (1.0f + expf(-pi));
        const float lam = p.in[I_LAM][(size_t)(l * 2 + d) * DLRU + ch];
        const float la = -8.0f * r * softplusf_(-lam);
        const float a = expf(la);
        const float bt = sqrtf(-expm1f(2.0f * la)) * (ig * u);
        AA[(size_t)d * TT * DLRU + i] = a; BB[(size_t)d * TT * DLRU + i] = bt;
    }
}
__global__ void __launch_bounds__(256) k_scan(P p) {
    const float* AA = (const float*)(p.ws + WS_AA); const float* BB = (const float*)(p.ws + WS_BB);
    float* HS = (float*)(p.ws + WS_HS);
    const int i = blockIdx.x * 256 + threadIdx.x;
    if (i >= NB * DLRU) return;
    const int b = i / DLRU, ch = i % DLRU;
    const size_t cbase = (size_t)(TL + b * CTXL) * DLRU + ch, lbase = (size_t)(b * SEQ) * DLRU + ch;
    float h = 0.f;
    for (int t = 0; t < CTXL; ++t) { const size_t o = cbase + (size_t)t * DLRU; h = AA[o] * h + BB[o]; HS[o] = h; }
    for (int t = 0; t < SEQ; ++t) { const size_t o = lbase + (size_t)t * DLRU; h = AA[o] * h + BB[o]; HS[o] = h; }
    const float* A1 = AA + (size_t)TT * DLRU; const float* B1 = BB + (size_t)TT * DLRU;
    h = 0.f;
    for (int t = CTXL - 1; t >= 0; --t) { const size_t o = cbase + (size_t)t * DLRU; h = A1[o] * h + B1[o]; HS[o] += h; }
    for (int t = SEQ - 1; t >= 0; --t) { const size_t o = lbase + (size_t)t * DLRU; h = A1[o] * h + B1[o]; HS[o] += h; }
}
__global__ void __launch_bounds__(256) k_mix(P p) {
    const bf16* Z = (const bf16*)(p.ws + WS_Z); const float* HS = (const float*)(p.ws + WS_HS); bf16* MIX = (bf16*)(p.ws + WS_MIX);
    const size_t i = (size_t)blockIdx.x * 256 + threadIdx.x;
    if (i >= (size_t)TT * DLRU) return;
    const int tok = (int)(i / DLRU), ch = (int)(i % DLRU);
    const float y = bf2f(Z[(size_t)tok * DIN + DLRU + ch]);
    MIX[(size_t)tok * D + ch] = (bf16)f2bf(HS[i] * gelu_tanh(y));
}
__global__ void __launch_bounds__(256) k_poold(P p) {
    const bf16* Z = (const bf16*)(p.ws + WS_Z); float* DD = (float*)(p.ws + WS_DD);
    const size_t i = (size_t)blockIdx.x * 256 + threadIdx.x;
    if (i >= (size_t)TT * DPOOL) return;
    const int tok = (int)(i / DPOOL), ch = (int)(i % DPOOL), g = ch / 128;
    int base, len, t; tok_seq(tok, base, len, t);
    const int win = 2 << g;
    int seg_lo = 0, seg_hi = len;
    if (tok < TL) { seg_lo = (t / GRIDW) * GRIDW; seg_hi = seg_lo + GRIDW; }
    int lo = t - win / 2; if (lo < seg_lo) lo = seg_lo;
    int hi = t + win / 2; if (hi > seg_hi) hi = seg_hi;
    float s = 0.f;
    for (int q = lo; q < hi; ++q) s += bf2f(Z[(size_t)(base + q) * DIN + 2 * DLRU + ch]);
    DD[i] = s / (float)(hi - lo) - bf2f(Z[(size_t)tok * DIN + 2 * DLRU + ch]);
}
__global__ void __launch_bounds__(256) k_poolmm(P p) {
    const int l = p.l;
    const float* DD = (const float*)(p.ws + WS_DD); bf16* MIX = (bf16*)(p.ws + WS_MIX);
    const size_t i = (size_t)blockIdx.x * 256 + threadIdx.x;
    if (i >= (size_t)TT * DPOOL) return;
    const int tok = (int)(i / DPOOL), ch = (int)(i % DPOOL), g = ch / 128, j = ch % 128;
    const float* w = p.in[I_POOLW] + ((size_t)l * 4 + g) * 128 * 128 + j;
    const float* d = DD + (size_t)tok * DPOOL + g * 128;
    float s = 0.f;
    for (int q = 0; q < 128; ++q) s += d[q] * w[q * 128];
    s = (s + p.in[I_POOLB][(size_t)l * DPOOL + ch]) * p.in[I_POOLS][(size_t)l * DPOOL + ch];
    MIX[(size_t)tok * D + DLRU + ch] = (bf16)f2bf(s);
}

__global__ void __launch_bounds__(512) k_ln1(P p) {
    const int l = p.l;
    const int lane = threadIdx.x & 63, gw = blockIdx.x * 8 + (threadIdx.x >> 6), ngw = gridDim.x * 8;
    const float* MOD = (const float*)(p.ws + WS_MOD) + (size_t)l * 9 * 6144;
    float* XL = (float*)(p.ws + WS_XL); bf16* H = (bf16*)(p.ws + WS_H); const bf16* Y1 = (const bf16*)(p.ws + WS_Y1);
    const float* lg = p.in[I_LN1G] + (size_t)l * D; const float* lb = p.in[I_LN1B] + (size_t)l * D;
    const float* rw = p.in[I_RW] + (size_t)l * D * NE; const float* rb = p.in[I_RB] + (size_t)l * NE;
    int* cnt = (int*)(p.ws + WS_CTL) + CW_CNT + 32 * l;
    int* TOPE = (int*)(p.ws + WS_TOPE); int* SLOT = (int*)(p.ws + WS_SLOT);
    int* ROWTOK = (int*)(p.ws + WS_ROWTOK); float* ROWGATE = (float*)(p.ws + WS_ROWGATE);
    const int ntok = (l == DEPTH - 1) ? TL : TT;
    for (int tok = gw; tok < ntok; tok += ngw) {
        const float* m = MOD + (size_t)mod_row(tok) * 6144;
        f32x4 v[4], h[4];
#pragma unroll
        for (int j = 0; j < 4; ++j) {
            const f32x4 x = ((const f32x4*)(XL + (size_t)tok * D))[lane + 64 * j];
            const u32x2 yr = ((const u32x2*)(Y1 + (size_t)tok * D))[lane + 64 * j];
            const f32x4 g1 = ((const f32x4*)(m + 2048))[lane + 64 * j];
            f32x4 y; y.x = __uint_as_float(yr.x << 16); y.y = __uint_as_float(yr.x & 0xffff0000u); y.z = __uint_as_float(yr.y << 16); y.w = __uint_as_float(yr.y & 0xffff0000u);
            v[j] = x * ALPHA + g1 * y;
        }
        float mean, rstd; ln_stats(v, mean, rstd);
#pragma unroll
        for (int j = 0; j < 4; ++j) {
            const f32x4 gg = ((const f32x4*)lg)[lane + 64 * j], bb = ((const f32x4*)lb)[lane + 64 * j];
            v[j] = (v[j] - mean) * rstd * gg + bb;
            ((f32x4*)(XL + (size_t)tok * D))[lane + 64 * j] = v[j];
            const f32x4 sh = ((const f32x4*)(m + 3072))[lane + 64 * j], sc = ((const f32x4*)(m + 4096))[lane + 64 * j];
            h[j] = v[j] * (sc + 1.0f) + sh;
        }
        store_bf16_row(H + (size_t)tok * D, lane, h);
        float acc[32];
#pragma unroll
        for (int e = 0; e < 32; ++e) acc[e] = 0.f;
#pragma unroll
        for (int j = 0; j < 4; ++j)
#pragma unroll
            for (int i = 0; i < 4; ++i) {
                const int k = 4 * lane + 256 * j + i; const float hv = h[j][i];
                const f32x4* wr = (const f32x4*)(rw + (size_t)k * NE);
#pragma unroll
                for (int q = 0; q < 8; ++q) { const f32x4 w = wr[q]; acc[4 * q] += hv * w.x; acc[4 * q + 1] += hv * w.y; acc[4 * q + 2] += hv * w.z; acc[4 * q + 3] += hv * w.w; }
            }
        float mylogit = 0.f;
#pragma unroll
        for (int e = 0; e < 32; ++e) { const float s = wave_sum(acc[e]); if ((lane & 31) == e) mylogit = s; }
        mylogit += rb[lane & 31];
        float tv[4]; int ti[4];
        float cur = mylogit;
#pragma unroll
        for (int k = 0; k < 4; ++k) {
            float bv = cur; int bi = lane & 31;
#pragma unroll
            for (int o = 1; o < 32; o <<= 1) { const float ov = __shfl_xor(bv, o); const int oi = __shfl_xor(bi, o); if (ov > bv || (ov == bv && oi < bi)) { bv = ov; bi = oi; } }
            tv[k] = bv; ti[k] = bi;
            if ((lane & 31) == bi) cur = -INFINITY;
        }
        const float e1 = __expf(tv[1] - tv[0]), e2 = __expf(tv[2] - tv[0]), e3 = __expf(tv[3] - tv[0]);
        const float inv = 1.0f / (1.0f + e1 + e2 + e3);
        if (lane < 4) {
            const int e = lane == 0 ? ti[0] : lane == 1 ? ti[1] : lane == 2 ? ti[2] : ti[3];
            const float pg = (lane == 0 ? 1.0f : lane == 1 ? e1 : lane == 2 ? e2 : e3) * inv;
            const int slot = atomicAdd(&cnt[e], 1);
            ROWTOK[(size_t)e * TT + slot] = tok; ROWGATE[(size_t)e * TT + slot] = pg;
            TOPE[tok * 4 + lane] = e; SLOT[tok * 4 + lane] = slot;
        }
    }
}

__global__ void __launch_bounds__(512) k_ln2(P p) {
    const int l = p.l;
    const int lane = threadIdx.x & 63, gw = blockIdx.x * 8 + (threadIdx.x >> 6), ngw = gridDim.x * 8;
    const float* MOD = (const float*)(p.ws + WS_MOD) + (size_t)l * 9 * 6144;
    float* XL = (float*)(p.ws + WS_XL); bf16* H = (bf16*)(p.ws + WS_H); const bf16* Y2 = (const bf16*)(p.ws + WS_Y2);
    const float* lg = p.in[I_LN2G] + (size_t)l * D; const float* lb = p.in[I_LN2B] + (size_t)l * D;
    const int* cnt = (const int*)(p.ws + WS_CTL) + CW_CNT + 32 * l;
    const int* TOPE = (const int*)(p.ws + WS_TOPE); const int* SLOT = (const int*)(p.ws + WS_SLOT);
    int offl;
    { const int c = lane < 32 ? pad256(cnt[lane]) : 0; int s = c;
#pragma unroll
      for (int o = 1; o < 32; o <<= 1) { const int t = __shfl_up(s, o); if ((lane & 31) >= o) s += t; }
      offl = s - c; }
    const bool last = (l == DEPTH - 1);
    const int ntok = last ? TL : TT;
    for (int tok = gw; tok < ntok; tok += ngw) {
        const float* m = MOD + (size_t)mod_row(tok) * 6144;
        f32x4 f[4];
#pragma unroll
        for (int j = 0; j < 4; ++j) f[j] = (f32x4){0.f, 0.f, 0.f, 0.f};
#pragma unroll
        for (int k = 0; k < 4; ++k) {
            const int e = TOPE[tok * 4 + k], slot = SLOT[tok * 4 + k];
            const int row = __shfl(offl, e) + slot;
            const u32x2* yr = (const u32x2*)(Y2 + (size_t)row * D);
#pragma unroll
            for (int j = 0; j < 4; ++j) { const u32x2 r = yr[lane + 64 * j];
                f[j].x += __uint_as_float(r.x << 16); f[j].y += __uint_as_float(r.x & 0xffff0000u); f[j].z += __uint_as_float(r.y << 16); f[j].w += __uint_as_float(r.y & 0xffff0000u); }
        }
        f32x4 v[4];
#pragma unroll
        for (int j = 0; j < 4; ++j) {
            const f32x4 x = ((const f32x4*)(XL + (size_t)tok * D))[lane + 64 * j];
            const f32x4 g2 = ((const f32x4*)(m + 5120))[lane + 64 * j];
            v[j] = x * ALPHA + g2 * f[j];
        }
        float mean, rstd; ln_stats(v, mean, rstd);
        f32x4 h[4];
        const float* mn = MOD + (size_t)9 * 6144 + (size_t)mod_row(tok) * 6144;
#pragma unroll
        for (int j = 0; j < 4; ++j) {
            const f32x4 gg = ((const f32x4*)lg)[lane + 64 * j], bb = ((const f32x4*)lb)[lane + 64 * j];
            v[j] = (v[j] - mean) * rstd * gg + bb;
            if (last) ((f32x4*)(p.out + (size_t)tok * D))[lane + 64 * j] = v[j];
            else {
                ((f32x4*)(XL + (size_t)tok * D))[lane + 64 * j] = v[j];
                const f32x4 sh = ((const f32x4*)mn)[lane + 64 * j], sc = ((const f32x4*)(mn + 1024))[lane + 64 * j];
                h[j] = v[j] * (sc + 1.0f) + sh;
            }
        }
        if (!last) store_bf16_row(H + (size_t)tok * D, lane, h);
    }
}

extern "C" void kernel_launch(void* const* d_in, const int* in_sizes, int n_in, void* d_out, int out_size, void* d_ws, size_t ws_size, hipStream_t stream) {
    if (n_in != N_IN || ws_size < WS_END || out_size != TL * D) { fprintf(stderr, "kernel_launch: unexpected shapes (n_in %d, out %d, ws %zu)\n", n_in, out_size, ws_size); return; }
    hipMemsetAsync((char*)d_ws + WS_CTL, 0, CTL_BYTES, stream);
    P p{};
    for (int i = 0; i < N_IN; ++i) p.in[i] = (const float*)d_in[i];
    p.out = (float*)d_out; p.ws = (unsigned char*)d_ws; p.l = 0; p.pad = 0;
    unsigned char* ws = (unsigned char*)d_ws;
    hipLaunchKernelGGL(k_pos, dim3(128), dim3(256), 0, stream, p);
    hipLaunchKernelGGL(k_mod, dim3(384), dim3(512), 0, stream, p);
    hipLaunchKernelGGL(k_entry, dim3(1024), dim3(512), 0, stream, p);
    const int nel = (TT * DLRU + 255) / 256;
    for (int l = 0; l < DEPTH; ++l) {
        p.l = l;
        const int* cnt = (const int*)(ws + WS_CTL) + CW_CNT + 32 * l;
        { NG g{}; g.A = (const bf16*)(ws + WS_H); g.W = p.in[I_WIN] + (size_t)l * D * DIN; g.C = (bf16*)(ws + WS_Z); g.lda = D; g.ldw = DIN; g.ldc = DIN; g.M = TT; g.N = DIN; g.K = D;
          hipLaunchKernelGGL(k_gemm_naive<0>, dim3(DIN / 64, TT / 64, 1), dim3(256), 0, stream, g); }
        hipLaunchKernelGGL(k_conv, dim3(nel), dim3(256), 0, stream, p);
        hipLaunchKernelGGL(k_gates, dim3(nel), dim3(256), 0, stream, p);
        hipLaunchKernelGGL(k_scan, dim3(NB * DLRU / 256), dim3(256), 0, stream, p);
        hipLaunchKernelGGL(k_mix, dim3(nel), dim3(256), 0, stream, p);
        hipLaunchKernelGGL(k_poold, dim3(nel), dim3(256), 0, stream, p);
        hipLaunchKernelGGL(k_poolmm, dim3(nel), dim3(256), 0, stream, p);
        { NG g{}; g.A = (const bf16*)(ws + WS_MIX); g.W = p.in[I_WOUT] + (size_t)l * D * D; g.C = (bf16*)(ws + WS_Y1); g.lda = D; g.ldw = D; g.ldc = D; g.M = TT; g.N = D; g.K = D;
          hipLaunchKernelGGL(k_gemm_naive<0>, dim3(D / 64, TT / 64, 1), dim3(256), 0, stream, g); }
        hipLaunchKernelGGL(k_ln1, dim3(1024), dim3(512), 0, stream, p);
        { NG g{}; g.A = (const bf16*)(ws + WS_H); g.W = p.in[I_W1] + (size_t)l * NE * D * 2 * DF; g.bias = p.in[I_B1] + (size_t)l * NE * 2 * DF; g.C = (bf16*)(ws + WS_ACT);
          g.cnt = cnt; g.rowtok = (const int*)(ws + WS_ROWTOK); g.rowgate = (const float*)(ws + WS_ROWGATE); g.lda = D; g.ldw = 2 * DF; g.ldc = DF; g.M = 0; g.N = DF; g.K = D;
          hipLaunchKernelGGL(k_gemm_naive<1>, dim3(DF / 64, TT / 64, NE), dim3(256), 0, stream, g); }
        { NG g{}; g.A = (const bf16*)(ws + WS_ACT); g.W = p.in[I_W2] + (size_t)l * NE * DF * D; g.bias = p.in[I_B2] + (size_t)l * NE * D; g.C = (bf16*)(ws + WS_Y2);
          g.cnt = cnt; g.rowtok = (const int*)(ws + WS_ROWTOK); g.rowgate = (const float*)(ws + WS_ROWGATE); g.lda = DF; g.ldw = D; g.ldc = D; g.M = 0; g.N = D; g.K = DF;
          hipLaunchKernelGGL(k_gemm_naive<2>, dim3(D / 64, TT / 64, NE), dim3(256), 0, stream, g); }
        hipLaunchKernelGGL(k_ln2, dim3(1024), dim3(512), 0, stream, p);
    }
}
```

```cpp
#include <hip/hip_runtime.h>
#include <cstdio>
#include <cstdint>

constexpr int NB = 8, SEQ = 2048, D = 1024, CTXL = 256, DEPTH = 2;
constexpr int TL = NB * SEQ;
constexpr int TC = NB * CTXL;
constexpr int TT = TL + TC;
constexpr int DLRU = 512, DPOOL = 512, DIN = 1536, NH = 8, HD = 64;
constexpr int NE = 32, TOPK = 4, DF = 1024;
constexpr int GRIDW = 64;
constexpr float LN_EPS = 1e-5f;
constexpr float ALPHA = 1.41421356237309515f;
constexpr int MAXROWS = 81920;

enum { I_X = 0, I_C, I_CTX, I_CCTX, I_WMOD, I_BMOD, I_WIN, I_CONVW, I_CONVB, I_GAW, I_GAB, I_GXW, I_GXB, I_LAM, I_POOLW, I_POOLB, I_POOLS,
       I_WOUT, I_LN1G, I_LN1B, I_RW, I_RB, I_W1, I_B1, I_W2, I_B2, I_LN2G, I_LN2B, N_IN };

constexpr size_t MiB = 1u << 20;
constexpr size_t WS_CTL = 0, CTL_BYTES = 1 * MiB;
constexpr size_t WS_MOD = 1 * MiB;
constexpr size_t WS_POS = 2 * MiB;
constexpr size_t WS_TOPE = 3 * MiB;
constexpr size_t WS_SLOT = 3 * MiB + 512 * 1024;
constexpr size_t WS_ROWTOK = 4 * MiB;
constexpr size_t WS_ROWGATE = 7 * MiB;
constexpr size_t WS_AGG = 10 * MiB;
constexpr size_t WS_WIN = 16 * MiB, WS_WOUT = 23 * MiB, WS_WG = 28 * MiB, WS_WP = 29 * MiB;
constexpr size_t WS_W1T = 32 * MiB, WS_W2T = 288 * MiB;
constexpr size_t WS_XL = 416 * MiB;
constexpr size_t WS_H = 488 * MiB;
constexpr size_t WS_Z = 524 * MiB;
constexpr size_t WS_MIX = 578 * MiB;
constexpr size_t WS_Y1 = 614 * MiB;
constexpr size_t WS_ACT = 650 * MiB;
constexpr size_t WS_Y2 = 810 * MiB;
constexpr size_t WS_U = 970 * MiB;
constexpr size_t WS_AA = 1006 * MiB;
constexpr size_t WS_BB = 1078 * MiB;
constexpr size_t WS_HS = 1150 * MiB;
constexpr size_t WS_DD = 1186 * MiB;
constexpr size_t WS_END = 1222 * MiB;
constexpr int CW_CNT = 64;

typedef unsigned short bf16;
typedef float f32x4 __attribute__((ext_vector_type(4)));
typedef unsigned u32x2 __attribute__((ext_vector_type(2)));
typedef unsigned u32x4 __attribute__((ext_vector_type(4)));

__device__ __forceinline__ float bf2f(bf16 v) { return __uint_as_float(((unsigned)v) << 16); }
__device__ __forceinline__ unsigned f2bf(float f) { unsigned u = __float_as_uint(f); return (u + 0x7fffu + ((u >> 16) & 1u)) >> 16; }
__device__ __forceinline__ unsigned pk2(float lo, float hi) { return f2bf(lo) | (f2bf(hi) << 16); }
__device__ __forceinline__ float wave_sum(float v) {
#pragma unroll
    for (int o = 1; o < 64; o <<= 1) v += __shfl_xor(v, o);
    return v;
}
__device__ __forceinline__ float sigmoidf_(float x) { return 1.0f / (1.0f + __expf(-x)); }
__device__ __forceinline__ float gelu_tanh(float x) {
    const float u = 0.7978845608028654f * (x + 0.044715f * x * x * x);
    const float t = 1.0f - 2.0f / (__expf(2.0f * u) + 1.0f);
    return 0.5f * x * (1.0f + t);
}

struct P {
    const float* in[N_IN];
    float* out;
    unsigned char* ws;
    int l;
    int pad;
};

__device__ __forceinline__ int mod_row(int tok) { return tok < TL ? (tok >> 11) : NB; }

__global__ void __launch_bounds__(256) k_pos(P p) {
    float* POS = (float*)(p.ws + WS_POS);
    const int i = blockIdx.x * 256 + threadIdx.x;
    if (i >= 64 * 512) return;
    const int n = i / 512, j = i % 512, q = j % 256;
    const float omega = 1.0f / powf(10000.0f, (float)q / 256.0f);
    const float ang = (float)n * omega;
    POS[i] = j < 256 ? sinf(ang) : cosf(ang);
}

__global__ void __launch_bounds__(512) k_mod(P p) {
    __shared__ float sl[9 * 1024];
    __shared__ float part[16][9][32];
    const int tid = threadIdx.x;
    const float* c = p.in[I_C]; const float* cc = p.in[I_CCTX];
    for (int i = tid; i < 9 * 1024; i += 512) { const float v = i < 8192 ? c[i] : cc[i - 8192]; sl[i] = v / (1.0f + __expf(-v)); }
    __syncthreads();
    float* MOD = (float*)(p.ws + WS_MOD);
    for (int u = blockIdx.x; u < 2 * 192; u += gridDim.x) {
        const int l = u / 192, n0 = (u % 192) * 32;
        const float* W = p.in[I_WMOD] + (size_t)l * 1024 * 6144;
        const int col = tid & 31, ks = tid >> 5;
        float acc[9];
#pragma unroll
        for (int r = 0; r < 9; ++r) acc[r] = 0.f;
#pragma unroll 8
        for (int kk = 0; kk < 64; ++kk) {
            const int k = ks * 64 + kk;
            const float w = W[(size_t)k * 6144 + n0 + col];
#pragma unroll
            for (int r = 0; r < 9; ++r) acc[r] += sl[r * 1024 + k] * w;
        }
#pragma unroll
        for (int r = 0; r < 9; ++r) part[ks][r][col] = acc[r];
        __syncthreads();
        if (tid < 9 * 32) {
            const int r = tid / 32, cl = tid % 32; float s = 0.f;
#pragma unroll
            for (int q = 0; q < 16; ++q) s += part[q][r][cl];
            MOD[((size_t)l * 9 + r) * 6144 + n0 + cl] = s + p.in[I_BMOD][(size_t)l * 6144 + n0 + cl];
        }
        __syncthreads();
    }
}

__device__ __forceinline__ void ln_stats(const f32x4 (&v)[4], float& mean, float& rstd) {
    float s = 0.f;
#pragma unroll
    for (int j = 0; j < 4; ++j) s += (v[j].x + v[j].y) + (v[j].z + v[j].w);
    mean = wave_sum(s) * (1.f / D);
    float s2 = 0.f;
#pragma unroll
    for (int j = 0; j < 4; ++j) { const f32x4 d = v[j] - mean; s2 += (d.x * d.x + d.y * d.y) + (d.z * d.z + d.w * d.w); }
    rstd = 1.0f / sqrtf(wave_sum(s2) * (1.f / D) + LN_EPS);
}
__device__ __forceinline__ void store_bf16_row(bf16* row, int lane, const f32x4 (&h)[4]) {
    u32x2* o = (u32x2*)row + lane;
#pragma unroll
    for (int j = 0; j < 4; ++j) { u32x2 w; w.x = pk2(h[j].x, h[j].y); w.y = pk2(h[j].z, h[j].w); o[64 * j] = w; }
}

__global__ void __launch_bounds__(512) k_entry(P p) {
    const int lane = threadIdx.x & 63, gw = blockIdx.x * 8 + (threadIdx.x >> 6), ngw = gridDim.x * 8;
    const float* POS = (const float*)(p.ws + WS_POS);
    const float* MOD = (const float*)(p.ws + WS_MOD);
    float* XL = (float*)(p.ws + WS_XL); bf16* H = (bf16*)(p.ws + WS_H);
    for (int tok = gw; tok < TT; tok += ngw) {
        const float* src = tok < TL ? p.in[I_X] + (size_t)tok * D : p.in[I_CTX] + (size_t)(tok - TL) * D;
        f32x4 v[4];
#pragma unroll
        for (int j = 0; j < 4; ++j) v[j] = ((const f32x4*)src)[lane + 64 * j];
        if (tok < TL) {
            const int s = tok & (SEQ - 1), pr = s / GRIDW, pc = s % GRIDW;
#pragma unroll
            for (int j = 0; j < 4; ++j) {
                const float* ps = POS + (size_t)(j < 2 ? pr : pc) * 512 + (4 * lane + 256 * (j & 1));
                v[j] += *(const f32x4*)ps;
            }
        }
        float mean, rstd; ln_stats(v, mean, rstd);
        const float* m = MOD + (size_t)mod_row(tok) * 6144;
        f32x4 h[4];
#pragma unroll
        for (int j = 0; j < 4; ++j) {
            v[j] = (v[j] - mean) * rstd;
            ((f32x4*)(XL + (size_t)tok * D))[lane + 64 * j] = v[j];
            const f32x4 sh = ((const f32x4*)m)[lane + 64 * j], sc = ((const f32x4*)(m + 1024))[lane + 64 * j];
            h[j] = v[j] * (sc + 1.0f) + sh;
        }
        store_bf16_row(H + (size_t)tok * D, lane, h);
    }
}

__device__ __forceinline__ int pad256(int c) { return (c + 255) & ~255; }

#define LAS __attribute__((address_space(3)))
__device__ __forceinline__ void transpose_tile(const float* src, int N, bf16* dst, int Kp, LAS float* scr, int lane) {
    f32x4 v[16];
#pragma unroll
    for (int i = 0; i < 16; ++i) { const int k = 4 * i + (lane >> 4); v[i] = *(const f32x4*)(src + (size_t)k * N + 4 * (lane & 15)); }
#pragma unroll
    for (int i = 0; i < 16; ++i) { const int k = 4 * i + (lane >> 4); const int nn = (4 * (lane & 15)) ^ (((k >> 3) & 3) << 3); *(LAS f32x4*)(scr + k * 64 + nn) = v[i]; }
    asm volatile("s_waitcnt lgkmcnt(0)" ::: "memory");
    const int c = lane & 7, sw = (c & 3) << 3;
#pragma unroll
    for (int j = 0; j < 8; ++j) {
        const int n = (lane >> 3) + 8 * j;
        const LAS float* s = scr + (8 * c) * 64 + (n ^ sw);
        u32x4 o; o.x = pk2(s[0], s[64]); o.y = pk2(s[128], s[192]); o.z = pk2(s[256], s[320]); o.w = pk2(s[384], s[448]);
        *(u32x4*)(dst + (size_t)n * Kp + 8 * c) = o;
    }
    asm volatile("s_waitcnt lgkmcnt(0)" ::: "memory");
}
__device__ __forceinline__ void convert_weights(const P& p, LAS unsigned char* lds, int gw, int ngw, int wave, int lane) {
    LAS float* scr = (LAS float*)(lds + wave * 16384);
    bf16* WINT = (bf16*)(p.ws + WS_WIN); bf16* WOUTT = (bf16*)(p.ws + WS_WOUT); bf16* W1T = (bf16*)(p.ws + WS_W1T); bf16* W2T = (bf16*)(p.ws + WS_W2T);
    bf16* WGT = (bf16*)(p.ws + WS_WG); bf16* WPT = (bf16*)(p.ws + WS_WP);
    constexpr int I_IN = DEPTH * 16 * 24, I_OUT = DEPTH * 16 * 16, I_G = DEPTH * 2 * 2 * NH, I_P = DEPTH * 4 * 4, I_1 = DEPTH * NE * 16 * 32, I_2 = DEPTH * NE * 16 * 16;
    constexpr int NITEMS = I_IN + I_OUT + I_G + I_P + I_1 + I_2;
    for (int it = gw; it < NITEMS; it += ngw) {
        int r = it;
        if (r < I_IN) { const int l = r / 384, q = r % 384, kb = q / 24, nb = q % 24;
            transpose_tile(p.in[I_WIN] + (size_t)l * D * DIN + (size_t)(64 * kb) * DIN + 64 * nb, DIN, WINT + ((size_t)l * DIN + 64 * nb) * D + 64 * kb, D, scr, lane); continue; }
        r -= I_IN;
        if (r < I_OUT) { const int l = r / 256, q = r % 256, kb = q / 16, nb = q % 16;
            transpose_tile(p.in[I_WOUT] + (size_t)l * D * D + (size_t)(64 * kb) * D + 64 * nb, D, WOUTT + ((size_t)l * D + 64 * nb) * D + 64 * kb, D, scr, lane); continue; }
        r -= I_OUT;
        if (r < I_G) {
            const int h = r % NH, gt = (r / NH) % 2, d = (r / (NH * 2)) % 2, l = r / (NH * 4);
            const float* s = (gt ? p.in[I_GXW] : p.in[I_GAW]) + ((size_t)(l * 2 + d) * NH + h) * HD * HD;
            transpose_tile(s, HD, WGT + ((size_t)(l * NH + h) * 256 + (d * 2 + gt) * 64) * HD, HD, scr, lane); continue; }
        r -= I_G;
        if (r < I_P) {
            const int nb = r % 2, kb = (r / 2) % 2, lg = r / 4;
            transpose_tile(p.in[I_POOLW] + (size_t)lg * 128 * 128 + (size_t)(64 * kb) * 128 + 64 * nb, 128, WPT + ((size_t)lg * 128 + 64 * nb) * 128 + 64 * kb, 128, scr, lane); continue; }
        r -= I_P;
        if (r < I_1) {
            const int le = r / 512, q = r % 512, kb = q / 32, nb = q % 32;
            const int n0 = 64 * nb, j0 = n0 % DF, half = n0 / DF, row0 = (j0 / 128) * 256 + half * 128 + (j0 % 128);
            transpose_tile(p.in[I_W1] + (size_t)le * D * 2 * DF + (size_t)(64 * kb) * (2 * DF) + n0, 2 * DF, W1T + ((size_t)le * 2 * DF + row0) * D + 64 * kb, D, scr, lane); continue; }
        r -= I_1;
        { const int le = r / 256, q = r % 256, kb = q / 16, nb = q % 16;
          transpose_tile(p.in[I_W2] + (size_t)le * DF * D + (size_t)(64 * kb) * D + 64 * nb, D, W2T + ((size_t)le * D + 64 * nb) * DF + 64 * kb, DF, scr, lane); }
    }
}
__global__ void __launch_bounds__(512, 2) k_convert(P p) {
    extern __shared__ __attribute__((aligned(16))) unsigned char lds[];
    const int wave = threadIdx.x >> 6, lane = threadIdx.x & 63;
    convert_weights(p, (LAS unsigned char*)lds, blockIdx.x * 8 + wave, gridDim.x * 8, wave, lane);
}

namespace pg8 {
typedef short bf16x8 __attribute__((ext_vector_type(8)));
constexpr int BM = 256, BK = 64, HALF = 128, HTB = HALF * BK * 2, STAGE_BYTES = 8 * HTB;
__host__ __device__ __forceinline__ int lds_byte(int r, int c) { const int st = (r >> 4) * 2 + (c >> 5), rr = r & 15, cc = c & 31, ob = rr * 64 + cc * 2; return st * 1024 + (ob ^ (((ob >> 9) & 1) << 5)); }
__host__ __device__ __forceinline__ void stage_rc(int b, int& R, int& C) { const int st = b / 1024, sb = b % 1024, swz = sb ^ (((sb >> 9) & 1) << 5); R = (st >> 1) * 16 + swz / 64; C = (st & 1) * 32 + (swz % 64) / 2; }
__host__ __device__ __forceinline__ int perm32(int rho) { const int n = rho >> 4, i = rho & 15; return 8 * (i >> 2) + 4 * n + (i & 3); }
__device__ __forceinline__ unsigned cvt_pk_bf16(float lo, float hi) { unsigned r; asm volatile("v_cvt_pk_bf16_f32 %0, %1, %2" : "=v"(r) : "v"(lo), "v"(hi)); return r; }

struct Unit { int a0, nvalid, b0, o0, pn, e, g0; };

template <bool GATHER, class Sched, class Epi>
__device__ __forceinline__ void gemm_phase(LAS unsigned char* lds, const bf16* Abase_, const bf16* Bt_, const int* glist, const Sched& S, const Epi& E) {
    constexpr int K = 1024, nt = K / BK;
    const int tid = threadIdx.x, wid = __builtin_amdgcn_readfirstlane(tid >> 6), lane = tid & 63, wr = wid >> 2, wc = wid & 3, fr = lane & 15, fq = lane >> 4;
    int Rr[2], Cc[2]; unsigned voffB[2];
#pragma unroll
    for (int i = 0; i < 2; ++i) { int R, C; stage_rc(tid * 16 + i * 8192, R, C); Rr[i] = R; Cc[i] = C; const int Rb = (R & ~31) + perm32(R & 31); voffB[i] = (unsigned)(Rb * K + C) * 2u; }
    constexpr size_t kstep = (size_t)(BK * 2);
    constexpr size_t hstep = (size_t)HALF * K * 2;
    const unsigned ldsw = (unsigned)wid * 1024u;
    const int aoff = lds_byte(wr * 64 + fr, fq * 8), boff = lds_byte(wc * 32 + fr, fq * 8);
    const char* Abase = (const char*)Abase_;
#define PG8_SA(b, h) (((b) * 2 + (h)) * HTB)
#define PG8_SB(b, h) ((4 + (b) * 2 + (h)) * HTB)
#define PG8_STAGE_B(bufoff, gbase) do { _Pragma("unroll") for (int _i = 0; _i < 2; ++_i) \
        __builtin_amdgcn_global_load_lds((const unsigned*)((const char*)(gbase) + voffB[_i]), (LAS unsigned*)(lds + (bufoff) + ldsw + _i * 8192), 16, 0, 0); } while (0)
#define PG8_STAGE_A(bufoff, gbase, o0_, o1_) do { \
        __builtin_amdgcn_global_load_lds((const unsigned*)((const char*)(gbase) + (o0_)), (LAS unsigned*)(lds + (bufoff) + ldsw), 16, 0, 0); \
        __builtin_amdgcn_global_load_lds((const unsigned*)((const char*)(gbase) + (o1_)), (LAS unsigned*)(lds + (bufoff) + ldsw + 8192), 16, 0, 0); } while (0)
#define PG8_LDA(dst, b, h) do { _Pragma("unroll") for (int m = 0; m < 4; ++m) _Pragma("unroll") for (int k = 0; k < 2; ++k) dst[m][k] = *(const LAS bf16x8*)(lds + PG8_SA(b, h) + aoff + m * 2048 + k * 1024); } while (0)
#define PG8_LDB(dst, b, h) do { _Pragma("unroll") for (int n = 0; n < 2; ++n) _Pragma("unroll") for (int k = 0; k < 2; ++k) dst[n][k] = *(const LAS bf16x8*)(lds + PG8_SB(b, h) + boff + n * 2048 + k * 1024); } while (0)
#define PG8_MMA(ai, bj, At, Bt) do { __builtin_amdgcn_s_setprio(1); _Pragma("unroll") for (int m = 0; m < 4; ++m) _Pragma("unroll") for (int n = 0; n < 2; ++n) _Pragma("unroll") for (int k = 0; k < 2; ++k) \
        acc[ai][bj][m][n] = __builtin_amdgcn_mfma_f32_16x16x32_bf16(Bt[n][k], At[m][k], acc[ai][bj][m][n], 0, 0, 0); __builtin_amdgcn_s_setprio(0); } while (0)
#define PG8_WAIT_V(n) asm volatile("s_waitcnt vmcnt(" #n ")" ::: "memory")
#define PG8_WAIT_L(n) asm volatile("s_waitcnt lgkmcnt(" #n ")" ::: "memory")
#define PG8_BAR __builtin_amdgcn_s_barrier()
#define PG8_SCHED __builtin_amdgcn_sched_barrier(0)
#define PG8_AOFFS(u, ao) do { _Pragma("unroll") for (int _h = 0; _h < 2; ++_h) _Pragma("unroll") for (int _i = 0; _i < 2; ++_i) { \
        const int _r = _h * HALF + Rr[_i]; int _row; \
        if (GATHER) { _row = (_r < (u).nvalid) ? glist[(u).a0 + _r] : 0; } else { _row = (u).a0 + _r; } \
        ao[_h][_i] = (unsigned)(_row * K + Cc[_i]) * 2u; } } while (0)
    Unit cur, nxt; int ui = 0;
    if (!S.next(0, cur)) return;
    f32x4 acc[2][2][4][2];
#pragma unroll
    for (int a = 0; a < 2; ++a)
#pragma unroll
        for (int b = 0; b < 2; ++b)
#pragma unroll
            for (int m = 0; m < 4; ++m)
#pragma unroll
                for (int n = 0; n < 2; ++n) acc[a][b][m][n] = (f32x4){0.f, 0.f, 0.f, 0.f};
    bf16x8 At[4][2], B0[2][2], B1[2][2];
    unsigned ao[2][2], nao[2][2];
    PG8_AOFFS(cur, ao);
    const char* cB = (const char*)Bt_ + (size_t)cur.b0 * (K * 2);
    PG8_STAGE_B(PG8_SB(0, 0), cB); PG8_STAGE_B(PG8_SB(0, 1), cB + hstep); PG8_STAGE_A(PG8_SA(0, 0), Abase, ao[0][0], ao[0][1]); PG8_STAGE_A(PG8_SA(0, 1), Abase, ao[1][0], ao[1][1]);
    if (wr == 1) PG8_BAR;
    PG8_WAIT_V(2); PG8_BAR;
    PG8_STAGE_B(PG8_SB(1, 0), cB + kstep); PG8_STAGE_A(PG8_SA(1, 0), Abase + kstep, ao[0][0], ao[0][1]); PG8_STAGE_B(PG8_SB(1, 1), cB + hstep + kstep);
    PG8_WAIT_V(6); PG8_BAR;
    for (;;) {
        const bool has_next = S.next(ui + 1, nxt);
        if (has_next) { PG8_AOFFS(nxt, nao); } else {
#pragma unroll
            for (int h = 0; h < 2; ++h)
#pragma unroll
                for (int i = 0; i < 2; ++i) nao[h][i] = ao[h][i]; }
        const char* nB = has_next ? (const char*)Bt_ + (size_t)nxt.b0 * (K * 2) : cB;
        for (int t = 0; t < nt; t += 2) {
            const bool last = (t == nt - 2);
            const char* a1 = Abase + (size_t)(t + 1) * kstep;
            const char* a2 = last ? Abase : Abase + (size_t)(t + 2) * kstep; const char* b2 = last ? nB : cB + (size_t)(t + 2) * kstep;
            const char* a3 = a2 + kstep; const char* b3 = b2 + kstep;
            const unsigned x00 = last ? nao[0][0] : ao[0][0], x01 = last ? nao[0][1] : ao[0][1], x10 = last ? nao[1][0] : ao[1][0], x11 = last ? nao[1][1] : ao[1][1];
            PG8_LDB(B0, 0, 0); PG8_LDB(B1, 0, 1); PG8_SCHED; PG8_LDA(At, 0, 0); PG8_STAGE_A(PG8_SA(1, 1), a1, ao[1][0], ao[1][1]);
            PG8_WAIT_V(8); PG8_WAIT_L(0); PG8_BAR; PG8_MMA(0, 0, At, B0); PG8_MMA(0, 1, At, B1); PG8_BAR; PG8_SCHED;
            PG8_LDA(At, 0, 1); PG8_STAGE_B(PG8_SB(0, 0), b2); PG8_STAGE_B(PG8_SB(0, 1), b2 + hstep); PG8_STAGE_A(PG8_SA(0, 0), a2, x00, x01);
            PG8_WAIT_V(8); PG8_WAIT_L(0); PG8_BAR; PG8_MMA(1, 0, At, B0); PG8_MMA(1, 1, At, B1); PG8_BAR; PG8_SCHED;
            PG8_LDB(B0, 1, 0); PG8_LDB(B1, 1, 1); PG8_SCHED; PG8_LDA(At, 1, 0); PG8_STAGE_A(PG8_SA(0, 1), a2, x10, x11);
            PG8_WAIT_V(8); PG8_WAIT_L(0); PG8_BAR; PG8_MMA(0, 0, At, B0); PG8_MMA(0, 1, At, B1); PG8_BAR; PG8_SCHED;
            PG8_LDA(At, 1, 1); PG8_STAGE_B(PG8_SB(1, 0), b3); PG8_STAGE_B(PG8_SB(1, 1), b3 + hstep); PG8_STAGE_A(PG8_SA(1, 0), a3, x00, x01);
            PG8_WAIT_V(8); PG8_WAIT_L(0); PG8_BAR; PG8_MMA(1, 0, At, B0); PG8_MMA(1, 1, At, B1); PG8_BAR; PG8_SCHED;
        }
        if (wr == 0) PG8_BAR;
        E(acc, cur, wr, wc, fr, fq);
        if (!has_next) break;
#pragma unroll
        for (int a = 0; a < 2; ++a)
#pragma unroll
            for (int b = 0; b < 2; ++b)
#pragma unroll
                for (int m = 0; m < 4; ++m)
#pragma unroll
                    for (int n = 0; n < 2; ++n) acc[a][b][m][n] = (f32x4){0.f, 0.f, 0.f, 0.f};
        cur = nxt; cB = nB; ++ui;
#pragma unroll
        for (int h = 0; h < 2; ++h)
#pragma unroll
            for (int i = 0; i < 2; ++i) ao[h][i] = nao[h][i];
        if (wr == 1) PG8_BAR;
    }
    PG8_WAIT_V(0);
    PG8_BAR;
#undef PG8_SA
#undef PG8_SB
#undef PG8_STAGE_A
#undef PG8_STAGE_B
#undef PG8_LDA
#undef PG8_LDB
#undef PG8_MMA
#undef PG8_WAIT_V
#undef PG8_WAIT_L
#undef PG8_BAR
#undef PG8_SCHED
#undef PG8_AOFFS
}

struct DenseOrder {
    int nM, nN, nwg, G, c;
    __device__ void init(int nM_, int nN_, int G_, int c_) { nM = nM_; nN = nN_; nwg = nM * nN; G = G_; c = c_; }
    __device__ bool next(int i, Unit& u) const {
        const long L = (long)i * G + c; if (L >= nwg) return false;
        int wgid = (int)L; { const int q = nwg / 8, r = nwg % 8, xcd = wgid % 8, off = wgid / 8; wgid = (xcd < r ? xcd * (q + 1) : r * (q + 1) + (xcd - r) * q) + off; }
        const int nig = 8 * nN, gid = wgid / nig, fm = gid * 8, gsz = (nM - fm) < 8 ? (nM - fm) : 8;
        const int pm = fm + ((wgid % nig) % gsz), pn = (wgid % nig) / gsz;
        u.a0 = pm * 256; u.nvalid = 256; u.b0 = pn * 256; u.o0 = pm * 256; u.pn = pn; u.e = 0; u.g0 = 0; return true;
    }
};
template <int NPN, bool UP> struct MoeOrder {
    const LAS int* tb; const int* cnt; int G, c;
    __device__ bool next(int i, Unit& u) const {
        const int L = i * G + c; const int total = tb[32] * NPN; if (L >= total) return false;
        int e = 0;
#pragma unroll 1
        for (int q = 16; q >= 1; q >>= 1) if (tb[e + q] * NPN <= L) e += q;
        const int te = tb[e + 1] - tb[e], j = L - tb[e] * NPN, pn = j / te, mt = j % te;
        const int ce = cnt[e];
        u.e = e; u.pn = pn; u.o0 = (tb[e] + mt) * 256; u.nvalid = min(256, ce - mt * 256);
        u.g0 = e * TT + mt * 256;
        u.a0 = UP ? u.g0 : u.o0;
        u.b0 = e * (UP ? 2 * DF : D) + pn * 256;
        return true;
    }
};

struct EpiStore {
    bf16* C; int ldc;
    __device__ __forceinline__ void operator()(const f32x4 (&acc)[2][2][4][2], const Unit& u, int wr, int wc, int fr, int fq) const {
        const int row0 = u.o0 + wr * 64 + fr, col0 = u.pn * 256 + wc * 32 + 8 * fq;
#pragma unroll
        for (int ai = 0; ai < 2; ++ai)
#pragma unroll
            for (int m = 0; m < 4; ++m) { bf16* rowp = C + (size_t)(row0 + ai * HALF + m * 16) * ldc + col0;
#pragma unroll
                for (int bj = 0; bj < 2; ++bj) { const f32x4 v0 = acc[ai][bj][m][0], v1 = acc[ai][bj][m][1];
                    u32x4 w; w.x = cvt_pk_bf16(v0[0], v0[1]); w.y = cvt_pk_bf16(v0[2], v0[3]); w.z = cvt_pk_bf16(v1[0], v1[1]); w.w = cvt_pk_bf16(v1[2], v1[3]);
                    *(u32x4*)(rowp + bj * HALF) = w; } }
    }
};
struct EpiSwiglu {
    bf16* C; const float* b1;
    __device__ __forceinline__ void operator()(const f32x4 (&acc)[2][2][4][2], const Unit& u, int wr, int wc, int fr, int fq) const {
        const int row0 = u.o0 + wr * 64 + fr, j0 = u.pn * 128 + wc * 32 + 8 * fq;
        const float* bb = b1 + (size_t)u.e * 2 * DF + j0;
        const f32x4 bg0 = *(const f32x4*)bb, bg1 = *(const f32x4*)(bb + 4), bl0 = *(const f32x4*)(bb + DF), bl1 = *(const f32x4*)(bb + DF + 4);
#pragma unroll
        for (int ai = 0; ai < 2; ++ai)
#pragma unroll
            for (int m = 0; m < 4; ++m) {
                float o[8];
#pragma unroll
                for (int n = 0; n < 2; ++n)
#pragma unroll
                    for (int q = 0; q < 4; ++q) {
                        const float gl = fminf(acc[ai][0][m][n][q] + (n ? bg1[q] : bg0[q]), 7.0f);
                        const float li = fminf(fmaxf(acc[ai][1][m][n][q] + (n ? bl1[q] : bl0[q]), -7.0f), 7.0f);
                        o[4 * n + q] = gl * __builtin_amdgcn_rcpf(1.0f + __expf(-1.702f * gl)) * (li + 1.0f);
                    }
                u32x4 w; w.x = cvt_pk_bf16(o[0], o[1]); w.y = cvt_pk_bf16(o[2], o[3]); w.z = cvt_pk_bf16(o[4], o[5]); w.w = cvt_pk_bf16(o[6], o[7]);
                *(u32x4*)(C + (size_t)(row0 + ai * HALF + m * 16) * DF + j0) = w;
            }
    }
};
struct EpiDown {
    bf16* C; const float* b2; const float* rowgate;
    __device__ __forceinline__ void operator()(const f32x4 (&acc)[2][2][4][2], const Unit& u, int wr, int wc, int fr, int fq) const {
        const int rt0 = wr * 64 + fr, col0 = u.pn * 256 + wc * 32 + 8 * fq;
        f32x4 bv[2][2];
#pragma unroll
        for (int bj = 0; bj < 2; ++bj)
#pragma unroll
            for (int n = 0; n < 2; ++n) bv[bj][n] = *(const f32x4*)(b2 + (size_t)u.e * D + col0 + bj * HALF + 4 * n);
#pragma unroll
        for (int ai = 0; ai < 2; ++ai)
#pragma unroll
            for (int m = 0; m < 4; ++m) {
                const int rt = rt0 + ai * HALF + m * 16;
                const float gt = (rt < u.nvalid) ? rowgate[u.g0 + rt] : 0.f;
                bf16* rowp = C + (size_t)(u.o0 + rt) * D + col0;
#pragma unroll
                for (int bj = 0; bj < 2; ++bj) { const f32x4 v0 = (acc[ai][bj][m][0] + bv[bj][0]) * gt, v1 = (acc[ai][bj][m][1] + bv[bj][1]) * gt;
                    u32x4 w; w.x = cvt_pk_bf16(v0[0], v0[1]); w.y = cvt_pk_bf16(v0[2], v0[3]); w.z = cvt_pk_bf16(v1[0], v1[1]); w.w = cvt_pk_bf16(v1[2], v1[3]);
                    *(u32x4*)(rowp + bj * HALF) = w; } }
    }
};
}

constexpr int GEMM_LDS = 147456;
constexpr int LDS_TB = 131072;

template <int WHICH> __global__ void __launch_bounds__(512, 2) k_gemm(P p) {
    extern __shared__ __attribute__((aligned(16))) unsigned char lds_[];
    LAS unsigned char* lds = (LAS unsigned char*)lds_;
    const int l = p.l;
    if constexpr (WHICH == 0) {
        pg8::DenseOrder S; S.init(TT / 256, DIN / 256, gridDim.x, blockIdx.x);
        pg8::EpiStore E{(bf16*)(p.ws + WS_Z), DIN};
        pg8::gemm_phase<false>(lds, (const bf16*)(p.ws + WS_H), (const bf16*)(p.ws + WS_WIN) + (size_t)l * DIN * D, nullptr, S, E);
    } else if constexpr (WHICH == 1) {
        pg8::DenseOrder S; S.init((l == DEPTH - 1 ? TL : TT) / 256, D / 256, gridDim.x, blockIdx.x);
        pg8::EpiStore E{(bf16*)(p.ws + WS_Y1), D};
        pg8::gemm_phase<false>(lds, (const bf16*)(p.ws + WS_MIX), (const bf16*)(p.ws + WS_WOUT) + (size_t)l * D * D, nullptr, S, E);
    } else {
        const int* cnt = (const int*)(p.ws + WS_CTL) + CW_CNT + 32 * l;
        LAS int* tb = (LAS int*)(lds + LDS_TB);
        if (threadIdx.x < 64) {
            const int lane = threadIdx.x; const int c = lane < 32 ? (cnt[lane] + 255) >> 8 : 0; int s = c;
#pragma unroll
            for (int o = 1; o < 32; o <<= 1) { const int t = __shfl_up(s, o); if (lane >= o) s += t; }
            if (lane < 32) tb[lane + 1] = s; if (lane == 0) tb[0] = 0;
        }
        __syncthreads();
        if constexpr (WHICH == 2) {
            pg8::MoeOrder<8, true> S{tb, cnt, (int)gridDim.x, (int)blockIdx.x};
            pg8::EpiSwiglu E{(bf16*)(p.ws + WS_ACT), p.in[I_B1] + (size_t)l * NE * 2 * DF};
            pg8::gemm_phase<true>(lds, (const bf16*)(p.ws + WS_H), (const bf16*)(p.ws + WS_W1T) + (size_t)l * NE * 2 * DF * D, (const int*)(p.ws + WS_ROWTOK), S, E);
        } else {
            pg8::MoeOrder<4, false> S{tb, cnt, (int)gridDim.x, (int)blockIdx.x};
            pg8::EpiDown E{(bf16*)(p.ws + WS_Y2), p.in[I_B2] + (size_t)l * NE * D, (const float*)(p.ws + WS_ROWGATE)};
            pg8::gemm_phase<false>(lds, (const bf16*)(p.ws + WS_ACT), (const bf16*)(p.ws + WS_W2T) + (size_t)l * NE * D * DF, nullptr, S, E);
        }
    }
}

__device__ __forceinline__ void tok_seq(int tok, int& base, int& len, int& t) {
    if (tok < TL) { base = tok & ~(SEQ - 1); len = SEQ; t = tok & (SEQ - 1); }
    else { const int q = tok - TL; base = TL + (q & ~(CTXL - 1)); len = CTXL; t = q & (CTXL - 1); }
}
__global__ void __launch_bounds__(256) k_conv(P p) {
    const int l = p.l;
    const bf16* Z = (const bf16*)(p.ws + WS_Z); float* U = (float*)(p.ws + WS_U);
    const float* cw = p.in[I_CONVW] + (size_t)l * 4 * DLRU; const float* cb = p.in[I_CONVB] + (size_t)l * DLRU;
    const size_t i = (size_t)blockIdx.x * 256 + threadIdx.x;
    if (i >= (size_t)TT * DLRU) return;
    const int tok = (int)(i / DLRU), ch = (int)(i % DLRU);
    int base, len, t; tok_seq(tok, base, len, t);
    float y = cb[ch];
#pragma unroll
    for (int k = 0; k < 4; ++k) { const int tt = t + k - 2; if (tt >= 0 && tt < len) y += bf2f(Z[(size_t)(base + tt) * DIN + ch]) * cw[k * DLRU + ch]; }
    U[i] = y;
}
__device__ __forceinline__ float softplusf_(float x) { return x > 20.f ? x : log1pf(expf(x)); }
__global__ void __launch_bounds__(256) k_gates(P p) {
    const int l = p.l;
    const float* U = (const float*)(p.ws + WS_U);
    float* AA = (float*)(p.ws + WS_AA); float* BB = (float*)(p.ws + WS_BB);
    const size_t i = (size_t)blockIdx.x * 256 + threadIdx.x;
    if (i >= (size_t)TT * DLRU) return;
    const int tok = (int)(i / DLRU), ch = (int)(i % DLRU), h = ch / HD, j = ch % HD;
    const float* ur = U + (size_t)tok * DLRU + h * HD;
    const float u = U[i];
#pragma unroll
    for (int d = 0; d < 2; ++d) {
        const float* wa = p.in[I_GAW] + ((size_t)(l * 2 + d) * NH + h) * HD * HD + j;
        const float* wx = p.in[I_GXW] + ((size_t)(l * 2 + d) * NH + h) * HD * HD + j;
        float pr = p.in[I_GAB][(size_t)(l * 2 + d) * DLRU + ch], pi = p.in[I_GXB][(size_t)(l * 2 + d) * DLRU + ch];
        for (int q = 0; q < HD; ++q) { const float uv = ur[q]; pr += uv * wa[q * HD]; pi += uv * wx[q * HD]; }
        const float r = 1.0f / (1.0f + expf(-pr)), ig = 1.0f / (1.0f + expf(-pi));
        const float lam = p.in[I_LAM][(size_t)(l * 2 + d) * DLRU + ch];
        const float la = -8.0f * r * softplusf_(-lam);
        const float a = expf(la);
        const float bt = sqrtf(-expm1f(2.0f * la)) * (ig * u);
        AA[(size_t)d * TT * DLRU + i] = a; BB[(size_t)d * TT * DLRU + i] = bt;
    }
}
__global__ void __launch_bounds__(256) k_scan(P p) {
    const float* AA = (const float*)(p.ws + WS_AA); const float* BB = (const float*)(p.ws + WS_BB);
    float* HS = (float*)(p.ws + WS_HS);
    const int i = blockIdx.x * 256 + threadIdx.x;
    if (i >= NB * DLRU) return;
    const int b = i / DLRU, ch = i % DLRU;
    const size_t cbase = (size_t)(TL + b * CTXL) * DLRU + ch, lbase = (size_t)(b * SEQ) * DLRU + ch;
    float h = 0.f;
    for (int t = 0; t < CTXL; ++t) { const size_t o = cbase + (size_t)t * DLRU; h = AA[o] * h + BB[o]; HS[o] = h; }
    for (int t = 0; t < SEQ; ++t) { const size_t o = lbase + (size_t)t * DLRU; h = AA[o] * h + BB[o]; HS[o] = h; }
    const float* A1 = AA + (size_t)TT * DLRU; const float* B1 = BB + (size_t)TT * DLRU;
    h = 0.f;
    for (int t = CTXL - 1; t >= 0; --t) { const size_t o = cbase + (size_t)t * DLRU; h = A1[o] * h + B1[o]; HS[o] += h; }
    for (int t = SEQ - 1; t >= 0; --t) { const size_t o = lbase + (size_t)t * DLRU; h = A1[o] * h + B1[o]; HS[o] += h; }
}
__global__ void __launch_bounds__(256) k_mix(P p) {
    const bf16* Z = (const bf16*)(p.ws + WS_Z); const float* HS = (const float*)(p.ws + WS_HS); bf16* MIX = (bf16*)(p.ws + WS_MIX);
    const size_t i = (size_t)blockIdx.x * 256 + threadIdx.x;
    if (i >= (size_t)TT * DLRU) return;
    const int tok = (int)(i / DLRU), ch = (int)(i % DLRU);
    const float y = bf2f(Z[(size_t)tok * DIN + DLRU + ch]);
    MIX[(size_t)tok * D + ch] = (bf16)f2bf(HS[i] * gelu_tanh(y));
}
__global__ void __launch_bounds__(256) k_poold(P p) {
    const bf16* Z = (const bf16*)(p.ws + WS_Z); float* DD = (float*)(p.ws + WS_DD);
    const size_t i = (size_t)blockIdx.x * 256 + threadIdx.x;
    if (i >= (size_t)TT * DPOOL) return;
    const int tok = (int)(i / DPOOL), ch = (int)(i % DPOOL), g = ch / 128;
    int base, len, t; tok_seq(tok, base, len, t);
    const int win = 2 << g;
    int seg_lo = 0, seg_hi = len;
    if (tok < TL) { seg_lo = (t / GRIDW) * GRIDW; seg_hi = seg_lo + GRIDW; }
    int lo = t - win / 2; if (lo < seg_lo) lo = seg_lo;
    int hi = t + win / 2; if (hi > seg_hi) hi = seg_hi;
    float s = 0.f;
    for (int q = lo; q < hi; ++q) s += bf2f(Z[(size_t)(base + q) * DIN + 2 * DLRU + ch]);
    DD[i] = s / (float)(hi - lo) - bf2f(Z[(size_t)tok * DIN + 2 * DLRU + ch]);
}
__global__ void __launch_bounds__(256) k_poolmm(P p) {
    const int l = p.l;
    const float* DD = (const float*)(p.ws + WS_DD); bf16* MIX = (bf16*)(p.ws + WS_MIX);
    const size_t i = (size_t)blockIdx.x * 256 + threadIdx.x;
    if (i >= (size_t)TT * DPOOL) return;
    const int tok = (int)(i / DPOOL), ch = (int)(i % DPOOL), g = ch / 128, j = ch % 128;
    const float* w = p.in[I_POOLW] + ((size_t)l * 4 + g) * 128 * 128 + j;
    const float* d = DD + (size_t)tok * DPOOL + g * 128;
    float s = 0.f;
    for (int q = 0; q < 128; ++q) s += d[q] * w[q * 128];
    s = (s + p.in[I_POOLB][(size_t)l * DPOOL + ch]) * p.in[I_POOLS][(size_t)l * DPOOL + ch];
    MIX[(size_t)tok * D + DLRU + ch] = (bf16)f2bf(s);
}

__global__ void __launch_bounds__(512) k_ln1(P p) {
    const int l = p.l;
    const int lane = threadIdx.x & 63, gw = blockIdx.x * 8 + (threadIdx.x >> 6), ngw = gridDim.x * 8;
    const float* MOD = (const float*)(p.ws + WS_MOD) + (size_t)l * 9 * 6144;
    float* XL = (float*)(p.ws + WS_XL); bf16* H = (bf16*)(p.ws + WS_H); const bf16* Y1 = (const bf16*)(p.ws + WS_Y1);
    const float* lg = p.in[I_LN1G] + (size_t)l * D; const float* lb = p.in[I_LN1B] + (size_t)l * D;
    const float* rw = p.in[I_RW] + (size_t)l * D * NE; const float* rb = p.in[I_RB] + (size_t)l * NE;
    int* cnt = (int*)(p.ws + WS_CTL) + CW_CNT + 32 * l;
    int* TOPE = (int*)(p.ws + WS_TOPE); int* SLOT = (int*)(p.ws + WS_SLOT);
    int* ROWTOK = (int*)(p.ws + WS_ROWTOK); float* ROWGATE = (float*)(p.ws + WS_ROWGATE);
    const int ntok = (l == DEPTH - 1) ? TL : TT;
    for (int tok = gw; tok < ntok; tok += ngw) {
        const float* m = MOD + (size_t)mod_row(tok) * 6144;
        f32x4 v[4], h[4];
#pragma unroll
        for (int j = 0; j < 4; ++j) {
            const f32x4 x = ((const f32x4*)(XL + (size_t)tok * D))[lane + 64 * j];
            const u32x2 yr = ((const u32x2*)(Y1 + (size_t)tok * D))[lane + 64 * j];
            const f32x4 g1 = ((const f32x4*)(m + 2048))[lane + 64 * j];
            f32x4 y; y.x = __uint_as_float(yr.x << 16); y.y = __uint_as_float(yr.x & 0xffff0000u); y.z = __uint_as_float(yr.y << 16); y.w = __uint_as_float(yr.y & 0xffff0000u);
            v[j] = x * ALPHA + g1 * y;
        }
        float mean, rstd; ln_stats(v, mean, rstd);
#pragma unroll
        for (int j = 0; j < 4; ++j) {
            const f32x4 gg = ((const f32x4*)lg)[lane + 64 * j], bb = ((const f32x4*)lb)[lane + 64 * j];
            v[j] = (v[j] - mean) * rstd * gg + bb;
            ((f32x4*)(XL + (size_t)tok * D))[lane + 64 * j] = v[j];
            const f32x4 sh = ((const f32x4*)(m + 3072))[lane + 64 * j], sc = ((const f32x4*)(m + 4096))[lane + 64 * j];
            h[j] = v[j] * (sc + 1.0f) + sh;
        }
        store_bf16_row(H + (size_t)tok * D, lane, h);
        float acc[32];
#pragma unroll
        for (int e = 0; e < 32; ++e) acc[e] = 0.f;
#pragma unroll
        for (int j = 0; j < 4; ++j)
#pragma unroll
            for (int i = 0; i < 4; ++i) {
                const int k = 4 * lane + 256 * j + i; const float hv = h[j][i];
                const f32x4* wr = (const f32x4*)(rw + (size_t)k * NE);
#pragma unroll
                for (int q = 0; q < 8; ++q) { const f32x4 w = wr[q]; acc[4 * q] += hv * w.x; acc[4 * q + 1] += hv * w.y; acc[4 * q + 2] += hv * w.z; acc[4 * q + 3] += hv * w.w; }
            }
        float mylogit = 0.f;
#pragma unroll
        for (int e = 0; e < 32; ++e) { const float s = wave_sum(acc[e]); if ((lane & 31) == e) mylogit = s; }
        mylogit += rb[lane & 31];
        float tv[4]; int ti[4];
        float cur = mylogit;
#pragma unroll
        for (int k = 0; k < 4; ++k) {
            float bv = cur; int bi = lane & 31;
#pragma unroll
            for (int o = 1; o < 32; o <<= 1) { const float ov = __shfl_xor(bv, o); const int oi = __shfl_xor(bi, o); if (ov > bv || (ov == bv && oi < bi)) { bv = ov; bi = oi; } }
            tv[k] = bv; ti[k] = bi;
            if ((lane & 31) == bi) cur = -INFINITY;
        }
        const float e1 = __expf(tv[1] - tv[0]), e2 = __expf(tv[2] - tv[0]), e3 = __expf(tv[3] - tv[0]);
        const float inv = 1.0f / (1.0f + e1 + e2 + e3);
        if (lane < 4) {
            const int e = lane == 0 ? ti[0] : lane == 1 ? ti[1] : lane == 2 ? ti[2] : ti[3];
            const float pg = (lane == 0 ? 1.0f : lane == 1 ? e1 : lane == 2 ? e2 : e3) * inv;
            const int slot = atomicAdd(&cnt[e], 1);
            ROWTOK[(size_t)e * TT + slot] = tok; ROWGATE[(size_t)e * TT + slot] = pg;
            TOPE[tok * 4 + lane] = e; SLOT[tok * 4 + lane] = slot;
        }
    }
}

__global__ void __launch_bounds__(512) k_ln2(P p) {
    const int l = p.l;
    const int lane = threadIdx.x & 63, gw = blockIdx.x * 8 + (threadIdx.x >> 6), ngw = gridDim.x * 8;
    const float* MOD = (const float*)(p.ws + WS_MOD) + (size_t)l * 9 * 6144;
    float* XL = (float*)(p.ws + WS_XL); bf16* H = (bf16*)(p.ws + WS_H); const bf16* Y2 = (const bf16*)(p.ws + WS_Y2);
    const float* lg = p.in[I_LN2G] + (size_t)l * D; const float* lb = p.in[I_LN2B] + (size_t)l * D;
    const int* cnt = (const int*)(p.ws + WS_CTL) + CW_CNT + 32 * l;
    const int* TOPE = (const int*)(p.ws + WS_TOPE); const int* SLOT = (const int*)(p.ws + WS_SLOT);
    int offl;
    { const int c = lane < 32 ? pad256(cnt[lane]) : 0; int s = c;
#pragma unroll
      for (int o = 1; o < 32; o <<= 1) { const int t = __shfl_up(s, o); if ((lane & 31) >= o) s += t; }
      offl = s - c; }
    const bool last = (l == DEPTH - 1);
    const int ntok = last ? TL : TT;
    for (int tok = gw; tok < ntok; tok += ngw) {
        const float* m = MOD + (size_t)mod_row(tok) * 6144;
        f32x4 f[4];
#pragma unroll
        for (int j = 0; j < 4; ++j) f[j] = (f32x4){0.f, 0.f, 0.f, 0.f};
#pragma unroll
        for (int k = 0; k < 4; ++k) {
            const int e = TOPE[tok * 4 + k], slot = SLOT[tok * 4 + k];
            const int row = __shfl(offl, e) + slot;
            const u32x2* yr = (const u32x2*)(Y2 + (size_t)row * D);
#pragma unroll
            for (int j = 0; j < 4; ++j) { const u32x2 r = yr[lane + 64 * j];
                f[j].x += __uint_as_float(r.x << 16); f[j].y += __uint_as_float(r.x & 0xffff0000u); f[j].z += __uint_as_float(r.y << 16); f[j].w += __uint_as_float(r.y & 0xffff0000u); }
        }
        f32x4 v[4];
#pragma unroll
        for (int j = 0; j < 4; ++j) {
            const f32x4 x = ((const f32x4*)(XL + (size_t)tok * D))[lane + 64 * j];
            const f32x4 g2 = ((const f32x4*)(m + 5120))[lane + 64 * j];
            v[j] = x * ALPHA + g2 * f[j];
        }
        float mean, rstd; ln_stats(v, mean, rstd);
        f32x4 h[4];
        const float* mn = MOD + (size_t)9 * 6144 + (size_t)mod_row(tok) * 6144;
#pragma unroll
        for (int j = 0; j < 4; ++j) {
            const f32x4 gg = ((const f32x4*)lg)[lane + 64 * j], bb = ((const f32x4*)lb)[lane + 64 * j];
            v[j] = (v[j] - mean) * rstd * gg + bb;
            if (last) ((f32x4*)(p.out + (size_t)tok * D))[lane + 64 * j] = v[j];
            else {
                ((f32x4*)(XL + (size_t)tok * D))[lane + 64 * j] = v[j];
                const f32x4 sh = ((const f32x4*)mn)[lane + 64 * j], sc = ((const f32x4*)(mn + 1024))[lane + 64 * j];
                h[j] = v[j] * (sc + 1.0f) + sh;
            }
        }
        if (!last) store_bf16_row(H + (size_t)tok * D, lane, h);
    }
}

template <class Kern> static void set_lds(Kern k, int bytes) { (void)hipFuncSetAttribute((const void*)k, hipFuncAttributeMaxDynamicSharedMemorySize, bytes); }
extern "C" void kernel_launch(void* const* d_in, const int* in_sizes, int n_in, void* d_out, int out_size, void* d_ws, size_t ws_size, hipStream_t stream) {
    if (n_in != N_IN || ws_size < WS_END || out_size != TL * D) { fprintf(stderr, "kernel_launch: unexpected shapes (n_in %d, out %d, ws %zu)\n", n_in, out_size, ws_size); return; }
    static bool once = false;
    if (!once) { once = true; set_lds(k_convert, 131072); set_lds(k_gemm<0>, GEMM_LDS); set_lds(k_gemm<1>, GEMM_LDS); set_lds(k_gemm<2>, GEMM_LDS); set_lds(k_gemm<3>, GEMM_LDS); }
    (void)hipMemsetAsync((char*)d_ws + WS_CTL, 0, CTL_BYTES, stream);
    P p{};
    for (int i = 0; i < N_IN; ++i) p.in[i] = (const float*)d_in[i];
    p.out = (float*)d_out; p.ws = (unsigned char*)d_ws; p.l = 0; p.pad = 0;
    hipLaunchKernelGGL(k_pos, dim3(128), dim3(256), 0, stream, p);
    hipLaunchKernelGGL(k_mod, dim3(384), dim3(512), 0, stream, p);
    hipLaunchKernelGGL(k_convert, dim3(256), dim3(512), 131072, stream, p);
    hipLaunchKernelGGL(k_entry, dim3(1024), dim3(512), 0, stream, p);
    const int nel = (TT * DLRU + 255) / 256;
    for (int l = 0; l < DEPTH; ++l) {
        p.l = l;
        hipLaunchKernelGGL(k_gemm<0>, dim3(256), dim3(512), GEMM_LDS, stream, p);
        hipLaunchKernelGGL(k_conv, dim3(nel), dim3(256), 0, stream, p);
        hipLaunchKernelGGL(k_gates, dim3(nel), dim3(256), 0, stream, p);
        hipLaunchKernelGGL(k_scan, dim3(NB * DLRU / 256), dim3(256), 0, stream, p);
        hipLaunchKernelGGL(k_mix, dim3(nel), dim3(256), 0, stream, p);
        hipLaunchKernelGGL(k_poold, dim3(nel), dim3(256), 0, stream, p);
        hipLaunchKernelGGL(k_poolmm, dim3(nel), dim3(256), 0, stream, p);
        hipLaunchKernelGGL(k_gemm<1>, dim3(256), dim3(512), GEMM_LDS, stream, p);
        hipLaunchKernelGGL(k_ln1, dim3(1024), dim3(512), 0, stream, p);
        hipLaunchKernelGGL(k_gemm<2>, dim3(256), dim3(512), GEMM_LDS, stream, p);
        hipLaunchKernelGGL(k_gemm<3>, dim3(256), dim3(512), GEMM_LDS, stream, p);
        hipLaunchKernelGGL(k_ln2, dim3(1024), dim3(512), 0, stream, p);
    }
}
```

```cpp
#include <hip/hip_runtime.h>
#include <cstdio>
#include <cstdint>

constexpr int NB = 8, SEQ = 2048, D = 1024, CTXL = 256, DEPTH = 2;
constexpr int TL = NB * SEQ;
constexpr int TC = NB * CTXL;
constexpr int TT = TL + TC;
constexpr int DLRU = 512, DPOOL = 512, DIN = 1536, NH = 8, HD = 64;
constexpr int NE = 32, TOPK = 4, DF = 1024;
constexpr int GRIDW = 64;
constexpr float LN_EPS = 1e-5f;
constexpr float ALPHA = 1.41421356237309515f;
constexpr int MAXROWS = 81920;
constexpr int NTILE = 72, NGRP = 9;

enum { I_X = 0, I_C, I_CTX, I_CCTX, I_WMOD, I_BMOD, I_WIN, I_CONVW, I_CONVB, I_GAW, I_GAB, I_GXW, I_GXB, I_LAM, I_POOLW, I_POOLB, I_POOLS,
       I_WOUT, I_LN1G, I_LN1B, I_RW, I_RB, I_W1, I_B1, I_W2, I_B2, I_LN2G, I_LN2B, N_IN };

constexpr size_t MiB = 1u << 20;
constexpr size_t WS_CTL = 0, CTL_BYTES = 1 * MiB;
constexpr size_t WS_MOD = 1 * MiB;
constexpr size_t WS_POS = 2 * MiB;
constexpr size_t WS_RWT = 2 * MiB + 512 * 1024;
constexpr size_t WS_TOPE = 3 * MiB;
constexpr size_t WS_SLOT = 3 * MiB + 512 * 1024;
constexpr size_t WS_ROWTOK = 4 * MiB;
constexpr size_t WS_ROWGATE = 7 * MiB;
constexpr size_t WS_AGGT = 10 * MiB;
constexpr size_t WS_AGGG = 15 * MiB;
constexpr size_t WS_WIN = 16 * MiB, WS_WOUT = 23 * MiB, WS_WG = 28 * MiB, WS_WP = 29 * MiB;
constexpr size_t WS_SP = 30 * MiB;
constexpr size_t WS_W1T = 32 * MiB, WS_W2T = 288 * MiB;
constexpr int SP_CW = 0, SP_CB = 2048, SP_GAB = 2560, SP_GXB = 3584, SP_CC = 4608, SP_PB = 5632, SP_PS = 6144, SP_L1G = 6656, SP_L1B = 7680, SP_L2G = 8704, SP_L2B = 9728, SP_RB = 10752,
              SP_B1 = 12288, SP_B2 = SP_B1 + 32 * 2048, SP_STRIDE = SP_B2 + 32 * 1024;
constexpr size_t WS_XL = 416 * MiB;
constexpr size_t WS_H = 488 * MiB;
constexpr size_t WS_Z = 524 * MiB;
constexpr size_t WS_MIX = 578 * MiB;
constexpr size_t WS_Y1 = 614 * MiB;
constexpr size_t WS_ACT = 650 * MiB;
constexpr size_t WS_Y2 = 810 * MiB;
constexpr size_t WS_END = 970 * MiB;
constexpr int CW_CNT = 64;
constexpr int CW_BAR = 4096;

typedef unsigned short bf16;
typedef float f32x4 __attribute__((ext_vector_type(4)));
typedef float f32x2 __attribute__((ext_vector_type(2)));
typedef float f32x16 __attribute__((ext_vector_type(16)));
typedef unsigned u32x2 __attribute__((ext_vector_type(2)));
typedef unsigned u32x4 __attribute__((ext_vector_type(4)));
typedef short bf16x8 __attribute__((ext_vector_type(8)));

__device__ __forceinline__ float bf2f(bf16 v) { return __uint_as_float(((unsigned)v) << 16); }
__device__ __forceinline__ float bflo(unsigned w) { return __uint_as_float(w << 16); }
__device__ __forceinline__ float bfhi(unsigned w) { return __uint_as_float(w & 0xffff0000u); }
__device__ __forceinline__ unsigned f2bf(float f) { unsigned u = __float_as_uint(f); return (u + 0x7fffu + ((u >> 16) & 1u)) >> 16; }
__device__ __forceinline__ unsigned pk2(float lo, float hi) { return f2bf(lo) | (f2bf(hi) << 16); }
__device__ __forceinline__ float wave_sum(float v) {
#pragma unroll
    for (int o = 1; o < 64; o <<= 1) v += __shfl_xor(v, o);
    return v;
}
__device__ __forceinline__ float fsigmoid(float x) { return __builtin_amdgcn_rcpf(1.0f + __expf(-x)); }
__device__ __forceinline__ float gelu_tanh(float x) {
    const float u = 0.7978845608028654f * (x + 0.044715f * x * x * x);
    const float t = 1.0f - 2.0f * __builtin_amdgcn_rcpf(__expf(2.0f * u) + 1.0f);
    return 0.5f * x * (1.0f + t);
}

struct P {
    const float* in[N_IN];
    float* out;
    unsigned char* ws;
    int ph_lo, ph_hi;
};

__device__ __forceinline__ int mod_row(int tok) { return tok < TL ? (tok >> 11) : NB; }
__device__ __forceinline__ int pad256(int c) { return (c + 255) & ~255; }

__device__ __forceinline__ void ln_stats(const f32x4 (&v)[4], float& mean, float& rstd) {
    float s = 0.f;
#pragma unroll
    for (int j = 0; j < 4; ++j) s += (v[j].x + v[j].y) + (v[j].z + v[j].w);
    mean = wave_sum(s) * (1.f / D);
    float s2 = 0.f;
#pragma unroll
    for (int j = 0; j < 4; ++j) { const f32x4 d = v[j] - mean; s2 += (d.x * d.x + d.y * d.y) + (d.z * d.z + d.w * d.w); }
    rstd = 1.0f / sqrtf(wave_sum(s2) * (1.f / D) + LN_EPS);
}
__device__ __forceinline__ void store_bf16_row(bf16* row, int lane, const f32x4 (&h)[4]) {
    u32x2* o = (u32x2*)row + lane;
#pragma unroll
    for (int j = 0; j < 4; ++j) { u32x2 w; w.x = pk2(h[j].x, h[j].y); w.y = pk2(h[j].z, h[j].w); o[64 * j] = w; }
}


#define LAS __attribute__((address_space(3)))
__device__ __forceinline__ void transpose_tile(const float* src, int N, bf16* dst, int Kp, LAS float* scr, int lane) {
    f32x4 v[16];
#pragma unroll
    for (int i = 0; i < 16; ++i) { const int k = 4 * i + (lane >> 4); v[i] = *(const f32x4*)(src + (size_t)k * N + 4 * (lane & 15)); }
#pragma unroll
    for (int i = 0; i < 16; ++i) { const int k = 4 * i + (lane >> 4); const int nn = (4 * (lane & 15)) ^ (((k >> 3) & 3) << 3); *(LAS f32x4*)(scr + k * 64 + nn) = v[i]; }
    asm volatile("s_waitcnt lgkmcnt(0)" ::: "memory");
    const int c = lane & 7, sw = (c & 3) << 3;
#pragma unroll
    for (int j = 0; j < 8; ++j) {
        const int n = (lane >> 3) + 8 * j;
        const LAS float* s = scr + (8 * c) * 64 + (n ^ sw);
        u32x4 o; o.x = pk2(s[0], s[64]); o.y = pk2(s[128], s[192]); o.z = pk2(s[256], s[320]); o.w = pk2(s[384], s[448]);
        *(u32x4*)(dst + (size_t)n * Kp + 8 * c) = o;
    }
    asm volatile("s_waitcnt lgkmcnt(0)" ::: "memory");
}
__device__ __forceinline__ void convert_weights(const P& p, LAS unsigned char* lds, int gw, int ngw, int wave, int lane) {
    LAS float* scr = (LAS float*)(lds + wave * 16384);
    bf16* WINT = (bf16*)(p.ws + WS_WIN); bf16* WOUTT = (bf16*)(p.ws + WS_WOUT); bf16* W1T = (bf16*)(p.ws + WS_W1T); bf16* W2T = (bf16*)(p.ws + WS_W2T);
    bf16* WGT = (bf16*)(p.ws + WS_WG); bf16* WPT = (bf16*)(p.ws + WS_WP);
    constexpr int I_IN = DEPTH * 16 * 24, I_OUT = DEPTH * 16 * 16, I_G = DEPTH * 2 * 2 * NH, I_P = DEPTH * 4 * 4, I_1 = DEPTH * NE * 16 * 32, I_2 = DEPTH * NE * 16 * 16;
    constexpr int NITEMS = I_IN + I_OUT + I_G + I_P + I_1 + I_2;
    for (int it = gw; it < NITEMS; it += ngw) {
        int r = it;
        if (r < I_IN) { const int l = r / 384, q = r % 384, kb = q / 24, nb = q % 24;
            transpose_tile(p.in[I_WIN] + (size_t)l * D * DIN + (size_t)(64 * kb) * DIN + 64 * nb, DIN, WINT + ((size_t)l * DIN + 64 * nb) * D + 64 * kb, D, scr, lane); continue; }
        r -= I_IN;
        if (r < I_OUT) { const int l = r / 256, q = r % 256, kb = q / 16, nb = q % 16;
            transpose_tile(p.in[I_WOUT] + (size_t)l * D * D + (size_t)(64 * kb) * D + 64 * nb, D, WOUTT + ((size_t)l * D + 64 * nb) * D + 64 * kb, D, scr, lane); continue; }
        r -= I_OUT;
        if (r < I_G) {
            const int h = r % NH, gt = (r / NH) % 2, d = (r / (NH * 2)) % 2, l = r / (NH * 4);
            const float* s = (gt ? p.in[I_GXW] : p.in[I_GAW]) + ((size_t)(l * 2 + d) * NH + h) * HD * HD;
            transpose_tile(s, HD, WGT + ((size_t)(l * NH + h) * 256 + (d * 2 + gt) * 64) * HD, HD, scr, lane); continue; }
        r -= I_G;
        if (r < I_P) {
            const int nb = r % 2, kb = (r / 2) % 2, lg = r / 4;
            transpose_tile(p.in[I_POOLW] + (size_t)lg * 128 * 128 + (size_t)(64 * kb) * 128 + 64 * nb, 128, WPT + ((size_t)lg * 128 + 64 * nb) * 128 + 64 * kb, 128, scr, lane); continue; }
        r -= I_P;
        if (r < I_1) {
            const int le = r / 512, q = r % 512, kb = q / 32, nb = q % 32;
            const int n0 = 64 * nb, j0 = n0 % DF, half = n0 / DF, row0 = (j0 / 128) * 256 + half * 128 + (j0 % 128);
            transpose_tile(p.in[I_W1] + (size_t)le * D * 2 * DF + (size_t)(64 * kb) * (2 * DF) + n0, 2 * DF, W1T + ((size_t)le * 2 * DF + row0) * D + 64 * kb, D, scr, lane); continue; }
        r -= I_1;
        { const int le = r / 256, q = r % 256, kb = q / 16, nb = q % 16;
          transpose_tile(p.in[I_W2] + (size_t)le * DF * D + (size_t)(64 * kb) * D + 64 * nb, D, W2T + ((size_t)le * D + 64 * nb) * DF + 64 * kb, DF, scr, lane); }
    }
}
namespace pg8 {
typedef short bf16x8 __attribute__((ext_vector_type(8)));
constexpr int BM = 256, BK = 64, HALF = 128, HTB = HALF * BK * 2, STAGE_BYTES = 8 * HTB;
__host__ __device__ __forceinline__ int lds_byte(int r, int c) { const int st = (r >> 4) * 2 + (c >> 5), rr = r & 15, cc = c & 31, ob = rr * 64 + cc * 2; return st * 1024 + (ob ^ (((ob >> 9) & 1) << 5)); }
__host__ __device__ __forceinline__ void stage_rc(int b, int& R, int& C) { const int st = b / 1024, sb = b % 1024, swz = sb ^ (((sb >> 9) & 1) << 5); R = (st >> 1) * 16 + swz / 64; C = (st & 1) * 32 + (swz % 64) / 2; }
__host__ __device__ __forceinline__ int perm32(int rho) { const int n = rho >> 4, i = rho & 15; return 8 * (i >> 2) + 4 * n + (i & 3); }
__device__ __forceinline__ unsigned cvt_pk_bf16(float lo, float hi) { unsigned r; asm volatile("v_cvt_pk_bf16_f32 %0, %1, %2" : "=v"(r) : "v"(lo), "v"(hi)); return r; }

struct Unit { int a0, nvalid, b0, o0, pn, e, g0; };

template <bool GATHER, class Sched, class Epi>
__device__ __forceinline__ void gemm_phase(LAS unsigned char* lds, int tid, const bf16* Abase_, const bf16* Bt_, const int* glist, const Sched& S, const Epi& E) {
    constexpr int K = 1024, nt = K / BK;
    const int wid = __builtin_amdgcn_readfirstlane(tid >> 6), lane = tid & 63, wr = wid >> 2, wc = wid & 3, fr = lane & 15, fq = lane >> 4;
    int Rr[2], Cc[2]; unsigned voffB[2];
#pragma unroll
    for (int i = 0; i < 2; ++i) { int R, C; stage_rc(tid * 16 + i * 8192, R, C); Rr[i] = R; Cc[i] = C; const int Rb = (R & ~31) + perm32(R & 31); voffB[i] = (unsigned)(Rb * K + C) * 2u; }
    constexpr size_t kstep = (size_t)(BK * 2);
    constexpr size_t hstep = (size_t)HALF * K * 2;
    const unsigned ldsw = (unsigned)wid * 1024u;
    const int aoff = lds_byte(wr * 64 + fr, fq * 8), boff = lds_byte(wc * 32 + fr, fq * 8);
    const char* Abase = (const char*)Abase_;
#define PG8_SA(b, h) (((b) * 2 + (h)) * HTB)
#define PG8_SB(b, h) ((4 + (b) * 2 + (h)) * HTB)
#define PG8_STAGE_B(bufoff, gbase) do { _Pragma("unroll") for (int _i = 0; _i < 2; ++_i) \
        __builtin_amdgcn_global_load_lds((const unsigned*)((const char*)(gbase) + voffB[_i]), (LAS unsigned*)(lds + (bufoff) + ldsw + _i * 8192), 16, 0, 0); } while (0)
#define PG8_STAGE_A(bufoff, gbase, o0_, o1_) do { \
        __builtin_amdgcn_global_load_lds((const unsigned*)((const char*)(gbase) + (o0_)), (LAS unsigned*)(lds + (bufoff) + ldsw), 16, 0, 0); \
        __builtin_amdgcn_global_load_lds((const unsigned*)((const char*)(gbase) + (o1_)), (LAS unsigned*)(lds + (bufoff) + ldsw + 8192), 16, 0, 0); } while (0)
#define PG8_LDA(dst, b, h) do { _Pragma("unroll") for (int m = 0; m < 4; ++m) _Pragma("unroll") for (int k = 0; k < 2; ++k) dst[m][k] = *(const LAS bf16x8*)(lds + PG8_SA(b, h) + aoff + m * 2048 + k * 1024); } while (0)
#define PG8_LDB(dst, b, h) do { _Pragma("unroll") for (int n = 0; n < 2; ++n) _Pragma("unroll") for (int k = 0; k < 2; ++k) dst[n][k] = *(const LAS bf16x8*)(lds + PG8_SB(b, h) + boff + n * 2048 + k * 1024); } while (0)
#define PG8_MMA(ai, bj, At, Bt) do { __builtin_amdgcn_s_setprio(1); _Pragma("unroll") for (int m = 0; m < 4; ++m) _Pragma("unroll") for (int n = 0; n < 2; ++n) _Pragma("unroll") for (int k = 0; k < 2; ++k) \
        acc[ai][bj][m][n] = __builtin_amdgcn_mfma_f32_16x16x32_bf16(Bt[n][k], At[m][k], acc[ai][bj][m][n], 0, 0, 0); __builtin_amdgcn_s_setprio(0); } while (0)
#define PG8_WAIT_V(n) asm volatile("s_waitcnt vmcnt(" #n ")" ::: "memory")
#define PG8_WAIT_L(n) asm volatile("s_waitcnt lgkmcnt(" #n ")" ::: "memory")
#define PG8_BAR __builtin_amdgcn_s_barrier()
#define PG8_SCHED __builtin_amdgcn_sched_barrier(0)
#define PG8_AOFFS(u, ao) do { _Pragma("unroll") for (int _h = 0; _h < 2; ++_h) _Pragma("unroll") for (int _i = 0; _i < 2; ++_i) { \
        const int _r = _h * HALF + Rr[_i]; int _row; \
        if (GATHER) { _row = (_r < (u).nvalid) ? glist[(u).a0 + _r] : 0; } else { _row = (u).a0 + _r; } \
        ao[_h][_i] = (unsigned)(_row * K + Cc[_i]) * 2u; } } while (0)
    Unit cur, nxt; int ui = 0;
    if (!S.next(0, cur)) return;
    f32x4 acc[2][2][4][2];
#pragma unroll
    for (int a = 0; a < 2; ++a)
#pragma unroll
        for (int b = 0; b < 2; ++b)
#pragma unroll
            for (int m = 0; m < 4; ++m)
#pragma unroll
                for (int n = 0; n < 2; ++n) acc[a][b][m][n] = (f32x4){0.f, 0.f, 0.f, 0.f};
    bf16x8 At[4][2], B0[2][2], B1[2][2];
    unsigned ao[2][2], nao[2][2];
    PG8_AOFFS(cur, ao);
    const char* cB = (const char*)Bt_ + (size_t)cur.b0 * (K * 2);
    PG8_STAGE_B(PG8_SB(0, 0), cB); PG8_STAGE_B(PG8_SB(0, 1), cB + hstep); PG8_STAGE_A(PG8_SA(0, 0), Abase, ao[0][0], ao[0][1]); PG8_STAGE_A(PG8_SA(0, 1), Abase, ao[1][0], ao[1][1]);
    if (wr == 1) PG8_BAR;
    PG8_WAIT_V(2); PG8_BAR;
    PG8_STAGE_B(PG8_SB(1, 0), cB + kstep); PG8_STAGE_A(PG8_SA(1, 0), Abase + kstep, ao[0][0], ao[0][1]); PG8_STAGE_B(PG8_SB(1, 1), cB + hstep + kstep);
    PG8_WAIT_V(6); PG8_BAR;
    for (;;) {
        const bool has_next = S.next(ui + 1, nxt);
        if (has_next) { PG8_AOFFS(nxt, nao); } else {
#pragma unroll
            for (int h = 0; h < 2; ++h)
#pragma unroll
                for (int i = 0; i < 2; ++i) nao[h][i] = ao[h][i]; }
        const char* nB = has_next ? (const char*)Bt_ + (size_t)nxt.b0 * (K * 2) : cB;
        for (int t = 0; t < nt; t += 2) {
            const bool last = (t == nt - 2);
            const char* a1 = Abase + (size_t)(t + 1) * kstep;
            const char* a2 = last ? Abase : Abase + (size_t)(t + 2) * kstep; const char* b2 = last ? nB : cB + (size_t)(t + 2) * kstep;
            const char* a3 = a2 + kstep; const char* b3 = b2 + kstep;
            const unsigned x00 = last ? nao[0][0] : ao[0][0], x01 = last ? nao[0][1] : ao[0][1], x10 = last ? nao[1][0] : ao[1][0], x11 = last ? nao[1][1] : ao[1][1];
            PG8_LDB(B0, 0, 0); PG8_LDB(B1, 0, 1); PG8_SCHED; PG8_LDA(At, 0, 0); PG8_STAGE_A(PG8_SA(1, 1), a1, ao[1][0], ao[1][1]);
            PG8_WAIT_V(8); PG8_WAIT_L(0); PG8_BAR; PG8_MMA(0, 0, At, B0); PG8_MMA(0, 1, At, B1); PG8_BAR; PG8_SCHED;
            PG8_LDA(At, 0, 1); PG8_STAGE_B(PG8_SB(0, 0), b2); PG8_STAGE_B(PG8_SB(0, 1), b2 + hstep); PG8_STAGE_A(PG8_SA(0, 0), a2, x00, x01);
            PG8_WAIT_V(8); PG8_WAIT_L(0); PG8_BAR; PG8_MMA(1, 0, At, B0); PG8_MMA(1, 1, At, B1); PG8_BAR; PG8_SCHED;
            PG8_LDB(B0, 1, 0); PG8_LDB(B1, 1, 1); PG8_SCHED; PG8_LDA(At, 1, 0); PG8_STAGE_A(PG8_SA(0, 1), a2, x10, x11);
            PG8_WAIT_V(8); PG8_WAIT_L(0); PG8_BAR; PG8_MMA(0, 0, At, B0); PG8_MMA(0, 1, At, B1); PG8_BAR; PG8_SCHED;
            PG8_LDA(At, 1, 1); PG8_STAGE_B(PG8_SB(1, 0), b3); PG8_STAGE_B(PG8_SB(1, 1), b3 + hstep); PG8_STAGE_A(PG8_SA(1, 0), a3, x00, x01);
            PG8_WAIT_V(8); PG8_WAIT_L(0); PG8_BAR; PG8_MMA(1, 0, At, B0); PG8_MMA(1, 1, At, B1); PG8_BAR; PG8_SCHED;
        }
        if (wr == 0) PG8_BAR;
        E(acc, cur, wr, wc, fr, fq);
        if (!has_next) break;
#pragma unroll
        for (int a = 0; a < 2; ++a)
#pragma unroll
            for (int b = 0; b < 2; ++b)
#pragma unroll
                for (int m = 0; m < 4; ++m)
#pragma unroll
                    for (int n = 0; n < 2; ++n) acc[a][b][m][n] = (f32x4){0.f, 0.f, 0.f, 0.f};
        cur = nxt; cB = nB; ++ui;
#pragma unroll
        for (int h = 0; h < 2; ++h)
#pragma unroll
            for (int i = 0; i < 2; ++i) ao[h][i] = nao[h][i];
        if (wr == 1) PG8_BAR;
    }
    PG8_WAIT_V(0);
    PG8_BAR;
#undef PG8_SA
#undef PG8_SB
#undef PG8_STAGE_A
#undef PG8_STAGE_B
#undef PG8_LDA
#undef PG8_LDB
#undef PG8_MMA
#undef PG8_WAIT_V
#undef PG8_WAIT_L
#undef PG8_BAR
#undef PG8_SCHED
#undef PG8_AOFFS
}

struct DenseOrder {
    int nM, nN, nwg, G, c;
    __device__ void init(int nM_, int nN_, int G_, int c_) { nM = nM_; nN = nN_; nwg = nM * nN; G = G_; c = c_; }
    __device__ bool next(int i, Unit& u) const {
        const long L = (long)i * G + c; if (L >= nwg) return false;
        int wgid = (int)L; { const int q = nwg / 8, r = nwg % 8, xcd = wgid % 8, off = wgid / 8; wgid = (xcd < r ? xcd * (q + 1) : r * (q + 1) + (xcd - r) * q) + off; }
        const int nig = 8 * nN, gid = wgid / nig, fm = gid * 8, gsz = (nM - fm) < 8 ? (nM - fm) : 8;
        const int pm = fm + ((wgid % nig) % gsz), pn = (wgid % nig) / gsz;
        u.a0 = pm * 256; u.nvalid = 256; u.b0 = pn * 256; u.o0 = pm * 256; u.pn = pn; u.e = 0; u.g0 = 0; return true;
    }
};
template <int NPN, bool UP> struct MoeOrder {
    const LAS int* tb; const int* cnt; int G, c;
    __device__ bool next(int i, Unit& u) const {
        const int L = i * G + c; const int total = tb[32] * NPN; if (L >= total) return false;
        int e = 0;
#pragma unroll 1
        for (int q = 16; q >= 1; q >>= 1) if (tb[e + q] * NPN <= L) e += q;
        const int te = tb[e + 1] - tb[e], j = L - tb[e] * NPN, pn = j / te, mt = j % te;
        const int ce = cnt[e];
        u.e = e; u.pn = pn; u.o0 = (tb[e] + mt) * 256; u.nvalid = min(256, ce - mt * 256);
        u.g0 = e * TT + mt * 256;
        u.a0 = UP ? u.g0 : u.o0;
        u.b0 = e * (UP ? 2 * DF : D) + pn * 256;
        return true;
    }
};

struct EpiStore {
    bf16* C; int ldc;
    __device__ __forceinline__ void operator()(const f32x4 (&acc)[2][2][4][2], const Unit& u, int wr, int wc, int fr, int fq) const {
        const int row0 = u.o0 + wr * 64 + fr, col0 = u.pn * 256 + wc * 32 + 8 * fq;
#pragma unroll
        for (int ai = 0; ai < 2; ++ai)
#pragma unroll
            for (int m = 0; m < 4; ++m) { bf16* rowp = C + (size_t)(row0 + ai * HALF + m * 16) * ldc + col0;
#pragma unroll
                for (int bj = 0; bj < 2; ++bj) { const f32x4 v0 = acc[ai][bj][m][0], v1 = acc[ai][bj][m][1];
                    u32x4 w; w.x = cvt_pk_bf16(v0[0], v0[1]); w.y = cvt_pk_bf16(v0[2], v0[3]); w.z = cvt_pk_bf16(v1[0], v1[1]); w.w = cvt_pk_bf16(v1[2], v1[3]);
                    *(u32x4*)(rowp + bj * HALF) = w; } }
    }
};
struct EpiSwiglu {
    bf16* C; const float* b1;
    __device__ __forceinline__ void operator()(const f32x4 (&acc)[2][2][4][2], const Unit& u, int wr, int wc, int fr, int fq) const {
        const int row0 = u.o0 + wr * 64 + fr, j0 = u.pn * 128 + wc * 32 + 8 * fq;
        const float* bb = b1 + (size_t)u.e * 2 * DF + j0;
        const f32x4 bg0 = *(const f32x4*)bb, bg1 = *(const f32x4*)(bb + 4), bl0 = *(const f32x4*)(bb + DF), bl1 = *(const f32x4*)(bb + DF + 4);
#pragma unroll
        for (int ai = 0; ai < 2; ++ai)
#pragma unroll
            for (int m = 0; m < 4; ++m) {
                float o[8];
#pragma unroll
                for (int n = 0; n < 2; ++n)
#pragma unroll
                    for (int q = 0; q < 4; ++q) {
                        const float gl = fminf(acc[ai][0][m][n][q] + (n ? bg1[q] : bg0[q]), 7.0f);
                        const float li = fminf(fmaxf(acc[ai][1][m][n][q] + (n ? bl1[q] : bl0[q]), -7.0f), 7.0f);
                        o[4 * n + q] = gl * __builtin_amdgcn_rcpf(1.0f + __expf(-1.702f * gl)) * (li + 1.0f);
                    }
                u32x4 w; w.x = cvt_pk_bf16(o[0], o[1]); w.y = cvt_pk_bf16(o[2], o[3]); w.z = cvt_pk_bf16(o[4], o[5]); w.w = cvt_pk_bf16(o[6], o[7]);
                *(u32x4*)(C + (size_t)(row0 + ai * HALF + m * 16) * DF + j0) = w;
            }
    }
};
struct EpiDown {
    bf16* C; const float* b2; const float* rowgate;
    __device__ __forceinline__ void operator()(const f32x4 (&acc)[2][2][4][2], const Unit& u, int wr, int wc, int fr, int fq) const {
        const int rt0 = wr * 64 + fr, col0 = u.pn * 256 + wc * 32 + 8 * fq;
#pragma unroll
        for (int ai = 0; ai < 2; ++ai) {
            float gt[4];
#pragma unroll
            for (int m = 0; m < 4; ++m) { const int rt = rt0 + ai * HALF + m * 16; gt[m] = (rt < u.nvalid) ? rowgate[u.g0 + rt] : 0.f; }
#pragma unroll
            for (int bj = 0; bj < 2; ++bj) {
                const f32x4 bv0 = *(const f32x4*)(b2 + (size_t)u.e * D + col0 + bj * HALF), bv1 = *(const f32x4*)(b2 + (size_t)u.e * D + col0 + bj * HALF + 4);
#pragma unroll
                for (int m = 0; m < 4; ++m) {
                    const int rt = rt0 + ai * HALF + m * 16;
                    const f32x4 v0 = (acc[ai][bj][m][0] + bv0) * gt[m], v1 = (acc[ai][bj][m][1] + bv1) * gt[m];
                    u32x4 w; w.x = cvt_pk_bf16(v0[0], v0[1]); w.y = cvt_pk_bf16(v0[2], v0[3]); w.z = cvt_pk_bf16(v1[0], v1[1]); w.w = cvt_pk_bf16(v1[2], v1[3]);
                    *(u32x4*)(C + (size_t)(u.o0 + rt) * D + col0 + bj * HALF) = w;
                }
            }
            asm volatile("" ::: "memory");
        }
    }
};
}

#define XB_TMO      128
#define XB_XCNT(j)  (256  + 64 * (j))
#define XB_XSUB(j)  (1280 + 64 * (j))
#define XB_XGEN(j)  (2304 + 64 * (j))
#define XB_TOP      3328
#define XB_TOPGEN   3392
#define XCD_BAR_WORDS 3456
#define XB_SPIN_CAP (1u << 18)
__device__ __forceinline__ unsigned xb_ld(unsigned* p)              { return __hip_atomic_load(p, __ATOMIC_RELAXED, __HIP_MEMORY_SCOPE_AGENT); }
__device__ __forceinline__ unsigned xb_add(unsigned* p, unsigned v) { return __hip_atomic_fetch_add(p, v, __ATOMIC_RELAXED, __HIP_MEMORY_SCOPE_AGENT); }
__device__ __forceinline__ unsigned xb_xcc_id() { return (unsigned)__builtin_amdgcn_s_getreg((3 << 11) | 20) & 0xFu; }
#define XB_SPIN(cond, bar) do { unsigned _sp = 0; while (cond) { __builtin_amdgcn_s_sleep(1); \
    if ((++_sp & 255u) == 0u) { if (xb_ld(&(bar)[XB_TMO])) break; if (_sp > XB_SPIN_CAP) { atomicAdd(&(bar)[XB_TMO], 1u); break; } } } } while (0)
struct XcdBarrier { unsigned* bar; unsigned x; volatile LAS unsigned* st; };
__device__ __forceinline__ XcdBarrier xcd_barrier_post(unsigned* bar, volatile LAS unsigned* st) {
    XcdBarrier b; b.bar = bar; b.x = xb_xcc_id(); b.st = st;
    if (threadIdx.x == 0) (void)xb_add(&bar[XB_XCNT(b.x)], 1u);
    return b;
}
__device__ __forceinline__ void xcd_barrier_complete(unsigned* bar, unsigned x, unsigned& nloc, unsigned& nx) {
    const unsigned G = gridDim.x * gridDim.y * gridDim.z;
    unsigned sum, cnt, mine, sp = 0u;
    for (;;) {
        sum = 0u; cnt = 0u; mine = 0u;
#pragma unroll
        for (unsigned j = 0; j < 16; ++j) { const unsigned c = xb_ld(&bar[XB_XCNT(j)]); sum += c; cnt += (c > 0u) ? 1u : 0u; mine = (j == x) ? c : mine; }
        if (sum == G) break;
        __builtin_amdgcn_s_sleep(1);
        if ((++sp & 255u) == 0u) { if (xb_ld(&bar[XB_TMO])) break; if (sp > XB_SPIN_CAP) { atomicAdd(&bar[XB_TMO], 1u); break; } }
    }
    nloc = mine > 0u ? mine : 1u; nx = cnt > 0u ? cnt : 1u;
}
__device__ __forceinline__ void xcd_barrier(const XcdBarrier& b) {
    asm volatile("s_waitcnt vmcnt(0)" ::: "memory");
    __syncthreads();
    if (threadIdx.x == 0) {
        unsigned* bar = b.bar;
        __builtin_amdgcn_s_waitcnt(0);
        unsigned nloc = b.st[0], nx = b.st[1];
        if (nloc == 0u) { xcd_barrier_complete(bar, b.x, nloc, nx); b.st[0] = nloc; b.st[1] = nx; }
        const unsigned old = xb_add(&bar[XB_XSUB(b.x)], 1u);
        const unsigned gen = old / nloc;
        if (old + 1u == (gen + 1u) * nloc) {
            __builtin_amdgcn_fence(__ATOMIC_RELEASE, "agent");
            asm volatile("s_waitcnt vmcnt(0)" ::: "memory");
            const unsigned og = xb_add(&bar[XB_TOP], 1u);
            const unsigned tg = og / nx;
            if (og + 1u == (tg + 1u) * nx) xb_add(&bar[XB_TOPGEN], 1u);
            else XB_SPIN(xb_ld(&bar[XB_TOPGEN]) == tg, bar);
            __builtin_amdgcn_fence(__ATOMIC_ACQUIRE, "agent");
            xb_add(&bar[XB_XGEN(b.x)], 1u);
            asm volatile("s_waitcnt vmcnt(0)" ::: "memory");
        } else {
            XB_SPIN(xb_ld(&bar[XB_XGEN(b.x)]) == gen, bar);
            __builtin_amdgcn_fence(__ATOMIC_ACQUIRE, "agent");
            asm volatile("s_waitcnt vmcnt(0)" ::: "memory");
        }
    }
    __syncthreads();
}

constexpr int LDS_BYTES = 147456;
constexpr int LDS_TB = 131072;
constexpr int LDS_MISC = 131072 + 1024;

__device__ __forceinline__ void phase_p0a(const P& p, LAS unsigned char* lds, int bid, int G, int tid, int wave, int lane) {
    { float* POS = (float*)(p.ws + WS_POS);
      for (int i = bid * 512 + tid; i < 64 * 512; i += G * 512) {
          const int n = i / 512, j = i % 512, q = j % 256;
          const float omega = 1.0f / powf(10000.0f, (float)q / 256.0f);
          const float ang = (float)n * omega;
          POS[i] = j < 256 ? sinf(ang) : cosf(ang);
      } }
    { bf16* RWT = (bf16*)(p.ws + WS_RWT);
      for (int i = bid * 512 + tid; i < DEPTH * NE * 128; i += G * 512) {
          const int kc = i % 128, e = (i / 128) % NE, l = i / (128 * NE);
          const float* s = p.in[I_RW] + (size_t)l * D * NE + (size_t)(8 * kc) * NE + e;
          u32x4 o; o.x = pk2(s[0], s[NE]); o.y = pk2(s[2 * NE], s[3 * NE]); o.z = pk2(s[4 * NE], s[5 * NE]); o.w = pk2(s[6 * NE], s[7 * NE]);
          *(u32x4*)(RWT + ((size_t)l * NE + e) * D + 8 * kc) = o;
      } }
    { float* SP = (float*)(p.ws + WS_SP);
      const int gt = bid * 512 + tid, gn = G * 512;
      for (int l = 0; l < DEPTH; ++l) {
          float* o = SP + (size_t)l * SP_STRIDE;
          for (int i = gt; i < 2048; i += gn) o[SP_CW + i] = p.in[I_CONVW][(size_t)l * 2048 + i];
          for (int i = gt; i < 512; i += gn) { o[SP_CB + i] = p.in[I_CONVB][(size_t)l * 512 + i]; o[SP_PB + i] = p.in[I_POOLB][(size_t)l * 512 + i]; o[SP_PS + i] = p.in[I_POOLS][(size_t)l * 512 + i]; }
          for (int i = gt; i < 1024; i += gn) { o[SP_GAB + i] = p.in[I_GAB][(size_t)l * 1024 + i]; o[SP_GXB + i] = p.in[I_GXB][(size_t)l * 1024 + i];
              const float nl = -p.in[I_LAM][(size_t)l * 1024 + i]; o[SP_CC + i] = 8.0f * (nl > 20.f ? nl : log1pf(expf(nl)));
              o[SP_L1G + i] = p.in[I_LN1G][(size_t)l * 1024 + i]; o[SP_L1B + i] = p.in[I_LN1B][(size_t)l * 1024 + i];
              o[SP_L2G + i] = p.in[I_LN2G][(size_t)l * 1024 + i]; o[SP_L2B + i] = p.in[I_LN2B][(size_t)l * 1024 + i]; }
          for (int i = gt; i < 32; i += gn) o[SP_RB + i] = p.in[I_RB][(size_t)l * 32 + i];
          for (int i = gt; i < 32 * 2048; i += gn) o[SP_B1 + i] = p.in[I_B1][(size_t)l * 32 * 2048 + i];
          for (int i = gt; i < 32 * 1024; i += gn) o[SP_B2 + i] = p.in[I_B2][(size_t)l * 32 * 1024 + i];
      } }
    { LAS float* sl = (LAS float*)lds; LAS float* part = sl + 9 * 1024;
      const float* c = p.in[I_C]; const float* cc = p.in[I_CCTX];
      for (int i = tid; i < 9 * 1024; i += 512) { const float v = i < 8192 ? c[i] : cc[i - 8192]; sl[i] = v / (1.0f + __expf(-v)); }
      __syncthreads();
      float* MOD = (float*)(p.ws + WS_MOD);
      for (int u = bid; u < 2 * 192; u += G) {
          const int l = u / 192, n0 = (u % 192) * 32;
          const float* W = p.in[I_WMOD] + (size_t)l * 1024 * 6144;
          const int col = tid & 31, ks = tid >> 5;
          float acc[9];
#pragma unroll
          for (int r = 0; r < 9; ++r) acc[r] = 0.f;
#pragma unroll 8
          for (int kk = 0; kk < 64; ++kk) {
              const int k = ks * 64 + kk;
              const float w = W[(size_t)k * 6144 + n0 + col];
#pragma unroll
              for (int r = 0; r < 9; ++r) acc[r] += sl[r * 1024 + k] * w;
          }
#pragma unroll
          for (int r = 0; r < 9; ++r) part[(ks * 9 + r) * 32 + col] = acc[r];
          __syncthreads();
          if (tid < 9 * 32) {
              const int r = tid / 32, cl = tid % 32; float s = 0.f;
#pragma unroll
              for (int q = 0; q < 16; ++q) s += part[(q * 9 + r) * 32 + cl];
              MOD[((size_t)l * 9 + r) * 6144 + n0 + cl] = s + p.in[I_BMOD][(size_t)l * 6144 + n0 + cl];
          }
          __syncthreads();
      } }
    __syncthreads();
    convert_weights(p, lds, bid * 8 + wave, G * 8, wave, lane);
}

__device__ __forceinline__ void phase_entry(const P& p, int gw, int ngw, int lane) {
    const float* POS = (const float*)(p.ws + WS_POS);
    const float* MOD = (const float*)(p.ws + WS_MOD);
    float* XL = (float*)(p.ws + WS_XL); bf16* H = (bf16*)(p.ws + WS_H);
    for (int tok = gw; tok < TT; tok += ngw) {
        const float* src = tok < TL ? p.in[I_X] + (size_t)tok * D : p.in[I_CTX] + (size_t)(tok - TL) * D;
        f32x4 v[4];
#pragma unroll
        for (int j = 0; j < 4; ++j) v[j] = ((const f32x4*)src)[lane + 64 * j];
        if (tok < TL) {
            const int s = tok & (SEQ - 1), pr = s / GRIDW, pc = s % GRIDW;
#pragma unroll
            for (int j = 0; j < 4; ++j) {
                const float* ps = POS + (size_t)(j < 2 ? pr : pc) * 512 + (4 * lane + 256 * (j & 1));
                v[j] += *(const f32x4*)ps;
            }
        }
        float mean, rstd; ln_stats(v, mean, rstd);
        const float* m = MOD + (size_t)mod_row(tok) * 6144;
        f32x4 h[4];
#pragma unroll
        for (int j = 0; j < 4; ++j) {
            v[j] = (v[j] - mean) * rstd;
            ((f32x4*)(XL + (size_t)tok * D))[lane + 64 * j] = v[j];
            const f32x4 sh = ((const f32x4*)m)[lane + 64 * j], sc = ((const f32x4*)(m + 1024))[lane + 64 * j];
            h[j] = v[j] * (sc + 1.0f) + sh;
        }
        store_bf16_row(H + (size_t)tok * D, lane, h);
    }
}

__device__ __forceinline__ float one_minus_exp_neg(float y) {
    const float s = y * (1.0f + y * (-0.5f + y * (0.16666667f + y * (-0.041666667f + y * (0.0083333333f - y * 0.0013888889f)))));
    const float d = 1.0f - __expf(-y);
    return y < 0.25f ? s : d;
}
template <bool FINAL>
__device__ __forceinline__ void lru_unit(unsigned char* ws, int l, LAS unsigned char* lds, int b, int grp, int h, int cb, int wave, int lane) {
    asm volatile("" : "+s"(wave)); asm volatile("" : "+v"(lane));
    const bf16* Z = (const bf16*)(ws + WS_Z);
    const int r = lane & 31, hh = lane >> 5;
    int seqbase, len, t0;
    if (grp == 0) { seqbase = TL + b * CTXL; len = CTXL; t0 = wave * 32; } else { seqbase = b * SEQ; len = SEQ; t0 = (grp - 1) * 256 + wave * 32; }
    const int t = t0 + r;
    const float* SP = (const float*)(ws + WS_SP) + (size_t)l * SP_STRIDE;
    const float* cw = SP + SP_CW; const float* cbias = SP + SP_CB;
    bf16x8 Af[4];
#pragma unroll
    for (int s = 0; s < 4; ++s) {
        const int c0 = 64 * h + 16 * s + 8 * hh;
        const f32x4 b0 = *(const f32x4*)(cbias + c0), b1 = *(const f32x4*)(cbias + c0 + 4);
        float u[8] = {b0.x, b0.y, b0.z, b0.w, b1.x, b1.y, b1.z, b1.w};
#pragma unroll
        for (int k = 0; k < 4; ++k) {
            const int tt = t + k - 2;
            u32x4 raw = (u32x4){0u, 0u, 0u, 0u};
            if (tt >= 0 && tt < len) raw = *(const u32x4*)(Z + (size_t)(seqbase + tt) * DIN + c0);
            const f32x4 w0 = *(const f32x4*)(cw + k * DLRU + c0), w1 = *(const f32x4*)(cw + k * DLRU + c0 + 4);
            u[0] += w0.x * bflo(raw.x); u[1] += w0.y * bfhi(raw.x); u[2] += w0.z * bflo(raw.y); u[3] += w0.w * bfhi(raw.y);
            u[4] += w1.x * bflo(raw.z); u[5] += w1.y * bfhi(raw.z); u[6] += w1.z * bflo(raw.w); u[7] += w1.w * bfhi(raw.w);
        }
        u32x4 pk; pk.x = pk2(u[0], u[1]); pk.y = pk2(u[2], u[3]); pk.z = pk2(u[4], u[5]); pk.w = pk2(u[6], u[7]);
        Af[s] = __builtin_bit_cast(bf16x8, pk);
        asm volatile("" ::: "memory");
    }
    const bf16* WG = (const bf16*)(ws + WS_WG) + (size_t)(l * NH + h) * 256 * HD;
    f32x16 accu;
#pragma unroll
    for (int i = 0; i < 16; ++i) accu[i] = 0.f;
    { const int nn = 32 * cb + r;
#pragma unroll
      for (int s = 0; s < 4; ++s) {
          u32x4 w = (u32x4){0u, 0u, 0u, 0u};
          if ((nn >> 4) == s && ((nn >> 3) & 1) == hh) { const unsigned one = 0x3F80u << (16 * (nn & 1)); const int wi = (nn & 7) >> 1;
              w.x = wi == 0 ? one : 0u; w.y = wi == 1 ? one : 0u; w.z = wi == 2 ? one : 0u; w.w = wi == 3 ? one : 0u; }
          accu = __builtin_amdgcn_mfma_f32_32x32x16_bf16(Af[s], __builtin_bit_cast(bf16x8, w), accu, 0, 0, 0);
      } }
    const int ch = 64 * h + 32 * cb + r;
    float C0 = 0.f, C1 = 0.f;
    if (FINAL) {
        const f32x2* AGGT = (const f32x2*)(ws + WS_AGGT); const f32x2* AGGG = (const f32x2*)(ws + WS_AGGG);
        float c = 0.f;
        const int d = hh;
        if (grp > 0) {
            { const f32x2 g0 = AGGG[((size_t)(b * NGRP + 0) * 2 + d) * DLRU + ch]; c = g0.y; }
            f32x2 gv[7];
#pragma unroll
            for (int i = 0; i < 7; ++i) { const int g = d ? 8 - i : 1 + i; const bool valid = d ? (i < 8 - grp) : (i < grp - 1);
                gv[i] = valid ? AGGG[((size_t)(b * NGRP + g) * 2 + d) * DLRU + ch] : (f32x2){1.f, 0.f}; }
#pragma unroll
            for (int i = 0; i < 7; ++i) c = gv[i].x * c + gv[i].y;
        }
        f32x2 tv[7];
#pragma unroll
        for (int i = 0; i < 7; ++i) { const int tw = d ? 7 - i : i; const bool valid = d ? (i < 7 - wave) : (i < wave);
            tv[i] = valid ? AGGT[((size_t)(b * NTILE + grp * 8 + tw) * 2 + d) * DLRU + ch] : (f32x2){1.f, 0.f}; }
#pragma unroll
        for (int i = 0; i < 7; ++i) c = tv[i].x * c + tv[i].y;
        C0 = __shfl(c, r); C1 = __shfl(c, 32 + r);
        asm volatile("" ::: "memory");
    }
    float hsum[16];
    float aggP[2], aggH[2];
#pragma unroll
    for (int d = 0; d < 2; ++d) {
        f32x16 ar, ai;
#pragma unroll
        for (int i = 0; i < 16; ++i) { ar[i] = 0.f; ai[i] = 0.f; }
        { const bf16* wr_ = WG + (size_t)((2 * d) * 64 + 32 * cb + r) * HD + 8 * hh; const bf16* wi_ = wr_ + 64 * HD;
#pragma unroll
          for (int s = 0; s < 4; ++s) { const bf16x8 Bf = *(const bf16x8*)(wr_ + 16 * s); ar = __builtin_amdgcn_mfma_f32_32x32x16_bf16(Af[s], Bf, ar, 0, 0, 0); }
#pragma unroll
          for (int s = 0; s < 4; ++s) { const bf16x8 Bf = *(const bf16x8*)(wi_ + 16 * s); ai = __builtin_amdgcn_mfma_f32_32x32x16_bf16(Af[s], Bf, ai, 0, 0, 0); } }
        const float ba = SP[SP_GAB + d * DLRU + ch], bx = SP[SP_GXB + d * DLRU + ch], cc = SP[SP_CC + d * DLRU + ch];
        float oP[4], oH[4];
#pragma unroll
        for (int q = 0; q < 4; ++q) {
#pragma unroll
            for (int j = 0; j < 4; ++j) { const int i = 4 * q + j;
                const float rr = fsigmoid(ar[i] + ba), ig = fsigmoid(ai[i] + bx);
                const float y = cc * rr;
                ar[i] = __expf(-y);
                ai[i] = sqrtf(one_minus_exp_neg(2.0f * y)) * (ig * accu[i]);
            }
            float Pp = 1.f, Hh = 0.f;
#pragma unroll
            for (int jj = 0; jj < 4; ++jj) { const int j = d ? 3 - jj : jj; Hh = ar[4 * q + j] * Hh + ai[4 * q + j]; Pp *= ar[4 * q + j]; }
            oP[q] = Pp; oH[q] = Hh;
            __builtin_amdgcn_sched_barrier(0);
        }
        float eP[4], eH[4], xP[4], xH[4];
#pragma unroll
        for (int q = 0; q < 4; ++q) { const float pP = __shfl_xor(oP[q], 32), pH = __shfl_xor(oH[q], 32);
            eP[q] = hh ? pP : oP[q]; eH[q] = hh ? pH : oH[q]; xP[q] = hh ? oP[q] : pP; xH[q] = hh ? oH[q] : pH; }
        float c = d ? C1 : C0, pall = 1.f;
        float mine[4];
        if (d == 0) {
#pragma unroll
            for (int q = 0; q < 4; ++q) { const float cE = c; c = eP[q] * c + eH[q]; const float cO = c; c = xP[q] * c + xH[q]; mine[q] = hh ? cO : cE; pall *= eP[q] * xP[q]; }
        } else {
#pragma unroll
            for (int q = 3; q >= 0; --q) { const float cO = c; c = xP[q] * c + xH[q]; const float cE = c; c = eP[q] * c + eH[q]; mine[q] = hh ? cO : cE; pall *= eP[q] * xP[q]; }
        }
        aggP[d] = pall; aggH[d] = c;
        if (FINAL) {
#pragma unroll
            for (int q = 0; q < 4; ++q) { float Hh = mine[q];
#pragma unroll
                for (int jj = 0; jj < 4; ++jj) { const int j = d ? 3 - jj : jj; Hh = ar[4 * q + j] * Hh + ai[4 * q + j]; if (d == 0) hsum[4 * q + j] = Hh; else hsum[4 * q + j] += Hh; } }
        }
        __builtin_amdgcn_sched_barrier(0);
    }
    if (!FINAL) {
        f32x2* AT = (f32x2*)(ws + WS_AGGT); f32x2* AG = (f32x2*)(ws + WS_AGGG);
        LAS f32x2* la = (LAS f32x2*)lds;
        if (hh == 0) {
#pragma unroll
            for (int d = 0; d < 2; ++d) { const f32x2 v = (f32x2){aggP[d], aggH[d]};
                AT[((size_t)(b * NTILE + grp * 8 + wave) * 2 + d) * DLRU + ch] = v; la[(wave * 2 + d) * 32 + r] = v; }
        }
        __syncthreads();
        if (wave == 0) {
            const int d = hh; float Pp = 1.f, Hh = 0.f;
#pragma unroll
            for (int i = 0; i < 8; ++i) { const int w = d ? 7 - i : i; const f32x2 v = la[(w * 2 + d) * 32 + r]; Hh = v.x * Hh + v.y; Pp *= v.x; }
            AG[((size_t)(b * NGRP + grp) * 2 + d) * DLRU + ch] = (f32x2){Pp, Hh};
        }
        __syncthreads();
    } else {
        bf16* MIX = (bf16*)(ws + WS_MIX);
#pragma unroll
        for (int i = 0; i < 16; ++i) {
            const int row = (i & 3) + 8 * (i >> 2) + 4 * hh;
            const size_t tok = (size_t)(seqbase + t0 + row);
            const float y = bf2f(Z[tok * DIN + DLRU + ch]);
            MIX[tok * D + ch] = (bf16)f2bf(hsum[i] * gelu_tanh(y));
        }
    }
}

constexpr int PX_PITCH = 528, PD_PITCH = 528;
constexpr int PX_OFF = 0, PD_OFF = 80 * PX_PITCH;
__device__ __forceinline__ void pool_unit(unsigned char* ws, int l, LAS unsigned char* lds, int c, int gp, int tid, int wave, int lane) {
    asm volatile("" : "+s"(wave)); asm volatile("" : "+v"(lane)); asm volatile("" : "+v"(tid));
    const bf16* Z = (const bf16*)(ws + WS_Z); bf16* MIX = (bf16*)(ws + WS_MIX);
    int seqbase, t0, seg_lo, seg_hi;
    if (c < 256) { seqbase = (c >> 5) * SEQ; t0 = (c & 31) * 64; seg_lo = t0; seg_hi = t0 + 64; }
    else { const int cc = c - 256; seqbase = TL + (cc >> 2) * CTXL; t0 = (cc & 3) * 64; seg_lo = 0; seg_hi = CTXL; }
    const int r_lo = max(t0 - 8, seg_lo), r_hi = min(t0 + 72, seg_hi);
    { const int sub = tid >> 5, l32 = tid & 31;
      for (int t = r_lo + sub; t < r_hi; t += 16) {
          const u32x4 v = *(const u32x4*)(Z + (size_t)(seqbase + t) * DIN + 2 * DLRU + 256 * gp + 8 * l32);
          *(LAS u32x4*)(lds + PX_OFF + (t - (t0 - 8)) * PX_PITCH + 16 * l32) = v;
      } }
    __syncthreads();
    { const int cp = tid & 127, tq = tid >> 7;
      const int g = 2 * gp + (cp >> 6);
      const int half = 1 << g;
      const LAS unsigned char* xb = lds + PX_OFF + 4 * cp - (t0 - 8) * PX_PITCH;
      int t = t0 + 16 * tq;
      int lo = max(t - half, seg_lo), hi = min(t + half, seg_hi);
      float s0 = 0.f, s1 = 0.f;
      for (int j = lo; j < hi; ++j) { const unsigned w = *(const LAS unsigned*)(xb + j * PX_PITCH); s0 += bflo(w); s1 += bfhi(w); }
#pragma unroll 4
      for (int i = 0; i < 16; ++i, ++t) {
          const unsigned wx = *(const LAS unsigned*)(xb + t * PX_PITCH);
          const float inv = 1.0f / (float)(hi - lo);
          const float d0 = s0 * inv - bflo(wx), d1 = s1 * inv - bfhi(wx);
          *(LAS unsigned*)(lds + PD_OFF + (t - t0) * PD_PITCH + 4 * cp) = pk2(d0, d1);
          const int nlo = max(t + 1 - half, seg_lo), nhi = min(t + 1 + half, seg_hi);
          if (nhi > hi) { const unsigned w = *(const LAS unsigned*)(xb + hi * PX_PITCH); s0 += bflo(w); s1 += bfhi(w); }
          if (nlo > lo) { const unsigned w = *(const LAS unsigned*)(xb + lo * PX_PITCH); s0 -= bflo(w); s1 -= bfhi(w); }
          lo = nlo; hi = nhi;
      } }
    __syncthreads();
    { const int gl = wave >> 2, th = (wave >> 1) & 1, nh = wave & 1, r = lane & 31, hh = lane >> 5;
      const int g = 2 * gp + gl;
      const bf16* WP = (const bf16*)(ws + WS_WP) + (size_t)(l * 4 + g) * 128 * 128;
      f32x16 acc[2];
#pragma unroll
      for (int q = 0; q < 2; ++q)
#pragma unroll
          for (int i = 0; i < 16; ++i) acc[q][i] = 0.f;
      const LAS unsigned char* arow = lds + PD_OFF + (th * 32 + r) * PD_PITCH + (gl * 128 + 8 * hh) * 2;
#pragma unroll
      for (int s = 0; s < 8; ++s) {
          const bf16x8 Af = *(const LAS bf16x8*)(arow + 32 * s);
#pragma unroll
          for (int nt = 0; nt < 2; ++nt) { const bf16x8 Bf = *(const bf16x8*)(WP + (size_t)(nh * 64 + nt * 32 + r) * 128 + 16 * s + 8 * hh);
              acc[nt] = __builtin_amdgcn_mfma_f32_32x32x16_bf16(Af, Bf, acc[nt], 0, 0, 0); }
      }
#pragma unroll
      for (int nt = 0; nt < 2; ++nt) {
          const int co = 128 * g + 64 * nh + 32 * nt + r;
          const float* SP = (const float*)(ws + WS_SP) + (size_t)l * SP_STRIDE; const float pb = SP[SP_PB + co], ps = SP[SP_PS + co];
#pragma unroll
          for (int i = 0; i < 16; ++i) {
              const int row = (i & 3) + 8 * (i >> 2) + 4 * hh;
              MIX[(size_t)(seqbase + t0 + th * 32 + row) * D + DLRU + co] = (bf16)f2bf((acc[nt][i] + pb) * ps);
          }
      } }
    __syncthreads();
}

constexpr int L1_PITCH = 2064;
constexpr int L1_PART = 16 * L1_PITCH;
__device__ __forceinline__ void phase_ln1(unsigned char* ws, int l, LAS unsigned char* lds, int bid, int G, int tid, int wave, int lane) {
    const float* MOD = (const float*)(ws + WS_MOD) + (size_t)l * 9 * 6144;
    float* XL = (float*)(ws + WS_XL); bf16* H = (bf16*)(ws + WS_H); const bf16* Y1 = (const bf16*)(ws + WS_Y1);
    const float* SP = (const float*)(ws + WS_SP) + (size_t)l * SP_STRIDE;
    const float* lg = SP + SP_L1G; const float* lb = SP + SP_L1B; const float* rb = SP + SP_RB;
    int* cnt = (int*)(ws + WS_CTL) + CW_CNT + 32 * l;
    int* TOPE = (int*)(ws + WS_TOPE); int* SLOT = (int*)(ws + WS_SLOT);
    int* ROWTOK = (int*)(ws + WS_ROWTOK); float* ROWGATE = (float*)(ws + WS_ROWGATE);
    const int ntok = (l == DEPTH - 1) ? TL : TT;
    const bf16* RWT = (const bf16*)(ws + WS_RWT) + (size_t)l * NE * D;
    bf16x8 Bf[4][2];
#pragma unroll
    for (int s = 0; s < 4; ++s)
#pragma unroll
        for (int nt = 0; nt < 2; ++nt) Bf[s][nt] = *(const bf16x8*)(RWT + (size_t)(16 * nt + (lane & 15)) * D + 128 * wave + 32 * s + 8 * (lane >> 4));
    LAS float* part = (LAS float*)(lds + L1_PART);
    for (int batch = bid; batch < ntok / 16; batch += G) {
#pragma unroll 1
        for (int rr = 0; rr < 2; ++rr) {
            const int trow = 2 * wave + rr, tok = batch * 16 + trow;
            const float* m = MOD + (size_t)mod_row(tok) * 6144;
            f32x4 v[4], h[4];
#pragma unroll
            for (int j = 0; j < 4; ++j) {
                const f32x4 x = ((const f32x4*)(XL + (size_t)tok * D))[lane + 64 * j];
                const u32x2 yr = ((const u32x2*)(Y1 + (size_t)tok * D))[lane + 64 * j];
                const f32x4 g1 = ((const f32x4*)(m + 2048))[lane + 64 * j];
                f32x4 y; y.x = bflo(yr.x); y.y = bfhi(yr.x); y.z = bflo(yr.y); y.w = bfhi(yr.y);
                v[j] = x * ALPHA + g1 * y;
            }
            float mean, rstd; ln_stats(v, mean, rstd);
#pragma unroll
            for (int j = 0; j < 4; ++j) {
                const f32x4 gg = ((const f32x4*)lg)[lane + 64 * j], bb = ((const f32x4*)lb)[lane + 64 * j];
                v[j] = (v[j] - mean) * rstd * gg + bb;
                ((f32x4*)(XL + (size_t)tok * D))[lane + 64 * j] = v[j];
                const f32x4 sh = ((const f32x4*)(m + 3072))[lane + 64 * j], sc = ((const f32x4*)(m + 4096))[lane + 64 * j];
                h[j] = v[j] * (sc + 1.0f) + sh;
                u32x2 w; w.x = pk2(h[j].x, h[j].y); w.y = pk2(h[j].z, h[j].w);
                ((u32x2*)(H + (size_t)tok * D))[lane + 64 * j] = w;
                *(LAS u32x2*)(lds + trow * L1_PITCH + (4 * lane + 256 * j) * 2) = w;
            }
        }
        __syncthreads();
        {
            f32x4 a2[2] = {(f32x4){0.f, 0.f, 0.f, 0.f}, (f32x4){0.f, 0.f, 0.f, 0.f}};
            const LAS unsigned char* arow = lds + (lane & 15) * L1_PITCH + (128 * wave + 8 * (lane >> 4)) * 2;
#pragma unroll
            for (int s = 0; s < 4; ++s) { const bf16x8 Af = *(const LAS bf16x8*)(arow + 64 * s);
#pragma unroll
                for (int nt = 0; nt < 2; ++nt) a2[nt] = __builtin_amdgcn_mfma_f32_16x16x32_bf16(Af, Bf[s][nt], a2[nt], 0, 0, 0); }
#pragma unroll
            for (int nt = 0; nt < 2; ++nt)
#pragma unroll
                for (int i = 0; i < 4; ++i) part[(wave * 16 + 4 * (lane >> 4) + i) * 32 + 16 * nt + (lane & 15)] = a2[nt][i];
        }
        __syncthreads();
        {
            const int trow = tid >> 5, e = tid & 31, tok = batch * 16 + trow;
            float lgt = rb[e];
#pragma unroll
            for (int w = 0; w < 8; ++w) lgt += part[(w * 16 + trow) * 32 + e];
            float tv[4]; int ti[4];
            float cur = lgt;
#pragma unroll
            for (int k = 0; k < 4; ++k) {
                float bv = cur; int bi = e;
#pragma unroll
                for (int o = 1; o < 32; o <<= 1) { const float ov = __shfl_xor(bv, o); const int oi = __shfl_xor(bi, o); if (ov > bv || (ov == bv && oi < bi)) { bv = ov; bi = oi; } }
                tv[k] = bv; ti[k] = bi;
                if (e == bi) cur = -INFINITY;
            }
            const float e1 = __expf(tv[1] - tv[0]), e2 = __expf(tv[2] - tv[0]), e3 = __expf(tv[3] - tv[0]);
            const float inv = 1.0f / (1.0f + e1 + e2 + e3);
            if (e < 4) {
                const int ex = e == 0 ? ti[0] : e == 1 ? ti[1] : e == 2 ? ti[2] : ti[3];
                const float pg = (e == 0 ? 1.0f : e == 1 ? e1 : e == 2 ? e2 : e3) * inv;
                const int slot = atomicAdd(&cnt[ex], 1);
                ROWTOK[(size_t)ex * TT + slot] = tok; ROWGATE[(size_t)ex * TT + slot] = pg;
                TOPE[tok * 4 + e] = ex; SLOT[tok * 4 + e] = slot;
            }
        }
        __syncthreads();
    }
}

__device__ __forceinline__ void phase_ln2(unsigned char* ws, float* out, int l, int gw, int ngw, int lane) {
    const float* MOD = (const float*)(ws + WS_MOD) + (size_t)l * 9 * 6144;
    float* XL = (float*)(ws + WS_XL); bf16* H = (bf16*)(ws + WS_H); const bf16* Y2 = (const bf16*)(ws + WS_Y2);
    const float* SP = (const float*)(ws + WS_SP) + (size_t)l * SP_STRIDE;
    const float* lg = SP + SP_L2G; const float* lb = SP + SP_L2B;
    const int* cnt = (const int*)(ws + WS_CTL) + CW_CNT + 32 * l;
    const int* TOPE = (const int*)(ws + WS_TOPE); const int* SLOT = (const int*)(ws + WS_SLOT);
    int offl;
    { const int c = lane < 32 ? pad256(cnt[lane]) : 0; int s = c;
#pragma unroll
      for (int o = 1; o < 32; o <<= 1) { const int t = __shfl_up(s, o); if ((lane & 31) >= o) s += t; }
      offl = s - c; }
    const bool last = (l == DEPTH - 1);
    const int ntok = last ? TL : TT;
    for (int tok = gw; tok < ntok; tok += ngw) {
        const float* m = MOD + (size_t)mod_row(tok) * 6144;
        f32x4 f[4];
#pragma unroll
        for (int j = 0; j < 4; ++j) f[j] = (f32x4){0.f, 0.f, 0.f, 0.f};
#pragma unroll
        for (int k = 0; k < 4; ++k) {
            const int e = TOPE[tok * 4 + k], slot = SLOT[tok * 4 + k];
            const int row = __shfl(offl, e) + slot;
            const u32x2* yr = (const u32x2*)(Y2 + (size_t)row * D);
#pragma unroll
            for (int j = 0; j < 4; ++j) { const u32x2 rw2 = yr[lane + 64 * j];
                f[j].x += bflo(rw2.x); f[j].y += bfhi(rw2.x); f[j].z += bflo(rw2.y); f[j].w += bfhi(rw2.y); }
        }
        f32x4 v[4];
#pragma unroll
        for (int j = 0; j < 4; ++j) {
            const f32x4 x = ((const f32x4*)(XL + (size_t)tok * D))[lane + 64 * j];
            const f32x4 g2 = ((const f32x4*)(m + 5120))[lane + 64 * j];
            v[j] = x * ALPHA + g2 * f[j];
        }
        float mean, rstd; ln_stats(v, mean, rstd);
        f32x4 h[4];
        const float* mn = MOD + (size_t)9 * 6144 + (size_t)mod_row(tok) * 6144;
#pragma unroll
        for (int j = 0; j < 4; ++j) {
            const f32x4 gg = ((const f32x4*)lg)[lane + 64 * j], bb = ((const f32x4*)lb)[lane + 64 * j];
            v[j] = (v[j] - mean) * rstd * gg + bb;
            if (last) ((f32x4*)(out + (size_t)tok * D))[lane + 64 * j] = v[j];
            else {
                ((f32x4*)(XL + (size_t)tok * D))[lane + 64 * j] = v[j];
                const f32x4 sh = ((const f32x4*)mn)[lane + 64 * j], sc = ((const f32x4*)(mn + 1024))[lane + 64 * j];
                h[j] = v[j] * (sc + 1.0f) + sh;
            }
        }
        if (!last) store_bf16_row(H + (size_t)tok * D, lane, h);
    }
}

constexpr int NPHASE = 2 + 8 * DEPTH;
#ifndef PHMASK
#define PHMASK 0xFFFF
#endif
#define PH_ON(k) (((PHMASK) >> (k)) & 1)
#ifndef MK_PER_PHASE
#define MK_PER_PHASE 0
#endif
__global__ void __launch_bounds__(512, 2) mk_fwd(P p) {
    extern __shared__ __attribute__((aligned(16))) unsigned char lds_[];
    LAS unsigned char* lds = (LAS unsigned char*)lds_;
    const int tid = threadIdx.x, lane = tid & 63, wave = __builtin_amdgcn_readfirstlane(tid >> 6);
    const int G = gridDim.x, bid = blockIdx.x;
    volatile LAS unsigned* MISC = (volatile LAS unsigned*)(lds + LDS_MISC);
    if (tid < 4) MISC[tid] = 0u;
    __syncthreads();
    unsigned* barw = (unsigned*)(p.ws + WS_CTL) + CW_BAR;
    XcdBarrier bar; bar.bar = barw; bar.x = 0; bar.st = MISC;
    if (!MK_PER_PHASE) bar = xcd_barrier_post(barw, MISC);
    const int lo = p.ph_lo, hi = p.ph_hi;
#define IN(k) (lo <= (k) && (k) < hi)
#define SEAM(k) do { if (IN(k) && IN((k) + 1)) xcd_barrier(bar); } while (0)
    if (PH_ON(0) && IN(0)) { phase_p0a(p, lds, bid, G, tid, wave, lane); }
    SEAM(0);
    if (PH_ON(1) && IN(1)) { phase_entry(p, bid * 8 + wave, G * 8, lane); }
    SEAM(1);
#pragma unroll 1
    for (int l = 0; l < DEPTH; ++l) {
        const int pb = 2 + 8 * l;
#define FRESH() int tid_ = threadIdx.x; asm volatile("" : "+v"(tid_)); const int lane_ = tid_ & 63; const int wave_ = __builtin_amdgcn_readfirstlane(tid_ >> 6); \
                size_t wz_ = 0; asm volatile("" : "+s"(wz_)); unsigned char* ws = p.ws + wz_; (void)lane_; (void)wave_
        if (PH_ON(2) && IN(pb + 0)) {
            FRESH();
            pg8::DenseOrder S; S.init(TT / 256, DIN / 256, G, bid);
            pg8::EpiStore E{(bf16*)(ws + WS_Z), DIN};
            pg8::gemm_phase<false>(lds, tid_, (const bf16*)(ws + WS_H), (const bf16*)(ws + WS_WIN) + (size_t)l * DIN * D, nullptr, S, E);
        }
        SEAM(pb + 0);
        if (PH_ON(3) && IN(pb + 1)) {
            FRESH();
            for (int u = bid; u < NB * NGRP * NH * 2; u += G) { const int cb = u & 1, h = (u >> 1) & 7, bg = u >> 4; lru_unit<false>(ws, l, lds, bg / NGRP, bg % NGRP, h, cb, wave_, lane_); }
        }
        SEAM(pb + 1);
        if (PH_ON(4) && IN(pb + 2)) {
            FRESH();
            const int g0 = (l == DEPTH - 1) ? 1 : 0, ng = NGRP - g0;
            const int nlru = NB * ng * NH * 2, npool = ((l == DEPTH - 1) ? 256 : 288) * 2;
            for (int u = bid; u < nlru + npool; u += G) {
                if (u < nlru) { const int cb = u & 1, h = (u >> 1) & 7, bg = u >> 4; lru_unit<true>(ws, l, lds, bg / ng, g0 + bg % ng, h, cb, wave_, lane_); }
                else { const int q = u - nlru; pool_unit(ws, l, lds, q >> 1, q & 1, tid_, wave_, lane_); }
            }
        }
        SEAM(pb + 2);
        if (PH_ON(5) && IN(pb + 3)) {
            FRESH();
            pg8::DenseOrder S; S.init((l == DEPTH - 1 ? TL : TT) / 256, D / 256, G, bid);
            pg8::EpiStore E{(bf16*)(ws + WS_Y1), D};
            pg8::gemm_phase<false>(lds, tid_, (const bf16*)(ws + WS_MIX), (const bf16*)(ws + WS_WOUT) + (size_t)l * D * D, nullptr, S, E);
        }
        SEAM(pb + 3);
        if (PH_ON(6) && IN(pb + 4)) { FRESH(); phase_ln1(ws, l, lds, bid, G, tid_, wave_, lane_); }
        SEAM(pb + 4);
        if (IN(pb + 5) || IN(pb + 6)) {
            FRESH();
            const int* cnt = (const int*)(ws + WS_CTL) + CW_CNT + 32 * l;
            LAS int* tb = (LAS int*)(lds + LDS_TB);
            if (tid_ < 64) { const int c = lane_ < 32 ? (cnt[lane_] + 255) >> 8 : 0; int s = c;
#pragma unroll
                for (int o = 1; o < 32; o <<= 1) { const int t = __shfl_up(s, o); if (lane_ >= o) s += t; }
                if (lane_ < 32) tb[lane_ + 1] = s; if (lane_ == 0) tb[0] = 0; }
            __syncthreads();
        }
        if (PH_ON(7) && IN(pb + 5)) {
            FRESH();
            const int* cnt = (const int*)(ws + WS_CTL) + CW_CNT + 32 * l;
            pg8::MoeOrder<8, true> S{(const LAS int*)(lds + LDS_TB), cnt, G, bid};
            pg8::EpiSwiglu E{(bf16*)(ws + WS_ACT), (const float*)(ws + WS_SP) + (size_t)l * SP_STRIDE + SP_B1};
            pg8::gemm_phase<true>(lds, tid_, (const bf16*)(ws + WS_H), (const bf16*)(ws + WS_W1T) + (size_t)l * NE * 2 * DF * D, (const int*)(ws + WS_ROWTOK), S, E);
        }
        SEAM(pb + 5);
        if (PH_ON(8) && IN(pb + 6)) {
            FRESH();
            const int* cnt = (const int*)(ws + WS_CTL) + CW_CNT + 32 * l;
            pg8::MoeOrder<4, false> S{(const LAS int*)(lds + LDS_TB), cnt, G, bid};
            pg8::EpiDown E{(bf16*)(ws + WS_Y2), (const float*)(ws + WS_SP) + (size_t)l * SP_STRIDE + SP_B2, (const float*)(ws + WS_ROWGATE)};
            pg8::gemm_phase<false>(lds, tid_, (const bf16*)(ws + WS_ACT), (const bf16*)(ws + WS_W2T) + (size_t)l * NE * D * DF, nullptr, S, E);
        }
        SEAM(pb + 6);
        if (PH_ON(9) && IN(pb + 7)) { FRESH(); phase_ln2(ws, p.out, l, bid * 8 + wave_, G * 8, lane_); }
        SEAM(pb + 7);
#undef FRESH
    }
#undef IN
#undef SEAM
}

extern "C" void kernel_launch(void* const* d_in, const int* in_sizes, int n_in, void* d_out, int out_size, void* d_ws, size_t ws_size, hipStream_t stream) {
    static int grid = 0;
    if (grid == 0) {
        if (n_in != N_IN || ws_size < WS_END || out_size != TL * D) { fprintf(stderr, "kernel_launch: unexpected shapes (n_in %d, out %d, ws %zu)\n", n_in, out_size, ws_size); grid = -1; return; }
        int dev = 0, cus = 0, per_cu = 0;
        if (hipGetDevice(&dev) != hipSuccess || hipDeviceGetAttribute(&cus, hipDeviceAttributeMultiprocessorCount, dev) != hipSuccess) { grid = -1; return; }
        if (hipFuncSetAttribute((const void*)mk_fwd, hipFuncAttributeMaxDynamicSharedMemorySize, LDS_BYTES) != hipSuccess) { fprintf(stderr, "kernel_launch: hipFuncSetAttribute failed\n"); grid = -1; return; }
        if (hipOccupancyMaxActiveBlocksPerMultiprocessor(&per_cu, (const void*)mk_fwd, 512, LDS_BYTES) != hipSuccess || per_cu < 1) { fprintf(stderr, "kernel_launch: occupancy query says %d\n", per_cu); }
        (void)hipGetLastError();
        grid = cus;
    }
    if (grid < 0) return;
    (void)hipMemsetAsync((char*)d_ws + WS_CTL, 0, CTL_BYTES, stream);
    P p{};
    for (int i = 0; i < N_IN; ++i) p.in[i] = (const float*)d_in[i];
    p.out = (float*)d_out; p.ws = (unsigned char*)d_ws;
#if MK_PER_PHASE
    for (int ph = 0; ph < NPHASE; ++ph) { p.ph_lo = ph; p.ph_hi = ph + 1; hipLaunchKernelGGL(mk_fwd, dim3(grid), dim3(512), LDS_BYTES, stream, p); }
#else
    p.ph_lo = 0; p.ph_hi = NPHASE;
    hipLaunchKernelGGL(mk_fwd, dim3(grid), dim3(512), LDS_BYTES, stream, p);
#endif
}
```

```cpp
#include <hip/hip_runtime.h>
#include <cstdio>
#include <cstdint>

constexpr int NB = 8, SEQ = 2048, D = 1024, CTXL = 256, DEPTH = 2;
constexpr int TL = NB * SEQ;
constexpr int TC = NB * CTXL;
constexpr int TT = TL + TC;
constexpr int DLRU = 512, DPOOL = 512, DIN = 1536, NH = 8, HD = 64;
constexpr int NE = 32, TOPK = 4, DF = 1024;
constexpr int GRIDW = 64;
constexpr float LN_EPS = 1e-5f;
constexpr float ALPHA = 1.41421356237309515f;
constexpr int MAXROWS = 81920;
constexpr int NTILE = 72, NGRP = 9;

enum { I_X = 0, I_C, I_CTX, I_CCTX, I_WMOD, I_BMOD, I_WIN, I_CONVW, I_CONVB, I_GAW, I_GAB, I_GXW, I_GXB, I_LAM, I_POOLW, I_POOLB, I_POOLS,
       I_WOUT, I_LN1G, I_LN1B, I_RW, I_RB, I_W1, I_B1, I_W2, I_B2, I_LN2G, I_LN2B, N_IN };

constexpr size_t MiB = 1u << 20;
constexpr size_t WS_CTL = 0, CTL_BYTES = 1 * MiB;
constexpr size_t WS_MOD = 1 * MiB;
constexpr size_t WS_POS = 2 * MiB;
constexpr size_t WS_RWT = 2 * MiB + 512 * 1024;
constexpr size_t WS_TOPE = 3 * MiB;
constexpr size_t WS_SLOT = 3 * MiB + 512 * 1024;
constexpr size_t WS_ROWTOK = 4 * MiB;
constexpr size_t WS_ROWGATE = 7 * MiB;
constexpr size_t WS_AGGT = 10 * MiB;
constexpr size_t WS_AGGG = 15 * MiB;
constexpr size_t WS_WIN = 16 * MiB, WS_WOUT = 23 * MiB, WS_WG = 28 * MiB, WS_WP = 29 * MiB;
constexpr size_t WS_SP = 30 * MiB;
constexpr size_t WS_W1T = 32 * MiB, WS_W2T = 288 * MiB;
constexpr int SP_CW = 0, SP_CB = 2048, SP_GAB = 2560, SP_GXB = 3584, SP_CC = 4608, SP_PB = 5632, SP_PS = 6144, SP_L1G = 6656, SP_L1B = 7680, SP_L2G = 8704, SP_L2B = 9728, SP_RB = 10752,
              SP_B1 = 12288, SP_B2 = SP_B1 + 32 * 2048, SP_STRIDE = SP_B2 + 32 * 1024;
constexpr size_t WS_XL = 416 * MiB;
constexpr size_t WS_H = 488 * MiB;
constexpr size_t WS_Z = 524 * MiB;
constexpr size_t WS_MIX = 578 * MiB;
constexpr size_t WS_Y1 = 614 * MiB;
constexpr size_t WS_ACT = 650 * MiB;
constexpr size_t WS_Y2 = 810 * MiB;
constexpr size_t WS_END = 970 * MiB;
constexpr int CW_CNT = 64;
constexpr int CW_BAR = 4096;

typedef unsigned short bf16;
typedef float f32x4 __attribute__((ext_vector_type(4)));
typedef float f32x2 __attribute__((ext_vector_type(2)));
typedef float f32x16 __attribute__((ext_vector_type(16)));
typedef unsigned u32x2 __attribute__((ext_vector_type(2)));
typedef unsigned u32x4 __attribute__((ext_vector_type(4)));
typedef short bf16x8 __attribute__((ext_vector_type(8)));

__device__ __forceinline__ float bf2f(bf16 v) { return __uint_as_float(((unsigned)v) << 16); }
__device__ __forceinline__ float bflo(unsigned w) { return __uint_as_float(w << 16); }
__device__ __forceinline__ float bfhi(unsigned w) { return __uint_as_float(w & 0xffff0000u); }
__device__ __forceinline__ unsigned f2bf(float f) { unsigned u = __float_as_uint(f); return (u + 0x7fffu + ((u >> 16) & 1u)) >> 16; }
__device__ __forceinline__ unsigned pk2(float lo, float hi) { return f2bf(lo) | (f2bf(hi) << 16); }
__device__ __forceinline__ float wave_sum(float v) {
#pragma unroll
    for (int o = 1; o < 64; o <<= 1) v += __shfl_xor(v, o);
    return v;
}
__device__ __forceinline__ float fsigmoid(float x) { return __builtin_amdgcn_rcpf(1.0f + __expf(-x)); }
__device__ __forceinline__ float gelu_tanh(float x) {
    const float u = 0.7978845608028654f * (x + 0.044715f * x * x * x);
    const float t = 1.0f - 2.0f * __builtin_amdgcn_rcpf(__expf(2.0f * u) + 1.0f);
    return 0.5f * x * (1.0f + t);
}

struct P {
    const float* in[N_IN];
    float* out;
    unsigned char* ws;
    int ph_lo, ph_hi;
};

__device__ __forceinline__ int mod_row(int tok) { return tok < TL ? (tok >> 11) : NB; }
__device__ __forceinline__ int pad256(int c) { return (c + 255) & ~255; }

__device__ __forceinline__ void ln_stats(const f32x4 (&v)[4], float& mean, float& rstd) {
    float s = 0.f;
#pragma unroll
    for (int j = 0; j < 4; ++j) s += (v[j].x + v[j].y) + (v[j].z + v[j].w);
    mean = wave_sum(s) * (1.f / D);
    float s2 = 0.f;
#pragma unroll
    for (int j = 0; j < 4; ++j) { const f32x4 d = v[j] - mean; s2 += (d.x * d.x + d.y * d.y) + (d.z * d.z + d.w * d.w); }
    rstd = 1.0f / sqrtf(wave_sum(s2) * (1.f / D) + LN_EPS);
}
__device__ __forceinline__ void store_bf16_row(bf16* row, int lane, const f32x4 (&h)[4]) {
    u32x2* o = (u32x2*)row + lane;
#pragma unroll
    for (int j = 0; j < 4; ++j) { u32x2 w; w.x = pk2(h[j].x, h[j].y); w.y = pk2(h[j].z, h[j].w); o[64 * j] = w; }
}


#define LAS __attribute__((address_space(3)))
__device__ __forceinline__ void transpose_tile(const float* src, int N, bf16* dst, int Kp, LAS float* scr, int lane) {
    f32x4 v[16];
#pragma unroll
    for (int i = 0; i < 16; ++i) { const int k = 4 * i + (lane >> 4); v[i] = *(const f32x4*)(src + (size_t)k * N + 4 * (lane & 15)); }
#pragma unroll
    for (int i = 0; i < 16; ++i) { const int k = 4 * i + (lane >> 4); const int nn = (4 * (lane & 15)) ^ (((k >> 3) & 3) << 3); *(LAS f32x4*)(scr + k * 64 + nn) = v[i]; }
    asm volatile("s_waitcnt lgkmcnt(0)" ::: "memory");
    const int c = lane & 7, sw = (c & 3) << 3;
#pragma unroll
    for (int j = 0; j < 8; ++j) {
        const int n = (lane >> 3) + 8 * j;
        const LAS float* s = scr + (8 * c) * 64 + (n ^ sw);
        u32x4 o; o.x = pk2(s[0], s[64]); o.y = pk2(s[128], s[192]); o.z = pk2(s[256], s[320]); o.w = pk2(s[384], s[448]);
        *(u32x4*)(dst + (size_t)n * Kp + 8 * c) = o;
    }
    asm volatile("s_waitcnt lgkmcnt(0)" ::: "memory");
}
__device__ __forceinline__ void convert_weights(const P& p, LAS unsigned char* lds, int gw, int ngw, int wave, int lane) {
    LAS float* scr = (LAS float*)(lds + wave * 16384);
    bf16* WINT = (bf16*)(p.ws + WS_WIN); bf16* WOUTT = (bf16*)(p.ws + WS_WOUT); bf16* W1T = (bf16*)(p.ws + WS_W1T); bf16* W2T = (bf16*)(p.ws + WS_W2T);
    bf16* WGT = (bf16*)(p.ws + WS_WG); bf16* WPT = (bf16*)(p.ws + WS_WP);
    constexpr int I_IN = DEPTH * 16 * 24, I_OUT = DEPTH * 16 * 16, I_G = DEPTH * 2 * 2 * NH, I_P = DEPTH * 4 * 4, I_1 = DEPTH * NE * 16 * 32, I_2 = DEPTH * NE * 16 * 16;
    constexpr int NITEMS = I_IN + I_OUT + I_G + I_P + I_1 + I_2;
    for (int it = gw; it < NITEMS; it += ngw) {
        int r = it;
        if (r < I_IN) { const int l = r / 384, q = r % 384, kb = q / 24, nb = q % 24;
            transpose_tile(p.in[I_WIN] + (size_t)l * D * DIN + (size_t)(64 * kb) * DIN + 64 * nb, DIN, WINT + ((size_t)l * DIN + 64 * nb) * D + 64 * kb, D, scr, lane); continue; }
        r -= I_IN;
        if (r < I_OUT) { const int l = r / 256, q = r % 256, kb = q / 16, nb = q % 16;
            transpose_tile(p.in[I_WOUT] + (size_t)l * D * D + (size_t)(64 * kb) * D + 64 * nb, D, WOUTT + ((size_t)l * D + 64 * nb) * D + 64 * kb, D, scr, lane); continue; }
        r -= I_OUT;
        if (r < I_G) {
            const int h = r % NH, gt = (r / NH) % 2, d = (r / (NH * 2)) % 2, l = r / (NH * 4);
            const float* s = (gt ? p.in[I_GXW] : p.in[I_GAW]) + ((size_t)(l * 2 + d) * NH + h) * HD * HD;
            transpose_tile(s, HD, WGT + ((size_t)(l * NH + h) * 256 + (d * 2 + gt) * 64) * HD, HD, scr, lane); continue; }
        r -= I_G;
        if (r < I_P) {
            const int nb = r % 2, kb = (r / 2) % 2, lg = r / 4;
            transpose_tile(p.in[I_POOLW] + (size_t)lg * 128 * 128 + (size_t)(64 * kb) * 128 + 64 * nb, 128, WPT + ((size_t)lg * 128 + 64 * nb) * 128 + 64 * kb, 128, scr, lane); continue; }
        r -= I_P;
        if (r < I_1) {
            const int le = r / 512, q = r % 512, kb = q / 32, nb = q % 32;
            const int n0 = 64 * nb, j0 = n0 % DF, half = n0 / DF, row0 = (j0 / 128) * 256 + half * 128 + (j0 % 128);
            transpose_tile(p.in[I_W1] + (size_t)le * D * 2 * DF + (size_t)(64 * kb) * (2 * DF) + n0, 2 * DF, W1T + ((size_t)le * 2 * DF + row0) * D + 64 * kb, D, scr, lane); continue; }
        r -= I_1;
        { const int le = r / 256, q = r % 256, kb = q / 16, nb = q % 16;
          transpose_tile(p.in[I_W2] + (size_t)le * DF * D + (size_t)(64 * kb) * D + 64 * nb, D, W2T + ((size_t)le * D + 64 * nb) * DF + 64 * kb, DF, scr, lane); }
    }
}
namespace pg8 {
typedef short bf16x8 __attribute__((ext_vector_type(8)));
constexpr int BM = 256, BK = 64, HALF = 128, HTB = HALF * BK * 2, STAGE_BYTES = 8 * HTB;
__host__ __device__ __forceinline__ int lds_byte(int r, int c) { const int st = (r >> 4) * 2 + (c >> 5), rr = r & 15, cc = c & 31, ob = rr * 64 + cc * 2; return st * 1024 + (ob ^ (((ob >> 9) & 1) << 5)); }
__host__ __device__ __forceinline__ void stage_rc(int b, int& R, int& C) { const int st = b / 1024, sb = b % 1024, swz = sb ^ (((sb >> 9) & 1) << 5); R = (st >> 1) * 16 + swz / 64; C = (st & 1) * 32 + (swz % 64) / 2; }
__host__ __device__ __forceinline__ int perm32(int rho) { const int n = rho >> 4, i = rho & 15; return 8 * (i >> 2) + 4 * n + (i & 3); }
__device__ __forceinline__ unsigned cvt_pk_bf16(float lo, float hi) { unsigned r; asm volatile("v_cvt_pk_bf16_f32 %0, %1, %2" : "=v"(r) : "v"(lo), "v"(hi)); return r; }

struct Unit { int a0, nvalid, b0, o0, pn, e, g0; };

template <bool GATHER, class Sched, class Epi>
__device__ __forceinline__ void gemm_phase(LAS unsigned char* lds, int tid, const bf16* Abase_, const bf16* Bt_, const int* glist, const Sched& S, const Epi& E) {
    constexpr int K = 1024, nt = K / BK;
    const int wid = __builtin_amdgcn_readfirstlane(tid >> 6), lane = tid & 63, wr = wid >> 2, wc = wid & 3, fr = lane & 15, fq = lane >> 4;
    int Rr[2], Cc[2]; unsigned voffB[2];
#pragma unroll
    for (int i = 0; i < 2; ++i) { int R, C; stage_rc(tid * 16 + i * 8192, R, C); Rr[i] = R; Cc[i] = C; const int Rb = (R & ~31) + perm32(R & 31); voffB[i] = (unsigned)(Rb * K + C) * 2u; }
    constexpr size_t kstep = (size_t)(BK * 2);
    constexpr size_t hstep = (size_t)HALF * K * 2;
    const unsigned ldsw = (unsigned)wid * 1024u;
    const int aoff = lds_byte(wr * 64 + fr, fq * 8), boff = lds_byte(wc * 32 + fr, fq * 8);
    const char* Abase = (const char*)Abase_;
#define PG8_SA(b, h) (((b) * 2 + (h)) * HTB)
#define PG8_SB(b, h) ((4 + (b) * 2 + (h)) * HTB)
#define PG8_STAGE_B(bufoff, gbase) do { _Pragma("unroll") for (int _i = 0; _i < 2; ++_i) \
        __builtin_amdgcn_global_load_lds((const unsigned*)((const char*)(gbase) + voffB[_i]), (LAS unsigned*)(lds + (bufoff) + ldsw + _i * 8192), 16, 0, 0); } while (0)
#define PG8_STAGE_A(bufoff, gbase, o0_, o1_) do { \
        __builtin_amdgcn_global_load_lds((const unsigned*)((const char*)(gbase) + (o0_)), (LAS unsigned*)(lds + (bufoff) + ldsw), 16, 0, 0); \
        __builtin_amdgcn_global_load_lds((const unsigned*)((const char*)(gbase) + (o1_)), (LAS unsigned*)(lds + (bufoff) + ldsw + 8192), 16, 0, 0); } while (0)
#define PG8_LDA(dst, b, h) do { _Pragma("unroll") for (int m = 0; m < 4; ++m) _Pragma("unroll") for (int k = 0; k < 2; ++k) dst[m][k] = *(const LAS bf16x8*)(lds + PG8_SA(b, h) + aoff + m * 2048 + k * 1024); } while (0)
#define PG8_LDB(dst, b, h) do { _Pragma("unroll") for (int n = 0; n < 2; ++n) _Pragma("unroll") for (int k = 0; k < 2; ++k) dst[n][k] = *(const LAS bf16x8*)(lds + PG8_SB(b, h) + boff + n * 2048 + k * 1024); } while (0)
#define PG8_MMA(ai, bj, At, Bt) do { __builtin_amdgcn_s_setprio(1); _Pragma("unroll") for (int m = 0; m < 4; ++m) _Pragma("unroll") for (int n = 0; n < 2; ++n) _Pragma("unroll") for (int k = 0; k < 2; ++k) \
        acc[ai][bj][m][n] = __builtin_amdgcn_mfma_f32_16x16x32_bf16(Bt[n][k], At[m][k], acc[ai][bj][m][n], 0, 0, 0); __builtin_amdgcn_s_setprio(0); } while (0)
#define PG8_WAIT_V(n) asm volatile("s_waitcnt vmcnt(" #n ")" ::: "memory")
#define PG8_WAIT_L(n) asm volatile("s_waitcnt lgkmcnt(" #n ")" ::: "memory")
#define PG8_BAR __builtin_amdgcn_s_barrier()
#define PG8_SCHED __builtin_amdgcn_sched_barrier(0)
#define PG8_AOFFS(u, ao) do { _Pragma("unroll") for (int _h = 0; _h < 2; ++_h) _Pragma("unroll") for (int _i = 0; _i < 2; ++_i) { \
        const int _r = _h * HALF + Rr[_i]; int _row; \
        if (GATHER) { _row = (_r < (u).nvalid) ? glist[(u).a0 + _r] : 0; } else { _row = (u).a0 + _r; } \
        ao[_h][_i] = (unsigned)(_row * K + Cc[_i]) * 2u; } } while (0)
    Unit cur, nxt; int ui = 0;
    if (!S.next(0, cur)) return;
    f32x4 acc[2][2][4][2];
#pragma unroll
    for (int a = 0; a < 2; ++a)
#pragma unroll
        for (int b = 0; b < 2; ++b)
#pragma unroll
            for (int m = 0; m < 4; ++m)
#pragma unroll
                for (int n = 0; n < 2; ++n) acc[a][b][m][n] = (f32x4){0.f, 0.f, 0.f, 0.f};
    bf16x8 At[4][2], B0[2][2], B1[2][2];
    unsigned ao[2][2], nao[2][2];
    PG8_AOFFS(cur, ao);
    const char* cB = (const char*)Bt_ + (size_t)cur.b0 * (K * 2);
    PG8_STAGE_B(PG8_SB(0, 0), cB); PG8_STAGE_B(PG8_SB(0, 1), cB + hstep); PG8_STAGE_A(PG8_SA(0, 0), Abase, ao[0][0], ao[0][1]); PG8_STAGE_A(PG8_SA(0, 1), Abase, ao[1][0], ao[1][1]);
    if (wr == 1) PG8_BAR;
    PG8_WAIT_V(2); PG8_BAR;
    PG8_STAGE_B(PG8_SB(1, 0), cB + kstep); PG8_STAGE_A(PG8_SA(1, 0), Abase + kstep, ao[0][0], ao[0][1]); PG8_STAGE_B(PG8_SB(1, 1), cB + hstep + kstep);
    PG8_WAIT_V(6); PG8_BAR;
    for (;;) {
        const bool has_next = S.next(ui + 1, nxt);
        if (has_next) { PG8_AOFFS(nxt, nao); } else {
#pragma unroll
            for (int h = 0; h < 2; ++h)
#pragma unroll
                for (int i = 0; i < 2; ++i) nao[h][i] = ao[h][i]; }
        const char* nB = has_next ? (const char*)Bt_ + (size_t)nxt.b0 * (K * 2) : cB;
        for (int t = 0; t < nt; t += 2) {
            const bool last = (t == nt - 2);
            const char* a1 = Abase + (size_t)(t + 1) * kstep;
            const char* a2 = last ? Abase : Abase + (size_t)(t + 2) * kstep; const char* b2 = last ? nB : cB + (size_t)(t + 2) * kstep;
            const char* a3 = a2 + kstep; const char* b3 = b2 + kstep;
            const unsigned x00 = last ? nao[0][0] : ao[0][0], x01 = last ? nao[0][1] : ao[0][1], x10 = last ? nao[1][0] : ao[1][0], x11 = last ? nao[1][1] : ao[1][1];
            PG8_LDB(B0, 0, 0); PG8_LDB(B1, 0, 1); PG8_SCHED; PG8_LDA(At, 0, 0); PG8_STAGE_A(PG8_SA(1, 1), a1, ao[1][0], ao[1][1]);
            PG8_WAIT_V(8); PG8_WAIT_L(0); PG8_BAR; PG8_MMA(0, 0, At, B0); PG8_MMA(0, 1, At, B1); PG8_BAR; PG8_SCHED;
            PG8_LDA(At, 0, 1); PG8_STAGE_B(PG8_SB(0, 0), b2); PG8_STAGE_B(PG8_SB(0, 1), b2 + hstep); PG8_STAGE_A(PG8_SA(0, 0), a2, x00, x01);
            PG8_WAIT_V(8); PG8_WAIT_L(0); PG8_BAR; PG8_MMA(1, 0, At, B0); PG8_MMA(1, 1, At, B1); PG8_BAR; PG8_SCHED;
            PG8_LDB(B0, 1, 0); PG8_LDB(B1, 1, 1); PG8_SCHED; PG8_LDA(At, 1, 0); PG8_STAGE_A(PG8_SA(0, 1), a2, x10, x11);
            PG8_WAIT_V(8); PG8_WAIT_L(0); PG8_BAR; PG8_MMA(0, 0, At, B0); PG8_MMA(0, 1, At, B1); PG8_BAR; PG8_SCHED;
            PG8_LDA(At, 1, 1); PG8_STAGE_B(PG8_SB(1, 0), b3); PG8_STAGE_B(PG8_SB(1, 1), b3 + hstep); PG8_STAGE_A(PG8_SA(1, 0), a3, x00, x01);
            PG8_WAIT_V(8); PG8_WAIT_L(0); PG8_BAR; PG8_MMA(1, 0, At, B0); PG8_MMA(1, 1, At, B1); PG8_BAR; PG8_SCHED;
        }
        if (wr == 0) PG8_BAR;
        E(acc, cur, wr, wc, fr, fq);
        if (!has_next) break;
#pragma unroll
        for (int a = 0; a < 2; ++a)
#pragma unroll
            for (int b = 0; b < 2; ++b)
#pragma unroll
                for (int m = 0; m < 4; ++m)
#pragma unroll
                    for (int n = 0; n < 2; ++n) acc[a][b][m][n] = (f32x4){0.f, 0.f, 0.f, 0.f};
        cur = nxt; cB = nB; ++ui;
#pragma unroll
        for (int h = 0; h < 2; ++h)
#pragma unroll
            for (int i = 0; i < 2; ++i) ao[h][i] = nao[h][i];
        if (wr == 1) PG8_BAR;
    }
    PG8_WAIT_V(0);
    PG8_BAR;
#undef PG8_SA
#undef PG8_SB
#undef PG8_STAGE_A
#undef PG8_STAGE_B
#undef PG8_LDA
#undef PG8_LDB
#undef PG8_MMA
#undef PG8_WAIT_V
#undef PG8_WAIT_L
#undef PG8_BAR
#undef PG8_SCHED
#undef PG8_AOFFS
}

struct DenseOrder {
    int nM, nN, nwg, G, c;
    __device__ void init(int nM_, int nN_, int G_, int c_) { nM = nM_; nN = nN_; nwg = nM * nN; G = G_; c = c_; }
    __device__ bool next(int i, Unit& u) const {
        const long L = (long)i * G + c; if (L >= nwg) return false;
        int wgid = (int)L; { const int q = nwg / 8, r = nwg % 8, xcd = wgid % 8, off = wgid / 8; wgid = (xcd < r ? xcd * (q + 1) : r * (q + 1) + (xcd - r) * q) + off; }
        const int nig = 8 * nN, gid = wgid / nig, fm = gid * 8, gsz = (nM - fm) < 8 ? (nM - fm) : 8;
        const int pm = fm + ((wgid % nig) % gsz), pn = (wgid % nig) / gsz;
        u.a0 = pm * 256; u.nvalid = 256; u.b0 = pn * 256; u.o0 = pm * 256; u.pn = pn; u.e = 0; u.g0 = 0; return true;
    }
};
template <int NPN, bool UP> struct MoeOrder {
    const LAS int* tb; const int* cnt; int G, c;
    __device__ bool next(int i, Unit& u) const {
        const int L = i * G + c; const int total = tb[32] * NPN; if (L >= total) return false;
        int e = 0;
#pragma unroll 1
        for (int q = 16; q >= 1; q >>= 1) if (tb[e + q] * NPN <= L) e += q;
        const int te = tb[e + 1] - tb[e], j = L - tb[e] * NPN, pn = j / te, mt = j % te;
        const int ce = cnt[e];
        u.e = e; u.pn = pn; u.o0 = (tb[e] + mt) * 256; u.nvalid = min(256, ce - mt * 256);
        u.g0 = e * TT + mt * 256;
        u.a0 = UP ? u.g0 : u.o0;
        u.b0 = e * (UP ? 2 * DF : D) + pn * 256;
        return true;
    }
};

struct EpiStore {
    bf16* C; int ldc;
    __device__ __forceinline__ void operator()(const f32x4 (&acc)[2][2][4][2], const Unit& u, int wr, int wc, int fr, int fq) const {
        const int row0 = u.o0 + wr * 64 + fr, col0 = u.pn * 256 + wc * 32 + 8 * fq;
#pragma unroll
        for (int ai = 0; ai < 2; ++ai)
#pragma unroll
            for (int m = 0; m < 4; ++m) { bf16* rowp = C + (size_t)(row0 + ai * HALF + m * 16) * ldc + col0;
#pragma unroll
                for (int bj = 0; bj < 2; ++bj) { const f32x4 v0 = acc[ai][bj][m][0], v1 = acc[ai][bj][m][1];
                    u32x4 w; w.x = cvt_pk_bf16(v0[0], v0[1]); w.y = cvt_pk_bf16(v0[2], v0[3]); w.z = cvt_pk_bf16(v1[0], v1[1]); w.w = cvt_pk_bf16(v1[2], v1[3]);
                    *(u32x4*)(rowp + bj * HALF) = w; } }
    }
};
struct EpiSwiglu {
    bf16* C; const float* b1;
    __device__ __forceinline__ void operator()(const f32x4 (&acc)[2][2][4][2], const Unit& u, int wr, int wc, int fr, int fq) const {
        const int row0 = u.o0 + wr * 64 + fr, j0 = u.pn * 128 + wc * 32 + 8 * fq;
        const float* bb = b1 + (size_t)u.e * 2 * DF + j0;
        const f32x4 bg0 = *(const f32x4*)bb, bg1 = *(const f32x4*)(bb + 4), bl0 = *(const f32x4*)(bb + DF), bl1 = *(const f32x4*)(bb + DF + 4);
#pragma unroll
        for (int ai = 0; ai < 2; ++ai)
#pragma unroll
            for (int m = 0; m < 4; ++m) {
                float o[8];
#pragma unroll
                for (int n = 0; n < 2; ++n)
#pragma unroll
                    for (int q = 0; q < 4; ++q) {
                        const float gl = fminf(acc[ai][0][m][n][q] + (n ? bg1[q] : bg0[q]), 7.0f);
                        const float li = fminf(fmaxf(acc[ai][1][m][n][q] + (n ? bl1[q] : bl0[q]), -7.0f), 7.0f);
                        o[4 * n + q] = gl * __builtin_amdgcn_rcpf(1.0f + __expf(-1.702f * gl)) * (li + 1.0f);
                    }
                u32x4 w; w.x = cvt_pk_bf16(o[0], o[1]); w.y = cvt_pk_bf16(o[2], o[3]); w.z = cvt_pk_bf16(o[4], o[5]); w.w = cvt_pk_bf16(o[6], o[7]);
                *(u32x4*)(C + (size_t)(row0 + ai * HALF + m * 16) * DF + j0) = w;
            }
    }
};
struct EpiDown {
    bf16* C; const float* b2; const float* rowgate;
    __device__ __forceinline__ void operator()(const f32x4 (&acc)[2][2][4][2], const Unit& u, int wr, int wc, int fr, int fq) const {
        const int rt0 = wr * 64 + fr, col0 = u.pn * 256 + wc * 32 + 8 * fq;
#pragma unroll
        for (int ai = 0; ai < 2; ++ai) {
            float gt[4];
#pragma unroll
            for (int m = 0; m < 4; ++m) { const int rt = rt0 + ai * HALF + m * 16; gt[m] = (rt < u.nvalid) ? rowgate[u.g0 + rt] : 0.f; }
#pragma unroll
            for (int bj = 0; bj < 2; ++bj) {
                const f32x4 bv0 = *(const f32x4*)(b2 + (size_t)u.e * D + col0 + bj * HALF), bv1 = *(const f32x4*)(b2 + (size_t)u.e * D + col0 + bj * HALF + 4);
#pragma unroll
                for (int m = 0; m < 4; ++m) {
                    const int rt = rt0 + ai * HALF + m * 16;
                    const f32x4 v0 = (acc[ai][bj][m][0] + bv0) * gt[m], v1 = (acc[ai][bj][m][1] + bv1) * gt[m];
                    u32x4 w; w.x = cvt_pk_bf16(v0[0], v0[1]); w.y = cvt_pk_bf16(v0[2], v0[3]); w.z = cvt_pk_bf16(v1[0], v1[1]); w.w = cvt_pk_bf16(v1[2], v1[3]);
                    *(u32x4*)(C + (size_t)(u.o0 + rt) * D + col0 + bj * HALF) = w;
                }
            }
            asm volatile("" ::: "memory");
        }
    }
};
}

#define XB_TMO      128
#define XB_XCNT(j)  (256  + 64 * (j))
#define XB_XSUB(j)  (1280 + 64 * (j))
#define XB_XGEN(j)  (2304 + 64 * (j))
#define XB_TOP      3328
#define XB_TOPGEN   3392
#define XCD_BAR_WORDS 3456
#define XB_SPIN_CAP (1u << 18)
__device__ __forceinline__ unsigned xb_ld(unsigned* p)              { return __hip_atomic_load(p, __ATOMIC_RELAXED, __HIP_MEMORY_SCOPE_AGENT); }
__device__ __forceinline__ unsigned xb_add(unsigned* p, unsigned v) { return __hip_atomic_fetch_add(p, v, __ATOMIC_RELAXED, __HIP_MEMORY_SCOPE_AGENT); }
__device__ __forceinline__ unsigned xb_xcc_id() { return (unsigned)__builtin_amdgcn_s_getreg((3 << 11) | 20) & 0xFu; }
#define XB_SPIN(cond, bar) do { unsigned _sp = 0; while (cond) { __builtin_amdgcn_s_sleep(1); \
    if ((++_sp & 255u) == 0u) { if (xb_ld(&(bar)[XB_TMO])) break; if (_sp > XB_SPIN_CAP) { atomicAdd(&(bar)[XB_TMO], 1u); break; } } } } while (0)
struct XcdBarrier { unsigned* bar; unsigned x; volatile LAS unsigned* st; };
__device__ __forceinline__ XcdBarrier xcd_barrier_post(unsigned* bar, volatile LAS unsigned* st) {
    XcdBarrier b; b.bar = bar; b.x = xb_xcc_id(); b.st = st;
    if (threadIdx.x == 0) (void)xb_add(&bar[XB_XCNT(b.x)], 1u);
    return b;
}
__device__ __forceinline__ void xcd_barrier_complete(unsigned* bar, unsigned x, unsigned& nloc, unsigned& nx) {
    const unsigned G = gridDim.x * gridDim.y * gridDim.z;
    unsigned sum, cnt, mine, sp = 0u;
    for (;;) {
        sum = 0u; cnt = 0u; mine = 0u;
#pragma unroll
        for (unsigned j = 0; j < 16; ++j) { const unsigned c = xb_ld(&bar[XB_XCNT(j)]); sum += c; cnt += (c > 0u) ? 1u : 0u; mine = (j == x) ? c : mine; }
        if (sum == G) break;
        __builtin_amdgcn_s_sleep(1);
        if ((++sp & 255u) == 0u) { if (xb_ld(&bar[XB_TMO])) break; if (sp > XB_SPIN_CAP) { atomicAdd(&bar[XB_TMO], 1u); break; } }
    }
    nloc = mine > 0u ? mine : 1u; nx = cnt > 0u ? cnt : 1u;
}
__device__ __forceinline__ void xcd_barrier(const XcdBarrier& b) {
    asm volatile("s_waitcnt vmcnt(0)" ::: "memory");
    __syncthreads();
    if (threadIdx.x == 0) {
        unsigned* bar = b.bar;
        __builtin_amdgcn_s_waitcnt(0);
        unsigned nloc = b.st[0], nx = b.st[1];
        if (nloc == 0u) { xcd_barrier_complete(bar, b.x, nloc, nx); b.st[0] = nloc; b.st[1] = nx; }
        const unsigned old = xb_add(&bar[XB_XSUB(b.x)], 1u);
        const unsigned gen = old / nloc;
        if (old + 1u == (gen + 1u) * nloc) {
            __builtin_amdgcn_fence(__ATOMIC_RELEASE, "agent");
            asm volatile("s_waitcnt vmcnt(0)" ::: "memory");
            const unsigned og = xb_add(&bar[XB_TOP], 1u);
            const unsigned tg = og / nx;
            if (og + 1u == (tg + 1u) * nx) xb_add(&bar[XB_TOPGEN], 1u);
            else XB_SPIN(xb_ld(&bar[XB_TOPGEN]) == tg, bar);
            __builtin_amdgcn_fence(__ATOMIC_ACQUIRE, "agent");
            xb_add(&bar[XB_XGEN(b.x)], 1u);
            asm volatile("s_waitcnt vmcnt(0)" ::: "memory");
        } else {
            XB_SPIN(xb_ld(&bar[XB_XGEN(b.x)]) == gen, bar);
            __builtin_amdgcn_fence(__ATOMIC_ACQUIRE, "agent");
            asm volatile("s_waitcnt vmcnt(0)" ::: "memory");
        }
    }
    __syncthreads();
}

constexpr int LDS_BYTES = 147456;
constexpr int LDS_TB = 131072;
constexpr int LDS_MISC = 131072 + 1024;

__device__ __forceinline__ void phase_p0a(const P& p, LAS unsigned char* lds, int bid, int G, int tid, int wave, int lane) {
    { float* POS = (float*)(p.ws + WS_POS);
      for (int i = bid * 512 + tid; i < 64 * 512; i += G * 512) {
          const int n = i / 512, j = i % 512, q = j % 256;
          const float omega = 1.0f / powf(10000.0f, (float)q / 256.0f);
          const float ang = (float)n * omega;
          POS[i] = j < 256 ? sinf(ang) : cosf(ang);
      } }
    { bf16* RWT = (bf16*)(p.ws + WS_RWT);
      for (int i = bid * 512 + tid; i < DEPTH * NE * 128; i += G * 512) {
          const int kc = i % 128, e = (i / 128) % NE, l = i / (128 * NE);
          const float* s = p.in[I_RW] + (size_t)l * D * NE + (size_t)(8 * kc) * NE + e;
          u32x4 o; o.x = pk2(s[0], s[NE]); o.y = pk2(s[2 * NE], s[3 * NE]); o.z = pk2(s[4 * NE], s[5 * NE]); o.w = pk2(s[6 * NE], s[7 * NE]);
          *(u32x4*)(RWT + ((size_t)l * NE + e) * D + 8 * kc) = o;
      } }
    { float* SP = (float*)(p.ws + WS_SP);
      const int gt = bid * 512 + tid, gn = G * 512;
      for (int l = 0; l < DEPTH; ++l) {
          float* o = SP + (size_t)l * SP_STRIDE;
          for (int i = gt; i < 2048; i += gn) o[SP_CW + i] = p.in[I_CONVW][(size_t)l * 2048 + i];
          for (int i = gt; i < 512; i += gn) { o[SP_CB + i] = p.in[I_CONVB][(size_t)l * 512 + i]; o[SP_PB + i] = p.in[I_POOLB][(size_t)l * 512 + i]; o[SP_PS + i] = p.in[I_POOLS][(size_t)l * 512 + i]; }
          for (int i = gt; i < 1024; i += gn) { o[SP_GAB + i] = p.in[I_GAB][(size_t)l * 1024 + i]; o[SP_GXB + i] = p.in[I_GXB][(size_t)l * 1024 + i];
              const float nl = -p.in[I_LAM][(size_t)l * 1024 + i]; o[SP_CC + i] = 8.0f * (nl > 20.f ? nl : log1pf(expf(nl)));
              o[SP_L1G + i] = p.in[I_LN1G][(size_t)l * 1024 + i]; o[SP_L1B + i] = p.in[I_LN1B][(size_t)l * 1024 + i];
              o[SP_L2G + i] = p.in[I_LN2G][(size_t)l * 1024 + i]; o[SP_L2B + i] = p.in[I_LN2B][(size_t)l * 1024 + i]; }
          for (int i = gt; i < 32; i += gn) o[SP_RB + i] = p.in[I_RB][(size_t)l * 32 + i];
          for (int i = gt; i < 32 * 2048; i += gn) o[SP_B1 + i] = p.in[I_B1][(size_t)l * 32 * 2048 + i];
          for (int i = gt; i < 32 * 1024; i += gn) o[SP_B2 + i] = p.in[I_B2][(size_t)l * 32 * 1024 + i];
      } }
    { LAS float* sl = (LAS float*)lds; LAS float* part = sl + 9 * 1024;
      const float* c = p.in[I_C]; const float* cc = p.in[I_CCTX];
      for (int i = tid; i < 9 * 1024; i += 512) { const float v = i < 8192 ? c[i] : cc[i - 8192]; sl[i] = v / (1.0f + __expf(-v)); }
      __syncthreads();
      float* MOD = (float*)(p.ws + WS_MOD);
      for (int u = bid; u < 2 * 192; u += G) {
          const int l = u / 192, n0 = (u % 192) * 32;
          const float* W = p.in[I_WMOD] + (size_t)l * 1024 * 6144;
          const int col = tid & 31, ks = tid >> 5;
          float acc[9];
#pragma unroll
          for (int r = 0; r < 9; ++r) acc[r] = 0.f;
#pragma unroll 8
          for (int kk = 0; kk < 64; ++kk) {
              const int k = ks * 64 + kk;
              const float w = W[(size_t)k * 6144 + n0 + col];
#pragma unroll
              for (int r = 0; r < 9; ++r) acc[r] += sl[r * 1024 + k] * w;
          }
#pragma unroll
          for (int r = 0; r < 9; ++r) part[(ks * 9 + r) * 32 + col] = acc[r];
          __syncthreads();
          if (tid < 9 * 32) {
              const int r = tid / 32, cl = tid % 32; float s = 0.f;
#pragma unroll
              for (int q = 0; q < 16; ++q) s += part[(q * 9 + r) * 32 + cl];
              MOD[((size_t)l * 9 + r) * 6144 + n0 + cl] = s + p.in[I_BMOD][(size_t)l * 6144 + n0 + cl];
          }
          __syncthreads();
      } }
    __syncthreads();
    convert_weights(p, lds, bid * 8 + wave, G * 8, wave, lane);
}

__device__ __forceinline__ void phase_entry(const P& p, int gw, int ngw, int lane) {
    const float* POS = (const float*)(p.ws + WS_POS);
    const float* MOD = (const float*)(p.ws + WS_MOD);
    float* XL = (float*)(p.ws + WS_XL); bf16* H = (bf16*)(p.ws + WS_H);
    for (int tok = gw; tok < TT; tok += ngw) {
        const float* src = tok < TL ? p.in[I_X] + (size_t)tok * D : p.in[I_CTX] + (size_t)(tok - TL) * D;
        f32x4 v[4];
#pragma unroll
        for (int j = 0; j < 4; ++j) v[j] = ((const f32x4*)src)[lane + 64 * j];
        if (tok < TL) {
            const int s = tok & (SEQ - 1), pr = s / GRIDW, pc = s % GRIDW;
#pragma unroll
            for (int j = 0; j < 4; ++j) {
                const float* ps = POS + (size_t)(j < 2 ? pr : pc) * 512 + (4 * lane + 256 * (j & 1));
                v[j] += *(const f32x4*)ps;
            }
        }
        float mean, rstd; ln_stats(v, mean, rstd);
        const float* m = MOD + (size_t)mod_row(tok) * 6144;
        f32x4 h[4];
#pragma unroll
        for (int j = 0; j < 4; ++j) {
            v[j] = (v[j] - mean) * rstd;
            ((f32x4*)(XL + (size_t)tok * D))[lane + 64 * j] = v[j];
            const f32x4 sh = ((const f32x4*)m)[lane + 64 * j], sc = ((const f32x4*)(m + 1024))[lane + 64 * j];
            h[j] = v[j] * (sc + 1.0f) + sh;
        }
        store_bf16_row(H + (size_t)tok * D, lane, h);
    }
}

__device__ __forceinline__ float one_minus_exp_neg(float y) {
    const float s = y * (1.0f + y * (-0.5f + y * (0.16666667f + y * (-0.041666667f + y * (0.0083333333f - y * 0.0013888889f)))));
    const float d = 1.0f - __expf(-y);
    return y < 0.25f ? s : d;
}
template <bool FINAL>
__device__ __forceinline__ void lru_unit(unsigned char* ws, int l, LAS unsigned char* lds, int b, int grp, int h, int cb, int wave, int lane) {
    asm volatile("" : "+s"(wave)); asm volatile("" : "+v"(lane));
    const bf16* Z = (const bf16*)(ws + WS_Z);
    const int r = lane & 31, hh = lane >> 5;
    int seqbase, len, t0;
    if (grp == 0) { seqbase = TL + b * CTXL; len = CTXL; t0 = wave * 32; } else { seqbase = b * SEQ; len = SEQ; t0 = (grp - 1) * 256 + wave * 32; }
    const int t = t0 + r;
    const float* SP = (const float*)(ws + WS_SP) + (size_t)l * SP_STRIDE;
    const float* cw = SP + SP_CW; const float* cbias = SP + SP_CB;
    bf16x8 Af[4];
#pragma unroll
    for (int s = 0; s < 4; ++s) {
        const int c0 = 64 * h + 16 * s + 8 * hh;
        const f32x4 b0 = *(const f32x4*)(cbias + c0), b1 = *(const f32x4*)(cbias + c0 + 4);
        float u[8] = {b0.x, b0.y, b0.z, b0.w, b1.x, b1.y, b1.z, b1.w};
#pragma unroll
        for (int k = 0; k < 4; ++k) {
            const int tt = t + k - 2;
            u32x4 raw = (u32x4){0u, 0u, 0u, 0u};
            if (tt >= 0 && tt < len) raw = *(const u32x4*)(Z + (size_t)(seqbase + tt) * DIN + c0);
            const f32x4 w0 = *(const f32x4*)(cw + k * DLRU + c0), w1 = *(const f32x4*)(cw + k * DLRU + c0 + 4);
            u[0] += w0.x * bflo(raw.x); u[1] += w0.y * bfhi(raw.x); u[2] += w0.z * bflo(raw.y); u[3] += w0.w * bfhi(raw.y);
            u[4] += w1.x * bflo(raw.z); u[5] += w1.y * bfhi(raw.z); u[6] += w1.z * bflo(raw.w); u[7] += w1.w * bfhi(raw.w);
        }
        u32x4 pk; pk.x = pk2(u[0], u[1]); pk.y = pk2(u[2], u[3]); pk.z = pk2(u[4], u[5]); pk.w = pk2(u[6], u[7]);
        Af[s] = __builtin_bit_cast(bf16x8, pk);
        asm volatile("" ::: "memory");
    }
    const bf16* WG = (const bf16*)(ws + WS_WG) + (size_t)(l * NH + h) * 256 * HD;
    f32x16 accu;
#pragma unroll
    for (int i = 0; i < 16; ++i) accu[i] = 0.f;
    { const int nn = 32 * cb + r;
#pragma unroll
      for (int s = 0; s < 4; ++s) {
          u32x4 w = (u32x4){0u, 0u, 0u, 0u};
          if ((nn >> 4) == s && ((nn >> 3) & 1) == hh) { const unsigned one = 0x3F80u << (16 * (nn & 1)); const int wi = (nn & 7) >> 1;
              w.x = wi == 0 ? one : 0u; w.y = wi == 1 ? one : 0u; w.z = wi == 2 ? one : 0u; w.w = wi == 3 ? one : 0u; }
          accu = __builtin_amdgcn_mfma_f32_32x32x16_bf16(Af[s], __builtin_bit_cast(bf16x8, w), accu, 0, 0, 0);
      } }
    const int ch = 64 * h + 32 * cb + r;
    float C0 = 0.f, C1 = 0.f;
    if (FINAL) {
        const f32x2* AGGT = (const f32x2*)(ws + WS_AGGT); const f32x2* AGGG = (const f32x2*)(ws + WS_AGGG);
        float c = 0.f;
        const int d = hh;
        if (grp > 0) {
            { const f32x2 g0 = AGGG[((size_t)(b * NGRP + 0) * 2 + d) * DLRU + ch]; c = g0.y; }
            f32x2 gv[7];
#pragma unroll
            for (int i = 0; i < 7; ++i) { const int g = d ? 8 - i : 1 + i; const bool valid = d ? (i < 8 - grp) : (i < grp - 1);
                gv[i] = valid ? AGGG[((size_t)(b * NGRP + g) * 2 + d) * DLRU + ch] : (f32x2){1.f, 0.f}; }
#pragma unroll
            for (int i = 0; i < 7; ++i) c = gv[i].x * c + gv[i].y;
        }
        f32x2 tv[7];
#pragma unroll
        for (int i = 0; i < 7; ++i) { const int tw = d ? 7 - i : i; const bool valid = d ? (i < 7 - wave) : (i < wave);
            tv[i] = valid ? AGGT[((size_t)(b * NTILE + grp * 8 + tw) * 2 + d) * DLRU + ch] : (f32x2){1.f, 0.f}; }
#pragma unroll
        for (int i = 0; i < 7; ++i) c = tv[i].x * c + tv[i].y;
        C0 = __shfl(c, r); C1 = __shfl(c, 32 + r);
        asm volatile("" ::: "memory");
    }
    float hsum[16];
    float aggP[2], aggH[2];
#pragma unroll
    for (int d = 0; d < 2; ++d) {
        f32x16 ar, ai;
#pragma unroll
        for (int i = 0; i < 16; ++i) { ar[i] = 0.f; ai[i] = 0.f; }
        { const bf16* wr_ = WG + (size_t)((2 * d) * 64 + 32 * cb + r) * HD + 8 * hh; const bf16* wi_ = wr_ + 64 * HD;
#pragma unroll
          for (int s = 0; s < 4; ++s) { const bf16x8 Bf = *(const bf16x8*)(wr_ + 16 * s); ar = __builtin_amdgcn_mfma_f32_32x32x16_bf16(Af[s], Bf, ar, 0, 0, 0); }
#pragma unroll
          for (int s = 0; s < 4; ++s) { const bf16x8 Bf = *(const bf16x8*)(wi_ + 16 * s); ai = __builtin_amdgcn_mfma_f32_32x32x16_bf16(Af[s], Bf, ai, 0, 0, 0); } }
        const float ba = SP[SP_GAB + d * DLRU + ch], bx = SP[SP_GXB + d * DLRU + ch], cc = SP[SP_CC + d * DLRU + ch];
        float oP[4], oH[4];
#pragma unroll
        for (int q = 0; q < 4; ++q) {
#pragma unroll
            for (int j = 0; j < 4; ++j) { const int i = 4 * q + j;
                const float rr = fsigmoid(ar[i] + ba), ig = fsigmoid(ai[i] + bx);
                const float y = cc * rr;
                ar[i] = __expf(-y);
                ai[i] = sqrtf(one_minus_exp_neg(2.0f * y)) * (ig * accu[i]);
            }
            float Pp = 1.f, Hh = 0.f;
#pragma unroll
            for (int jj = 0; jj < 4; ++jj) { const int j = d ? 3 - jj : jj; Hh = ar[4 * q + j] * Hh + ai[4 * q + j]; Pp *= ar[4 * q + j]; }
            oP[q] = Pp; oH[q] = Hh;
            __builtin_amdgcn_sched_barrier(0);
        }
        float eP[4], eH[4], xP[4], xH[4];
#pragma unroll
        for (int q = 0; q < 4; ++q) { const float pP = __shfl_xor(oP[q], 32), pH = __shfl_xor(oH[q], 32);
            eP[q] = hh ? pP : oP[q]; eH[q] = hh ? pH : oH[q]; xP[q] = hh ? oP[q] : pP; xH[q] = hh ? oH[q] : pH; }
        float c = d ? C1 : C0, pall = 1.f;
        float mine[4];
        if (d == 0) {
#pragma unroll
            for (int q = 0; q < 4; ++q) { const float cE = c; c = eP[q] * c + eH[q]; const float cO = c; c = xP[q] * c + xH[q]; mine[q] = hh ? cO : cE; pall *= eP[q] * xP[q]; }
        } else {
#pragma unroll
            for (int q = 3; q >= 0; --q) { const float cO = c; c = xP[q] * c + xH[q]; const float cE = c; c = eP[q] * c + eH[q]; mine[q] = hh ? cO : cE; pall *= eP[q] * xP[q]; }
        }
        aggP[d] = pall; aggH[d] = c;
        if (FINAL) {
#pragma unroll
            for (int q = 0; q < 4; ++q) { float Hh = mine[q];
#pragma unroll
                for (int jj = 0; jj < 4; ++jj) { const int j = d ? 3 - jj : jj; Hh = ar[4 * q + j] * Hh + ai[4 * q + j]; if (d == 0) hsum[4 * q + j] = Hh; else hsum[4 * q + j] += Hh; } }
        }
        __builtin_amdgcn_sched_barrier(0);
    }
    if (!FINAL) {
        f32x2* AT = (f32x2*)(ws + WS_AGGT); f32x2* AG = (f32x2*)(ws + WS_AGGG);
        LAS f32x2* la = (LAS f32x2*)lds;
        if (hh == 0) {
#pragma unroll
            for (int d = 0; d < 2; ++d) { const f32x2 v = (f32x2){aggP[d], aggH[d]};
                AT[((size_t)(b * NTILE + grp * 8 + wave) * 2 + d) * DLRU + ch] = v; la[(wave * 2 + d) * 32 + r] = v; }
        }
        __syncthreads();
        if (wave == 0) {
            const int d = hh; float Pp = 1.f, Hh = 0.f;
#pragma unroll
            for (int i = 0; i < 8; ++i) { const int w = d ? 7 - i : i; const f32x2 v = la[(w * 2 + d) * 32 + r]; Hh = v.x * Hh + v.y; Pp *= v.x; }
            AG[((size_t)(b * NGRP + grp) * 2 + d) * DLRU + ch] = (f32x2){Pp, Hh};
        }
        __syncthreads();
    } else {
        bf16* MIX = (bf16*)(ws + WS_MIX);
#pragma unroll
        for (int i = 0; i < 16; ++i) {
            const int row = (i & 3) + 8 * (i >> 2) + 4 * hh;
            const size_t tok = (size_t)(seqbase + t0 + row);
            const float y = bf2f(Z[tok * DIN + DLRU + ch]);
            MIX[tok * D + ch] = (bf16)f2bf(hsum[i] * gelu_tanh(y));
        }
    }
}

constexpr int PX_PITCH = 528, PD_PITCH = 528;
constexpr int PX_OFF = 0, PD_OFF = 80 * PX_PITCH;
__device__ __forceinline__ void pool_unit(unsigned char* ws, int l, LAS unsigned char* lds, int c, int gp, int tid, int wave, int lane) {
    asm volatile("" : "+s"(wave)); asm volatile("" : "+v"(lane)); asm volatile("" : "+v"(tid));
    const bf16* Z = (const bf16*)(ws + WS_Z); bf16* MIX = (bf16*)(ws + WS_MIX);
    int seqbase, t0, seg_lo, seg_hi;
    if (c < 256) { seqbase = (c >> 5) * SEQ; t0 = (c & 31) * 64; seg_lo = t0; seg_hi = t0 + 64; }
    else { const int cc = c - 256; seqbase = TL + (cc >> 2) * CTXL; t0 = (cc & 3) * 64; seg_lo = 0; seg_hi = CTXL; }
    const int r_lo = max(t0 - 8, seg_lo), r_hi = min(t0 + 72, seg_hi);
    { const int sub = tid >> 5, l32 = tid & 31;
      for (int t = r_lo + sub; t < r_hi; t += 16) {
          const u32x4 v = *(const u32x4*)(Z + (size_t)(seqbase + t) * DIN + 2 * DLRU + 256 * gp + 8 * l32);
          *(LAS u32x4*)(lds + PX_OFF + (t - (t0 - 8)) * PX_PITCH + 16 * l32) = v;
      } }
    __syncthreads();
    { const int cp = tid & 127, tq = tid >> 7;
      const int g = 2 * gp + (cp >> 6);
      const int half = 1 << g;
      const LAS unsigned char* xb = lds + PX_OFF + 4 * cp - (t0 - 8) * PX_PITCH;
      int t = t0 + 16 * tq;
      int lo = max(t - half, seg_lo), hi = min(t + half, seg_hi);
      float s0 = 0.f, s1 = 0.f;
      for (int j = lo; j < hi; ++j) { const unsigned w = *(const LAS unsigned*)(xb + j * PX_PITCH); s0 += bflo(w); s1 += bfhi(w); }
#pragma unroll 4
      for (int i = 0; i < 16; ++i, ++t) {
          const unsigned wx = *(const LAS unsigned*)(xb + t * PX_PITCH);
          const float inv = 1.0f / (float)(hi - lo);
          const float d0 = s0 * inv - bflo(wx), d1 = s1 * inv - bfhi(wx);
          *(LAS unsigned*)(lds + PD_OFF + (t - t0) * PD_PITCH + 4 * cp) = pk2(d0, d1);
          const int nlo = max(t + 1 - half, seg_lo), nhi = min(t + 1 + half, seg_hi);
          if (nhi > hi) { const unsigned w = *(const LAS unsigned*)(xb + hi * PX_PITCH); s0 += bflo(w); s1 += bfhi(w); }
          if (nlo > lo) { const unsigned w = *(const LAS unsigned*)(xb + lo * PX_PITCH); s0 -= bflo(w); s1 -= bfhi(w); }
          lo = nlo; hi = nhi;
      } }
    __syncthreads();
    { const int gl = wave >> 2, th = (wave >> 1) & 1, nh = wave & 1, r = lane & 31, hh = lane >> 5;
      const int g = 2 * gp + gl;
      const bf16* WP = (const bf16*)(ws + WS_WP) + (size_t)(l * 4 + g) * 128 * 128;
      f32x16 acc[2];
#pragma unroll
      for (int q = 0; q < 2; ++q)
#pragma unroll
          for (int i = 0; i < 16; ++i) acc[q][i] = 0.f;
      const LAS unsigned char* arow = lds + PD_OFF + (th * 32 + r) * PD_PITCH + (gl * 128 + 8 * hh) * 2;
#pragma unroll
      for (int s = 0; s < 8; ++s) {
          const bf16x8 Af = *(const LAS bf16x8*)(arow + 32 * s);
#pragma unroll
          for (int nt = 0; nt < 2; ++nt) { const bf16x8 Bf = *(const bf16x8*)(WP + (size_t)(nh * 64 + nt * 32 + r) * 128 + 16 * s + 8 * hh);
              acc[nt] = __builtin_amdgcn_mfma_f32_32x32x16_bf16(Af, Bf, acc[nt], 0, 0, 0); }
      }
#pragma unroll
      for (int nt = 0; nt < 2; ++nt) {
          const int co = 128 * g + 64 * nh + 32 * nt + r;
          const float* SP = (const float*)(ws + WS_SP) + (size_t)l * SP_STRIDE; const float pb = SP[SP_PB + co], ps = SP[SP_PS + co];
#pragma unroll
          for (int i = 0; i < 16; ++i) {
              const int row = (i & 3) + 8 * (i >> 2) + 4 * hh;
              MIX[(size_t)(seqbase + t0 + th * 32 + row) * D + DLRU + co] = (bf16)f2bf((acc[nt][i] + pb) * ps);
          }
      } }
    __syncthreads();
}

constexpr int L1_PITCH = 2064;
constexpr int L1_PART = 16 * L1_PITCH;
__device__ __forceinline__ void phase_ln1(unsigned char* ws, int l, LAS unsigned char* lds, int bid, int G, int tid, int wave, int lane) {
    const float* MOD = (const float*)(ws + WS_MOD) + (size_t)l * 9 * 6144;
    float* XL = (float*)(ws + WS_XL); bf16* H = (bf16*)(ws + WS_H); const bf16* Y1 = (const bf16*)(ws + WS_Y1);
    const float* SP = (const float*)(ws + WS_SP) + (size_t)l * SP_STRIDE;
    const float* lg = SP + SP_L1G; const float* lb = SP + SP_L1B; const float* rb = SP + SP_RB;
    int* cnt = (int*)(ws + WS_CTL) + CW_CNT + 32 * l;
    int* TOPE = (int*)(ws + WS_TOPE); int* SLOT = (int*)(ws + WS_SLOT);
    int* ROWTOK = (int*)(ws + WS_ROWTOK); float* ROWGATE = (float*)(ws + WS_ROWGATE);
    const int ntok = (l == DEPTH - 1) ? TL : TT;
    const bf16* RWT = (const bf16*)(ws + WS_RWT) + (size_t)l * NE * D;
    bf16x8 Bf[4][2];
#pragma unroll
    for (int s = 0; s < 4; ++s)
#pragma unroll
        for (int nt = 0; nt < 2; ++nt) Bf[s][nt] = *(const bf16x8*)(RWT + (size_t)(16 * nt + (lane & 15)) * D + 128 * wave + 32 * s + 8 * (lane >> 4));
    LAS float* part = (LAS float*)(lds + L1_PART);
    LAS int* lcnt = (LAS int*)(lds + L1_PART + 16384);
    LAS int* lbase = lcnt + 32;
    LAS u32x4* ent = (LAS u32x4*)(lds + L1_PART + 16384 + 256);
    if (tid < 32) lcnt[tid] = 0;
    int nb_local = 0;
    __syncthreads();
    for (int batch = bid; batch < ntok / 16; batch += G) {
#pragma unroll 1
        for (int rr = 0; rr < 2; ++rr) {
            const int trow = 2 * wave + rr, tok = batch * 16 + trow;
            const float* m = MOD + (size_t)mod_row(tok) * 6144;
            f32x4 v[4], h[4];
#pragma unroll
            for (int j = 0; j < 4; ++j) {
                const f32x4 x = ((const f32x4*)(XL + (size_t)tok * D))[lane + 64 * j];
                const u32x2 yr = ((const u32x2*)(Y1 + (size_t)tok * D))[lane + 64 * j];
                const f32x4 g1 = ((const f32x4*)(m + 2048))[lane + 64 * j];
                f32x4 y; y.x = bflo(yr.x); y.y = bfhi(yr.x); y.z = bflo(yr.y); y.w = bfhi(yr.y);
                v[j] = x * ALPHA + g1 * y;
            }
            float mean, rstd; ln_stats(v, mean, rstd);
#pragma unroll
            for (int j = 0; j < 4; ++j) {
                const f32x4 gg = ((const f32x4*)lg)[lane + 64 * j], bb = ((const f32x4*)lb)[lane + 64 * j];
                v[j] = (v[j] - mean) * rstd * gg + bb;
                ((f32x4*)(XL + (size_t)tok * D))[lane + 64 * j] = v[j];
                const f32x4 sh = ((const f32x4*)(m + 3072))[lane + 64 * j], sc = ((const f32x4*)(m + 4096))[lane + 64 * j];
                h[j] = v[j] * (sc + 1.0f) + sh;
                u32x2 w; w.x = pk2(h[j].x, h[j].y); w.y = pk2(h[j].z, h[j].w);
                ((u32x2*)(H + (size_t)tok * D))[lane + 64 * j] = w;
                *(LAS u32x2*)(lds + trow * L1_PITCH + (4 * lane + 256 * j) * 2) = w;
            }
        }
        __syncthreads();
        {
            f32x4 a2[2] = {(f32x4){0.f, 0.f, 0.f, 0.f}, (f32x4){0.f, 0.f, 0.f, 0.f}};
            const LAS unsigned char* arow = lds + (lane & 15) * L1_PITCH + (128 * wave + 8 * (lane >> 4)) * 2;
#pragma unroll
            for (int s = 0; s < 4; ++s) { const bf16x8 Af = *(const LAS bf16x8*)(arow + 64 * s);
#pragma unroll
                for (int nt = 0; nt < 2; ++nt) a2[nt] = __builtin_amdgcn_mfma_f32_16x16x32_bf16(Af, Bf[s][nt], a2[nt], 0, 0, 0); }
#pragma unroll
            for (int nt = 0; nt < 2; ++nt)
#pragma unroll
                for (int i = 0; i < 4; ++i) part[(wave * 16 + 4 * (lane >> 4) + i) * 32 + 16 * nt + (lane & 15)] = a2[nt][i];
        }
        __syncthreads();
        {
            const int trow = tid >> 5, e = tid & 31, tok = batch * 16 + trow;
            float lgt = rb[e];
#pragma unroll
            for (int w = 0; w < 8; ++w) lgt += part[(w * 16 + trow) * 32 + e];
            float tv[4]; int ti[4];
            float cur = lgt;
#pragma unroll
            for (int k = 0; k < 4; ++k) {
                float bv = cur; int bi = e;
#pragma unroll
                for (int o = 1; o < 32; o <<= 1) { const float ov = __shfl_xor(bv, o); const int oi = __shfl_xor(bi, o); if (ov > bv || (ov == bv && oi < bi)) { bv = ov; bi = oi; } }
                tv[k] = bv; ti[k] = bi;
                if (e == bi) cur = -INFINITY;
            }
            const float e1 = __expf(tv[1] - tv[0]), e2 = __expf(tv[2] - tv[0]), e3 = __expf(tv[3] - tv[0]);
            const float inv = 1.0f / (1.0f + e1 + e2 + e3);
            if (e < 4) {
                const int ex = e == 0 ? ti[0] : e == 1 ? ti[1] : e == 2 ? ti[2] : ti[3];
                const float pg = (e == 0 ? 1.0f : e == 1 ? e1 : e == 2 ? e2 : e3) * inv;
                const int ls = __hip_atomic_fetch_add(lcnt + ex, 1, __ATOMIC_RELAXED, __HIP_MEMORY_SCOPE_WORKGROUP);
                const int idx = (nb_local * 16 + trow) * 4 + e;
                ent[idx] = (u32x4){(unsigned)tok, (unsigned)ex, (unsigned)ls, __float_as_uint(pg)};
            }
        }
        ++nb_local;
        __syncthreads();
    }
    if (tid < 32) { const int c = lcnt[tid]; lbase[tid] = c > 0 ? atomicAdd(&cnt[tid], c) : 0; }
    __syncthreads();
    for (int i = tid; i < nb_local * 64; i += 512) {
        const u32x4 en = ent[i]; const int tok = (int)en.x, ex = (int)en.y, slot = lbase[ex] + (int)en.z;
        ROWTOK[(size_t)ex * TT + slot] = tok; ROWGATE[(size_t)ex * TT + slot] = __uint_as_float(en.w);
        TOPE[tok * 4 + (i & 3)] = ex; SLOT[tok * 4 + (i & 3)] = slot;
    }
    __syncthreads();
}

__device__ __forceinline__ void phase_ln2(unsigned char* ws, float* out, int l, int gw, int ngw, int lane) {
    const float* MOD = (const float*)(ws + WS_MOD) + (size_t)l * 9 * 6144;
    float* XL = (float*)(ws + WS_XL); bf16* H = (bf16*)(ws + WS_H); const bf16* Y2 = (const bf16*)(ws + WS_Y2);
    const float* SP = (const float*)(ws + WS_SP) + (size_t)l * SP_STRIDE;
    const float* lg = SP + SP_L2G; const float* lb = SP + SP_L2B;
    const int* cnt = (const int*)(ws + WS_CTL) + CW_CNT + 32 * l;
    const int* TOPE = (const int*)(ws + WS_TOPE); const int* SLOT = (const int*)(ws + WS_SLOT);
    int offl;
    { const int c = lane < 32 ? pad256(cnt[lane]) : 0; int s = c;
#pragma unroll
      for (int o = 1; o < 32; o <<= 1) { const int t = __shfl_up(s, o); if ((lane & 31) >= o) s += t; }
      offl = s - c; }
    const bool last = (l == DEPTH - 1);
    const int ntok = last ? TL : TT;
    for (int tok = gw; tok < ntok; tok += ngw) {
        const float* m = MOD + (size_t)mod_row(tok) * 6144;
        f32x4 f[4];
#pragma unroll
        for (int j = 0; j < 4; ++j) f[j] = (f32x4){0.f, 0.f, 0.f, 0.f};
#pragma unroll
        for (int k = 0; k < 4; ++k) {
            const int e = TOPE[tok * 4 + k], slot = SLOT[tok * 4 + k];
            const int row = __shfl(offl, e) + slot;
            const u32x2* yr = (const u32x2*)(Y2 + (size_t)row * D);
#pragma unroll
            for (int j = 0; j < 4; ++j) { const u32x2 rw2 = yr[lane + 64 * j];
                f[j].x += bflo(rw2.x); f[j].y += bfhi(rw2.x); f[j].z += bflo(rw2.y); f[j].w += bfhi(rw2.y); }
        }
        f32x4 v[4];
#pragma unroll
        for (int j = 0; j < 4; ++j) {
            const f32x4 x = ((const f32x4*)(XL + (size_t)tok * D))[lane + 64 * j];
            const f32x4 g2 = ((const f32x4*)(m + 5120))[lane + 64 * j];
            v[j] = x * ALPHA + g2 * f[j];
        }
        float mean, rstd; ln_stats(v, mean, rstd);
        f32x4 h[4];
        const float* mn = MOD + (size_t)9 * 6144 + (size_t)mod_row(tok) * 6144;
#pragma unroll
        for (int j = 0; j < 4; ++j) {
            const f32x4 gg = ((const f32x4*)lg)[lane + 64 * j], bb = ((const f32x4*)lb)[lane + 64 * j];
            v[j] = (v[j] - mean) * rstd * gg + bb;
            if (last) ((f32x4*)(out + (size_t)tok * D))[lane + 64 * j] = v[j];
            else {
                ((f32x4*)(XL + (size_t)tok * D))[lane + 64 * j] = v[j];
                const f32x4 sh = ((const f32x4*)mn)[lane + 64 * j], sc = ((const f32x4*)(mn + 1024))[lane + 64 * j];
                h[j] = v[j] * (sc + 1.0f) + sh;
            }
        }
        if (!last) store_bf16_row(H + (size_t)tok * D, lane, h);
    }
}

constexpr int NPHASE = 2 + 8 * DEPTH;
#ifndef PHMASK
#define PHMASK 0xFFFF
#endif
#define PH_ON(k) (((PHMASK) >> (k)) & 1)
#ifndef MK_PER_PHASE
#define MK_PER_PHASE 0
#endif
__global__ void __launch_bounds__(512, 2) mk_fwd(P p) {
    extern __shared__ __attribute__((aligned(16))) unsigned char lds_[];
    LAS unsigned char* lds = (LAS unsigned char*)lds_;
    const int tid = threadIdx.x, lane = tid & 63, wave = __builtin_amdgcn_readfirstlane(tid >> 6);
    const int G = gridDim.x, bid = blockIdx.x;
    volatile LAS unsigned* MISC = (volatile LAS unsigned*)(lds + LDS_MISC);
    if (tid < 4) MISC[tid] = 0u;
    __syncthreads();
    unsigned* barw = (unsigned*)(p.ws + WS_CTL) + CW_BAR;
    XcdBarrier bar; bar.bar = barw; bar.x = 0; bar.st = MISC;
    if (!MK_PER_PHASE) bar = xcd_barrier_post(barw, MISC);
    const int lo = p.ph_lo, hi = p.ph_hi;
#define IN(k) (lo <= (k) && (k) < hi)
#define SEAM(k) do { if (IN(k) && IN((k) + 1)) xcd_barrier(bar); } while (0)
    if (PH_ON(0) && IN(0)) { phase_p0a(p, lds, bid, G, tid, wave, lane); }
    SEAM(0);
    if (PH_ON(1) && IN(1)) { phase_entry(p, bid * 8 + wave, G * 8, lane); }
    SEAM(1);
#pragma unroll 1
    for (int l = 0; l < DEPTH; ++l) {
        const int pb = 2 + 8 * l;
#define FRESH() int tid_ = threadIdx.x; asm volatile("" : "+v"(tid_)); const int lane_ = tid_ & 63; const int wave_ = __builtin_amdgcn_readfirstlane(tid_ >> 6); \
                size_t wz_ = 0; asm volatile("" : "+s"(wz_)); unsigned char* ws = p.ws + wz_; (void)lane_; (void)wave_
        if (PH_ON(2) && IN(pb + 0)) {
            FRESH();
            pg8::DenseOrder S; S.init(TT / 256, DIN / 256, G, bid);
            pg8::EpiStore E{(bf16*)(ws + WS_Z), DIN};
            pg8::gemm_phase<false>(lds, tid_, (const bf16*)(ws + WS_H), (const bf16*)(ws + WS_WIN) + (size_t)l * DIN * D, nullptr, S, E);
        }
        SEAM(pb + 0);
        if (PH_ON(3) && IN(pb + 1)) {
            FRESH();
            for (int u = bid; u < NB * NGRP * NH * 2; u += G) { const int cb = u & 1, h = (u >> 1) & 7, bg = u >> 4; lru_unit<false>(ws, l, lds, bg / NGRP, bg % NGRP, h, cb, wave_, lane_); }
        }
        SEAM(pb + 1);
        if (PH_ON(4) && IN(pb + 2)) {
            FRESH();
            const int g0 = (l == DEPTH - 1) ? 1 : 0, ng = NGRP - g0;
            const int nlru = NB * ng * NH * 2, npool = ((l == DEPTH - 1) ? 256 : 288) * 2;
            for (int u = bid; u < nlru + npool; u += G) {
                if (u < nlru) { const int cb = u & 1, h = (u >> 1) & 7, bg = u >> 4; lru_unit<true>(ws, l, lds, bg / ng, g0 + bg % ng, h, cb, wave_, lane_); }
                else { const int q = u - nlru; pool_unit(ws, l, lds, q >> 1, q & 1, tid_, wave_, lane_); }
            }
        }
        SEAM(pb + 2);
        if (PH_ON(5) && IN(pb + 3)) {
            FRESH();
            pg8::DenseOrder S; S.init((l == DEPTH - 1 ? TL : TT) / 256, D / 256, G, bid);
            pg8::EpiStore E{(bf16*)(ws + WS_Y1), D};
            pg8::gemm_phase<false>(lds, tid_, (const bf16*)(ws + WS_MIX), (const bf16*)(ws + WS_WOUT) + (size_t)l * D * D, nullptr, S, E);
        }
        SEAM(pb + 3);
        if (PH_ON(6) && IN(pb + 4)) { FRESH(); phase_ln1(ws, l, lds, bid, G, tid_, wave_, lane_); }
        SEAM(pb + 4);
        if (IN(pb + 5) || IN(pb + 6)) {
            FRESH();
            const int* cnt = (const int*)(ws + WS_CTL) + CW_CNT + 32 * l;
            LAS int* tb = (LAS int*)(lds + LDS_TB);
            if (tid_ < 64) { const int c = lane_ < 32 ? (cnt[lane_] + 255) >> 8 : 0; int s = c;
#pragma unroll
                for (int o = 1; o < 32; o <<= 1) { const int t = __shfl_up(s, o); if (lane_ >= o) s += t; }
                if (lane_ < 32) tb[lane_ + 1] = s; if (lane_ == 0) tb[0] = 0; }
            __syncthreads();
        }
        if (PH_ON(7) && IN(pb + 5)) {
            FRESH();
            const int* cnt = (const int*)(ws + WS_CTL) + CW_CNT + 32 * l;
            pg8::MoeOrder<8, true> S{(const LAS int*)(lds + LDS_TB), cnt, G, bid};
            pg8::EpiSwiglu E{(bf16*)(ws + WS_ACT), (const float*)(ws + WS_SP) + (size_t)l * SP_STRIDE + SP_B1};
            pg8::gemm_phase<true>(lds, tid_, (const bf16*)(ws + WS_H), (const bf16*)(ws + WS_W1T) + (size_t)l * NE * 2 * DF * D, (const int*)(ws + WS_ROWTOK), S, E);
        }
        SEAM(pb + 5);
        if (PH_ON(8) && IN(pb + 6)) {
            FRESH();
            const int* cnt = (const int*)(ws + WS_CTL) + CW_CNT + 32 * l;
            pg8::MoeOrder<4, false> S{(const LAS int*)(lds + LDS_TB), cnt, G, bid};
            pg8::EpiDown E{(bf16*)(ws + WS_Y2), (const float*)(ws + WS_SP) + (size_t)l * SP_STRIDE + SP_B2, (const float*)(ws + WS_ROWGATE)};
            pg8::gemm_phase<false>(lds, tid_, (const bf16*)(ws + WS_ACT), (const bf16*)(ws + WS_W2T) + (size_t)l * NE * D * DF, nullptr, S, E);
        }
        SEAM(pb + 6);
        if (PH_ON(9) && IN(pb + 7)) { FRESH(); phase_ln2(ws, p.out, l, bid * 8 + wave_, G * 8, lane_); }
        SEAM(pb + 7);
#undef FRESH
    }
#undef IN
#undef SEAM
}

extern "C" void kernel_launch(void* const* d_in, const int* in_sizes, int n_in, void* d_out, int out_size, void* d_ws, size_t ws_size, hipStream_t stream) {
    static int grid = 0;
    if (grid == 0) {
        if (n_in != N_IN || ws_size < WS_END || out_size != TL * D) { fprintf(stderr, "kernel_launch: unexpected shapes (n_in %d, out %d, ws %zu)\n", n_in, out_size, ws_size); grid = -1; return; }
        int dev = 0, cus = 0, per_cu = 0;
        if (hipGetDevice(&dev) != hipSuccess || hipDeviceGetAttribute(&cus, hipDeviceAttributeMultiprocessorCount, dev) != hipSuccess) { grid = -1; return; }
        if (hipFuncSetAttribute((const void*)mk_fwd, hipFuncAttributeMaxDynamicSharedMemorySize, LDS_BYTES) != hipSuccess) { fprintf(stderr, "kernel_launch: hipFuncSetAttribute failed\n"); grid = -1; return; }
        if (hipOccupancyMaxActiveBlocksPerMultiprocessor(&per_cu, (const void*)mk_fwd, 512, LDS_BYTES) != hipSuccess || per_cu < 1) { fprintf(stderr, "kernel_launch: occupancy query says %d\n", per_cu); }
        (void)hipGetLastError();
        grid = cus;
    }
    if (grid < 0) return;
    (void)hipMemsetAsync((char*)d_ws + WS_CTL, 0, CTL_BYTES, stream);
    P p{};
    for (int i = 0; i < N_IN; ++i) p.in[i] = (const float*)d_in[i];
    p.out = (float*)d_out; p.ws = (unsigned char*)d_ws;
#if MK_PER_PHASE
    for (int ph = 0; ph < NPHASE; ++ph) { p.ph_lo = ph; p.ph_hi = ph + 1; hipLaunchKernelGGL(mk_fwd, dim3(grid), dim3(512), LDS_BYTES, stream, p);
#ifdef EXTRA_PHASE
        if (ph == EXTRA_PHASE) for (int r = 0; r < EXTRA_REPS; ++r) hipLaunchKernelGGL(mk_fwd, dim3(grid), dim3(512), LDS_BYTES, stream, p);
#endif
    }
#else
    p.ph_lo = 0; p.ph_hi = NPHASE;
    hipLaunchKernelGGL(mk_fwd, dim3(grid), dim3(512), LDS_BYTES, stream, p);
#endif
}
```

```cpp
#include <hip/hip_runtime.h>
#include <cstdio>
#include <cstdint>

constexpr int NB = 8, SEQ = 2048, D = 1024, CTXL = 256, DEPTH = 2;
constexpr int TL = NB * SEQ;
constexpr int TC = NB * CTXL;
constexpr int TT = TL + TC;
constexpr int DLRU = 512, DPOOL = 512, DIN = 1536, NH = 8, HD = 64;
constexpr int NE = 32, TOPK = 4, DF = 1024;
constexpr int GRIDW = 64;
constexpr float LN_EPS = 1e-5f;
constexpr float ALPHA = 1.41421356237309515f;
constexpr int MAXROWS = 81920;
constexpr int NTILE = 72, NGRP = 9;

enum { I_X = 0, I_C, I_CTX, I_CCTX, I_WMOD, I_BMOD, I_WIN, I_CONVW, I_CONVB, I_GAW, I_GAB, I_GXW, I_GXB, I_LAM, I_POOLW, I_POOLB, I_POOLS,
       I_WOUT, I_LN1G, I_LN1B, I_RW, I_RB, I_W1, I_B1, I_W2, I_B2, I_LN2G, I_LN2B, N_IN };

constexpr size_t MiB = 1u << 20;
constexpr size_t WS_CTL = 0, CTL_BYTES = 1 * MiB;
constexpr size_t WS_MOD = 1 * MiB;
constexpr size_t WS_POS = 2 * MiB;
constexpr size_t WS_RWT = 2 * MiB + 512 * 1024;
constexpr size_t WS_ROWTOK = 4 * MiB;
constexpr size_t WS_ROWGATE = 7 * MiB;
constexpr size_t WS_AGGT = 10 * MiB;
constexpr size_t WS_AGGG = 15 * MiB;
constexpr size_t WS_WIN = 16 * MiB, WS_WOUT = 23 * MiB, WS_WG = 28 * MiB, WS_WP = 29 * MiB;
constexpr size_t WS_SP = 30 * MiB;
constexpr size_t WS_W1T = 32 * MiB, WS_W2T = 288 * MiB;
constexpr int SP_CW = 0, SP_CB = 2048, SP_GAB = 2560, SP_GXB = 3584, SP_CC = 4608, SP_PB = 5632, SP_PS = 6144, SP_L1G = 6656, SP_L1B = 7680, SP_L2G = 8704, SP_L2B = 9728, SP_RB = 10752,
              SP_B1 = 12288, SP_B2 = SP_B1 + 32 * 2048, SP_STRIDE = SP_B2 + 32 * 1024;
constexpr size_t WS_XL = 416 * MiB;
constexpr size_t WS_H = 488 * MiB;
constexpr size_t WS_Z = 524 * MiB;
constexpr size_t WS_MIX = 578 * MiB;
constexpr size_t WS_Y1 = 614 * MiB;
constexpr size_t WS_ACT = 650 * MiB;
constexpr size_t WS_Y2 = 810 * MiB;
constexpr size_t WS_YB = 970 * MiB;
constexpr size_t WS_ROWDST = 1046 * MiB;
constexpr size_t WS_END = 1049 * MiB;
constexpr int CW_CNT = 64;
constexpr int CW_BAR = 4096;

typedef unsigned short bf16;
typedef float f32x4 __attribute__((ext_vector_type(4)));
typedef float f32x2 __attribute__((ext_vector_type(2)));
typedef float f32x16 __attribute__((ext_vector_type(16)));
typedef unsigned u32x2 __attribute__((ext_vector_type(2)));
typedef unsigned u32x4 __attribute__((ext_vector_type(4)));
typedef short bf16x8 __attribute__((ext_vector_type(8)));

__device__ __forceinline__ float bf2f(bf16 v) { return __uint_as_float(((unsigned)v) << 16); }
__device__ __forceinline__ float bflo(unsigned w) { return __uint_as_float(w << 16); }
__device__ __forceinline__ float bfhi(unsigned w) { return __uint_as_float(w & 0xffff0000u); }
__device__ __forceinline__ unsigned f2bf(float f) { unsigned u = __float_as_uint(f); return (u + 0x7fffu + ((u >> 16) & 1u)) >> 16; }
__device__ __forceinline__ unsigned pk2(float lo, float hi) { return f2bf(lo) | (f2bf(hi) << 16); }
__device__ __forceinline__ float wave_sum(float v) {
#pragma unroll
    for (int o = 1; o < 64; o <<= 1) v += __shfl_xor(v, o);
    return v;
}
__device__ __forceinline__ float fsigmoid(float x) { return __builtin_amdgcn_rcpf(1.0f + __expf(-x)); }
__device__ __forceinline__ float gelu_tanh(float x) {
    const float u = 0.7978845608028654f * (x + 0.044715f * x * x * x);
    const float t = 1.0f - 2.0f * __builtin_amdgcn_rcpf(__expf(2.0f * u) + 1.0f);
    return 0.5f * x * (1.0f + t);
}

struct P {
    const float* in[N_IN];
    float* out;
    unsigned char* ws;
    int ph_lo, ph_hi;
};

__device__ __forceinline__ int mod_row(int tok) { return tok < TL ? (tok >> 11) : NB; }
__device__ __forceinline__ int pad256(int c) { return (c + 255) & ~255; }

__device__ __forceinline__ void ln_stats(const f32x4 (&v)[4], float& mean, float& rstd) {
    float s = 0.f;
#pragma unroll
    for (int j = 0; j < 4; ++j) s += (v[j].x + v[j].y) + (v[j].z + v[j].w);
    mean = wave_sum(s) * (1.f / D);
    float s2 = 0.f;
#pragma unroll
    for (int j = 0; j < 4; ++j) { const f32x4 d = v[j] - mean; s2 += (d.x * d.x + d.y * d.y) + (d.z * d.z + d.w * d.w); }
    rstd = 1.0f / sqrtf(wave_sum(s2) * (1.f / D) + LN_EPS);
}
__device__ __forceinline__ void store_bf16_row(bf16* row, int lane, const f32x4 (&h)[4]) {
    u32x2* o = (u32x2*)row + lane;
#pragma unroll
    for (int j = 0; j < 4; ++j) { u32x2 w; w.x = pk2(h[j].x, h[j].y); w.y = pk2(h[j].z, h[j].w); o[64 * j] = w; }
}


#define LAS __attribute__((address_space(3)))
__device__ __forceinline__ void transpose_tile(const float* src, int N, bf16* dst, int Kp, LAS float* scr, int lane) {
    f32x4 v[16];
#pragma unroll
    for (int i = 0; i < 16; ++i) { const int k = 4 * i + (lane >> 4); v[i] = *(const f32x4*)(src + (size_t)k * N + 4 * (lane & 15)); }
#pragma unroll
    for (int i = 0; i < 16; ++i) { const int k = 4 * i + (lane >> 4); const int nn = (4 * (lane & 15)) ^ (((k >> 3) & 3) << 3); *(LAS f32x4*)(scr + k * 64 + nn) = v[i]; }
    asm volatile("s_waitcnt lgkmcnt(0)" ::: "memory");
    const int c = lane & 7, sw = (c & 3) << 3;
#pragma unroll
    for (int j = 0; j < 8; ++j) {
        const int n = (lane >> 3) + 8 * j;
        const LAS float* s = scr + (8 * c) * 64 + (n ^ sw);
        u32x4 o; o.x = pk2(s[0], s[64]); o.y = pk2(s[128], s[192]); o.z = pk2(s[256], s[320]); o.w = pk2(s[384], s[448]);
        *(u32x4*)(dst + (size_t)n * Kp + 8 * c) = o;
    }
    asm volatile("s_waitcnt lgkmcnt(0)" ::: "memory");
}
__device__ __forceinline__ void convert_weights(const P& p, LAS unsigned char* lds, int gw, int ngw, int wave, int lane) {
    LAS float* scr = (LAS float*)(lds + wave * 16384);
    bf16* WINT = (bf16*)(p.ws + WS_WIN); bf16* WOUTT = (bf16*)(p.ws + WS_WOUT); bf16* W1T = (bf16*)(p.ws + WS_W1T); bf16* W2T = (bf16*)(p.ws + WS_W2T);
    bf16* WGT = (bf16*)(p.ws + WS_WG); bf16* WPT = (bf16*)(p.ws + WS_WP);
    constexpr int I_IN = DEPTH * 16 * 24, I_OUT = DEPTH * 16 * 16, I_G = DEPTH * 2 * 2 * NH, I_P = DEPTH * 4 * 4, I_1 = DEPTH * NE * 16 * 32, I_2 = DEPTH * NE * 16 * 16;
    constexpr int NITEMS = I_IN + I_OUT + I_G + I_P + I_1 + I_2;
    for (int it = gw; it < NITEMS; it += ngw) {
        int r = it;
        if (r < I_IN) { const int l = r / 384, q = r % 384, kb = q / 24, nb = q % 24;
            transpose_tile(p.in[I_WIN] + (size_t)l * D * DIN + (size_t)(64 * kb) * DIN + 64 * nb, DIN, WINT + ((size_t)l * DIN + 64 * nb) * D + 64 * kb, D, scr, lane); continue; }
        r -= I_IN;
        if (r < I_OUT) { const int l = r / 256, q = r % 256, kb = q / 16, nb = q % 16;
            transpose_tile(p.in[I_WOUT] + (size_t)l * D * D + (size_t)(64 * kb) * D + 64 * nb, D, WOUTT + ((size_t)l * D + 64 * nb) * D + 64 * kb, D, scr, lane); continue; }
        r -= I_OUT;
        if (r < I_G) {
            const int h = r % NH, gt = (r / NH) % 2, d = (r / (NH * 2)) % 2, l = r / (NH * 4);
            const float* s = (gt ? p.in[I_GXW] : p.in[I_GAW]) + ((size_t)(l * 2 + d) * NH + h) * HD * HD;
            transpose_tile(s, HD, WGT + ((size_t)(l * NH + h) * 256 + (d * 2 + gt) * 64) * HD, HD, scr, lane); continue; }
        r -= I_G;
        if (r < I_P) {
            const int nb = r % 2, kb = (r / 2) % 2, lg = r / 4;
            transpose_tile(p.in[I_POOLW] + (size_t)lg * 128 * 128 + (size_t)(64 * kb) * 128 + 64 * nb, 128, WPT + ((size_t)lg * 128 + 64 * nb) * 128 + 64 * kb, 128, scr, lane); continue; }
        r -= I_P;
        if (r < I_1) {
            const int le = r / 512, q = r % 512, kb = q / 32, nb = q % 32;
            const int n0 = 64 * nb, j0 = n0 % DF, half = n0 / DF, row0 = (j0 / 128) * 256 + half * 128 + (j0 % 128);
            transpose_tile(p.in[I_W1] + (size_t)le * D * 2 * DF + (size_t)(64 * kb) * (2 * DF) + n0, 2 * DF, W1T + ((size_t)le * 2 * DF + row0) * D + 64 * kb, D, scr, lane); continue; }
        r -= I_1;
        { const int le = r / 256, q = r % 256, kb = q / 16, nb = q % 16;
          transpose_tile(p.in[I_W2] + (size_t)le * DF * D + (size_t)(64 * kb) * D + 64 * nb, D, W2T + ((size_t)le * D + 64 * nb) * DF + 64 * kb, DF, scr, lane); }
    }
}
namespace pg8 {
typedef short bf16x8 __attribute__((ext_vector_type(8)));
constexpr int BM = 256, BK = 64, HALF = 128, HTB = HALF * BK * 2, STAGE_BYTES = 8 * HTB;
__host__ __device__ __forceinline__ int lds_byte(int r, int c) { const int st = (r >> 4) * 2 + (c >> 5), rr = r & 15, cc = c & 31, ob = rr * 64 + cc * 2; return st * 1024 + (ob ^ (((ob >> 9) & 1) << 5)); }
__host__ __device__ __forceinline__ void stage_rc(int b, int& R, int& C) { const int st = b / 1024, sb = b % 1024, swz = sb ^ (((sb >> 9) & 1) << 5); R = (st >> 1) * 16 + swz / 64; C = (st & 1) * 32 + (swz % 64) / 2; }
__host__ __device__ __forceinline__ int perm32(int rho) { const int n = rho >> 4, i = rho & 15; return 8 * (i >> 2) + 4 * n + (i & 3); }
__device__ __forceinline__ unsigned cvt_pk_bf16(float lo, float hi) { unsigned r; asm volatile("v_cvt_pk_bf16_f32 %0, %1, %2" : "=v"(r) : "v"(lo), "v"(hi)); return r; }

struct Unit { int a0, nvalid, b0, o0, pn, e, g0; };

template <bool GATHER, class Sched, class Epi>
__device__ __forceinline__ void gemm_phase(LAS unsigned char* lds, int tid, const bf16* Abase_, const bf16* Bt_, const int* glist, const Sched& S, const Epi& E) {
    constexpr int K = 1024, nt = K / BK;
    const int wid = __builtin_amdgcn_readfirstlane(tid >> 6), lane = tid & 63, wr = wid >> 2, wc = wid & 3, fr = lane & 15, fq = lane >> 4;
    int Rr[2], Cc[2]; unsigned voffB[2];
#pragma unroll
    for (int i = 0; i < 2; ++i) { int R, C; stage_rc(tid * 16 + i * 8192, R, C); Rr[i] = R; Cc[i] = C; const int Rb = (R & ~31) + perm32(R & 31); voffB[i] = (unsigned)(Rb * K + C) * 2u; }
    constexpr size_t kstep = (size_t)(BK * 2);
    constexpr size_t hstep = (size_t)HALF * K * 2;
    const unsigned ldsw = (unsigned)wid * 1024u;
    const int aoff = lds_byte(wr * 64 + fr, fq * 8), boff = lds_byte(wc * 32 + fr, fq * 8);
    const char* Abase = (const char*)Abase_;
#define PG8_SA(b, h) (((b) * 2 + (h)) * HTB)
#define PG8_SB(b, h) ((4 + (b) * 2 + (h)) * HTB)
#define PG8_STAGE_B(bufoff, gbase) do { _Pragma("unroll") for (int _i = 0; _i < 2; ++_i) \
        __builtin_amdgcn_global_load_lds((const unsigned*)((const char*)(gbase) + voffB[_i]), (LAS unsigned*)(lds + (bufoff) + ldsw + _i * 8192), 16, 0, 0); } while (0)
#define PG8_STAGE_A(bufoff, gbase, o0_, o1_) do { \
        __builtin_amdgcn_global_load_lds((const unsigned*)((const char*)(gbase) + (o0_)), (LAS unsigned*)(lds + (bufoff) + ldsw), 16, 0, 0); \
        __builtin_amdgcn_global_load_lds((const unsigned*)((const char*)(gbase) + (o1_)), (LAS unsigned*)(lds + (bufoff) + ldsw + 8192), 16, 0, 0); } while (0)
#define PG8_LDA(dst, b, h) do { _Pragma("unroll") for (int m = 0; m < 4; ++m) _Pragma("unroll") for (int k = 0; k < 2; ++k) dst[m][k] = *(const LAS bf16x8*)(lds + PG8_SA(b, h) + aoff + m * 2048 + k * 1024); } while (0)
#define PG8_LDB(dst, b, h) do { _Pragma("unroll") for (int n = 0; n < 2; ++n) _Pragma("unroll") for (int k = 0; k < 2; ++k) dst[n][k] = *(const LAS bf16x8*)(lds + PG8_SB(b, h) + boff + n * 2048 + k * 1024); } while (0)
#define PG8_MMA(ai, bj, At, Bt) do { __builtin_amdgcn_s_setprio(1); _Pragma("unroll") for (int m = 0; m < 4; ++m) _Pragma("unroll") for (int n = 0; n < 2; ++n) _Pragma("unroll") for (int k = 0; k < 2; ++k) \
        acc[ai][bj][m][n] = __builtin_amdgcn_mfma_f32_16x16x32_bf16(Bt[n][k], At[m][k], acc[ai][bj][m][n], 0, 0, 0); __builtin_amdgcn_s_setprio(0); } while (0)
#define PG8_WAIT_V(n) asm volatile("s_waitcnt vmcnt(" #n ")" ::: "memory")
#define PG8_WAIT_L(n) asm volatile("s_waitcnt lgkmcnt(" #n ")" ::: "memory")
#define PG8_BAR __builtin_amdgcn_s_barrier()
#define PG8_SCHED __builtin_amdgcn_sched_barrier(0)
#define PG8_AOFFS(u, ao) do { _Pragma("unroll") for (int _h = 0; _h < 2; ++_h) _Pragma("unroll") for (int _i = 0; _i < 2; ++_i) { \
        const int _r = _h * HALF + Rr[_i]; int _row; \
        if (GATHER) { _row = (_r < (u).nvalid) ? glist[(u).a0 + _r] : 0; } else { _row = (u).a0 + _r; } \
        ao[_h][_i] = (unsigned)(_row * K + Cc[_i]) * 2u; } } while (0)
    Unit cur, nxt; int ui = 0;
    if (!S.next(0, cur)) return;
    f32x4 acc[2][2][4][2];
#pragma unroll
    for (int a = 0; a < 2; ++a)
#pragma unroll
        for (int b = 0; b < 2; ++b)
#pragma unroll
            for (int m = 0; m < 4; ++m)
#pragma unroll
                for (int n = 0; n < 2; ++n) acc[a][b][m][n] = (f32x4){0.f, 0.f, 0.f, 0.f};
    bf16x8 At[4][2], B0[2][2], B1[2][2];
    unsigned ao[2][2], nao[2][2];
    PG8_AOFFS(cur, ao);
    const char* cB = (const char*)Bt_ + (size_t)cur.b0 * (K * 2);
    PG8_STAGE_B(PG8_SB(0, 0), cB); PG8_STAGE_B(PG8_SB(0, 1), cB + hstep); PG8_STAGE_A(PG8_SA(0, 0), Abase, ao[0][0], ao[0][1]); PG8_STAGE_A(PG8_SA(0, 1), Abase, ao[1][0], ao[1][1]);
    if (wr == 1) PG8_BAR;
    PG8_WAIT_V(2); PG8_BAR;
    PG8_STAGE_B(PG8_SB(1, 0), cB + kstep); PG8_STAGE_A(PG8_SA(1, 0), Abase + kstep, ao[0][0], ao[0][1]); PG8_STAGE_B(PG8_SB(1, 1), cB + hstep + kstep);
    PG8_WAIT_V(6); PG8_BAR;
    for (;;) {
        const bool has_next = S.next(ui + 1, nxt);
        if (has_next) { PG8_AOFFS(nxt, nao); } else {
#pragma unroll
            for (int h = 0; h < 2; ++h)
#pragma unroll
                for (int i = 0; i < 2; ++i) nao[h][i] = ao[h][i]; }
        const char* nB = has_next ? (const char*)Bt_ + (size_t)nxt.b0 * (K * 2) : cB;
        for (int t = 0; t < nt; t += 2) {
            const bool last = (t == nt - 2);
            const char* a1 = Abase + (size_t)(t + 1) * kstep;
            const char* a2 = last ? Abase : Abase + (size_t)(t + 2) * kstep; const char* b2 = last ? nB : cB + (size_t)(t + 2) * kstep;
            const char* a3 = a2 + kstep; const char* b3 = b2 + kstep;
            const unsigned x00 = last ? nao[0][0] : ao[0][0], x01 = last ? nao[0][1] : ao[0][1], x10 = last ? nao[1][0] : ao[1][0], x11 = last ? nao[1][1] : ao[1][1];
            PG8_LDB(B0, 0, 0); PG8_LDB(B1, 0, 1); PG8_SCHED; PG8_LDA(At, 0, 0); PG8_STAGE_A(PG8_SA(1, 1), a1, ao[1][0], ao[1][1]);
            PG8_WAIT_V(8); PG8_WAIT_L(0); PG8_BAR; PG8_MMA(0, 0, At, B0); PG8_MMA(0, 1, At, B1); PG8_BAR; PG8_SCHED;
            PG8_LDA(At, 0, 1); PG8_STAGE_B(PG8_SB(0, 0), b2); PG8_STAGE_B(PG8_SB(0, 1), b2 + hstep); PG8_STAGE_A(PG8_SA(0, 0), a2, x00, x01);
            PG8_WAIT_V(8); PG8_WAIT_L(0); PG8_BAR; PG8_MMA(1, 0, At, B0); PG8_MMA(1, 1, At, B1); PG8_BAR; PG8_SCHED;
            PG8_LDB(B0, 1, 0); PG8_LDB(B1, 1, 1); PG8_SCHED; PG8_LDA(At, 1, 0); PG8_STAGE_A(PG8_SA(0, 1), a2, x10, x11);
            PG8_WAIT_V(8); PG8_WAIT_L(0); PG8_BAR; PG8_MMA(0, 0, At, B0); PG8_MMA(0, 1, At, B1); PG8_BAR; PG8_SCHED;
            PG8_LDA(At, 1, 1); PG8_STAGE_B(PG8_SB(1, 0), b3); PG8_STAGE_B(PG8_SB(1, 1), b3 + hstep); PG8_STAGE_A(PG8_SA(1, 0), a3, x00, x01);
            PG8_WAIT_V(8); PG8_WAIT_L(0); PG8_BAR; PG8_MMA(1, 0, At, B0); PG8_MMA(1, 1, At, B1); PG8_BAR; PG8_SCHED;
        }
        if (wr == 0) PG8_BAR;
        E(acc, cur, wr, wc, fr, fq);
        if (!has_next) break;
#pragma unroll
        for (int a = 0; a < 2; ++a)
#pragma unroll
            for (int b = 0; b < 2; ++b)
#pragma unroll
                for (int m = 0; m < 4; ++m)
#pragma unroll
                    for (int n = 0; n < 2; ++n) acc[a][b][m][n] = (f32x4){0.f, 0.f, 0.f, 0.f};
        cur = nxt; cB = nB; ++ui;
#pragma unroll
        for (int h = 0; h < 2; ++h)
#pragma unroll
            for (int i = 0; i < 2; ++i) ao[h][i] = nao[h][i];
        if (wr == 1) PG8_BAR;
    }
    PG8_WAIT_V(0);
    PG8_BAR;
#undef PG8_SA
#undef PG8_SB
#undef PG8_STAGE_A
#undef PG8_STAGE_B
#undef PG8_LDA
#undef PG8_LDB
#undef PG8_MMA
#undef PG8_WAIT_V
#undef PG8_WAIT_L
#undef PG8_BAR
#undef PG8_SCHED
#undef PG8_AOFFS
}

struct DenseOrder {
    int nM, nN, nwg, G, c;
    __device__ void init(int nM_, int nN_, int G_, int c_) { nM = nM_; nN = nN_; nwg = nM * nN; G = G_; c = c_; }
    __device__ bool next(int i, Unit& u) const {
        const long L = (long)i * G + c; if (L >= nwg) return false;
        int wgid = (int)L; { const int q = nwg / 8, r = nwg % 8, xcd = wgid % 8, off = wgid / 8; wgid = (xcd < r ? xcd * (q + 1) : r * (q + 1) + (xcd - r) * q) + off; }
        const int nig = 8 * nN, gid = wgid / nig, fm = gid * 8, gsz = (nM - fm) < 8 ? (nM - fm) : 8;
        const int pm = fm + ((wgid % nig) % gsz), pn = (wgid % nig) / gsz;
        u.a0 = pm * 256; u.nvalid = 256; u.b0 = pn * 256; u.o0 = pm * 256; u.pn = pn; u.e = 0; u.g0 = 0; return true;
    }
};
template <int NPN, bool UP> struct MoeOrder {
    const LAS int* tb; const int* cnt; int G, c;
    __device__ bool next(int i, Unit& u) const {
        const int L = i * G + c; const int total = tb[32] * NPN; if (L >= total) return false;
        int e = 0;
#pragma unroll 1
        for (int q = 16; q >= 1; q >>= 1) if (tb[e + q] * NPN <= L) e += q;
        const int te = tb[e + 1] - tb[e], j = L - tb[e] * NPN, pn = j / te, mt = j % te;
        const int ce = cnt[e];
        u.e = e; u.pn = pn; u.o0 = (tb[e] + mt) * 256; u.nvalid = min(256, ce - mt * 256);
        u.g0 = e * TT + mt * 256;
        u.a0 = UP ? u.g0 : u.o0;
        u.b0 = e * (UP ? 2 * DF : D) + pn * 256;
        return true;
    }
};

struct EpiStore {
    bf16* C; int ldc;
    __device__ __forceinline__ void operator()(const f32x4 (&acc)[2][2][4][2], const Unit& u, int wr, int wc, int fr, int fq) const {
        const int row0 = u.o0 + wr * 64 + fr, col0 = u.pn * 256 + wc * 32 + 8 * fq;
#pragma unroll
        for (int ai = 0; ai < 2; ++ai)
#pragma unroll
            for (int m = 0; m < 4; ++m) { bf16* rowp = C + (size_t)(row0 + ai * HALF + m * 16) * ldc + col0;
#pragma unroll
                for (int bj = 0; bj < 2; ++bj) { const f32x4 v0 = acc[ai][bj][m][0], v1 = acc[ai][bj][m][1];
                    u32x4 w; w.x = cvt_pk_bf16(v0[0], v0[1]); w.y = cvt_pk_bf16(v0[2], v0[3]); w.z = cvt_pk_bf16(v1[0], v1[1]); w.w = cvt_pk_bf16(v1[2], v1[3]);
                    *(u32x4*)(rowp + bj * HALF) = w; } }
    }
};
struct EpiSwiglu {
    bf16* C; const float* b1;
    __device__ __forceinline__ void operator()(const f32x4 (&acc)[2][2][4][2], const Unit& u, int wr, int wc, int fr, int fq) const {
        const int row0 = u.o0 + wr * 64 + fr, j0 = u.pn * 128 + wc * 32 + 8 * fq;
        const float* bb = b1 + (size_t)u.e * 2 * DF + j0;
        const f32x4 bg0 = *(const f32x4*)bb, bg1 = *(const f32x4*)(bb + 4), bl0 = *(const f32x4*)(bb + DF), bl1 = *(const f32x4*)(bb + DF + 4);
#pragma unroll
        for (int ai = 0; ai < 2; ++ai)
#pragma unroll
            for (int m = 0; m < 4; ++m) {
                float o[8];
#pragma unroll
                for (int n = 0; n < 2; ++n)
#pragma unroll
                    for (int q = 0; q < 4; ++q) {
                        const float gl = fminf(acc[ai][0][m][n][q] + (n ? bg1[q] : bg0[q]), 7.0f);
                        const float li = fminf(fmaxf(acc[ai][1][m][n][q] + (n ? bl1[q] : bl0[q]), -7.0f), 7.0f);
                        o[4 * n + q] = gl * __builtin_amdgcn_rcpf(1.0f + __expf(-1.702f * gl)) * (li + 1.0f);
                    }
                u32x4 w; w.x = cvt_pk_bf16(o[0], o[1]); w.y = cvt_pk_bf16(o[2], o[3]); w.z = cvt_pk_bf16(o[4], o[5]); w.w = cvt_pk_bf16(o[6], o[7]);
                *(u32x4*)(C + (size_t)(row0 + ai * HALF + m * 16) * DF + j0) = w;
            }
    }
};
struct EpiDown {
    bf16* C; const float* b2; const float* rowgate; const int* rowdst;
    __device__ __forceinline__ void operator()(const f32x4 (&acc)[2][2][4][2], const Unit& u, int wr, int wc, int fr, int fq) const {
        const int rt0 = wr * 64 + fr, col0 = u.pn * 256 + wc * 32 + 8 * fq;
#pragma unroll
        for (int ai = 0; ai < 2; ++ai) {
            float gt[4]; int dst[4];
#pragma unroll
            for (int m = 0; m < 4; ++m) { const int rt = rt0 + ai * HALF + m * 16; const bool ok = rt < u.nvalid; gt[m] = ok ? rowgate[u.g0 + rt] : 0.f; dst[m] = ok ? rowdst[u.g0 + rt] : -1; }
#pragma unroll
            for (int bj = 0; bj < 2; ++bj) {
                const f32x4 bv0 = *(const f32x4*)(b2 + (size_t)u.e * D + col0 + bj * HALF), bv1 = *(const f32x4*)(b2 + (size_t)u.e * D + col0 + bj * HALF + 4);
#pragma unroll
                for (int m = 0; m < 4; ++m) {
                    const f32x4 v0 = (acc[ai][bj][m][0] + bv0) * gt[m], v1 = (acc[ai][bj][m][1] + bv1) * gt[m];
                    u32x4 w; w.x = cvt_pk_bf16(v0[0], v0[1]); w.y = cvt_pk_bf16(v0[2], v0[3]); w.z = cvt_pk_bf16(v1[0], v1[1]); w.w = cvt_pk_bf16(v1[2], v1[3]);
                    if (dst[m] >= 0) *(u32x4*)(C + (size_t)dst[m] * D + col0 + bj * HALF) = w;
                }
            }
            asm volatile("" ::: "memory");
        }
    }
};
}

#define XB_TMO      128
#define XB_XCNT(j)  (256  + 64 * (j))
#define XB_XSUB(j)  (1280 + 64 * (j))
#define XB_XGEN(j)  (2304 + 64 * (j))
#define XB_TOP      3328
#define XB_TOPGEN   3392
#define XCD_BAR_WORDS 3456
#define XB_SPIN_CAP (1u << 18)
__device__ __forceinline__ unsigned xb_ld(unsigned* p)              { return __hip_atomic_load(p, __ATOMIC_RELAXED, __HIP_MEMORY_SCOPE_AGENT); }
__device__ __forceinline__ unsigned xb_add(unsigned* p, unsigned v) { return __hip_atomic_fetch_add(p, v, __ATOMIC_RELAXED, __HIP_MEMORY_SCOPE_AGENT); }
__device__ __forceinline__ unsigned xb_xcc_id() { return (unsigned)__builtin_amdgcn_s_getreg((3 << 11) | 20) & 0xFu; }
#define XB_SPIN(cond, bar) do { unsigned _sp = 0; while (cond) { __builtin_amdgcn_s_sleep(1); \
    if ((++_sp & 255u) == 0u) { if (xb_ld(&(bar)[XB_TMO])) break; if (_sp > XB_SPIN_CAP) { atomicAdd(&(bar)[XB_TMO], 1u); break; } } } } while (0)
struct XcdBarrier { unsigned* bar; unsigned x; volatile LAS unsigned* st; };
__device__ __forceinline__ XcdBarrier xcd_barrier_post(unsigned* bar, volatile LAS unsigned* st) {
    XcdBarrier b; b.bar = bar; b.x = xb_xcc_id(); b.st = st;
    if (threadIdx.x == 0) (void)xb_add(&bar[XB_XCNT(b.x)], 1u);
    return b;
}
__device__ __forceinline__ void xcd_barrier_complete(unsigned* bar, unsigned x, unsigned& nloc, unsigned& nx) {
    const unsigned G = gridDim.x * gridDim.y * gridDim.z;
    unsigned sum, cnt, mine, sp = 0u;
    for (;;) {
        sum = 0u; cnt = 0u; mine = 0u;
#pragma unroll
        for (unsigned j = 0; j < 16; ++j) { const unsigned c = xb_ld(&bar[XB_XCNT(j)]); sum += c; cnt += (c > 0u) ? 1u : 0u; mine = (j == x) ? c : mine; }
        if (sum == G) break;
        __builtin_amdgcn_s_sleep(1);
        if ((++sp & 255u) == 0u) { if (xb_ld(&bar[XB_TMO])) break; if (sp > XB_SPIN_CAP) { atomicAdd(&bar[XB_TMO], 1u); break; } }
    }
    nloc = mine > 0u ? mine : 1u; nx = cnt > 0u ? cnt : 1u;
}
__device__ __forceinline__ void xcd_barrier(const XcdBarrier& b) {
    asm volatile("s_waitcnt vmcnt(0)" ::: "memory");
    __syncthreads();
    if (threadIdx.x == 0) {
        unsigned* bar = b.bar;
        __builtin_amdgcn_s_waitcnt(0);
        unsigned nloc = b.st[0], nx = b.st[1];
        if (nloc == 0u) { xcd_barrier_complete(bar, b.x, nloc, nx); b.st[0] = nloc; b.st[1] = nx; }
        const unsigned old = xb_add(&bar[XB_XSUB(b.x)], 1u);
        const unsigned gen = old / nloc;
        if (old + 1u == (gen + 1u) * nloc) {
            __builtin_amdgcn_fence(__ATOMIC_RELEASE, "agent");
            asm volatile("s_waitcnt vmcnt(0)" ::: "memory");
            const unsigned og = xb_add(&bar[XB_TOP], 1u);
            const unsigned tg = og / nx;
            if (og + 1u == (tg + 1u) * nx) xb_add(&bar[XB_TOPGEN], 1u);
            else XB_SPIN(xb_ld(&bar[XB_TOPGEN]) == tg, bar);
            __builtin_amdgcn_fence(__ATOMIC_ACQUIRE, "agent");
            xb_add(&bar[XB_XGEN(b.x)], 1u);
            asm volatile("s_waitcnt vmcnt(0)" ::: "memory");
        } else {
            XB_SPIN(xb_ld(&bar[XB_XGEN(b.x)]) == gen, bar);
            __builtin_amdgcn_fence(__ATOMIC_ACQUIRE, "agent");
            asm volatile("s_waitcnt vmcnt(0)" ::: "memory");
        }
    }
    __syncthreads();
}

constexpr int LDS_BYTES = 147456;
constexpr int LDS_TB = 131072;
constexpr int LDS_MISC = 131072 + 1024;

__device__ __forceinline__ void phase_p0a(const P& p, LAS unsigned char* lds, int bid, int G, int tid, int wave, int lane) {
    { float* POS = (float*)(p.ws + WS_POS);
      for (int i = bid * 512 + tid; i < 64 * 512; i += G * 512) {
          const int n = i / 512, j = i % 512, q = j % 256;
          const float omega = 1.0f / powf(10000.0f, (float)q / 256.0f);
          const float ang = (float)n * omega;
          POS[i] = j < 256 ? sinf(ang) : cosf(ang);
      } }
    { bf16* RWT = (bf16*)(p.ws + WS_RWT);
      for (int i = bid * 512 + tid; i < DEPTH * NE * 128; i += G * 512) {
          const int kc = i % 128, e = (i / 128) % NE, l = i / (128 * NE);
          const float* s = p.in[I_RW] + (size_t)l * D * NE + (size_t)(8 * kc) * NE + e;
          u32x4 o; o.x = pk2(s[0], s[NE]); o.y = pk2(s[2 * NE], s[3 * NE]); o.z = pk2(s[4 * NE], s[5 * NE]); o.w = pk2(s[6 * NE], s[7 * NE]);
          *(u32x4*)(RWT + ((size_t)l * NE + e) * D + 8 * kc) = o;
      } }
    { float* SP = (float*)(p.ws + WS_SP);
      const int gt = bid * 512 + tid, gn = G * 512;
      for (int l = 0; l < DEPTH; ++l) {
          float* o = SP + (size_t)l * SP_STRIDE;
          for (int i = gt; i < 2048; i += gn) o[SP_CW + i] = p.in[I_CONVW][(size_t)l * 2048 + i];
          for (int i = gt; i < 512; i += gn) { o[SP_CB + i] = p.in[I_CONVB][(size_t)l * 512 + i]; o[SP_PB + i] = p.in[I_POOLB][(size_t)l * 512 + i]; o[SP_PS + i] = p.in[I_POOLS][(size_t)l * 512 + i]; }
          for (int i = gt; i < 1024; i += gn) { o[SP_GAB + i] = p.in[I_GAB][(size_t)l * 1024 + i]; o[SP_GXB + i] = p.in[I_GXB][(size_t)l * 1024 + i];
              const float nl = -p.in[I_LAM][(size_t)l * 1024 + i]; o[SP_CC + i] = 8.0f * (nl > 20.f ? nl : log1pf(expf(nl)));
              o[SP_L1G + i] = p.in[I_LN1G][(size_t)l * 1024 + i]; o[SP_L1B + i] = p.in[I_LN1B][(size_t)l * 1024 + i];
              o[SP_L2G + i] = p.in[I_LN2G][(size_t)l * 1024 + i]; o[SP_L2B + i] = p.in[I_LN2B][(size_t)l * 1024 + i]; }
          for (int i = gt; i < 32; i += gn) o[SP_RB + i] = p.in[I_RB][(size_t)l * 32 + i];
          for (int i = gt; i < 32 * 2048; i += gn) o[SP_B1 + i] = p.in[I_B1][(size_t)l * 32 * 2048 + i];
          for (int i = gt; i < 32 * 1024; i += gn) o[SP_B2 + i] = p.in[I_B2][(size_t)l * 32 * 1024 + i];
      } }
    { LAS float* sl = (LAS float*)lds; LAS float* part = sl + 9 * 1024;
      const float* c = p.in[I_C]; const float* cc = p.in[I_CCTX];
      for (int i = tid; i < 9 * 1024; i += 512) { const float v = i < 8192 ? c[i] : cc[i - 8192]; sl[i] = v / (1.0f + __expf(-v)); }
      __syncthreads();
      float* MOD = (float*)(p.ws + WS_MOD);
      for (int u = bid; u < 2 * 192; u += G) {
          const int l = u / 192, n0 = (u % 192) * 32;
          const float* W = p.in[I_WMOD] + (size_t)l * 1024 * 6144;
          const int col = tid & 31, ks = tid >> 5;
          float acc[9];
#pragma unroll
          for (int r = 0; r < 9; ++r) acc[r] = 0.f;
#pragma unroll 8
          for (int kk = 0; kk < 64; ++kk) {
              const int k = ks * 64 + kk;
              const float w = W[(size_t)k * 6144 + n0 + col];
#pragma unroll
              for (int r = 0; r < 9; ++r) acc[r] += sl[r * 1024 + k] * w;
          }
#pragma unroll
          for (int r = 0; r < 9; ++r) part[(ks * 9 + r) * 32 + col] = acc[r];
          __syncthreads();
          if (tid < 9 * 32) {
              const int r = tid / 32, cl = tid % 32; float s = 0.f;
#pragma unroll
              for (int q = 0; q < 16; ++q) s += part[(q * 9 + r) * 32 + cl];
              MOD[((size_t)l * 9 + r) * 6144 + n0 + cl] = s + p.in[I_BMOD][(size_t)l * 6144 + n0 + cl];
          }
          __syncthreads();
      } }
    __syncthreads();
    convert_weights(p, lds, bid * 8 + wave, G * 8, wave, lane);
}

__device__ __forceinline__ void phase_entry(const P& p, int gw, int ngw, int lane) {
    const float* POS = (const float*)(p.ws + WS_POS);
    const float* MOD = (const float*)(p.ws + WS_MOD);
    float* XL = (float*)(p.ws + WS_XL); bf16* H = (bf16*)(p.ws + WS_H);
    for (int tok = gw; tok < TT; tok += ngw) {
        const float* src = tok < TL ? p.in[I_X] + (size_t)tok * D : p.in[I_CTX] + (size_t)(tok - TL) * D;
        f32x4 v[4];
#pragma unroll
        for (int j = 0; j < 4; ++j) v[j] = ((const f32x4*)src)[lane + 64 * j];
        if (tok < TL) {
            const int s = tok & (SEQ - 1), pr = s / GRIDW, pc = s % GRIDW;
#pragma unroll
            for (int j = 0; j < 4; ++j) {
                const float* ps = POS + (size_t)(j < 2 ? pr : pc) * 512 + (4 * lane + 256 * (j & 1));
                v[j] += *(const f32x4*)ps;
            }
        }
        float mean, rstd; ln_stats(v, mean, rstd);
        const float* m = MOD + (size_t)mod_row(tok) * 6144;
        f32x4 h[4];
#pragma unroll
        for (int j = 0; j < 4; ++j) {
            v[j] = (v[j] - mean) * rstd;
            ((f32x4*)(XL + (size_t)tok * D))[lane + 64 * j] = v[j];
            const f32x4 sh = ((const f32x4*)m)[lane + 64 * j], sc = ((const f32x4*)(m + 1024))[lane + 64 * j];
            h[j] = v[j] * (sc + 1.0f) + sh;
        }
        store_bf16_row(H + (size_t)tok * D, lane, h);
    }
}

constexpr float LOG2E = 1.4426950408889634f;
__device__ __forceinline__ float fast_sigmoid(float x) { return __builtin_amdgcn_rcpf(1.0f + __builtin_amdgcn_exp2f(-LOG2E * x)); }
__device__ __forceinline__ int lru_item(int b, int grp, int h, int cb, int wave) { return ((((b * NGRP + grp) * NH + h) * 2 + cb) * 8 + wave); }

template <bool FINAL>
__device__ __forceinline__ void tile_scan(const f32x16& ar, const f32x16& ai, int d, int hh, float cin, float& aggP, float& aggH, float (&hsum)[16]) {
    float oP[4], oH[4];
#pragma unroll
    for (int q = 0; q < 4; ++q) {
        float Pp = 1.f, Hh = 0.f;
#pragma unroll
        for (int jj = 0; jj < 4; ++jj) { const int j = d ? 3 - jj : jj; Hh = ar[4 * q + j] * Hh + ai[4 * q + j]; Pp *= ar[4 * q + j]; }
        oP[q] = Pp; oH[q] = Hh;
    }
    float eP[4], eH[4], xP[4], xH[4];
#pragma unroll
    for (int q = 0; q < 4; ++q) { const float pP = __shfl_xor(oP[q], 32), pH = __shfl_xor(oH[q], 32);
        eP[q] = hh ? pP : oP[q]; eH[q] = hh ? pH : oH[q]; xP[q] = hh ? oP[q] : pP; xH[q] = hh ? oH[q] : pH; }
    float c = cin, pall = 1.f;
    float mine[4];
    if (d == 0) {
#pragma unroll
        for (int q = 0; q < 4; ++q) { const float cE = c; c = eP[q] * c + eH[q]; const float cO = c; c = xP[q] * c + xH[q]; mine[q] = hh ? cO : cE; pall *= eP[q] * xP[q]; }
    } else {
#pragma unroll
        for (int q = 3; q >= 0; --q) { const float cO = c; c = xP[q] * c + xH[q]; const float cE = c; c = eP[q] * c + eH[q]; mine[q] = hh ? cO : cE; pall *= eP[q] * xP[q]; }
    }
    aggP = pall; aggH = c;
    if (FINAL) {
#pragma unroll
        for (int q = 0; q < 4; ++q) { float Hh = mine[q];
#pragma unroll
            for (int jj = 0; jj < 4; ++jj) { const int j = d ? 3 - jj : jj; Hh = ar[4 * q + j] * Hh + ai[4 * q + j]; if (d == 0) hsum[4 * q + j] = Hh; else hsum[4 * q + j] += Hh; } }
    }
}

__device__ __forceinline__ void lru_agg_unit(unsigned char* ws, int l, LAS unsigned char* lds, int b, int grp, int h, int cb, int wave, int lane) {
    asm volatile("" : "+s"(wave)); asm volatile("" : "+v"(lane));
    const bf16* Z = (const bf16*)(ws + WS_Z);
    const int r = lane & 31, hh = lane >> 5;
    int seqbase, len, t0;
    if (grp == 0) { seqbase = TL + b * CTXL; len = CTXL; t0 = wave * 32; } else { seqbase = b * SEQ; len = SEQ; t0 = (grp - 1) * 256 + wave * 32; }
    const int t = t0 + r;
    const float* SP = (const float*)(ws + WS_SP) + (size_t)l * SP_STRIDE;
    const float* cw = SP + SP_CW; const float* cbias = SP + SP_CB;
    bf16x8 Af[4];
#pragma unroll
    for (int s = 0; s < 4; ++s) {
        const int c0 = 64 * h + 16 * s + 8 * hh;
        const f32x4 b0 = *(const f32x4*)(cbias + c0), b1 = *(const f32x4*)(cbias + c0 + 4);
        float u[8] = {b0.x, b0.y, b0.z, b0.w, b1.x, b1.y, b1.z, b1.w};
#pragma unroll
        for (int k = 0; k < 4; ++k) {
            const int tt = t + k - 2;
            u32x4 raw = (u32x4){0u, 0u, 0u, 0u};
            if (tt >= 0 && tt < len) raw = *(const u32x4*)(Z + (size_t)(seqbase + tt) * DIN + c0);
            const f32x4 w0 = *(const f32x4*)(cw + k * DLRU + c0), w1 = *(const f32x4*)(cw + k * DLRU + c0 + 4);
            u[0] += w0.x * bflo(raw.x); u[1] += w0.y * bfhi(raw.x); u[2] += w0.z * bflo(raw.y); u[3] += w0.w * bfhi(raw.y);
            u[4] += w1.x * bflo(raw.z); u[5] += w1.y * bfhi(raw.z); u[6] += w1.z * bflo(raw.w); u[7] += w1.w * bfhi(raw.w);
        }
        u32x4 pk; pk.x = pg8::cvt_pk_bf16(u[0], u[1]); pk.y = pg8::cvt_pk_bf16(u[2], u[3]); pk.z = pg8::cvt_pk_bf16(u[4], u[5]); pk.w = pg8::cvt_pk_bf16(u[6], u[7]);
        Af[s] = __builtin_bit_cast(bf16x8, pk);
        asm volatile("" ::: "memory");
    }
    const bf16* WG = (const bf16*)(ws + WS_WG) + (size_t)(l * NH + h) * 256 * HD;
    f32x16 accu;
#pragma unroll
    for (int i = 0; i < 16; ++i) accu[i] = 0.f;
    { const int nn = 32 * cb + r;
#pragma unroll
      for (int s = 0; s < 4; ++s) {
          u32x4 w = (u32x4){0u, 0u, 0u, 0u};
          if ((nn >> 4) == s && ((nn >> 3) & 1) == hh) { const unsigned one = 0x3F80u << (16 * (nn & 1)); const int wi = (nn & 7) >> 1;
              w.x = wi == 0 ? one : 0u; w.y = wi == 1 ? one : 0u; w.z = wi == 2 ? one : 0u; w.w = wi == 3 ? one : 0u; }
          accu = __builtin_amdgcn_mfma_f32_32x32x16_bf16(Af[s], __builtin_bit_cast(bf16x8, w), accu, 0, 0, 0);
      } }
    const int ch = 64 * h + 32 * cb + r;
    u32x4* YB = (u32x4*)(ws + WS_YB) + (size_t)lru_item(b, grp, h, cb, wave) * 8 * 64 + lane;
    float aggP[2], aggH[2];
    float hdummy[16];
#pragma unroll
    for (int d = 0; d < 2; ++d) {
        f32x16 ar, ai;
#pragma unroll
        for (int i = 0; i < 16; ++i) { ar[i] = 0.f; ai[i] = 0.f; }
        { const bf16* wr_ = WG + (size_t)((2 * d) * 64 + 32 * cb + r) * HD + 8 * hh; const bf16* wi_ = wr_ + 64 * HD;
#pragma unroll
          for (int s = 0; s < 4; ++s) { const bf16x8 Bf = *(const bf16x8*)(wr_ + 16 * s); ar = __builtin_amdgcn_mfma_f32_32x32x16_bf16(Af[s], Bf, ar, 0, 0, 0); }
#pragma unroll
          for (int s = 0; s < 4; ++s) { const bf16x8 Bf = *(const bf16x8*)(wi_ + 16 * s); ai = __builtin_amdgcn_mfma_f32_32x32x16_bf16(Af[s], Bf, ai, 0, 0, 0); } }
        const float ba = SP[SP_GAB + d * DLRU + ch], bx = SP[SP_GXB + d * DLRU + ch], cc = SP[SP_CC + d * DLRU + ch];
#pragma unroll
        for (int q = 0; q < 4; ++q) {
            u32x4 wq;
#pragma unroll
            for (int j = 0; j < 4; ++j) { const int i = 4 * q + j;
                const float rr = fast_sigmoid(ar[i] + ba), ig = fast_sigmoid(ai[i] + bx);
                const float y = cc * rr;
                const float a0 = __builtin_amdgcn_exp2f(-LOG2E * y);
                const float bt = __builtin_amdgcn_sqrtf(fmaf(-a0, a0, 1.0f)) * (ig * accu[i]);
                const unsigned w = pg8::cvt_pk_bf16(y, bt);
                wq[j] = w;
                ar[i] = __builtin_amdgcn_exp2f(-LOG2E * bflo(w)); ai[i] = bfhi(w);
            }
            YB[(d * 4 + q) * 64] = wq;
            __builtin_amdgcn_sched_barrier(0);
        }
        tile_scan<false>(ar, ai, d, hh, 0.f, aggP[d], aggH[d], hdummy);
        __builtin_amdgcn_sched_barrier(0);
    }
    f32x2* AT = (f32x2*)(ws + WS_AGGT); f32x2* AG = (f32x2*)(ws + WS_AGGG);
    LAS f32x2* la = (LAS f32x2*)lds;
    if (hh == 0) {
#pragma unroll
        for (int d = 0; d < 2; ++d) { const f32x2 v = (f32x2){aggP[d], aggH[d]};
            AT[((size_t)(b * NTILE + grp * 8 + wave) * 2 + d) * DLRU + ch] = v; la[(wave * 2 + d) * 32 + r] = v; }
    }
    __syncthreads();
    if (wave == 0) {
        const int d = hh; float Pp = 1.f, Hh = 0.f;
#pragma unroll
        for (int i = 0; i < 8; ++i) { const int w = d ? 7 - i : i; const f32x2 v = la[(w * 2 + d) * 32 + r]; Hh = v.x * Hh + v.y; Pp *= v.x; }
        AG[((size_t)(b * NGRP + grp) * 2 + d) * DLRU + ch] = (f32x2){Pp, Hh};
    }
    __syncthreads();
}

__device__ __forceinline__ void lru_final_unit(unsigned char* ws, int l, int b, int grp, int h, int cb, int wave, int lane) {
    asm volatile("" : "+s"(wave)); asm volatile("" : "+v"(lane));
    const bf16* Z = (const bf16*)(ws + WS_Z);
    const int r = lane & 31, hh = lane >> 5;
    int seqbase, t0;
    if (grp == 0) { seqbase = TL + b * CTXL; t0 = wave * 32; } else { seqbase = b * SEQ; t0 = (grp - 1) * 256 + wave * 32; }
    const int ch = 64 * h + 32 * cb + r;
    const u32x4* YB = (const u32x4*)(ws + WS_YB) + (size_t)lru_item(b, grp, h, cb, wave) * 8 * 64 + lane;
    u32x4 W[8];
#pragma unroll
    for (int j = 0; j < 8; ++j) W[j] = YB[j * 64];
    unsigned short yg[16];
#pragma unroll
    for (int i = 0; i < 16; ++i) { const int row = (i & 3) + 8 * (i >> 2) + 4 * hh; yg[i] = Z[(size_t)(seqbase + t0 + row) * DIN + DLRU + ch]; }
    float C0, C1;
    {
        const f32x2* AGGT = (const f32x2*)(ws + WS_AGGT); const f32x2* AGGG = (const f32x2*)(ws + WS_AGGG);
        float c = 0.f;
        const int d = hh;
        if (grp > 0) {
            { const f32x2 g0 = AGGG[((size_t)(b * NGRP + 0) * 2 + d) * DLRU + ch]; c = g0.y; }
            f32x2 gv[7];
#pragma unroll
            for (int i = 0; i < 7; ++i) { const int g = d ? 8 - i : 1 + i; const bool valid = d ? (i < 8 - grp) : (i < grp - 1);
                gv[i] = valid ? AGGG[((size_t)(b * NGRP + g) * 2 + d) * DLRU + ch] : (f32x2){1.f, 0.f}; }
#pragma unroll
            for (int i = 0; i < 7; ++i) c = gv[i].x * c + gv[i].y;
        }
        f32x2 tv[7];
#pragma unroll
        for (int i = 0; i < 7; ++i) { const int tw = d ? 7 - i : i; const bool valid = d ? (i < 7 - wave) : (i < wave);
            tv[i] = valid ? AGGT[((size_t)(b * NTILE + grp * 8 + tw) * 2 + d) * DLRU + ch] : (f32x2){1.f, 0.f}; }
#pragma unroll
        for (int i = 0; i < 7; ++i) c = tv[i].x * c + tv[i].y;
        C0 = __shfl(c, r); C1 = __shfl(c, 32 + r);
    }
    float hsum[16];
#pragma unroll
    for (int d = 0; d < 2; ++d) {
        f32x16 ar, ai;
#pragma unroll
        for (int q = 0; q < 4; ++q)
#pragma unroll
            for (int j = 0; j < 4; ++j) { const unsigned w = W[d * 4 + q][j]; ar[4 * q + j] = __builtin_amdgcn_exp2f(-LOG2E * bflo(w)); ai[4 * q + j] = bfhi(w); }
        float aP, aH;
        tile_scan<true>(ar, ai, d, hh, d ? C1 : C0, aP, aH, hsum);
    }
    bf16* MIX = (bf16*)(ws + WS_MIX);
#pragma unroll
    for (int i = 0; i < 16; ++i) {
        const int row = (i & 3) + 8 * (i >> 2) + 4 * hh;
        MIX[(size_t)(seqbase + t0 + row) * D + ch] = (bf16)f2bf(hsum[i] * gelu_tanh(bf2f(yg[i])));
    }
}

constexpr int PX_PITCH = 528, PD_PITCH = 528;
constexpr int PX_OFF = 0, PD_OFF = 80 * PX_PITCH;
__device__ __forceinline__ void pool_unit(unsigned char* ws, int l, LAS unsigned char* lds, int c, int gp, int tid, int wave, int lane) {
    asm volatile("" : "+s"(wave)); asm volatile("" : "+v"(lane)); asm volatile("" : "+v"(tid));
    const bf16* Z = (const bf16*)(ws + WS_Z); bf16* MIX = (bf16*)(ws + WS_MIX);
    int seqbase, t0, seg_lo, seg_hi;
    if (c < 256) { seqbase = (c >> 5) * SEQ; t0 = (c & 31) * 64; seg_lo = t0; seg_hi = t0 + 64; }
    else { const int cc = c - 256; seqbase = TL + (cc >> 2) * CTXL; t0 = (cc & 3) * 64; seg_lo = 0; seg_hi = CTXL; }
    const int r_lo = max(t0 - 8, seg_lo), r_hi = min(t0 + 72, seg_hi);
    { const int sub = tid >> 5, l32 = tid & 31;
      for (int t = r_lo + sub; t < r_hi; t += 16) {
          const u32x4 v = *(const u32x4*)(Z + (size_t)(seqbase + t) * DIN + 2 * DLRU + 256 * gp + 8 * l32);
          *(LAS u32x4*)(lds + PX_OFF + (t - (t0 - 8)) * PX_PITCH + 16 * l32) = v;
      } }
    __syncthreads();
    { const int cp = tid & 127, tq = tid >> 7;
      const int g = 2 * gp + (cp >> 6);
      const int half = 1 << g;
      const LAS unsigned char* xb = lds + PX_OFF + 4 * cp - (t0 - 8) * PX_PITCH;
      int t = t0 + 16 * tq;
      int lo = max(t - half, seg_lo), hi = min(t + half, seg_hi);
      float s0 = 0.f, s1 = 0.f;
      for (int j = lo; j < hi; ++j) { const unsigned w = *(const LAS unsigned*)(xb + j * PX_PITCH); s0 += bflo(w); s1 += bfhi(w); }
#pragma unroll 4
      for (int i = 0; i < 16; ++i, ++t) {
          const unsigned wx = *(const LAS unsigned*)(xb + t * PX_PITCH);
          const float inv = 1.0f / (float)(hi - lo);
          const float d0 = s0 * inv - bflo(wx), d1 = s1 * inv - bfhi(wx);
          *(LAS unsigned*)(lds + PD_OFF + (t - t0) * PD_PITCH + 4 * cp) = pk2(d0, d1);
          const int nlo = max(t + 1 - half, seg_lo), nhi = min(t + 1 + half, seg_hi);
          if (nhi > hi) { const unsigned w = *(const LAS unsigned*)(xb + hi * PX_PITCH); s0 += bflo(w); s1 += bfhi(w); }
          if (nlo > lo) { const unsigned w = *(const LAS unsigned*)(xb + lo * PX_PITCH); s0 -= bflo(w); s1 -= bfhi(w); }
          lo = nlo; hi = nhi;
      } }
    __syncthreads();
    { const int gl = wave >> 2, th = (wave >> 1) & 1, nh = wave & 1, r = lane & 31, hh = lane >> 5;
      const int g = 2 * gp + gl;
      const bf16* WP = (const bf16*)(ws + WS_WP) + (size_t)(l * 4 + g) * 128 * 128;
      f32x16 acc[2];
#pragma unroll
      for (int q = 0; q < 2; ++q)
#pragma unroll
          for (int i = 0; i < 16; ++i) acc[q][i] = 0.f;
      const LAS unsigned char* arow = lds + PD_OFF + (th * 32 + r) * PD_PITCH + (gl * 128 + 8 * hh) * 2;
#pragma unroll
      for (int s = 0; s < 8; ++s) {
          const bf16x8 Af = *(const LAS bf16x8*)(arow + 32 * s);
#pragma unroll
          for (int nt = 0; nt < 2; ++nt) { const bf16x8 Bf = *(const bf16x8*)(WP + (size_t)(nh * 64 + nt * 32 + r) * 128 + 16 * s + 8 * hh);
              acc[nt] = __builtin_amdgcn_mfma_f32_32x32x16_bf16(Af, Bf, acc[nt], 0, 0, 0); }
      }
#pragma unroll
      for (int nt = 0; nt < 2; ++nt) {
          const int co = 128 * g + 64 * nh + 32 * nt + r;
          const float* SP = (const float*)(ws + WS_SP) + (size_t)l * SP_STRIDE; const float pb = SP[SP_PB + co], ps = SP[SP_PS + co];
#pragma unroll
          for (int i = 0; i < 16; ++i) {
              const int row = (i & 3) + 8 * (i >> 2) + 4 * hh;
              MIX[(size_t)(seqbase + t0 + th * 32 + row) * D + DLRU + co] = (bf16)f2bf((acc[nt][i] + pb) * ps);
          }
      } }
    __syncthreads();
}

constexpr int L1_PITCH = 2064;
constexpr int L1_PART = 16 * L1_PITCH;
__device__ __forceinline__ void phase_ln1(unsigned char* ws, int l, LAS unsigned char* lds, int bid, int G, int tid, int wave, int lane) {
    const float* MOD = (const float*)(ws + WS_MOD) + (size_t)l * 9 * 6144;
    float* XL = (float*)(ws + WS_XL); bf16* H = (bf16*)(ws + WS_H); const bf16* Y1 = (const bf16*)(ws + WS_Y1);
    const float* SP = (const float*)(ws + WS_SP) + (size_t)l * SP_STRIDE;
    const float* lg = SP + SP_L1G; const float* lb = SP + SP_L1B; const float* rb = SP + SP_RB;
    int* cnt = (int*)(ws + WS_CTL) + CW_CNT + 32 * l;
    int* ROWTOK = (int*)(ws + WS_ROWTOK); float* ROWGATE = (float*)(ws + WS_ROWGATE); int* ROWDST = (int*)(ws + WS_ROWDST);
    const int ntok = (l == DEPTH - 1) ? TL : TT;
    const bf16* RWT = (const bf16*)(ws + WS_RWT) + (size_t)l * NE * D;
    bf16x8 Bf[4][2];
#pragma unroll
    for (int s = 0; s < 4; ++s)
#pragma unroll
        for (int nt = 0; nt < 2; ++nt) Bf[s][nt] = *(const bf16x8*)(RWT + (size_t)(16 * nt + (lane & 15)) * D + 128 * wave + 32 * s + 8 * (lane >> 4));
    LAS float* part = (LAS float*)(lds + L1_PART);
    LAS int* lcnt = (LAS int*)(lds + L1_PART + 16384);
    LAS int* lbase = lcnt + 32;
    LAS u32x4* ent = (LAS u32x4*)(lds + L1_PART + 16384 + 256);
    if (tid < 32) lcnt[tid] = 0;
    int nb_local = 0;
    __syncthreads();
    for (int batch = bid; batch < ntok / 16; batch += G) {
#pragma unroll
        for (int rr = 0; rr < 2; ++rr) {
            const int trow = 2 * wave + rr, tok = batch * 16 + trow;
            const float* m = MOD + (size_t)mod_row(tok) * 6144;
            f32x4 v[4], h[4];
#pragma unroll
            for (int j = 0; j < 4; ++j) {
                const f32x4 x = ((const f32x4*)(XL + (size_t)tok * D))[lane + 64 * j];
                const u32x2 yr = ((const u32x2*)(Y1 + (size_t)tok * D))[lane + 64 * j];
                const f32x4 g1 = ((const f32x4*)(m + 2048))[lane + 64 * j];
                f32x4 y; y.x = bflo(yr.x); y.y = bfhi(yr.x); y.z = bflo(yr.y); y.w = bfhi(yr.y);
                v[j] = x * ALPHA + g1 * y;
            }
            float mean, rstd; ln_stats(v, mean, rstd);
#pragma unroll
            for (int j = 0; j < 4; ++j) {
                const f32x4 gg = ((const f32x4*)lg)[lane + 64 * j], bb = ((const f32x4*)lb)[lane + 64 * j];
                v[j] = (v[j] - mean) * rstd * gg + bb;
                ((f32x4*)(XL + (size_t)tok * D))[lane + 64 * j] = v[j];
                const f32x4 sh = ((const f32x4*)(m + 3072))[lane + 64 * j], sc = ((const f32x4*)(m + 4096))[lane + 64 * j];
                h[j] = v[j] * (sc + 1.0f) + sh;
                u32x2 w; w.x = pk2(h[j].x, h[j].y); w.y = pk2(h[j].z, h[j].w);
                ((u32x2*)(H + (size_t)tok * D))[lane + 64 * j] = w;
                *(LAS u32x2*)(lds + trow * L1_PITCH + (4 * lane + 256 * j) * 2) = w;
            }
        }
        __syncthreads();
        {
            f32x4 a2[2] = {(f32x4){0.f, 0.f, 0.f, 0.f}, (f32x4){0.f, 0.f, 0.f, 0.f}};
            const LAS unsigned char* arow = lds + (lane & 15) * L1_PITCH + (128 * wave + 8 * (lane >> 4)) * 2;
#pragma unroll
            for (int s = 0; s < 4; ++s) { const bf16x8 Af = *(const LAS bf16x8*)(arow + 64 * s);
#pragma unroll
                for (int nt = 0; nt < 2; ++nt) a2[nt] = __builtin_amdgcn_mfma_f32_16x16x32_bf16(Af, Bf[s][nt], a2[nt], 0, 0, 0); }
#pragma unroll
            for (int nt = 0; nt < 2; ++nt)
#pragma unroll
                for (int i = 0; i < 4; ++i) part[(wave * 16 + 4 * (lane >> 4) + i) * 32 + 16 * nt + (lane & 15)] = a2[nt][i];
        }
        __syncthreads();
        {
            const int trow = tid >> 5, e = tid & 31, tok = batch * 16 + trow;
            float lgt = rb[e];
#pragma unroll
            for (int w = 0; w < 8; ++w) lgt += part[(w * 16 + trow) * 32 + e];
            float tv[4]; int ti[4];
            float cur = lgt;
#pragma unroll
            for (int k = 0; k < 4; ++k) {
                float bv = cur; int bi = e;
#pragma unroll
                for (int o = 1; o < 32; o <<= 1) { const float ov = __shfl_xor(bv, o); const int oi = __shfl_xor(bi, o); if (ov > bv || (ov == bv && oi < bi)) { bv = ov; bi = oi; } }
                tv[k] = bv; ti[k] = bi;
                if (e == bi) cur = -INFINITY;
            }
            const float e1 = __expf(tv[1] - tv[0]), e2 = __expf(tv[2] - tv[0]), e3 = __expf(tv[3] - tv[0]);
            const float inv = 1.0f / (1.0f + e1 + e2 + e3);
            if (e < 4) {
                const int ex = e == 0 ? ti[0] : e == 1 ? ti[1] : e == 2 ? ti[2] : ti[3];
                const float pg = (e == 0 ? 1.0f : e == 1 ? e1 : e == 2 ? e2 : e3) * inv;
                const int ls = __hip_atomic_fetch_add(lcnt + ex, 1, __ATOMIC_RELAXED, __HIP_MEMORY_SCOPE_WORKGROUP);
                const int idx = (nb_local * 16 + trow) * 4 + e;
                ent[idx] = (u32x4){(unsigned)tok, (unsigned)ex, (unsigned)ls, __float_as_uint(pg)};
            }
        }
        ++nb_local;
        __syncthreads();
    }
    if (tid < 32) { const int c = lcnt[tid]; lbase[tid] = c > 0 ? atomicAdd(&cnt[tid], c) : 0; }
    __syncthreads();
    for (int i = tid; i < nb_local * 64; i += 512) {
        const u32x4 en = ent[i]; const int tok = (int)en.x, ex = (int)en.y, slot = lbase[ex] + (int)en.z;
        ROWTOK[(size_t)ex * TT + slot] = tok; ROWGATE[(size_t)ex * TT + slot] = __uint_as_float(en.w); ROWDST[(size_t)ex * TT + slot] = tok * 4 + (i & 3);
    }
    __syncthreads();
}

__device__ __forceinline__ void phase_ln2(unsigned char* ws, float* out, int l, int gw, int ngw, int lane) {
    const float* MOD = (const float*)(ws + WS_MOD) + (size_t)l * 9 * 6144;
    float* XL = (float*)(ws + WS_XL); bf16* H = (bf16*)(ws + WS_H); const bf16* Y2 = (const bf16*)(ws + WS_Y2);
    const float* SP = (const float*)(ws + WS_SP) + (size_t)l * SP_STRIDE;
    const float* lg = SP + SP_L2G; const float* lb = SP + SP_L2B;
    const bool last = (l == DEPTH - 1);
    const int ntok = last ? TL : TT;
    for (int tok0 = gw * 2; tok0 < ntok; tok0 += ngw * 2) {
        f32x4 v[2][4]; u32x2 yr[2][4][4]; f32x4 g2[2][4];
#pragma unroll
        for (int t = 0; t < 2; ++t) {
            const int tok = tok0 + t;
            const float* m = MOD + (size_t)mod_row(tok) * 6144;
#pragma unroll
            for (int j = 0; j < 4; ++j) {
                v[t][j] = ((const f32x4*)(XL + (size_t)tok * D))[lane + 64 * j];
                g2[t][j] = ((const f32x4*)(m + 5120))[lane + 64 * j];
#pragma unroll
                for (int k = 0; k < 4; ++k) yr[t][k][j] = ((const u32x2*)(Y2 + ((size_t)tok * 4 + k) * D))[lane + 64 * j];
            }
        }
#pragma unroll
        for (int t = 0; t < 2; ++t) {
            const int tok = tok0 + t;
#pragma unroll
            for (int j = 0; j < 4; ++j) {
                f32x4 f = (f32x4){0.f, 0.f, 0.f, 0.f};
#pragma unroll
                for (int k = 0; k < 4; ++k) { const u32x2 r = yr[t][k][j]; f.x += bflo(r.x); f.y += bfhi(r.x); f.z += bflo(r.y); f.w += bfhi(r.y); }
                v[t][j] = v[t][j] * ALPHA + g2[t][j] * f;
            }
            float mean, rstd; ln_stats(v[t], mean, rstd);
            f32x4 h[4];
            const float* mn = MOD + (size_t)9 * 6144 + (size_t)mod_row(tok) * 6144;
#pragma unroll
            for (int j = 0; j < 4; ++j) {
                const f32x4 gg = ((const f32x4*)lg)[lane + 64 * j], bb = ((const f32x4*)lb)[lane + 64 * j];
                const f32x4 o = (v[t][j] - mean) * rstd * gg + bb;
                if (last) ((f32x4*)(out + (size_t)tok * D))[lane + 64 * j] = o;
                else {
                    ((f32x4*)(XL + (size_t)tok * D))[lane + 64 * j] = o;
                    const f32x4 sh = ((const f32x4*)mn)[lane + 64 * j], sc = ((const f32x4*)(mn + 1024))[lane + 64 * j];
                    h[j] = o * (sc + 1.0f) + sh;
                }
            }
            if (!last) store_bf16_row(H + (size_t)tok * D, lane, h);
        }
    }
}

constexpr int NPHASE = 2 + 8 * DEPTH;
#ifndef PHMASK
#define PHMASK 0xFFFF
#endif
#define PH_ON(k) (((PHMASK) >> (k)) & 1)
#ifndef MK_PER_PHASE
#define MK_PER_PHASE 0
#endif
__global__ void __launch_bounds__(512, 2) mk_fwd(P p) {
    extern __shared__ __attribute__((aligned(16))) unsigned char lds_[];
    LAS unsigned char* lds = (LAS unsigned char*)lds_;
    const int tid = threadIdx.x, lane = tid & 63, wave = __builtin_amdgcn_readfirstlane(tid >> 6);
    const int G = gridDim.x, bid = blockIdx.x;
    volatile LAS unsigned* MISC = (volatile LAS unsigned*)(lds + LDS_MISC);
    if (tid < 4) MISC[tid] = 0u;
    __syncthreads();
    unsigned* barw = (unsigned*)(p.ws + WS_CTL) + CW_BAR;
    XcdBarrier bar; bar.bar = barw; bar.x = 0; bar.st = MISC;
    if (!MK_PER_PHASE) bar = xcd_barrier_post(barw, MISC);
    const int lo = p.ph_lo, hi = p.ph_hi;
#define IN(k) (lo <= (k) && (k) < hi)
#define SEAM(k) do { if (IN(k) && IN((k) + 1)) xcd_barrier(bar); } while (0)
    if (PH_ON(0) && IN(0)) { phase_p0a(p, lds, bid, G, tid, wave, lane); }
    SEAM(0);
    if (PH_ON(1) && IN(1)) { phase_entry(p, bid * 8 + wave, G * 8, lane); }
    SEAM(1);
#pragma unroll 1
    for (int l = 0; l < DEPTH; ++l) {
        const int pb = 2 + 8 * l;
#define FRESH() int tid_ = threadIdx.x; asm volatile("" : "+v"(tid_)); const int lane_ = tid_ & 63; const int wave_ = __builtin_amdgcn_readfirstlane(tid_ >> 6); \
                size_t wz_ = 0; asm volatile("" : "+s"(wz_)); unsigned char* ws = p.ws + wz_; (void)lane_; (void)wave_
        if (PH_ON(2) && IN(pb + 0)) {
            FRESH();
            pg8::DenseOrder S; S.init(TT / 256, DIN / 256, G, bid);
            pg8::EpiStore E{(bf16*)(ws + WS_Z), DIN};
            pg8::gemm_phase<false>(lds, tid_, (const bf16*)(ws + WS_H), (const bf16*)(ws + WS_WIN) + (size_t)l * DIN * D, nullptr, S, E);
        }
        SEAM(pb + 0);
        if (PH_ON(3) && IN(pb + 1)) {
            FRESH();
            for (int u = bid; u < NB * NGRP * NH * 2; u += G) { const int cb = u & 1, h = (u >> 1) & 7, bg = u >> 4; lru_agg_unit(ws, l, lds, bg / NGRP, bg % NGRP, h, cb, wave_, lane_); }
        }
        SEAM(pb + 1);
        if (PH_ON(4) && IN(pb + 2)) {
            FRESH();
            const int g0 = (l == DEPTH - 1) ? 1 : 0, ng = NGRP - g0;
            const int nlru = NB * ng * NH * 2, npool = ((l == DEPTH - 1) ? 256 : 288) * 2;
            for (int u = bid; u < nlru + npool; u += G) {
                if (u < nlru) { const int cb = u & 1, h = (u >> 1) & 7, bg = u >> 4; lru_final_unit(ws, l, bg / ng, g0 + bg % ng, h, cb, wave_, lane_); }
                else { const int q = u - nlru; pool_unit(ws, l, lds, q >> 1, q & 1, tid_, wave_, lane_); }
            }
        }
        SEAM(pb + 2);
        if (PH_ON(5) && IN(pb + 3)) {
            FRESH();
            pg8::DenseOrder S; S.init((l == DEPTH - 1 ? TL : TT) / 256, D / 256, G, bid);
            pg8::EpiStore E{(bf16*)(ws + WS_Y1), D};
            pg8::gemm_phase<false>(lds, tid_, (const bf16*)(ws + WS_MIX), (const bf16*)(ws + WS_WOUT) + (size_t)l * D * D, nullptr, S, E);
        }
        SEAM(pb + 3);
        if (PH_ON(6) && IN(pb + 4)) { FRESH(); phase_ln1(ws, l, lds, bid, G, tid_, wave_, lane_); }
        SEAM(pb + 4);
        if (IN(pb + 5) || IN(pb + 6)) {
            FRESH();
            const int* cnt = (const int*)(ws + WS_CTL) + CW_CNT + 32 * l;
            LAS int* tb = (LAS int*)(lds + LDS_TB);
            if (tid_ < 64) { const int c = lane_ < 32 ? (cnt[lane_] + 255) >> 8 : 0; int s = c;
#pragma unroll
                for (int o = 1; o < 32; o <<= 1) { const int t = __shfl_up(s, o); if (lane_ >= o) s += t; }
                if (lane_ < 32) tb[lane_ + 1] = s; if (lane_ == 0) tb[0] = 0; }
            __syncthreads();
        }
        if (PH_ON(7) && IN(pb + 5)) {
            FRESH();
            const int* cnt = (const int*)(ws + WS_CTL) + CW_CNT + 32 * l;
            pg8::MoeOrder<8, true> S{(const LAS int*)(lds + LDS_TB), cnt, G, bid};
            pg8::EpiSwiglu E{(bf16*)(ws + WS_ACT), (const float*)(ws + WS_SP) + (size_t)l * SP_STRIDE + SP_B1};
            pg8::gemm_phase<true>(lds, tid_, (const bf16*)(ws + WS_H), (const bf16*)(ws + WS_W1T) + (size_t)l * NE * 2 * DF * D, (const int*)(ws + WS_ROWTOK), S, E);
        }
        SEAM(pb + 5);
        if (PH_ON(8) && IN(pb + 6)) {
            FRESH();
            const int* cnt = (const int*)(ws + WS_CTL) + CW_CNT + 32 * l;
            pg8::MoeOrder<4, false> S{(const LAS int*)(lds + LDS_TB), cnt, G, bid};
            pg8::EpiDown E{(bf16*)(ws + WS_Y2), (const float*)(ws + WS_SP) + (size_t)l * SP_STRIDE + SP_B2, (const float*)(ws + WS_ROWGATE), (const int*)(ws + WS_ROWDST)};
            pg8::gemm_phase<false>(lds, tid_, (const bf16*)(ws + WS_ACT), (const bf16*)(ws + WS_W2T) + (size_t)l * NE * D * DF, nullptr, S, E);
        }
        SEAM(pb + 6);
        if (PH_ON(9) && IN(pb + 7)) { FRESH(); phase_ln2(ws, p.out, l, bid * 8 + wave_, G * 8, lane_); }
        SEAM(pb + 7);
#undef FRESH
    }
#undef IN
#undef SEAM
}

extern "C" void kernel_launch(void* const* d_in, const int* in_sizes, int n_in, void* d_out, int out_size, void* d_ws, size_t ws_size, hipStream_t stream) {
    static int grid = 0;
    if (grid == 0) {
        if (n_in != N_IN || ws_size < WS_END || out_size != TL * D) { fprintf(stderr, "kernel_launch: unexpected shapes (n_in %d, out %d, ws %zu)\n", n_in, out_size, ws_size); grid = -1; return; }
        int dev = 0, cus = 0, per_cu = 0;
        if (hipGetDevice(&dev) != hipSuccess || hipDeviceGetAttribute(&cus, hipDeviceAttributeMultiprocessorCount, dev) != hipSuccess) { grid = -1; return; }
        if (hipFuncSetAttribute((const void*)mk_fwd, hipFuncAttributeMaxDynamicSharedMemorySize, LDS_BYTES) != hipSuccess) { fprintf(stderr, "kernel_launch: hipFuncSetAttribute failed\n"); grid = -1; return; }
        if (hipOccupancyMaxActiveBlocksPerMultiprocessor(&per_cu, (const void*)mk_fwd, 512, LDS_BYTES) != hipSuccess || per_cu < 1) { fprintf(stderr, "kernel_launch: occupancy query says %d\n", per_cu); }
        (void)hipGetLastError();
        grid = cus;
    }
    if (grid < 0) return;
    (void)hipMemsetAsync((char*)d_ws + WS_CTL, 0, CTL_BYTES, stream);
    P p{};
    for (int i = 0; i < N_IN; ++i) p.in[i] = (const float*)d_in[i];
    p.out = (float*)d_out; p.ws = (unsigned char*)d_ws;
#if MK_PER_PHASE
    for (int ph = 0; ph < NPHASE; ++ph) { p.ph_lo = ph; p.ph_hi = ph + 1; hipLaunchKernelGGL(mk_fwd, dim3(grid), dim3(512), LDS_BYTES, stream, p);
#ifdef EXTRA_PHASE
        if (ph == EXTRA_PHASE) for (int r = 0; r < EXTRA_REPS; ++r) hipLaunchKernelGGL(mk_fwd, dim3(grid), dim3(512), LDS_BYTES, stream, p);
#endif
    }
#else
    p.ph_lo = 0; p.ph_hi = NPHASE;
    hipLaunchKernelGGL(mk_fwd, dim3(grid), dim3(512), LDS_BYTES, stream, p);
#endif
}
```

```cpp
#include <hip/hip_runtime.h>
#include <cstdio>
#include <cstdint>

constexpr int NB = 8, SEQ = 2048, D = 1024, CTXL = 256, DEPTH = 2;
constexpr int TL = NB * SEQ;
constexpr int TC = NB * CTXL;
constexpr int TT = TL + TC;
constexpr int DLRU = 512, DPOOL = 512, DIN = 1536, NH = 8, HD = 64;
constexpr int NE = 32, TOPK = 4, DF = 1024;
constexpr int GRIDW = 64;
constexpr float LN_EPS = 1e-5f;
constexpr float ALPHA = 1.41421356237309515f;
constexpr int MAXROWS = 81920;
constexpr int NTILE = 72, NGRP = 9;

enum { I_X = 0, I_C, I_CTX, I_CCTX, I_WMOD, I_BMOD, I_WIN, I_CONVW, I_CONVB, I_GAW, I_GAB, I_GXW, I_GXB, I_LAM, I_POOLW, I_POOLB, I_POOLS,
       I_WOUT, I_LN1G, I_LN1B, I_RW, I_RB, I_W1, I_B1, I_W2, I_B2, I_LN2G, I_LN2B, N_IN };

constexpr size_t MiB = 1u << 20;
constexpr size_t WS_CTL = 0, CTL_BYTES = 1 * MiB;
constexpr size_t WS_MOD = 1 * MiB;
constexpr size_t WS_POS = 2 * MiB;
constexpr size_t WS_RWT = 2 * MiB + 512 * 1024;
constexpr size_t WS_TOPG = 7 * MiB;
constexpr size_t WS_AGGT = 10 * MiB;
constexpr size_t WS_AGGG = 15 * MiB;
constexpr size_t WS_WIN = 16 * MiB, WS_WOUT = 23 * MiB, WS_WG = 28 * MiB, WS_WP = 29 * MiB;
constexpr size_t WS_SP = 30 * MiB;
constexpr size_t WS_W1T = 32 * MiB, WS_W2T = 160 * MiB;
constexpr size_t WS_H8S = 1052 * MiB;
constexpr int W1_SH = 6, W2_SH = 7;
constexpr int SP_CW = 0, SP_CB = 2048, SP_GAB = 2560, SP_GXB = 3584, SP_CC = 4608, SP_PB = 5632, SP_PS = 6144, SP_L1G = 6656, SP_L1B = 7680, SP_L2G = 8704, SP_L2B = 9728, SP_RB = 10752,
              SP_B1 = 12288, SP_B2 = SP_B1 + 32 * 2048, SP_STRIDE = SP_B2 + 32 * 1024;
constexpr size_t WS_XL = 416 * MiB;
constexpr size_t WS_H = 488 * MiB;
constexpr size_t WS_Z = 524 * MiB;
constexpr size_t WS_MIX = 578 * MiB;
constexpr size_t WS_Y1 = 614 * MiB;
constexpr size_t WS_ACT = 650 * MiB;
constexpr size_t WS_Y2 = 810 * MiB;
constexpr size_t WS_YB = 970 * MiB;
constexpr size_t WS_ROWDST = 1046 * MiB;
constexpr size_t WS_END = 1628 * MiB;
constexpr int CW_CNT = 64;
constexpr int CW_BAR = 4096;

typedef unsigned short bf16;
typedef float f32x4 __attribute__((ext_vector_type(4)));
typedef float f32x2 __attribute__((ext_vector_type(2)));
typedef float f32x16 __attribute__((ext_vector_type(16)));
typedef unsigned u32x2 __attribute__((ext_vector_type(2)));
typedef unsigned u32x4 __attribute__((ext_vector_type(4)));
typedef short bf16x8 __attribute__((ext_vector_type(8)));
typedef int i32x8 __attribute__((ext_vector_type(8)));
typedef unsigned char fp8;

__device__ __forceinline__ float bf2f(bf16 v) { return __uint_as_float(((unsigned)v) << 16); }
__device__ __forceinline__ float bflo(unsigned w) { return __uint_as_float(w << 16); }
__device__ __forceinline__ float bfhi(unsigned w) { return __uint_as_float(w & 0xffff0000u); }
__device__ __forceinline__ unsigned f2bf(float f) { unsigned u = __float_as_uint(f); return (u + 0x7fffu + ((u >> 16) & 1u)) >> 16; }
__device__ __forceinline__ unsigned pk2(float lo, float hi) { return f2bf(lo) | (f2bf(hi) << 16); }
__device__ __forceinline__ float wave_sum(float v) {
#pragma unroll
    for (int o = 1; o < 64; o <<= 1) v += __shfl_xor(v, o);
    return v;
}
__device__ __forceinline__ float fsigmoid(float x) { return __builtin_amdgcn_rcpf(1.0f + __expf(-x)); }
__device__ __forceinline__ float gelu_tanh(float x) {
    const float u = 0.7978845608028654f * (x + 0.044715f * x * x * x);
    const float t = 1.0f - 2.0f * __builtin_amdgcn_rcpf(__expf(2.0f * u) + 1.0f);
    return 0.5f * x * (1.0f + t);
}

struct P {
    const float* in[N_IN];
    float* out;
    unsigned char* ws;
    int ph_lo, ph_hi;
};

__device__ __forceinline__ int mod_row(int tok) { return tok < TL ? (tok >> 11) : NB; }
__device__ __forceinline__ int pad256(int c) { return (c + 255) & ~255; }

__device__ __forceinline__ void ln_stats(const f32x4 (&v)[4], float& mean, float& rstd) {
    float s = 0.f;
#pragma unroll
    for (int j = 0; j < 4; ++j) s += (v[j].x + v[j].y) + (v[j].z + v[j].w);
    mean = wave_sum(s) * (1.f / D);
    float s2 = 0.f;
#pragma unroll
    for (int j = 0; j < 4; ++j) { const f32x4 d = v[j] - mean; s2 += (d.x * d.x + d.y * d.y) + (d.z * d.z + d.w * d.w); }
    rstd = 1.0f / sqrtf(wave_sum(s2) * (1.f / D) + LN_EPS);
}
__device__ __forceinline__ void store_bf16_row(bf16* row, int lane, const f32x4 (&h)[4]) {
    u32x2* o = (u32x2*)row + lane;
#pragma unroll
    for (int j = 0; j < 4; ++j) { u32x2 w; w.x = pk2(h[j].x, h[j].y); w.y = pk2(h[j].z, h[j].w); o[64 * j] = w; }
}


#define LAS __attribute__((address_space(3)))
__device__ __forceinline__ void transpose_tile(const float* src, int N, bf16* dst, int Kp, LAS float* scr, int lane) {
    f32x4 v[16];
#pragma unroll
    for (int i = 0; i < 16; ++i) { const int k = 4 * i + (lane >> 4); v[i] = *(const f32x4*)(src + (size_t)k * N + 4 * (lane & 15)); }
#pragma unroll
    for (int i = 0; i < 16; ++i) { const int k = 4 * i + (lane >> 4); const int nn = (4 * (lane & 15)) ^ (((k >> 3) & 3) << 3); *(LAS f32x4*)(scr + k * 64 + nn) = v[i]; }
    asm volatile("s_waitcnt lgkmcnt(0)" ::: "memory");
    const int c = lane & 7, sw = (c & 3) << 3;
#pragma unroll
    for (int j = 0; j < 8; ++j) {
        const int n = (lane >> 3) + 8 * j;
        const LAS float* s = scr + (8 * c) * 64 + (n ^ sw);
        u32x4 o; o.x = pk2(s[0], s[64]); o.y = pk2(s[128], s[192]); o.z = pk2(s[256], s[320]); o.w = pk2(s[384], s[448]);
        *(u32x4*)(dst + (size_t)n * Kp + 8 * c) = o;
    }
    asm volatile("s_waitcnt lgkmcnt(0)" ::: "memory");
}
__device__ __forceinline__ void transpose_tile_fp8(const float* src, int N, fp8* dst, int Kp, float scale, LAS float* scr, int lane) {
    f32x4 v[16];
#pragma unroll
    for (int i = 0; i < 16; ++i) { const int k = 4 * i + (lane >> 4); v[i] = *(const f32x4*)(src + (size_t)k * N + 4 * (lane & 15)); }
#pragma unroll
    for (int i = 0; i < 16; ++i) { const int k = 4 * i + (lane >> 4); const int nn = (4 * (lane & 15)) ^ (((k >> 3) & 3) << 3); *(LAS f32x4*)(scr + k * 64 + nn) = v[i]; }
    asm volatile("s_waitcnt lgkmcnt(0)" ::: "memory");
    const int c = lane & 7, sw = (c & 3) << 3;
#pragma unroll
    for (int j = 0; j < 8; ++j) {
        const int n = (lane >> 3) + 8 * j;
        const LAS float* s = scr + (8 * c) * 64 + (n ^ sw);
        int w0 = 0, w1 = 0;
        w0 = __builtin_amdgcn_cvt_pk_fp8_f32(s[0] * scale, s[64] * scale, w0, false); w0 = __builtin_amdgcn_cvt_pk_fp8_f32(s[128] * scale, s[192] * scale, w0, true);
        w1 = __builtin_amdgcn_cvt_pk_fp8_f32(s[256] * scale, s[320] * scale, w1, false); w1 = __builtin_amdgcn_cvt_pk_fp8_f32(s[384] * scale, s[448] * scale, w1, true);
        *(u32x2*)(dst + (size_t)n * Kp + 8 * c) = (u32x2){(unsigned)w0, (unsigned)w1};
    }
    asm volatile("s_waitcnt lgkmcnt(0)" ::: "memory");
}
__device__ __forceinline__ void convert_weights(const P& p, LAS unsigned char* lds, int gw, int ngw, int wave, int lane) {
    LAS float* scr = (LAS float*)(lds + wave * 16384);
    bf16* WINT = (bf16*)(p.ws + WS_WIN); bf16* WOUTT = (bf16*)(p.ws + WS_WOUT); fp8* W1T = (fp8*)(p.ws + WS_W1T); fp8* W2T = (fp8*)(p.ws + WS_W2T);
    bf16* WGT = (bf16*)(p.ws + WS_WG); bf16* WPT = (bf16*)(p.ws + WS_WP);
    constexpr int I_IN = DEPTH * 16 * 24, I_OUT = DEPTH * 16 * 16, I_G = DEPTH * 2 * 2 * NH, I_P = DEPTH * 4 * 4, I_1 = DEPTH * NE * 16 * 32, I_2 = DEPTH * NE * 16 * 16;
    constexpr int NITEMS = I_IN + I_OUT + I_G + I_P + I_1 + I_2;
    for (int it = gw; it < NITEMS; it += ngw) {
        int r = it;
        if (r < I_IN) { const int l = r / 384, q = r % 384, kb = q / 24, nb = q % 24;
            transpose_tile(p.in[I_WIN] + (size_t)l * D * DIN + (size_t)(64 * kb) * DIN + 64 * nb, DIN, WINT + ((size_t)l * DIN + 64 * nb) * D + 64 * kb, D, scr, lane); continue; }
        r -= I_IN;
        if (r < I_OUT) { const int l = r / 256, q = r % 256, kb = q / 16, nb = q % 16;
            transpose_tile(p.in[I_WOUT] + (size_t)l * D * D + (size_t)(64 * kb) * D + 64 * nb, D, WOUTT + ((size_t)l * D + 64 * nb) * D + 64 * kb, D, scr, lane); continue; }
        r -= I_OUT;
        if (r < I_G) {
            const int h = r % NH, gt = (r / NH) % 2, d = (r / (NH * 2)) % 2, l = r / (NH * 4);
            const float* s = (gt ? p.in[I_GXW] : p.in[I_GAW]) + ((size_t)(l * 2 + d) * NH + h) * HD * HD;
            transpose_tile(s, HD, WGT + ((size_t)(l * NH + h) * 256 + (d * 2 + gt) * 64) * HD, HD, scr, lane); continue; }
        r -= I_G;
        if (r < I_P) {
            const int nb = r % 2, kb = (r / 2) % 2, lg = r / 4;
            transpose_tile(p.in[I_POOLW] + (size_t)lg * 128 * 128 + (size_t)(64 * kb) * 128 + 64 * nb, 128, WPT + ((size_t)lg * 128 + 64 * nb) * 128 + 64 * kb, 128, scr, lane); continue; }
        r -= I_P;
        if (r < I_1) {
            const int le = r / 512, q = r % 512, kb = q / 32, nb = q % 32;
            const int n0 = 64 * nb, j0 = n0 % DF, half = n0 / DF, row0 = (j0 / 128) * 256 + half * 128 + (j0 % 128);
            transpose_tile_fp8(p.in[I_W1] + (size_t)le * D * 2 * DF + (size_t)(64 * kb) * (2 * DF) + n0, 2 * DF, W1T + ((size_t)le * 2 * DF + row0) * D + 64 * kb, D, (float)(1 << W1_SH), scr, lane); continue; }
        r -= I_1;
        { const int le = r / 256, q = r % 256, kb = q / 16, nb = q % 16;
          transpose_tile_fp8(p.in[I_W2] + (size_t)le * DF * D + (size_t)(64 * kb) * D + 64 * nb, D, W2T + ((size_t)le * D + 64 * nb) * DF + 64 * kb, DF, (float)(1 << W2_SH), scr, lane); }
    }
}
namespace pg8 {
typedef short bf16x8 __attribute__((ext_vector_type(8)));
constexpr int BM = 256, BK = 64, HALF = 128, HTB = HALF * BK * 2, STAGE_BYTES = 8 * HTB;
__host__ __device__ __forceinline__ int lds_byte(int r, int c) { const int st = (r >> 4) * 2 + (c >> 5), rr = r & 15, cc = c & 31, ob = rr * 64 + cc * 2; return st * 1024 + (ob ^ (((ob >> 9) & 1) << 5)); }
__host__ __device__ __forceinline__ void stage_rc(int b, int& R, int& C) { const int st = b / 1024, sb = b % 1024, swz = sb ^ (((sb >> 9) & 1) << 5); R = (st >> 1) * 16 + swz / 64; C = (st & 1) * 32 + (swz % 64) / 2; }
__host__ __device__ __forceinline__ int perm32(int rho) { const int n = rho >> 4, i = rho & 15; return 8 * (i >> 2) + 4 * n + (i & 3); }
__device__ __forceinline__ unsigned cvt_pk_bf16(float lo, float hi) { unsigned r; asm volatile("v_cvt_pk_bf16_f32 %0, %1, %2" : "=v"(r) : "v"(lo), "v"(hi)); return r; }

struct Unit { int a0, nvalid, b0, o0, pn, e, g0; };

template <bool F8, class Sched, class Epi>
__device__ __forceinline__ void gemm_phase(LAS unsigned char* lds, int tid, const void* Abase_, const void* Bt_, const Sched& S, const Epi& E) {
    constexpr int RP = F8 ? 1024 : 2048, nt = F8 ? 8 : 16;
    const int wid = __builtin_amdgcn_readfirstlane(tid >> 6), lane = tid & 63, wr = wid >> 2, wc = wid & 3, fr = lane & 15, fq = lane >> 4;
    unsigned voffA, voffB;
    { int R, C; stage_rc(tid * 16, R, C); const int Rb = (R & ~31) + perm32(R & 31); voffA = (unsigned)(R * RP + 2 * C); voffB = (unsigned)(Rb * RP + 2 * C); }
    constexpr size_t kstep = (size_t)(BK * 2);
    constexpr size_t hstep = (size_t)HALF * RP;
    const unsigned ldsw = (unsigned)wid * 1024u;
    const int aoff = F8 ? lds_byte(wr * 64 + fr, fq * 16) : lds_byte(wr * 64 + fr, fq * 8), boff = F8 ? lds_byte(wc * 32 + fr, fq * 16) : lds_byte(wc * 32 + fr, fq * 8);
    const int one_scale = 0x7F7F7F7F;
#define PG8_SA(b, h) (((b) * 2 + (h)) * HTB)
#define PG8_SB(b, h) ((4 + (b) * 2 + (h)) * HTB)
#define PG8_STAGE(bufoff, gbase, voff) do { _Pragma("unroll") for (int _i = 0; _i < 2; ++_i) { unsigned _vo = (voff); asm volatile("" : "+v"(_vo)); \
        __builtin_amdgcn_global_load_lds((const unsigned*)((const char*)(gbase) + (size_t)_i * (64 * RP) + _vo), (LAS unsigned*)(lds + (bufoff) + ldsw + _i * 8192), 16, 0, 0); } } while (0)
#define PG8_LD8(addr) __builtin_bit_cast(i32x8, __builtin_shufflevector(*(const LAS u32x4*)(addr), *(const LAS u32x4*)((addr) + 16), 0, 1, 2, 3, 4, 5, 6, 7))
#define PG8_LDA(dst, b, h) do { _Pragma("unroll") for (int m = 0; m < 4; ++m) { \
        if constexpr (F8) dst##8[m] = PG8_LD8(lds + PG8_SA(b, h) + aoff + m * 2048); \
        else { _Pragma("unroll") for (int k = 0; k < 2; ++k) dst[m][k] = *(const LAS bf16x8*)(lds + PG8_SA(b, h) + aoff + m * 2048 + k * 1024); } } } while (0)
#define PG8_LDB(dst, b, h) do { _Pragma("unroll") for (int n = 0; n < 2; ++n) { \
        if constexpr (F8) dst##8[n] = PG8_LD8(lds + PG8_SB(b, h) + boff + n * 2048); \
        else { _Pragma("unroll") for (int k = 0; k < 2; ++k) dst[n][k] = *(const LAS bf16x8*)(lds + PG8_SB(b, h) + boff + n * 2048 + k * 1024); } } } while (0)
#define PG8_MMA(ai, bj, At, Bt) do { __builtin_amdgcn_s_setprio(1); _Pragma("unroll") for (int m = 0; m < 4; ++m) _Pragma("unroll") for (int n = 0; n < 2; ++n) { \
        if constexpr (F8) acc[ai][bj][m][n] = __builtin_amdgcn_mfma_scale_f32_16x16x128_f8f6f4(Bt##8[n], At##8[m], acc[ai][bj][m][n], 0, 0, 0, one_scale, 0, one_scale); \
        else { _Pragma("unroll") for (int k = 0; k < 2; ++k) acc[ai][bj][m][n] = __builtin_amdgcn_mfma_f32_16x16x32_bf16(Bt[n][k], At[m][k], acc[ai][bj][m][n], 0, 0, 0); } } \
        __builtin_amdgcn_s_setprio(0); } while (0)
#define PG8_WAIT_V(n) asm volatile("s_waitcnt vmcnt(" #n ")" ::: "memory")
#define PG8_WAIT_L(n) asm volatile("s_waitcnt lgkmcnt(" #n ")" ::: "memory")
#define PG8_BAR __builtin_amdgcn_s_barrier()
#define PG8_SCHED __builtin_amdgcn_sched_barrier(0)
    Unit cur, nxt; int ui = 0;
    if (!S.next(0, cur)) return;
    f32x4 acc[2][2][4][2];
#pragma unroll
    for (int a = 0; a < 2; ++a)
#pragma unroll
        for (int b = 0; b < 2; ++b)
#pragma unroll
            for (int m = 0; m < 4; ++m)
#pragma unroll
                for (int n = 0; n < 2; ++n) acc[a][b][m][n] = (f32x4){0.f, 0.f, 0.f, 0.f};
    bf16x8 At[4][2], B0[2][2], B1[2][2];
    i32x8 At8[4], B08[2], B18[2];
    const char* cA = (const char*)Abase_ + (size_t)cur.a0 * RP; const char* cB = (const char*)Bt_ + (size_t)cur.b0 * RP;
    PG8_STAGE(PG8_SB(0, 0), cB, voffB); PG8_STAGE(PG8_SB(0, 1), cB + hstep, voffB); PG8_STAGE(PG8_SA(0, 0), cA, voffA); PG8_STAGE(PG8_SA(0, 1), cA + hstep, voffA);
    if (wr == 1) PG8_BAR;
    PG8_WAIT_V(2); PG8_BAR;
    PG8_STAGE(PG8_SB(1, 0), cB + kstep, voffB); PG8_STAGE(PG8_SA(1, 0), cA + kstep, voffA); PG8_STAGE(PG8_SB(1, 1), cB + hstep + kstep, voffB);
    PG8_WAIT_V(6); PG8_BAR;
    for (;;) {
        const bool has_next = S.next(ui + 1, nxt);
        const char* nA = has_next ? (const char*)Abase_ + (size_t)nxt.a0 * RP : cA; const char* nB = has_next ? (const char*)Bt_ + (size_t)nxt.b0 * RP : cB;
#pragma unroll 1
        for (int t = 0; t < nt; t += 2) {
            const bool last = (t == nt - 2);
            const char* a1 = cA + (size_t)(t + 1) * kstep;
            const char* a2 = last ? nA : cA + (size_t)(t + 2) * kstep; const char* b2 = last ? nB : cB + (size_t)(t + 2) * kstep;
            const char* a3 = a2 + kstep; const char* b3 = b2 + kstep;
            PG8_LDB(B0, 0, 0); PG8_LDB(B1, 0, 1); PG8_SCHED; PG8_LDA(At, 0, 0); PG8_STAGE(PG8_SA(1, 1), a1 + hstep, voffA);
            PG8_WAIT_V(8); PG8_WAIT_L(0); PG8_BAR; PG8_MMA(0, 0, At, B0); PG8_MMA(0, 1, At, B1); PG8_BAR; PG8_SCHED;
            PG8_LDA(At, 0, 1); PG8_STAGE(PG8_SB(0, 0), b2, voffB); PG8_STAGE(PG8_SB(0, 1), b2 + hstep, voffB); PG8_STAGE(PG8_SA(0, 0), a2, voffA);
            PG8_WAIT_V(8); PG8_WAIT_L(0); PG8_BAR; PG8_MMA(1, 0, At, B0); PG8_MMA(1, 1, At, B1); PG8_BAR; PG8_SCHED;
            PG8_LDB(B0, 1, 0); PG8_LDB(B1, 1, 1); PG8_SCHED; PG8_LDA(At, 1, 0); PG8_STAGE(PG8_SA(0, 1), a2 + hstep, voffA);
            PG8_WAIT_V(8); PG8_WAIT_L(0); PG8_BAR; PG8_MMA(0, 0, At, B0); PG8_MMA(0, 1, At, B1); PG8_BAR; PG8_SCHED;
            PG8_LDA(At, 1, 1); PG8_STAGE(PG8_SB(1, 0), b3, voffB); PG8_STAGE(PG8_SB(1, 1), b3 + hstep, voffB); PG8_STAGE(PG8_SA(1, 0), a3, voffA);
            PG8_WAIT_V(8); PG8_WAIT_L(0); PG8_BAR; PG8_MMA(1, 0, At, B0); PG8_MMA(1, 1, At, B1); PG8_BAR; PG8_SCHED;
        }
        if (wr == 0) PG8_BAR;
        PG8_SCHED; { int fr_ = fr, fq_ = fq; asm volatile("" : "+v"(fr_), "+v"(fq_)); E(acc, cur, wr, wc, fr_, fq_); } PG8_SCHED;
        if (!has_next) break;
#pragma unroll
        for (int a = 0; a < 2; ++a)
#pragma unroll
            for (int b = 0; b < 2; ++b)
#pragma unroll
                for (int m = 0; m < 4; ++m)
#pragma unroll
                    for (int n = 0; n < 2; ++n) acc[a][b][m][n] = (f32x4){0.f, 0.f, 0.f, 0.f};
        cur = nxt; cA = nA; cB = nB; ++ui;
        if (wr == 1) PG8_BAR;
    }
    PG8_WAIT_V(0);
    PG8_BAR;
#undef PG8_SA
#undef PG8_SB
#undef PG8_STAGE
#undef PG8_LDA
#undef PG8_LDB
#undef PG8_MMA
#undef PG8_LD8
#undef PG8_WAIT_V
#undef PG8_WAIT_L
#undef PG8_BAR
#undef PG8_SCHED
}

struct DenseOrder {
    int nM, nN, nwg, G, c;
    __device__ void init(int nM_, int nN_, int G_, int c_) { nM = nM_; nN = nN_; nwg = nM * nN; G = G_; c = c_; }
    __device__ bool next(int i, Unit& u) const {
        const long L = (long)i * G + c; if (L >= nwg) return false;
        int wgid = (int)L; { const int q = nwg / 8, r = nwg % 8, xcd = wgid % 8, off = wgid / 8; wgid = (xcd < r ? xcd * (q + 1) : r * (q + 1) + (xcd - r) * q) + off; }
        const int nig = 8 * nN, gid = wgid / nig, fm = gid * 8, gsz = (nM - fm) < 8 ? (nM - fm) : 8;
        const int pm = fm + ((wgid % nig) % gsz), pn = (wgid % nig) / gsz;
        u.a0 = pm * 256; u.nvalid = 256; u.b0 = pn * 256; u.o0 = pm * 256; u.pn = pn; u.e = 0; u.g0 = 0; return true;
    }
};
template <int NPN, bool UP> struct MoeOrder {
    const LAS int* tb; const int* cnt; int G, c;
    __device__ bool next(int i, Unit& u) const {
        const int L = i * G + c; const int total = tb[32] * NPN; if (L >= total) return false;
        int e = 0;
#pragma unroll 1
        for (int q = 16; q >= 1; q >>= 1) if (tb[e + q] * NPN <= L) e += q;
        const int te = tb[e + 1] - tb[e], j = L - tb[e] * NPN, pn = j / te, mt = j % te;
        const int ce = cnt[e];
        u.e = e; u.pn = pn; u.o0 = (tb[e] + mt) * 256; u.nvalid = min(256, ce - mt * 256);
        u.g0 = e * TT + mt * 256;
        u.a0 = UP ? u.g0 : u.o0;
        u.b0 = e * (UP ? 2 * DF : D) + pn * 256;
        return true;
    }
};

struct EpiStore {
    bf16* C; int ldc;
    __device__ __forceinline__ void operator()(const f32x4 (&acc)[2][2][4][2], const Unit& u, int wr, int wc, int fr, int fq) const {
        const int row0 = u.o0 + wr * 64 + fr, col0 = u.pn * 256 + wc * 32 + 8 * fq;
#pragma unroll
        for (int ai = 0; ai < 2; ++ai)
#pragma unroll
            for (int m = 0; m < 4; ++m) { bf16* rowp = C + (size_t)(row0 + ai * HALF + m * 16) * ldc + col0;
#pragma unroll
                for (int bj = 0; bj < 2; ++bj) { const f32x4 v0 = acc[ai][bj][m][0], v1 = acc[ai][bj][m][1];
                    u32x4 w; w.x = cvt_pk_bf16(v0[0], v0[1]); w.y = cvt_pk_bf16(v0[2], v0[3]); w.z = cvt_pk_bf16(v1[0], v1[1]); w.w = cvt_pk_bf16(v1[2], v1[3]);
                    *(u32x4*)(rowp + bj * HALF) = w; } }
    }
};
struct EpiSwiglu {
    fp8* C; const float* b1;
    __device__ __forceinline__ void operator()(const f32x4 (&acc)[2][2][4][2], const Unit& u, int wr, int wc, int fr, int fq) const {
        const int row0 = u.o0 + wr * 64 + fr, j0 = u.pn * 128 + wc * 32 + 8 * fq;
        const float* bb = b1 + (size_t)u.e * 2 * DF + j0;
        const f32x4 bg0 = *(const f32x4*)bb, bg1 = *(const f32x4*)(bb + 4), bl0 = *(const f32x4*)(bb + DF), bl1 = *(const f32x4*)(bb + DF + 4);
#pragma unroll
        for (int ai = 0; ai < 2; ++ai)
#pragma unroll
            for (int m = 0; m < 4; ++m) {
                float o[8];
#pragma unroll
                for (int n = 0; n < 2; ++n)
#pragma unroll
                    for (int q = 0; q < 4; ++q) {
                        constexpr float ws = 1.0f / (float)(1 << W1_SH);
                        const float gl = fminf(fmaf(acc[ai][0][m][n][q], ws, n ? bg1[q] : bg0[q]), 7.0f);
                        const float li = fminf(fmaxf(fmaf(acc[ai][1][m][n][q], ws, n ? bl1[q] : bl0[q]), -7.0f), 7.0f);
                        o[4 * n + q] = gl * __builtin_amdgcn_rcpf(1.0f + __expf(-1.702f * gl)) * (li + 1.0f);
                    }
                int w0 = 0, w1 = 0;
                w0 = __builtin_amdgcn_cvt_pk_fp8_f32(o[0], o[1], w0, false); w0 = __builtin_amdgcn_cvt_pk_fp8_f32(o[2], o[3], w0, true);
                w1 = __builtin_amdgcn_cvt_pk_fp8_f32(o[4], o[5], w1, false); w1 = __builtin_amdgcn_cvt_pk_fp8_f32(o[6], o[7], w1, true);
                *(u32x2*)(C + (size_t)(row0 + ai * HALF + m * 16) * DF + j0) = (u32x2){(unsigned)w0, (unsigned)w1};
            }
    }
};
struct EpiDown {
    bf16* C; const float* b2; const int* rowdst;
    __device__ __forceinline__ void operator()(const f32x4 (&acc)[2][2][4][2], const Unit& u, int wr, int wc, int fr, int fq) const {
        const int rt0 = wr * 64 + fr, col0 = u.pn * 256 + wc * 32 + 8 * fq;
        const float* bp = b2 + (size_t)u.e * D + col0;
#pragma unroll
        for (int ai = 0; ai < 2; ++ai) {
#pragma unroll
            for (int m = 0; m < 4; ++m) {
                const int rt = rt0 + ai * HALF + m * 16;
                const int dst = (rt < u.nvalid) ? rowdst[u.g0 + rt] : -1;
#pragma unroll
                for (int bj = 0; bj < 2; ++bj) {
                    constexpr float ws = 1.0f / (float)(1 << W2_SH);
                    const f32x4 v0 = acc[ai][bj][m][0] * ws + *(const f32x4*)(bp + bj * HALF), v1 = acc[ai][bj][m][1] * ws + *(const f32x4*)(bp + bj * HALF + 4);
                    u32x4 w; w.x = cvt_pk_bf16(v0[0], v0[1]); w.y = cvt_pk_bf16(v0[2], v0[3]); w.z = cvt_pk_bf16(v1[0], v1[1]); w.w = cvt_pk_bf16(v1[2], v1[3]);
                    if (dst >= 0) *(u32x4*)(C + (size_t)dst * D + col0 + bj * HALF) = w;
                }
                __builtin_amdgcn_sched_barrier(0);
            }
        }
    }
};
}

#define XB_TMO      128
#define XB_XCNT(j)  (256  + 64 * (j))
#define XB_XSUB(j)  (1280 + 64 * (j))
#define XB_XGEN(j)  (2304 + 64 * (j))
#define XB_TOP      3328
#define XB_TOPGEN   3392
#define XCD_BAR_WORDS 3456
#define XB_SPIN_CAP (1u << 18)
__device__ __forceinline__ unsigned xb_ld(unsigned* p)              { return __hip_atomic_load(p, __ATOMIC_RELAXED, __HIP_MEMORY_SCOPE_AGENT); }
__device__ __forceinline__ unsigned xb_add(unsigned* p, unsigned v) { return __hip_atomic_fetch_add(p, v, __ATOMIC_RELAXED, __HIP_MEMORY_SCOPE_AGENT); }
__device__ __forceinline__ unsigned xb_xcc_id() { return (unsigned)__builtin_amdgcn_s_getreg((3 << 11) | 20) & 0xFu; }
#define XB_SPIN(cond, bar) do { unsigned _sp = 0; while (cond) { __builtin_amdgcn_s_sleep(1); \
    if ((++_sp & 255u) == 0u) { if (xb_ld(&(bar)[XB_TMO])) break; if (_sp > XB_SPIN_CAP) { atomicAdd(&(bar)[XB_TMO], 1u); break; } } } } while (0)
struct XcdBarrier { unsigned* bar; unsigned x; volatile LAS unsigned* st; };
__device__ __forceinline__ XcdBarrier xcd_barrier_post(unsigned* bar, volatile LAS unsigned* st) {
    XcdBarrier b; b.bar = bar; b.x = xb_xcc_id(); b.st = st;
    if (threadIdx.x == 0) (void)xb_add(&bar[XB_XCNT(b.x)], 1u);
    return b;
}
__device__ __forceinline__ void xcd_barrier_complete(unsigned* bar, unsigned x, unsigned& nloc, unsigned& nx) {
    const unsigned G = gridDim.x * gridDim.y * gridDim.z;
    unsigned sum, cnt, mine, sp = 0u;
    for (;;) {
        sum = 0u; cnt = 0u; mine = 0u;
#pragma unroll
        for (unsigned j = 0; j < 16; ++j) { const unsigned c = xb_ld(&bar[XB_XCNT(j)]); sum += c; cnt += (c > 0u) ? 1u : 0u; mine = (j == x) ? c : mine; }
        if (sum == G) break;
        __builtin_amdgcn_s_sleep(1);
        if ((++sp & 255u) == 0u) { if (xb_ld(&bar[XB_TMO])) break; if (sp > XB_SPIN_CAP) { atomicAdd(&bar[XB_TMO], 1u); break; } }
    }
    nloc = mine > 0u ? mine : 1u; nx = cnt > 0u ? cnt : 1u;
}
__device__ __forceinline__ void xcd_barrier(const XcdBarrier& b, bool leader) {
    asm volatile("s_waitcnt vmcnt(0)" ::: "memory");
    __syncthreads();
    if (leader) {
        unsigned* bar = b.bar;
        __builtin_amdgcn_s_waitcnt(0);
        unsigned nloc = b.st[0], nx = b.st[1];
        if (nloc == 0u) { xcd_barrier_complete(bar, b.x, nloc, nx); b.st[0] = nloc; b.st[1] = nx; }
        const unsigned old = xb_add(&bar[XB_XSUB(b.x)], 1u);
        const unsigned gen = old / nloc;
        if (old + 1u == (gen + 1u) * nloc) {
            __builtin_amdgcn_fence(__ATOMIC_RELEASE, "agent");
            asm volatile("s_waitcnt vmcnt(0)" ::: "memory");
            const unsigned og = xb_add(&bar[XB_TOP], 1u);
            const unsigned tg = og / nx;
            if (og + 1u == (tg + 1u) * nx) xb_add(&bar[XB_TOPGEN], 1u);
            else XB_SPIN(xb_ld(&bar[XB_TOPGEN]) == tg, bar);
            __builtin_amdgcn_fence(__ATOMIC_ACQUIRE, "agent");
            xb_add(&bar[XB_XGEN(b.x)], 1u);
            asm volatile("s_waitcnt vmcnt(0)" ::: "memory");
        } else {
            XB_SPIN(xb_ld(&bar[XB_XGEN(b.x)]) == gen, bar);
            __builtin_amdgcn_fence(__ATOMIC_ACQUIRE, "agent");
            asm volatile("s_waitcnt vmcnt(0)" ::: "memory");
        }
    }
    __syncthreads();
}

constexpr int LDS_BYTES = 147456;
constexpr int LDS_TB = LDS_BYTES - 1024;
constexpr int LDS_MISC = LDS_BYTES - 512;

__device__ __forceinline__ void phase_p0a(const P& p, LAS unsigned char* lds, int bid, int G, int tid, int wave, int lane) {
    { float* POS = (float*)(p.ws + WS_POS);
      for (int i = bid * 512 + tid; i < 64 * 512; i += G * 512) {
          const int n = i / 512, j = i % 512, q = j % 256;
          const float omega = 1.0f / powf(10000.0f, (float)q / 256.0f);
          const float ang = (float)n * omega;
          POS[i] = j < 256 ? sinf(ang) : cosf(ang);
      } }
    { bf16* RWT = (bf16*)(p.ws + WS_RWT);
      for (int i = bid * 512 + tid; i < DEPTH * NE * 128; i += G * 512) {
          const int kc = i % 128, e = (i / 128) % NE, l = i / (128 * NE);
          const float* s = p.in[I_RW] + (size_t)l * D * NE + (size_t)(8 * kc) * NE + e;
          u32x4 o; o.x = pk2(s[0], s[NE]); o.y = pk2(s[2 * NE], s[3 * NE]); o.z = pk2(s[4 * NE], s[5 * NE]); o.w = pk2(s[6 * NE], s[7 * NE]);
          *(u32x4*)(RWT + ((size_t)l * NE + e) * D + 8 * kc) = o;
      } }
    { float* SP = (float*)(p.ws + WS_SP);
      const int gt = bid * 512 + tid, gn = G * 512;
      for (int l = 0; l < DEPTH; ++l) {
          float* o = SP + (size_t)l * SP_STRIDE;
          for (int i = gt; i < 2048; i += gn) o[SP_CW + i] = p.in[I_CONVW][(size_t)l * 2048 + i];
          for (int i = gt; i < 512; i += gn) { o[SP_CB + i] = p.in[I_CONVB][(size_t)l * 512 + i]; o[SP_PB + i] = p.in[I_POOLB][(size_t)l * 512 + i]; o[SP_PS + i] = p.in[I_POOLS][(size_t)l * 512 + i]; }
          for (int i = gt; i < 1024; i += gn) { o[SP_GAB + i] = p.in[I_GAB][(size_t)l * 1024 + i]; o[SP_GXB + i] = p.in[I_GXB][(size_t)l * 1024 + i];
              const float nl = -p.in[I_LAM][(size_t)l * 1024 + i]; o[SP_CC + i] = 8.0f * (nl > 20.f ? nl : log1pf(expf(nl)));
              o[SP_L1G + i] = p.in[I_LN1G][(size_t)l * 1024 + i]; o[SP_L1B + i] = p.in[I_LN1B][(size_t)l * 1024 + i];
              o[SP_L2G + i] = p.in[I_LN2G][(size_t)l * 1024 + i]; o[SP_L2B + i] = p.in[I_LN2B][(size_t)l * 1024 + i]; }
          for (int i = gt; i < 32; i += gn) o[SP_RB + i] = p.in[I_RB][(size_t)l * 32 + i];
          for (int i = gt; i < 32 * 2048; i += gn) o[SP_B1 + i] = p.in[I_B1][(size_t)l * 32 * 2048 + i];
          for (int i = gt; i < 32 * 1024; i += gn) o[SP_B2 + i] = p.in[I_B2][(size_t)l * 32 * 1024 + i];
      } }
    { LAS float* sl = (LAS float*)lds; LAS float* part = sl + 9 * 1024;
      const float* c = p.in[I_C]; const float* cc = p.in[I_CCTX];
      for (int i = tid; i < 9 * 1024; i += 512) { const float v = i < 8192 ? c[i] : cc[i - 8192]; sl[i] = v / (1.0f + __expf(-v)); }
      __syncthreads();
      float* MOD = (float*)(p.ws + WS_MOD);
      for (int u = bid; u < 2 * 192; u += G) {
          const int l = u / 192, n0 = (u % 192) * 32;
          const float* W = p.in[I_WMOD] + (size_t)l * 1024 * 6144;
          const int col = tid & 31, ks = tid >> 5;
          float acc[9];
#pragma unroll
          for (int r = 0; r < 9; ++r) acc[r] = 0.f;
#pragma unroll 8
          for (int kk = 0; kk < 64; ++kk) {
              const int k = ks * 64 + kk;
              const float w = W[(size_t)k * 6144 + n0 + col];
#pragma unroll
              for (int r = 0; r < 9; ++r) acc[r] += sl[r * 1024 + k] * w;
          }
#pragma unroll
          for (int r = 0; r < 9; ++r) part[(ks * 9 + r) * 32 + col] = acc[r];
          __syncthreads();
          if (tid < 9 * 32) {
              const int r = tid / 32, cl = tid % 32; float s = 0.f;
#pragma unroll
              for (int q = 0; q < 16; ++q) s += part[(q * 9 + r) * 32 + cl];
              MOD[((size_t)l * 9 + r) * 6144 + n0 + cl] = s + p.in[I_BMOD][(size_t)l * 6144 + n0 + cl];
          }
          __syncthreads();
      } }
    __syncthreads();
    convert_weights(p, lds, bid * 8 + wave, G * 8, wave, lane);
}

__device__ __forceinline__ void phase_entry(const P& p, int gw, int ngw, int lane) {
    const float* POS = (const float*)(p.ws + WS_POS);
    const float* MOD = (const float*)(p.ws + WS_MOD);
    float* XL = (float*)(p.ws + WS_XL); bf16* H = (bf16*)(p.ws + WS_H);
    for (int tok = gw; tok < TT; tok += ngw) {
        const float* src = tok < TL ? p.in[I_X] + (size_t)tok * D : p.in[I_CTX] + (size_t)(tok - TL) * D;
        f32x4 v[4];
#pragma unroll
        for (int j = 0; j < 4; ++j) v[j] = ((const f32x4*)src)[lane + 64 * j];
        if (tok < TL) {
            const int s = tok & (SEQ - 1), pr = s / GRIDW, pc = s % GRIDW;
#pragma unroll
            for (int j = 0; j < 4; ++j) {
                const float* ps = POS + (size_t)(j < 2 ? pr : pc) * 512 + (4 * lane + 256 * (j & 1));
                v[j] += *(const f32x4*)ps;
            }
        }
        float mean, rstd; ln_stats(v, mean, rstd);
        const float* m = MOD + (size_t)mod_row(tok) * 6144;
        f32x4 h[4];
#pragma unroll
        for (int j = 0; j < 4; ++j) {
            v[j] = (v[j] - mean) * rstd;
            ((f32x4*)(XL + (size_t)tok * D))[lane + 64 * j] = v[j];
            const f32x4 sh = ((const f32x4*)m)[lane + 64 * j], sc = ((const f32x4*)(m + 1024))[lane + 64 * j];
            h[j] = v[j] * (sc + 1.0f) + sh;
        }
        store_bf16_row(H + (size_t)tok * D, lane, h);
    }
}

constexpr float LOG2E = 1.4426950408889634f;
__device__ __forceinline__ float fast_sigmoid(float x) { return __builtin_amdgcn_rcpf(1.0f + __builtin_amdgcn_exp2f(-LOG2E * x)); }
__device__ __forceinline__ int lru_item(int b, int grp, int h, int cb, int wave) { return ((((b * NGRP + grp) * NH + h) * 2 + cb) * 8 + wave); }

template <bool FINAL>
__device__ __forceinline__ void tile_scan(const f32x16& ar, const f32x16& ai, int d, int hh, float cin, float& aggP, float& aggH, float (&hsum)[16]) {
    float oP[4], oH[4];
#pragma unroll
    for (int q = 0; q < 4; ++q) {
        float Pp = 1.f, Hh = 0.f;
#pragma unroll
        for (int jj = 0; jj < 4; ++jj) { const int j = d ? 3 - jj : jj; Hh = ar[4 * q + j] * Hh + ai[4 * q + j]; Pp *= ar[4 * q + j]; }
        oP[q] = Pp; oH[q] = Hh;
    }
    float eP[4], eH[4], xP[4], xH[4];
#pragma unroll
    for (int q = 0; q < 4; ++q) { const float pP = __shfl_xor(oP[q], 32), pH = __shfl_xor(oH[q], 32);
        eP[q] = hh ? pP : oP[q]; eH[q] = hh ? pH : oH[q]; xP[q] = hh ? oP[q] : pP; xH[q] = hh ? oH[q] : pH; }
    float c = cin, pall = 1.f;
    float mine[4];
    if (d == 0) {
#pragma unroll
        for (int q = 0; q < 4; ++q) { const float cE = c; c = eP[q] * c + eH[q]; const float cO = c; c = xP[q] * c + xH[q]; mine[q] = hh ? cO : cE; pall *= eP[q] * xP[q]; }
    } else {
#pragma unroll
        for (int q = 3; q >= 0; --q) { const float cO = c; c = xP[q] * c + xH[q]; const float cE = c; c = eP[q] * c + eH[q]; mine[q] = hh ? cO : cE; pall *= eP[q] * xP[q]; }
    }
    aggP = pall; aggH = c;
    if (FINAL) {
#pragma unroll
        for (int q = 0; q < 4; ++q) { float Hh = mine[q];
#pragma unroll
            for (int jj = 0; jj < 4; ++jj) { const int j = d ? 3 - jj : jj; Hh = ar[4 * q + j] * Hh + ai[4 * q + j]; if (d == 0) hsum[4 * q + j] = Hh; else hsum[4 * q + j] += Hh; } }
    }
}

__device__ __forceinline__ void lru_agg_unit(unsigned char* ws, int l, LAS unsigned char* lds, int b, int grp, int h, int cb, int wave, int lane) {
    asm volatile("" : "+s"(wave)); asm volatile("" : "+v"(lane));
    const bf16* Z = (const bf16*)(ws + WS_Z);
    const int r = lane & 31, hh = lane >> 5;
    int seqbase, len, t0;
    if (grp == 0) { seqbase = TL + b * CTXL; len = CTXL; t0 = wave * 32; } else { seqbase = b * SEQ; len = SEQ; t0 = (grp - 1) * 256 + wave * 32; }
    const int t = t0 + r;
    const float* SP = (const float*)(ws + WS_SP) + (size_t)l * SP_STRIDE;
    const float* cw = SP + SP_CW; const float* cbias = SP + SP_CB;
    bf16x8 Af[4];
#pragma unroll
    for (int s = 0; s < 4; ++s) {
        const int c0 = 64 * h + 16 * s + 8 * hh;
        const f32x4 b0 = *(const f32x4*)(cbias + c0), b1 = *(const f32x4*)(cbias + c0 + 4);
        float u[8] = {b0.x, b0.y, b0.z, b0.w, b1.x, b1.y, b1.z, b1.w};
#pragma unroll
        for (int k = 0; k < 4; ++k) {
            const int tt = t + k - 2;
            u32x4 raw = (u32x4){0u, 0u, 0u, 0u};
            if (tt >= 0 && tt < len) raw = *(const u32x4*)(Z + (size_t)(seqbase + tt) * DIN + c0);
            const f32x4 w0 = *(const f32x4*)(cw + k * DLRU + c0), w1 = *(const f32x4*)(cw + k * DLRU + c0 + 4);
            u[0] += w0.x * bflo(raw.x); u[1] += w0.y * bfhi(raw.x); u[2] += w0.z * bflo(raw.y); u[3] += w0.w * bfhi(raw.y);
            u[4] += w1.x * bflo(raw.z); u[5] += w1.y * bfhi(raw.z); u[6] += w1.z * bflo(raw.w); u[7] += w1.w * bfhi(raw.w);
        }
        u32x4 pk; pk.x = pg8::cvt_pk_bf16(u[0], u[1]); pk.y = pg8::cvt_pk_bf16(u[2], u[3]); pk.z = pg8::cvt_pk_bf16(u[4], u[5]); pk.w = pg8::cvt_pk_bf16(u[6], u[7]);
        Af[s] = __builtin_bit_cast(bf16x8, pk);
        asm volatile("" ::: "memory");
    }
    const bf16* WG = (const bf16*)(ws + WS_WG) + (size_t)(l * NH + h) * 256 * HD;
    f32x16 accu;
#pragma unroll
    for (int i = 0; i < 16; ++i) accu[i] = 0.f;
    { const int nn = 32 * cb + r;
#pragma unroll
      for (int s = 0; s < 4; ++s) {
          u32x4 w = (u32x4){0u, 0u, 0u, 0u};
          if ((nn >> 4) == s && ((nn >> 3) & 1) == hh) { const unsigned one = 0x3F80u << (16 * (nn & 1)); const int wi = (nn & 7) >> 1;
              w.x = wi == 0 ? one : 0u; w.y = wi == 1 ? one : 0u; w.z = wi == 2 ? one : 0u; w.w = wi == 3 ? one : 0u; }
          accu = __builtin_amdgcn_mfma_f32_32x32x16_bf16(Af[s], __builtin_bit_cast(bf16x8, w), accu, 0, 0, 0);
      } }
    const int ch = 64 * h + 32 * cb + r;
    u32x4* YB = (u32x4*)(ws + WS_YB) + (size_t)lru_item(b, grp, h, cb, wave) * 8 * 64 + lane;
    float aggP[2], aggH[2];
    float hdummy[16];
#pragma unroll
    for (int d = 0; d < 2; ++d) {
        f32x16 ar, ai;
#pragma unroll
        for (int i = 0; i < 16; ++i) { ar[i] = 0.f; ai[i] = 0.f; }
        { const bf16* wr_ = WG + (size_t)((2 * d) * 64 + 32 * cb + r) * HD + 8 * hh; const bf16* wi_ = wr_ + 64 * HD;
#pragma unroll
          for (int s = 0; s < 4; ++s) { const bf16x8 Bf = *(const bf16x8*)(wr_ + 16 * s); ar = __builtin_amdgcn_mfma_f32_32x32x16_bf16(Af[s], Bf, ar, 0, 0, 0); }
#pragma unroll
          for (int s = 0; s < 4; ++s) { const bf16x8 Bf = *(const bf16x8*)(wi_ + 16 * s); ai = __builtin_amdgcn_mfma_f32_32x32x16_bf16(Af[s], Bf, ai, 0, 0, 0); } }
        const float ba = SP[SP_GAB + d * DLRU + ch], bx = SP[SP_GXB + d * DLRU + ch], cc = SP[SP_CC + d * DLRU + ch];
#pragma unroll
        for (int q = 0; q < 4; ++q) {
            u32x4 wq;
#pragma unroll
            for (int j = 0; j < 4; ++j) { const int i = 4 * q + j;
                const float rr = fast_sigmoid(ar[i] + ba), ig = fast_sigmoid(ai[i] + bx);
                const float y = cc * rr;
                const float a0 = __builtin_amdgcn_exp2f(-LOG2E * y);
                const float bt = __builtin_amdgcn_sqrtf(fmaf(-a0, a0, 1.0f)) * (ig * accu[i]);
                const unsigned w = pg8::cvt_pk_bf16(y, bt);
                wq[j] = w;
                ar[i] = __builtin_amdgcn_exp2f(-LOG2E * bflo(w)); ai[i] = bfhi(w);
            }
            YB[(d * 4 + q) * 64] = wq;
            __builtin_amdgcn_sched_barrier(0);
        }
        tile_scan<false>(ar, ai, d, hh, 0.f, aggP[d], aggH[d], hdummy);
        __builtin_amdgcn_sched_barrier(0);
    }
    f32x2* AT = (f32x2*)(ws + WS_AGGT); f32x2* AG = (f32x2*)(ws + WS_AGGG);
    LAS f32x2* la = (LAS f32x2*)lds;
    if (hh == 0) {
#pragma unroll
        for (int d = 0; d < 2; ++d) { const f32x2 v = (f32x2){aggP[d], aggH[d]};
            AT[((size_t)(b * NTILE + grp * 8 + wave) * 2 + d) * DLRU + ch] = v; la[(wave * 2 + d) * 32 + r] = v; }
    }
    __syncthreads();
    if (wave == 0) {
        const int d = hh; float Pp = 1.f, Hh = 0.f;
#pragma unroll
        for (int i = 0; i < 8; ++i) { const int w = d ? 7 - i : i; const f32x2 v = la[(w * 2 + d) * 32 + r]; Hh = v.x * Hh + v.y; Pp *= v.x; }
        AG[((size_t)(b * NGRP + grp) * 2 + d) * DLRU + ch] = (f32x2){Pp, Hh};
    }
    __syncthreads();
}

__device__ __forceinline__ void lru_final_unit(unsigned char* ws, int l, int b, int grp, int h, int cb, int wave, int lane) {
    asm volatile("" : "+s"(wave)); asm volatile("" : "+v"(lane));
    const bf16* Z = (const bf16*)(ws + WS_Z);
    const int r = lane & 31, hh = lane >> 5;
    int seqbase, t0;
    if (grp == 0) { seqbase = TL + b * CTXL; t0 = wave * 32; } else { seqbase = b * SEQ; t0 = (grp - 1) * 256 + wave * 32; }
    const int ch = 64 * h + 32 * cb + r;
    const u32x4* YB = (const u32x4*)(ws + WS_YB) + (size_t)lru_item(b, grp, h, cb, wave) * 8 * 64 + lane;
    u32x4 W[8];
#pragma unroll
    for (int j = 0; j < 8; ++j) W[j] = YB[j * 64];
    unsigned short yg[16];
#pragma unroll
    for (int i = 0; i < 16; ++i) { const int row = (i & 3) + 8 * (i >> 2) + 4 * hh; yg[i] = Z[(size_t)(seqbase + t0 + row) * DIN + DLRU + ch]; }
    float C0, C1;
    {
        const f32x2* AGGT = (const f32x2*)(ws + WS_AGGT); const f32x2* AGGG = (const f32x2*)(ws + WS_AGGG);
        float c = 0.f;
        const int d = hh;
        if (grp > 0) {
            { const f32x2 g0 = AGGG[((size_t)(b * NGRP + 0) * 2 + d) * DLRU + ch]; c = g0.y; }
            f32x2 gv[7];
#pragma unroll
            for (int i = 0; i < 7; ++i) { const int g = d ? 8 - i : 1 + i; const bool valid = d ? (i < 8 - grp) : (i < grp - 1);
                gv[i] = valid ? AGGG[((size_t)(b * NGRP + g) * 2 + d) * DLRU + ch] : (f32x2){1.f, 0.f}; }
#pragma unroll
            for (int i = 0; i < 7; ++i) c = gv[i].x * c + gv[i].y;
        }
        f32x2 tv[7];
#pragma unroll
        for (int i = 0; i < 7; ++i) { const int tw = d ? 7 - i : i; const bool valid = d ? (i < 7 - wave) : (i < wave);
            tv[i] = valid ? AGGT[((size_t)(b * NTILE + grp * 8 + tw) * 2 + d) * DLRU + ch] : (f32x2){1.f, 0.f}; }
#pragma unroll
        for (int i = 0; i < 7; ++i) c = tv[i].x * c + tv[i].y;
        C0 = __shfl(c, r); C1 = __shfl(c, 32 + r);
    }
    float hsum[16];
#pragma unroll
    for (int d = 0; d < 2; ++d) {
        f32x16 ar, ai;
#pragma unroll
        for (int q = 0; q < 4; ++q)
#pragma unroll
            for (int j = 0; j < 4; ++j) { const unsigned w = W[d * 4 + q][j]; ar[4 * q + j] = __builtin_amdgcn_exp2f(-LOG2E * bflo(w)); ai[4 * q + j] = bfhi(w); }
        float aP, aH;
        tile_scan<true>(ar, ai, d, hh, d ? C1 : C0, aP, aH, hsum);
    }
    bf16* MIX = (bf16*)(ws + WS_MIX);
#pragma unroll
    for (int i = 0; i < 16; ++i) {
        const int row = (i & 3) + 8 * (i >> 2) + 4 * hh;
        MIX[(size_t)(seqbase + t0 + row) * D + ch] = (bf16)f2bf(hsum[i] * gelu_tanh(bf2f(yg[i])));
    }
}

constexpr int PX_PITCH = 528, PD_PITCH = 528;
constexpr int PX_OFF = 0, PD_OFF = 80 * PX_PITCH;
__device__ __forceinline__ void pool_unit(unsigned char* ws, int l, LAS unsigned char* lds, int c, int gp, int tid, int wave, int lane) {
    asm volatile("" : "+s"(wave)); asm volatile("" : "+v"(lane)); asm volatile("" : "+v"(tid));
    const bf16* Z = (const bf16*)(ws + WS_Z); bf16* MIX = (bf16*)(ws + WS_MIX);
    int seqbase, t0, seg_lo, seg_hi;
    if (c < 256) { seqbase = (c >> 5) * SEQ; t0 = (c & 31) * 64; seg_lo = t0; seg_hi = t0 + 64; }
    else { const int cc = c - 256; seqbase = TL + (cc >> 2) * CTXL; t0 = (cc & 3) * 64; seg_lo = 0; seg_hi = CTXL; }
    const int r_lo = max(t0 - 8, seg_lo), r_hi = min(t0 + 72, seg_hi);
    { const int sub = tid >> 5, l32 = tid & 31;
      for (int t = r_lo + sub; t < r_hi; t += 16) {
          const u32x4 v = *(const u32x4*)(Z + (size_t)(seqbase + t) * DIN + 2 * DLRU + 256 * gp + 8 * l32);
          *(LAS u32x4*)(lds + PX_OFF + (t - (t0 - 8)) * PX_PITCH + 16 * l32) = v;
      } }
    __syncthreads();
    { const int cp = tid & 127, tq = tid >> 7;
      const int g = 2 * gp + (cp >> 6);
      const int half = 1 << g;
      const LAS unsigned char* xb = lds + PX_OFF + 4 * cp - (t0 - 8) * PX_PITCH;
      int t = t0 + 16 * tq;
      int lo = max(t - half, seg_lo), hi = min(t + half, seg_hi);
      float s0 = 0.f, s1 = 0.f;
      for (int j = lo; j < hi; ++j) { const unsigned w = *(const LAS unsigned*)(xb + j * PX_PITCH); s0 += bflo(w); s1 += bfhi(w); }
#pragma unroll 4
      for (int i = 0; i < 16; ++i, ++t) {
          const unsigned wx = *(const LAS unsigned*)(xb + t * PX_PITCH);
          const float inv = 1.0f / (float)(hi - lo);
          const float d0 = s0 * inv - bflo(wx), d1 = s1 * inv - bfhi(wx);
          *(LAS unsigned*)(lds + PD_OFF + (t - t0) * PD_PITCH + 4 * cp) = pk2(d0, d1);
          const int nlo = max(t + 1 - half, seg_lo), nhi = min(t + 1 + half, seg_hi);
          if (nhi > hi) { const unsigned w = *(const LAS unsigned*)(xb + hi * PX_PITCH); s0 += bflo(w); s1 += bfhi(w); }
          if (nlo > lo) { const unsigned w = *(const LAS unsigned*)(xb + lo * PX_PITCH); s0 -= bflo(w); s1 -= bfhi(w); }
          lo = nlo; hi = nhi;
      } }
    __syncthreads();
    { const int gl = wave >> 2, th = (wave >> 1) & 1, nh = wave & 1, r = lane & 31, hh = lane >> 5;
      const int g = 2 * gp + gl;
      const bf16* WP = (const bf16*)(ws + WS_WP) + (size_t)(l * 4 + g) * 128 * 128;
      f32x16 acc[2];
#pragma unroll
      for (int q = 0; q < 2; ++q)
#pragma unroll
          for (int i = 0; i < 16; ++i) acc[q][i] = 0.f;
      const LAS unsigned char* arow = lds + PD_OFF + (th * 32 + r) * PD_PITCH + (gl * 128 + 8 * hh) * 2;
#pragma unroll
      for (int s = 0; s < 8; ++s) {
          const bf16x8 Af = *(const LAS bf16x8*)(arow + 32 * s);
#pragma unroll
          for (int nt = 0; nt < 2; ++nt) { const bf16x8 Bf = *(const bf16x8*)(WP + (size_t)(nh * 64 + nt * 32 + r) * 128 + 16 * s + 8 * hh);
              acc[nt] = __builtin_amdgcn_mfma_f32_32x32x16_bf16(Af, Bf, acc[nt], 0, 0, 0); }
      }
#pragma unroll
      for (int nt = 0; nt < 2; ++nt) {
          const int co = 128 * g + 64 * nh + 32 * nt + r;
          const float* SP = (const float*)(ws + WS_SP) + (size_t)l * SP_STRIDE; const float pb = SP[SP_PB + co], ps = SP[SP_PS + co];
#pragma unroll
          for (int i = 0; i < 16; ++i) {
              const int row = (i & 3) + 8 * (i >> 2) + 4 * hh;
              MIX[(size_t)(seqbase + t0 + th * 32 + row) * D + DLRU + co] = (bf16)f2bf((acc[nt][i] + pb) * ps);
          }
      } }
    __syncthreads();
}

constexpr int L1_PITCH = 2064;
constexpr int L1_PART = 16 * L1_PITCH;
constexpr int L1_MAXB = 5;
constexpr int L1_ROWS = L1_PART + 16384 + 256 + L1_MAXB * 64 * 16;
static_assert(L1_ROWS + L1_MAXB * 16 * 1024 <= LDS_TB, "LN1 LDS map");
__device__ __forceinline__ void phase_ln1(unsigned char* ws, int l, LAS unsigned char* lds, int bid, int G, int tid, int wave, int lane) {
    const float* MOD = (const float*)(ws + WS_MOD) + (size_t)l * 9 * 6144;
    float* XL = (float*)(ws + WS_XL); fp8* H8S = (fp8*)(ws + WS_H8S); const bf16* Y1 = (const bf16*)(ws + WS_Y1);
    const float* SP = (const float*)(ws + WS_SP) + (size_t)l * SP_STRIDE;
    const float* lg = SP + SP_L1G; const float* lb = SP + SP_L1B; const float* rb = SP + SP_RB;
    int* cnt = (int*)(ws + WS_CTL) + CW_CNT + 32 * l;
    float* TOPG = (float*)(ws + WS_TOPG); int* ROWDST = (int*)(ws + WS_ROWDST);
    const int ntok = (l == DEPTH - 1) ? TL : TT;
    const bf16* RWT = (const bf16*)(ws + WS_RWT) + (size_t)l * NE * D;
    bf16x8 Bf[4][2];
#pragma unroll
    for (int s = 0; s < 4; ++s)
#pragma unroll
        for (int nt = 0; nt < 2; ++nt) Bf[s][nt] = *(const bf16x8*)(RWT + (size_t)(16 * nt + (lane & 15)) * D + 128 * wave + 32 * s + 8 * (lane >> 4));
    LAS float* part = (LAS float*)(lds + L1_PART);
    LAS int* lcnt = (LAS int*)(lds + L1_PART + 16384);
    LAS int* lbase = lcnt + 32;
    LAS u32x4* ent = (LAS u32x4*)(lds + L1_PART + 16384 + 256);
    if (tid < 32) lcnt[tid] = 0;
    int nb_local = 0;
    __syncthreads();
    for (int batch = bid; batch < ntok / 16 && nb_local < L1_MAXB; batch += G) {
#pragma unroll
        for (int rr = 0; rr < 2; ++rr) {
            const int trow = 2 * wave + rr, tok = batch * 16 + trow;
            const float* m = MOD + (size_t)mod_row(tok) * 6144;
            f32x4 v[4], h[4];
#pragma unroll
            for (int j = 0; j < 4; ++j) {
                const f32x4 x = ((const f32x4*)(XL + (size_t)tok * D))[lane + 64 * j];
                const u32x2 yr = ((const u32x2*)(Y1 + (size_t)tok * D))[lane + 64 * j];
                const f32x4 g1 = ((const f32x4*)(m + 2048))[lane + 64 * j];
                f32x4 y; y.x = bflo(yr.x); y.y = bfhi(yr.x); y.z = bflo(yr.y); y.w = bfhi(yr.y);
                v[j] = x * ALPHA + g1 * y;
            }
            float mean, rstd; ln_stats(v, mean, rstd);
#pragma unroll
            for (int j = 0; j < 4; ++j) {
                const f32x4 gg = ((const f32x4*)lg)[lane + 64 * j], bb = ((const f32x4*)lb)[lane + 64 * j];
                v[j] = (v[j] - mean) * rstd * gg + bb;
                ((f32x4*)(XL + (size_t)tok * D))[lane + 64 * j] = v[j];
                const f32x4 sh = ((const f32x4*)(m + 3072))[lane + 64 * j], sc = ((const f32x4*)(m + 4096))[lane + 64 * j];
                h[j] = v[j] * (sc + 1.0f) + sh;
                u32x2 w; w.x = pk2(h[j].x, h[j].y); w.y = pk2(h[j].z, h[j].w);
                int w8 = 0; w8 = __builtin_amdgcn_cvt_pk_fp8_f32(h[j].x, h[j].y, w8, false); w8 = __builtin_amdgcn_cvt_pk_fp8_f32(h[j].z, h[j].w, w8, true);
                *(LAS unsigned*)(lds + L1_ROWS + (nb_local * 16 + trow) * 1024 + (4 * lane + 256 * j)) = (unsigned)w8;
                *(LAS u32x2*)(lds + trow * L1_PITCH + (4 * lane + 256 * j) * 2) = w;
            }
        }
        __syncthreads();
        {
            f32x4 a2[2] = {(f32x4){0.f, 0.f, 0.f, 0.f}, (f32x4){0.f, 0.f, 0.f, 0.f}};
            const LAS unsigned char* arow = lds + (lane & 15) * L1_PITCH + (128 * wave + 8 * (lane >> 4)) * 2;
#pragma unroll
            for (int s = 0; s < 4; ++s) { const bf16x8 Af = *(const LAS bf16x8*)(arow + 64 * s);
#pragma unroll
                for (int nt = 0; nt < 2; ++nt) a2[nt] = __builtin_amdgcn_mfma_f32_16x16x32_bf16(Af, Bf[s][nt], a2[nt], 0, 0, 0); }
#pragma unroll
            for (int nt = 0; nt < 2; ++nt)
#pragma unroll
                for (int i = 0; i < 4; ++i) part[(wave * 16 + 4 * (lane >> 4) + i) * 32 + 16 * nt + (lane & 15)] = a2[nt][i];
        }
        __syncthreads();
        {
            const int trow = tid >> 5, e = tid & 31, tok = batch * 16 + trow;
            float lgt = rb[e];
#pragma unroll
            for (int w = 0; w < 8; ++w) lgt += part[(w * 16 + trow) * 32 + e];
            float tv[4]; int ti[4];
            float cur = lgt;
#pragma unroll
            for (int k = 0; k < 4; ++k) {
                float bv = cur; int bi = e;
#pragma unroll
                for (int o = 1; o < 32; o <<= 1) { const float ov = __shfl_xor(bv, o); const int oi = __shfl_xor(bi, o); if (ov > bv || (ov == bv && oi < bi)) { bv = ov; bi = oi; } }
                tv[k] = bv; ti[k] = bi;
                if (e == bi) cur = -INFINITY;
            }
            const float e1 = __expf(tv[1] - tv[0]), e2 = __expf(tv[2] - tv[0]), e3 = __expf(tv[3] - tv[0]);
            const float inv = 1.0f / (1.0f + e1 + e2 + e3);
            if (e < 4) {
                const int ex = e == 0 ? ti[0] : e == 1 ? ti[1] : e == 2 ? ti[2] : ti[3];
                const float pg = (e == 0 ? 1.0f : e == 1 ? e1 : e == 2 ? e2 : e3) * inv;
                const int ls = __hip_atomic_fetch_add(lcnt + ex, 1, __ATOMIC_RELAXED, __HIP_MEMORY_SCOPE_WORKGROUP);
                const int idx = (nb_local * 16 + trow) * 4 + e;
                ent[idx] = (u32x4){(unsigned)tok, (unsigned)ex, (unsigned)ls, __float_as_uint(pg)};
            }
        }
        ++nb_local;
        __syncthreads();
    }
    if (tid < 32) { const int c = lcnt[tid]; lbase[tid] = c > 0 ? atomicAdd(&cnt[tid], c) : 0; }
    __syncthreads();
    for (int i = wave; i < nb_local * 64; i += 8) {
        const u32x4 en = ent[i]; const int tok = (int)en.x, ex = (int)en.y, slot = lbase[ex] + (int)en.z;
        if (lane == 0) { TOPG[tok * 4 + (i & 3)] = __uint_as_float(en.w); ROWDST[(size_t)ex * TT + slot] = tok * 4 + (i & 3); }
        const u32x4 v = *(const LAS u32x4*)(lds + L1_ROWS + (i >> 2) * 1024 + 16 * lane);
        *(u32x4*)(H8S + ((size_t)ex * TT + slot) * D + 16 * lane) = v;
    }
    __syncthreads();
}

__device__ __forceinline__ void phase_ln2(unsigned char* ws, float* out, int l, int gw, int ngw, int lane) {
    const float* MOD = (const float*)(ws + WS_MOD) + (size_t)l * 9 * 6144;
    float* XL = (float*)(ws + WS_XL); bf16* H = (bf16*)(ws + WS_H); const bf16* Y2 = (const bf16*)(ws + WS_Y2); const f32x4* TOPG = (const f32x4*)(ws + WS_TOPG);
    const float* SP = (const float*)(ws + WS_SP) + (size_t)l * SP_STRIDE;
    const float* lg = SP + SP_L2G; const float* lb = SP + SP_L2B;
    const bool last = (l == DEPTH - 1);
    const int ntok = last ? TL : TT;
    for (int tok0 = gw * 2; tok0 < ntok; tok0 += ngw * 2) {
        f32x4 v[2][4]; u32x2 yr[2][4][4]; f32x4 g2[2][4]; f32x4 gk[2];
#pragma unroll
        for (int t = 0; t < 2; ++t) {
            const int tok = tok0 + t;
            const float* m = MOD + (size_t)mod_row(tok) * 6144;
            gk[t] = TOPG[tok];
#pragma unroll
            for (int j = 0; j < 4; ++j) {
                v[t][j] = ((const f32x4*)(XL + (size_t)tok * D))[lane + 64 * j];
                g2[t][j] = ((const f32x4*)(m + 5120))[lane + 64 * j];
#pragma unroll
                for (int k = 0; k < 4; ++k) yr[t][k][j] = ((const u32x2*)(Y2 + ((size_t)tok * 4 + k) * D))[lane + 64 * j];
            }
        }
#pragma unroll
        for (int t = 0; t < 2; ++t) {
            const int tok = tok0 + t;
#pragma unroll
            for (int j = 0; j < 4; ++j) {
                f32x4 f = (f32x4){0.f, 0.f, 0.f, 0.f};
#pragma unroll
                for (int k = 0; k < 4; ++k) { const u32x2 r = yr[t][k][j]; const float g = gk[t][k]; f.x += g * bflo(r.x); f.y += g * bfhi(r.x); f.z += g * bflo(r.y); f.w += g * bfhi(r.y); }
                v[t][j] = v[t][j] * ALPHA + g2[t][j] * f;
            }
            float mean, rstd; ln_stats(v[t], mean, rstd);
            f32x4 h[4];
            const float* mn = MOD + (size_t)9 * 6144 + (size_t)mod_row(tok) * 6144;
#pragma unroll
            for (int j = 0; j < 4; ++j) {
                const f32x4 gg = ((const f32x4*)lg)[lane + 64 * j], bb = ((const f32x4*)lb)[lane + 64 * j];
                const f32x4 o = (v[t][j] - mean) * rstd * gg + bb;
                if (last) ((f32x4*)(out + (size_t)tok * D))[lane + 64 * j] = o;
                else {
                    ((f32x4*)(XL + (size_t)tok * D))[lane + 64 * j] = o;
                    const f32x4 sh = ((const f32x4*)mn)[lane + 64 * j], sc = ((const f32x4*)(mn + 1024))[lane + 64 * j];
                    h[j] = o * (sc + 1.0f) + sh;
                }
            }
            if (!last) store_bf16_row(H + (size_t)tok * D, lane, h);
        }
    }
}

constexpr int NPHASE = 2 + 8 * DEPTH;
#ifndef PHMASK
#define PHMASK 0xFFFF
#endif
#define PH_ON(k) (((PHMASK) >> (k)) & 1)
#ifndef MK_PER_PHASE
#define MK_PER_PHASE 0
#endif
__global__ void __launch_bounds__(512, 2) mk_fwd(P p) {
    extern __shared__ __attribute__((aligned(16))) unsigned char lds_[];
    LAS unsigned char* lds = (LAS unsigned char*)lds_;
    const int tid = threadIdx.x, lane = tid & 63, wave = __builtin_amdgcn_readfirstlane(tid >> 6);
    const int G = gridDim.x, bid = blockIdx.x;
    volatile LAS unsigned* MISC = (volatile LAS unsigned*)(lds + LDS_MISC);
    if (tid < 4) MISC[tid] = 0u;
    __syncthreads();
    unsigned* barw = (unsigned*)(p.ws + WS_CTL) + CW_BAR;
    XcdBarrier bar; bar.bar = barw; bar.x = 0; bar.st = MISC;
    if (!MK_PER_PHASE) bar = xcd_barrier_post(barw, MISC);
    const int lo = p.ph_lo, hi = p.ph_hi;
#define IN(k) (lo <= (k) && (k) < hi)
#define SEAM(k) do { if (IN(k) && IN((k) + 1)) xcd_barrier(bar, wave == 0 && (int)__lane_id() == 0); } while (0)
    if (PH_ON(0) && IN(0)) { phase_p0a(p, lds, bid, G, tid, wave, lane); }
    SEAM(0);
    if (PH_ON(1) && IN(1)) { phase_entry(p, bid * 8 + wave, G * 8, lane); }
    SEAM(1);
#pragma unroll 1
    for (int l = 0; l < DEPTH; ++l) {
        const int pb = 2 + 8 * l;
#define FRESH() int tid_ = wave * 64 + (int)__lane_id(); asm volatile("" : "+v"(tid_)); const int lane_ = tid_ & 63; const int wave_ = __builtin_amdgcn_readfirstlane(tid_ >> 6); \
                size_t wz_ = 0; asm volatile("" : "+s"(wz_)); unsigned char* ws = p.ws + wz_; (void)lane_; (void)wave_
        if (PH_ON(2) && IN(pb + 0)) {
            FRESH();
            pg8::DenseOrder S; S.init(TT / 256, DIN / 256, G, bid);
            pg8::EpiStore E{(bf16*)(ws + WS_Z), DIN};
            pg8::gemm_phase<false>(lds, tid_, ws + WS_H, (const bf16*)(ws + WS_WIN) + (size_t)l * DIN * D, S, E);
        }
        SEAM(pb + 0);
        if (PH_ON(3) && IN(pb + 1)) {
            FRESH();
            for (int u = bid; u < NB * NGRP * NH * 2; u += G) { const int cb = u & 1, h = (u >> 1) & 7, bg = u >> 4; lru_agg_unit(ws, l, lds, bg / NGRP, bg % NGRP, h, cb, wave_, lane_); }
        }
        SEAM(pb + 1);
        if (PH_ON(4) && IN(pb + 2)) {
            FRESH();
            const int g0 = (l == DEPTH - 1) ? 1 : 0, ng = NGRP - g0;
            const int nlru = NB * ng * NH * 2, npool = ((l == DEPTH - 1) ? 256 : 288) * 2;
            for (int u = bid; u < nlru + npool; u += G) {
                if (u < nlru) { const int cb = u & 1, h = (u >> 1) & 7, bg = u >> 4; lru_final_unit(ws, l, bg / ng, g0 + bg % ng, h, cb, wave_, lane_); }
                else { const int q = u - nlru; pool_unit(ws, l, lds, q >> 1, q & 1, tid_, wave_, lane_); }
            }
        }
        SEAM(pb + 2);
        if (PH_ON(5) && IN(pb + 3)) {
            FRESH();
            pg8::DenseOrder S; S.init((l == DEPTH - 1 ? TL : TT) / 256, D / 256, G, bid);
            pg8::EpiStore E{(bf16*)(ws + WS_Y1), D};
            pg8::gemm_phase<false>(lds, tid_, ws + WS_MIX, (const bf16*)(ws + WS_WOUT) + (size_t)l * D * D, S, E);
        }
        SEAM(pb + 3);
        if (PH_ON(6) && IN(pb + 4)) { FRESH(); phase_ln1(ws, l, lds, bid, G, tid_, wave_, lane_); }
        SEAM(pb + 4);
        if (IN(pb + 5) || IN(pb + 6)) {
            FRESH();
            const int* cnt = (const int*)(ws + WS_CTL) + CW_CNT + 32 * l;
            LAS int* tb = (LAS int*)(lds + LDS_TB);
            if (tid_ < 64) { const int c = lane_ < 32 ? (cnt[lane_] + 255) >> 8 : 0; int s = c;
#pragma unroll
                for (int o = 1; o < 32; o <<= 1) { const int t = __shfl_up(s, o); if (lane_ >= o) s += t; }
                if (lane_ < 32) tb[lane_ + 1] = s; if (lane_ == 0) tb[0] = 0; }
            __syncthreads();
        }
        if (PH_ON(7) && IN(pb + 5)) {
            FRESH();
            const int* cnt = (const int*)(ws + WS_CTL) + CW_CNT + 32 * l;
            pg8::MoeOrder<8, true> S{(const LAS int*)(lds + LDS_TB), cnt, G, bid};
            pg8::EpiSwiglu E{(fp8*)(ws + WS_ACT), (const float*)(ws + WS_SP) + (size_t)l * SP_STRIDE + SP_B1};
            pg8::gemm_phase<true>(lds, tid_, ws + WS_H8S, ws + WS_W1T + (size_t)l * NE * 2 * DF * D, S, E);
        }
        SEAM(pb + 5);
        if (PH_ON(8) && IN(pb + 6)) {
            FRESH();
            const int* cnt = (const int*)(ws + WS_CTL) + CW_CNT + 32 * l;
            pg8::MoeOrder<4, false> S{(const LAS int*)(lds + LDS_TB), cnt, G, bid};
            pg8::EpiDown E{(bf16*)(ws + WS_Y2), (const float*)(ws + WS_SP) + (size_t)l * SP_STRIDE + SP_B2, (const int*)(ws + WS_ROWDST)};
            pg8::gemm_phase<true>(lds, tid_, ws + WS_ACT, ws + WS_W2T + (size_t)l * NE * D * DF, S, E);
        }
        SEAM(pb + 6);
        if (PH_ON(9) && IN(pb + 7)) { FRESH(); phase_ln2(ws, p.out, l, bid * 8 + wave_, G * 8, lane_); }
        SEAM(pb + 7);
#undef FRESH
    }
#undef IN
#undef SEAM
}

extern "C" void kernel_launch(void* const* d_in, const int* in_sizes, int n_in, void* d_out, int out_size, void* d_ws, size_t ws_size, hipStream_t stream) {
    static int grid = 0;
    if (grid == 0) {
        if (n_in != N_IN || ws_size < WS_END || out_size != TL * D) { fprintf(stderr, "kernel_launch: unexpected shapes (n_in %d, out %d, ws %zu)\n", n_in, out_size, ws_size); grid = -1; return; }
        int dev = 0, cus = 0, per_cu = 0;
        if (hipGetDevice(&dev) != hipSuccess || hipDeviceGetAttribute(&cus, hipDeviceAttributeMultiprocessorCount, dev) != hipSuccess) { grid = -1; return; }
        if (hipFuncSetAttribute((const void*)mk_fwd, hipFuncAttributeMaxDynamicSharedMemorySize, LDS_BYTES) != hipSuccess) { fprintf(stderr, "kernel_launch: hipFuncSetAttribute failed\n"); grid = -1; return; }
        if (hipOccupancyMaxActiveBlocksPerMultiprocessor(&per_cu, (const void*)mk_fwd, 512, LDS_BYTES) != hipSuccess || per_cu < 1) { fprintf(stderr, "kernel_launch: occupancy query says %d\n", per_cu); }
        (void)hipGetLastError();
        grid = cus;
        if (grid < 231) { fprintf(stderr, "kernel_launch: this build needs at least 231 CUs (has %d)\n", cus); grid = -1; return; }
    }
    if (grid < 0) return;
    (void)hipMemsetAsync((char*)d_ws + WS_CTL, 0, CTL_BYTES, stream);
    P p{};
    for (int i = 0; i < N_IN; ++i) p.in[i] = (const float*)d_in[i];
    p.out = (float*)d_out; p.ws = (unsigned char*)d_ws;
#if MK_PER_PHASE
    for (int ph = 0; ph < NPHASE; ++ph) { p.ph_lo = ph; p.ph_hi = ph + 1; hipLaunchKernelGGL(mk_fwd, dim3(grid), dim3(512), LDS_BYTES, stream, p);
#ifdef EXTRA_PHASE
        if (ph == EXTRA_PHASE) for (int r = 0; r < EXTRA_REPS; ++r) hipLaunchKernelGGL(mk_fwd, dim3(grid), dim3(512), LDS_BYTES, stream, p);
#endif
    }
#else
    p.ph_lo = 0; p.ph_hi = NPHASE;
    hipLaunchKernelGGL(mk_fwd, dim3(grid), dim3(512), LDS_BYTES, stream, p);
#endif
}
```

```cpp
#include <hip/hip_runtime.h>
#include <cstdio>
#include <cstdint>

constexpr int NB = 8, SEQ = 2048, D = 1024, CTXL = 256, DEPTH = 2;
constexpr int TL = NB * SEQ;
constexpr int TC = NB * CTXL;
constexpr int TT = TL + TC;
constexpr int DLRU = 512, DPOOL = 512, DIN = 1536, NH = 8, HD = 64;
constexpr int NE = 32, TOPK = 4, DF = 1024;
constexpr int GRIDW = 64;
constexpr float LN_EPS = 1e-5f;
constexpr float ALPHA = 1.41421356237309515f;
constexpr int MAXROWS = 81920;
constexpr int NTILE = 72, NGRP = 9;

enum { I_X = 0, I_C, I_CTX, I_CCTX, I_WMOD, I_BMOD, I_WIN, I_CONVW, I_CONVB, I_GAW, I_GAB, I_GXW, I_GXB, I_LAM, I_POOLW, I_POOLB, I_POOLS,
       I_WOUT, I_LN1G, I_LN1B, I_RW, I_RB, I_W1, I_B1, I_W2, I_B2, I_LN2G, I_LN2B, N_IN };

constexpr size_t MiB = 1u << 20;
constexpr size_t WS_CTL = 0, CTL_BYTES = 1 * MiB;
constexpr size_t WS_MOD = 1 * MiB;
constexpr size_t WS_POS = 2 * MiB;
constexpr size_t WS_RWT = 2 * MiB + 512 * 1024;
constexpr size_t WS_TOPG = 7 * MiB;
constexpr size_t WS_AGGT = 10 * MiB;
constexpr size_t WS_AGGG = 15 * MiB;
constexpr size_t WS_WIN = 16 * MiB, WS_WOUT = 23 * MiB, WS_WG = 28 * MiB, WS_WP = 29 * MiB;
constexpr size_t WS_SP = 30 * MiB;
constexpr size_t WS_W1T = 32 * MiB, WS_W2T = 160 * MiB;
constexpr size_t WS_H8S = 1052 * MiB;
constexpr int W1_SH = 6, W2_SH = 7;
constexpr int SP_CW = 0, SP_CB = 2048, SP_GAB = 2560, SP_GXB = 3584, SP_CC = 4608, SP_PB = 5632, SP_PS = 6144, SP_L1G = 6656, SP_L1B = 7680, SP_L2G = 8704, SP_L2B = 9728, SP_RB = 10752,
              SP_B1 = 12288, SP_B2 = SP_B1 + 32 * 2048, SP_STRIDE = SP_B2 + 32 * 1024;
constexpr size_t WS_XL = 416 * MiB;
constexpr size_t WS_H = 488 * MiB;
constexpr size_t WS_Z = 524 * MiB;
constexpr size_t WS_MIX = 578 * MiB;
constexpr size_t WS_Y1 = 614 * MiB;
constexpr size_t WS_ACT = 650 * MiB;
constexpr size_t WS_Y2 = 810 * MiB;
constexpr size_t WS_YB = 970 * MiB;
constexpr size_t WS_ROWDST = 1046 * MiB;
constexpr size_t WS_END = 1628 * MiB;
constexpr int CW_CNT = 64;
constexpr int CW_BAR = 4096;

typedef unsigned short bf16;
typedef float f32x4 __attribute__((ext_vector_type(4)));
typedef float f32x2 __attribute__((ext_vector_type(2)));
typedef float f32x16 __attribute__((ext_vector_type(16)));
typedef unsigned u32x2 __attribute__((ext_vector_type(2)));
typedef unsigned u32x4 __attribute__((ext_vector_type(4)));
typedef short bf16x8 __attribute__((ext_vector_type(8)));
typedef int i32x8 __attribute__((ext_vector_type(8)));
typedef unsigned char fp8;

__device__ __forceinline__ float bf2f(bf16 v) { return __uint_as_float(((unsigned)v) << 16); }
__device__ __forceinline__ float bflo(unsigned w) { return __uint_as_float(w << 16); }
__device__ __forceinline__ float bfhi(unsigned w) { return __uint_as_float(w & 0xffff0000u); }
__device__ __forceinline__ unsigned f2bf(float f) { unsigned u = __float_as_uint(f); return (u + 0x7fffu + ((u >> 16) & 1u)) >> 16; }
__device__ __forceinline__ unsigned pk2(float lo, float hi) { return f2bf(lo) | (f2bf(hi) << 16); }
__device__ __forceinline__ float wave_sum(float v) {
#pragma unroll
    for (int o = 1; o < 64; o <<= 1) v += __shfl_xor(v, o);
    return v;
}
__device__ __forceinline__ float fsigmoid(float x) { return __builtin_amdgcn_rcpf(1.0f + __expf(-x)); }
__device__ __forceinline__ float gelu_tanh(float x) {
    const float u = 0.7978845608028654f * (x + 0.044715f * x * x * x);
    const float t = 1.0f - 2.0f * __builtin_amdgcn_rcpf(__expf(2.0f * u) + 1.0f);
    return 0.5f * x * (1.0f + t);
}

struct P {
    const float* in[N_IN];
    float* out;
    unsigned char* ws;
    int ph_lo, ph_hi;
};

__device__ __forceinline__ int mod_row(int tok) { return tok < TL ? (tok >> 11) : NB; }
__device__ __forceinline__ int pad256(int c) { return (c + 255) & ~255; }

__device__ __forceinline__ void ln_stats(const f32x4 (&v)[4], float& mean, float& rstd) {
    float s = 0.f;
#pragma unroll
    for (int j = 0; j < 4; ++j) s += (v[j].x + v[j].y) + (v[j].z + v[j].w);
    mean = wave_sum(s) * (1.f / D);
    float s2 = 0.f;
#pragma unroll
    for (int j = 0; j < 4; ++j) { const f32x4 d = v[j] - mean; s2 += (d.x * d.x + d.y * d.y) + (d.z * d.z + d.w * d.w); }
    rstd = 1.0f / sqrtf(wave_sum(s2) * (1.f / D) + LN_EPS);
}
__device__ __forceinline__ void store_bf16_row(bf16* row, int lane, const f32x4 (&h)[4]) {
    u32x2* o = (u32x2*)row + lane;
#pragma unroll
    for (int j = 0; j < 4; ++j) { u32x2 w; w.x = pk2(h[j].x, h[j].y); w.y = pk2(h[j].z, h[j].w); o[64 * j] = w; }
}


#define LAS __attribute__((address_space(3)))
struct CvtItem { const float* src; unsigned char* dst; int N, Kp, f8; float scale; };
__device__ __forceinline__ void tile_load(const CvtItem& it, int lane, f32x4 (&v)[16]) {
#pragma unroll
    for (int i = 0; i < 16; ++i) { const int k = 4 * i + (lane >> 4); v[i] = __builtin_nontemporal_load((const f32x4*)(it.src + (size_t)k * it.N + 4 * (lane & 15))); }
}
__device__ __forceinline__ void tile_store(const CvtItem& it, const f32x4 (&v)[16], LAS float* scr, int lane) {
#pragma unroll
    for (int i = 0; i < 16; ++i) { const int k = 4 * i + (lane >> 4); const int nn = (4 * (lane & 15)) ^ (((k >> 3) & 3) << 3); *(LAS f32x4*)(scr + k * 64 + nn) = v[i]; }
    asm volatile("s_waitcnt lgkmcnt(0)" ::: "memory");
    const int c = lane & 7, sw = (c & 3) << 3;
    if (it.f8) {
#pragma unroll
        for (int j = 0; j < 8; ++j) {
            const int n = (lane >> 3) + 8 * j;
            const LAS float* s = scr + (8 * c) * 64 + (n ^ sw);
            const float sc = it.scale;
            int w0 = 0, w1 = 0;
            w0 = __builtin_amdgcn_cvt_pk_fp8_f32(s[0] * sc, s[64] * sc, w0, false); w0 = __builtin_amdgcn_cvt_pk_fp8_f32(s[128] * sc, s[192] * sc, w0, true);
            w1 = __builtin_amdgcn_cvt_pk_fp8_f32(s[256] * sc, s[320] * sc, w1, false); w1 = __builtin_amdgcn_cvt_pk_fp8_f32(s[384] * sc, s[448] * sc, w1, true);
            *(u32x2*)(it.dst + (size_t)n * it.Kp + 8 * c) = (u32x2){(unsigned)w0, (unsigned)w1};
        }
    } else {
#pragma unroll
        for (int j = 0; j < 8; ++j) {
            const int n = (lane >> 3) + 8 * j;
            const LAS float* s = scr + (8 * c) * 64 + (n ^ sw);
            u32x4 o; o.x = pk2(s[0], s[64]); o.y = pk2(s[128], s[192]); o.z = pk2(s[256], s[320]); o.w = pk2(s[384], s[448]);
            *(u32x4*)(it.dst + ((size_t)n * it.Kp + 8 * c) * 2) = o;
        }
    }
    asm volatile("s_waitcnt lgkmcnt(0)" ::: "memory");
}
constexpr int CV_IN = DEPTH * 16 * 24, CV_OUT = DEPTH * 16 * 16, CV_G = DEPTH * 2 * 2 * NH, CV_P = DEPTH * 4 * 4, CV_1 = DEPTH * NE * 16 * 32, CV_2 = DEPTH * NE * 16 * 16;
constexpr int CV_ITEMS = CV_IN + CV_OUT + CV_G + CV_P + CV_1 + CV_2;
__device__ __forceinline__ CvtItem cvt_decode(const P& p, int r) {
    CvtItem it; it.f8 = 0; it.scale = 1.0f;
    if (r < CV_IN) { const int l = r / 384, q = r % 384, kb = q / 24, nb = q % 24;
        it.src = p.in[I_WIN] + (size_t)l * D * DIN + (size_t)(64 * kb) * DIN + 64 * nb; it.N = DIN; it.Kp = D; it.dst = p.ws + WS_WIN + (((size_t)l * DIN + 64 * nb) * D + 64 * kb) * 2; return it; }
    r -= CV_IN;
    if (r < CV_OUT) { const int l = r / 256, q = r % 256, kb = q / 16, nb = q % 16;
        it.src = p.in[I_WOUT] + (size_t)l * D * D + (size_t)(64 * kb) * D + 64 * nb; it.N = D; it.Kp = D; it.dst = p.ws + WS_WOUT + (((size_t)l * D + 64 * nb) * D + 64 * kb) * 2; return it; }
    r -= CV_OUT;
    if (r < CV_G) {
        const int h = r % NH, gt = (r / NH) % 2, d = (r / (NH * 2)) % 2, l = r / (NH * 4);
        it.src = (gt ? p.in[I_GXW] : p.in[I_GAW]) + ((size_t)(l * 2 + d) * NH + h) * HD * HD; it.N = HD; it.Kp = HD;
        it.dst = p.ws + WS_WG + (((size_t)(l * NH + h) * 256 + (d * 2 + gt) * 64) * HD) * 2; return it; }
    r -= CV_G;
    if (r < CV_P) {
        const int nb = r % 2, kb = (r / 2) % 2, lg = r / 4;
        it.src = p.in[I_POOLW] + (size_t)lg * 128 * 128 + (size_t)(64 * kb) * 128 + 64 * nb; it.N = 128; it.Kp = 128; it.dst = p.ws + WS_WP + (((size_t)lg * 128 + 64 * nb) * 128 + 64 * kb) * 2; return it; }
    r -= CV_P;
    it.f8 = 1;
    if (r < CV_1) {
        const int le = r / 512, q = r % 512, kb = q / 32, nb = q % 32;
        const int n0 = 64 * nb, j0 = n0 % DF, half = n0 / DF, row0 = (j0 / 128) * 256 + half * 128 + (j0 % 128);
        it.src = p.in[I_W1] + (size_t)le * D * 2 * DF + (size_t)(64 * kb) * (2 * DF) + n0; it.N = 2 * DF; it.Kp = D; it.scale = (float)(1 << W1_SH);
        it.dst = p.ws + WS_W1T + ((size_t)le * 2 * DF + row0) * D + 64 * kb; return it; }
    r -= CV_1;
    { const int le = r / 256, q = r % 256, kb = q / 16, nb = q % 16;
      it.src = p.in[I_W2] + (size_t)le * DF * D + (size_t)(64 * kb) * D + 64 * nb; it.N = D; it.Kp = DF; it.scale = (float)(1 << W2_SH);
      it.dst = p.ws + WS_W2T + ((size_t)le * D + 64 * nb) * DF + 64 * kb; }
    return it;
}
__device__ __forceinline__ void convert_weights(const P& p, LAS unsigned char* lds, int gw, int ngw, int wave, int lane) {
    LAS float* scr = (LAS float*)(lds + wave * 16384);
    int r = gw;
    if (r >= CV_ITEMS) return;
    CvtItem cur = cvt_decode(p, r);
    f32x4 v[16], vn[16];
    tile_load(cur, lane, v);
    for (;;) {
        const int rn = r + ngw; const bool more = rn < CV_ITEMS;
        CvtItem nxt = cur;
        if (more) { nxt = cvt_decode(p, rn); tile_load(nxt, lane, vn); }
        tile_store(cur, v, scr, lane);
        if (!more) break;
#pragma unroll
        for (int i = 0; i < 16; ++i) v[i] = vn[i];
        cur = nxt; r = rn;
    }
}

namespace pg8 {
typedef short bf16x8 __attribute__((ext_vector_type(8)));
constexpr int BM = 256, BK = 64, HALF = 128, HTB = HALF * BK * 2, STAGE_BYTES = 8 * HTB;
template <int XB> __host__ __device__ __forceinline__ int lds_byte(int r, int c) { const int st = (r >> 4) * 2 + (c >> 5), rr = r & 15, cc = c & 31, ob = rr * 64 + cc * 2; return st * 1024 + (ob ^ (((ob >> 9) & 1) << XB)); }
template <int XB> __host__ __device__ __forceinline__ void stage_rc(int b, int& R, int& C) { const int st = b / 1024, sb = b % 1024, swz = sb ^ (((sb >> 9) & 1) << XB); R = (st >> 1) * 16 + swz / 64; C = (st & 1) * 32 + (swz % 64) / 2; }
__host__ __device__ __forceinline__ int perm32(int rho) { const int n = rho >> 4, i = rho & 15; return 8 * (i >> 2) + 4 * n + (i & 3); }
__device__ __forceinline__ unsigned cvt_pk_bf16(float lo, float hi) { unsigned r; asm volatile("v_cvt_pk_bf16_f32 %0, %1, %2" : "=v"(r) : "v"(lo), "v"(hi)); return r; }

struct Unit { int a0, nvalid, b0, o0, pn, e, g0; };

template <bool F8, class Sched, class Epi>
__device__ __forceinline__ void gemm_phase(LAS unsigned char* lds, int tid, const void* Abase_, const void* Bt_, const Sched& S, const Epi& E) {
    constexpr int RP = F8 ? 1024 : 2048, nt = F8 ? 8 : 16;
    const int wid = __builtin_amdgcn_readfirstlane(tid >> 6), lane = tid & 63, wr = wid >> 2, wc = wid & 3, fr = lane & 15, fq = lane >> 4;
    unsigned voffA, voffB;
    { int R, C; stage_rc<F8 ? 4 : 5>(tid * 16, R, C); const int Rb = (R & ~31) + perm32(R & 31); voffA = (unsigned)(R * RP + 2 * C); voffB = (unsigned)(Rb * RP + 2 * C); }
    constexpr size_t kstep = (size_t)(BK * 2);
    constexpr size_t hstep = (size_t)HALF * RP;
    const unsigned ldsw = (unsigned)wid * 1024u;
    const int aoff = F8 ? lds_byte<4>(wr * 64 + fr, fq * 16) : lds_byte<5>(wr * 64 + fr, fq * 8), boff = F8 ? lds_byte<4>(wc * 32 + fr, fq * 16) : lds_byte<5>(wc * 32 + fr, fq * 8);
    const int one_scale = 0x7F7F7F7F;
#define PG8_SA(b, h) (((b) * 2 + (h)) * HTB)
#define PG8_SB(b, h) ((4 + (b) * 2 + (h)) * HTB)
#define PG8_STAGE(bufoff, gbase, voff) do { _Pragma("unroll") for (int _i = 0; _i < 2; ++_i) { unsigned _vo = (voff); asm volatile("" : "+v"(_vo)); \
        __builtin_amdgcn_global_load_lds((const unsigned*)((const char*)(gbase) + (size_t)_i * (64 * RP) + _vo), (LAS unsigned*)(lds + (bufoff) + ldsw + _i * 8192), 16, 0, 0); } } while (0)
#define PG8_LD8(base, off) __builtin_bit_cast(i32x8, __builtin_shufflevector(*(const LAS u32x4*)((base) + (off)), *(const LAS u32x4*)((base) + ((off) ^ 16)), 0, 1, 2, 3, 4, 5, 6, 7))
#define PG8_LDA(dst, b, h) do { _Pragma("unroll") for (int m = 0; m < 4; ++m) { \
        if constexpr (F8) dst##8[m] = PG8_LD8(lds + PG8_SA(b, h) + m * 2048, aoff); \
        else { _Pragma("unroll") for (int k = 0; k < 2; ++k) dst[m][k] = *(const LAS bf16x8*)(lds + PG8_SA(b, h) + aoff + m * 2048 + k * 1024); } } } while (0)
#define PG8_LDB(dst, b, h) do { _Pragma("unroll") for (int n = 0; n < 2; ++n) { \
        if constexpr (F8) dst##8[n] = PG8_LD8(lds + PG8_SB(b, h) + n * 2048, boff); \
        else { _Pragma("unroll") for (int k = 0; k < 2; ++k) dst[n][k] = *(const LAS bf16x8*)(lds + PG8_SB(b, h) + boff + n * 2048 + k * 1024); } } } while (0)
#define PG8_MMA(ai, bj, At, Bt) do { __builtin_amdgcn_s_setprio(1); _Pragma("unroll") for (int m = 0; m < 4; ++m) _Pragma("unroll") for (int n = 0; n < 2; ++n) { \
        if constexpr (F8) acc[ai][bj][m][n] = __builtin_amdgcn_mfma_scale_f32_16x16x128_f8f6f4(Bt##8[n], At##8[m], acc[ai][bj][m][n], 0, 0, 0, one_scale, 0, one_scale); \
        else { _Pragma("unroll") for (int k = 0; k < 2; ++k) acc[ai][bj][m][n] = __builtin_amdgcn_mfma_f32_16x16x32_bf16(Bt[n][k], At[m][k], acc[ai][bj][m][n], 0, 0, 0); } } \
        __builtin_amdgcn_s_setprio(0); } while (0)
#define PG8_WAIT_V(n) asm volatile("s_waitcnt vmcnt(" #n ")" ::: "memory")
#define PG8_WAIT_L(n) asm volatile("s_waitcnt lgkmcnt(" #n ")" ::: "memory")
#define PG8_BAR __builtin_amdgcn_s_barrier()
#define PG8_SCHED __builtin_amdgcn_sched_barrier(0)
    Unit cur, nxt; int ui = 0;
    if (!S.next(0, cur)) return;
    f32x4 acc[2][2][4][2];
#pragma unroll
    for (int a = 0; a < 2; ++a)
#pragma unroll
        for (int b = 0; b < 2; ++b)
#pragma unroll
            for (int m = 0; m < 4; ++m)
#pragma unroll
                for (int n = 0; n < 2; ++n) acc[a][b][m][n] = (f32x4){0.f, 0.f, 0.f, 0.f};
    bf16x8 At[4][2], B0[2][2], B1[2][2];
    i32x8 At8[4], B08[2], B18[2];
    const char* cA = (const char*)Abase_ + (size_t)cur.a0 * RP; const char* cB = (const char*)Bt_ + (size_t)cur.b0 * RP;
    PG8_STAGE(PG8_SB(0, 0), cB, voffB); PG8_STAGE(PG8_SB(0, 1), cB + hstep, voffB); PG8_STAGE(PG8_SA(0, 0), cA, voffA); PG8_STAGE(PG8_SA(0, 1), cA + hstep, voffA);
    if (wr == 1) PG8_BAR;
    PG8_WAIT_V(2); PG8_BAR;
    PG8_STAGE(PG8_SB(1, 0), cB + kstep, voffB); PG8_STAGE(PG8_SA(1, 0), cA + kstep, voffA); PG8_STAGE(PG8_SB(1, 1), cB + hstep + kstep, voffB);
    PG8_WAIT_V(6); PG8_BAR;
    for (;;) {
        const bool has_next = S.next(ui + 1, nxt);
        const char* nA = has_next ? (const char*)Abase_ + (size_t)nxt.a0 * RP : cA; const char* nB = has_next ? (const char*)Bt_ + (size_t)nxt.b0 * RP : cB;
#pragma unroll 1
        for (int t = 0; t < nt; t += 2) {
            const bool last = (t == nt - 2);
            const char* a1 = cA + (size_t)(t + 1) * kstep;
            const char* a2 = last ? nA : cA + (size_t)(t + 2) * kstep; const char* b2 = last ? nB : cB + (size_t)(t + 2) * kstep;
            const char* a3 = a2 + kstep; const char* b3 = b2 + kstep;
            PG8_LDB(B0, 0, 0); PG8_LDB(B1, 0, 1); PG8_SCHED; PG8_LDA(At, 0, 0); PG8_STAGE(PG8_SA(1, 1), a1 + hstep, voffA);
            PG8_WAIT_V(8); PG8_WAIT_L(0); PG8_BAR; PG8_MMA(0, 0, At, B0); PG8_MMA(0, 1, At, B1); PG8_BAR; PG8_SCHED;
            PG8_LDA(At, 0, 1); PG8_STAGE(PG8_SB(0, 0), b2, voffB); PG8_STAGE(PG8_SB(0, 1), b2 + hstep, voffB); PG8_STAGE(PG8_SA(0, 0), a2, voffA);
            PG8_WAIT_V(8); PG8_WAIT_L(0); PG8_BAR; PG8_MMA(1, 0, At, B0); PG8_MMA(1, 1, At, B1); PG8_BAR; PG8_SCHED;
            PG8_LDB(B0, 1, 0); PG8_LDB(B1, 1, 1); PG8_SCHED; PG8_LDA(At, 1, 0); PG8_STAGE(PG8_SA(0, 1), a2 + hstep, voffA);
            PG8_WAIT_V(8); PG8_WAIT_L(0); PG8_BAR; PG8_MMA(0, 0, At, B0); PG8_MMA(0, 1, At, B1); PG8_BAR; PG8_SCHED;
            PG8_LDA(At, 1, 1); PG8_STAGE(PG8_SB(1, 0), b3, voffB); PG8_STAGE(PG8_SB(1, 1), b3 + hstep, voffB); PG8_STAGE(PG8_SA(1, 0), a3, voffA);
            PG8_WAIT_V(8); PG8_WAIT_L(0); PG8_BAR; PG8_MMA(1, 0, At, B0); PG8_MMA(1, 1, At, B1); PG8_BAR; PG8_SCHED;
        }
        if (wr == 0) PG8_BAR;
        PG8_SCHED; { int fr_ = fr, fq_ = fq; asm volatile("" : "+v"(fr_), "+v"(fq_)); E(acc, cur, wr, wc, fr_, fq_); } PG8_SCHED;
        if (!has_next) break;
#pragma unroll
        for (int a = 0; a < 2; ++a)
#pragma unroll
            for (int b = 0; b < 2; ++b)
#pragma unroll
                for (int m = 0; m < 4; ++m)
#pragma unroll
                    for (int n = 0; n < 2; ++n) acc[a][b][m][n] = (f32x4){0.f, 0.f, 0.f, 0.f};
        cur = nxt; cA = nA; cB = nB; ++ui;
        if (wr == 1) PG8_BAR;
    }
    PG8_WAIT_V(0);
    PG8_BAR;
#undef PG8_SA
#undef PG8_SB
#undef PG8_STAGE
#undef PG8_LDA
#undef PG8_LDB
#undef PG8_MMA
#undef PG8_LD8
#undef PG8_WAIT_V
#undef PG8_WAIT_L
#undef PG8_BAR
#undef PG8_SCHED
}

struct DenseOrder {
    int nM, nN, nwg, G, c;
    __device__ void init(int nM_, int nN_, int G_, int c_) { nM = nM_; nN = nN_; nwg = nM * nN; G = G_; c = c_; }
    __device__ bool next(int i, Unit& u) const {
        const long L = (long)i * G + c; if (L >= nwg) return false;
        int wgid = (int)L; { const int q = nwg / 8, r = nwg % 8, xcd = wgid % 8, off = wgid / 8; wgid = (xcd < r ? xcd * (q + 1) : r * (q + 1) + (xcd - r) * q) + off; }
        const int nig = 8 * nN, gid = wgid / nig, fm = gid * 8, gsz = (nM - fm) < 8 ? (nM - fm) : 8;
        const int pm = fm + ((wgid % nig) % gsz), pn = (wgid % nig) / gsz;
        u.a0 = pm * 256; u.nvalid = 256; u.b0 = pn * 256; u.o0 = pm * 256; u.pn = pn; u.e = 0; u.g0 = 0; return true;
    }
};
template <int NPN, bool UP> struct MoeOrder {
    const LAS int* tb; const int* cnt; int G, c;
    __device__ bool next(int i, Unit& u) const {
        const int L = i * G + c; const int total = tb[32] * NPN; if (L >= total) return false;
        int e = 0;
#pragma unroll 1
        for (int q = 16; q >= 1; q >>= 1) if (tb[e + q] * NPN <= L) e += q;
        const int te = tb[e + 1] - tb[e], j = L - tb[e] * NPN, pn = j / te, mt = j % te;
        const int ce = cnt[e];
        u.e = e; u.pn = pn; u.o0 = (tb[e] + mt) * 256; u.nvalid = min(256, ce - mt * 256);
        u.g0 = e * TT + mt * 256;
        u.a0 = UP ? u.g0 : u.o0;
        u.b0 = e * (UP ? 2 * DF : D) + pn * 256;
        return true;
    }
};

struct EpiStore {
    bf16* C; int ldc;
    __device__ __forceinline__ void operator()(const f32x4 (&acc)[2][2][4][2], const Unit& u, int wr, int wc, int fr, int fq) const {
        const int row0 = u.o0 + wr * 64 + fr, col0 = u.pn * 256 + wc * 32 + 8 * fq;
#pragma unroll
        for (int ai = 0; ai < 2; ++ai)
#pragma unroll
            for (int m = 0; m < 4; ++m) { bf16* rowp = C + (size_t)(row0 + ai * HALF + m * 16) * ldc + col0;
#pragma unroll
                for (int bj = 0; bj < 2; ++bj) { const f32x4 v0 = acc[ai][bj][m][0], v1 = acc[ai][bj][m][1];
                    u32x4 w; w.x = cvt_pk_bf16(v0[0], v0[1]); w.y = cvt_pk_bf16(v0[2], v0[3]); w.z = cvt_pk_bf16(v1[0], v1[1]); w.w = cvt_pk_bf16(v1[2], v1[3]);
                    *(u32x4*)(rowp + bj * HALF) = w; } }
    }
};
struct EpiSwiglu {
    fp8* C; const float* b1;
    __device__ __forceinline__ void operator()(const f32x4 (&acc)[2][2][4][2], const Unit& u, int wr, int wc, int fr, int fq) const {
        const int row0 = u.o0 + wr * 64 + fr, j0 = u.pn * 128 + wc * 32 + 8 * fq;
        const float* bb = b1 + (size_t)u.e * 2 * DF + j0;
        const f32x4 bg0 = *(const f32x4*)bb, bg1 = *(const f32x4*)(bb + 4), bl0 = *(const f32x4*)(bb + DF), bl1 = *(const f32x4*)(bb + DF + 4);
#pragma unroll
        for (int ai = 0; ai < 2; ++ai)
#pragma unroll
            for (int m = 0; m < 4; ++m) {
                float o[8];
#pragma unroll
                for (int n = 0; n < 2; ++n)
#pragma unroll
                    for (int q = 0; q < 4; ++q) {
                        constexpr float ws = 1.0f / (float)(1 << W1_SH);
                        const float gl = fminf(fmaf(acc[ai][0][m][n][q], ws, n ? bg1[q] : bg0[q]), 7.0f);
                        const float li = fminf(fmaxf(fmaf(acc[ai][1][m][n][q], ws, n ? bl1[q] : bl0[q]), -7.0f), 7.0f);
                        o[4 * n + q] = gl * __builtin_amdgcn_rcpf(1.0f + __expf(-1.702f * gl)) * (li + 1.0f);
                    }
                int w0 = 0, w1 = 0;
                w0 = __builtin_amdgcn_cvt_pk_fp8_f32(o[0], o[1], w0, false); w0 = __builtin_amdgcn_cvt_pk_fp8_f32(o[2], o[3], w0, true);
                w1 = __builtin_amdgcn_cvt_pk_fp8_f32(o[4], o[5], w1, false); w1 = __builtin_amdgcn_cvt_pk_fp8_f32(o[6], o[7], w1, true);
                *(u32x2*)(C + (size_t)(row0 + ai * HALF + m * 16) * DF + j0) = (u32x2){(unsigned)w0, (unsigned)w1};
            }
    }
};
struct EpiDown {
    bf16* C; const float* b2; const int* rowdst;
    __device__ __forceinline__ void operator()(const f32x4 (&acc)[2][2][4][2], const Unit& u, int wr, int wc, int fr, int fq) const {
        const int rt0 = wr * 64 + fr, col0 = u.pn * 256 + wc * 32 + 8 * fq;
        const float* bp = b2 + (size_t)u.e * D + col0;
        int dst[2][4];
#pragma unroll
        for (int ai = 0; ai < 2; ++ai)
#pragma unroll
            for (int m = 0; m < 4; ++m) { const int rt = rt0 + ai * HALF + m * 16; dst[ai][m] = rowdst[u.g0 + min(rt, u.nvalid - 1)]; if (rt >= u.nvalid) dst[ai][m] = -1; }
        constexpr float ws = 1.0f / (float)(1 << W2_SH);
#pragma unroll
        for (int bj = 0; bj < 2; ++bj) {
            const f32x4 bv0 = *(const f32x4*)(bp + bj * HALF), bv1 = *(const f32x4*)(bp + bj * HALF + 4);
#pragma unroll
            for (int ai = 0; ai < 2; ++ai)
#pragma unroll
                for (int m = 0; m < 4; ++m) {
                    const f32x4 v0 = acc[ai][bj][m][0] * ws + bv0, v1 = acc[ai][bj][m][1] * ws + bv1;
                    u32x4 w; w.x = cvt_pk_bf16(v0[0], v0[1]); w.y = cvt_pk_bf16(v0[2], v0[3]); w.z = cvt_pk_bf16(v1[0], v1[1]); w.w = cvt_pk_bf16(v1[2], v1[3]);
                    if (dst[ai][m] >= 0) *(u32x4*)(C + (size_t)dst[ai][m] * D + col0 + bj * HALF) = w;
                }
        }
    }
};
}

#define XB_TMO      128
#define XB_XCNT(j)  (256  + 64 * (j))
#define XB_XSUB(j)  (1280 + 64 * (j))
#define XB_XGEN(j)  (2304 + 64 * (j))
#define XB_TOP      3328
#define XB_TOPGEN   3392
#define XCD_BAR_WORDS 3456
#define XB_SPIN_CAP (1u << 18)
__device__ __forceinline__ unsigned xb_ld(unsigned* p)              { return __hip_atomic_load(p, __ATOMIC_RELAXED, __HIP_MEMORY_SCOPE_AGENT); }
__device__ __forceinline__ unsigned xb_add(unsigned* p, unsigned v) { return __hip_atomic_fetch_add(p, v, __ATOMIC_RELAXED, __HIP_MEMORY_SCOPE_AGENT); }
__device__ __forceinline__ unsigned xb_xcc_id() { return (unsigned)__builtin_amdgcn_s_getreg((3 << 11) | 20) & 0xFu; }
#define XB_SPIN(cond, bar) do { unsigned _sp = 0; while (cond) { __builtin_amdgcn_s_sleep(1); \
    if ((++_sp & 255u) == 0u) { if (xb_ld(&(bar)[XB_TMO])) break; if (_sp > XB_SPIN_CAP) { atomicAdd(&(bar)[XB_TMO], 1u); break; } } } } while (0)
struct XcdBarrier { unsigned* bar; unsigned x; volatile LAS unsigned* st; };
__device__ __forceinline__ XcdBarrier xcd_barrier_post(unsigned* bar, volatile LAS unsigned* st) {
    XcdBarrier b; b.bar = bar; b.x = xb_xcc_id(); b.st = st;
    if (threadIdx.x == 0) (void)xb_add(&bar[XB_XCNT(b.x)], 1u);
    return b;
}
__device__ __forceinline__ void xcd_barrier_complete(unsigned* bar, unsigned x, unsigned& nloc, unsigned& nx) {
    const unsigned G = gridDim.x * gridDim.y * gridDim.z;
    unsigned sum, cnt, mine, sp = 0u;
    for (;;) {
        sum = 0u; cnt = 0u; mine = 0u;
#pragma unroll
        for (unsigned j = 0; j < 16; ++j) { const unsigned c = xb_ld(&bar[XB_XCNT(j)]); sum += c; cnt += (c > 0u) ? 1u : 0u; mine = (j == x) ? c : mine; }
        if (sum == G) break;
        __builtin_amdgcn_s_sleep(1);
        if ((++sp & 255u) == 0u) { if (xb_ld(&bar[XB_TMO])) break; if (sp > XB_SPIN_CAP) { atomicAdd(&bar[XB_TMO], 1u); break; } }
    }
    nloc = mine > 0u ? mine : 1u; nx = cnt > 0u ? cnt : 1u;
}
__device__ __forceinline__ void xcd_barrier(const XcdBarrier& b, bool leader) {
    asm volatile("s_waitcnt vmcnt(0)" ::: "memory");
    __syncthreads();
    if (leader) {
        unsigned* bar = b.bar;
        __builtin_amdgcn_s_waitcnt(0);
        unsigned nloc = b.st[0], nx = b.st[1];
        if (nloc == 0u) { xcd_barrier_complete(bar, b.x, nloc, nx); b.st[0] = nloc; b.st[1] = nx; }
        const unsigned old = xb_add(&bar[XB_XSUB(b.x)], 1u);
        const unsigned gen = old / nloc;
        if (old + 1u == (gen + 1u) * nloc) {
            __builtin_amdgcn_fence(__ATOMIC_RELEASE, "agent");
            asm volatile("s_waitcnt vmcnt(0)" ::: "memory");
            const unsigned og = xb_add(&bar[XB_TOP], 1u);
            const unsigned tg = og / nx;
            if (og + 1u == (tg + 1u) * nx) xb_add(&bar[XB_TOPGEN], 1u);
            else XB_SPIN(xb_ld(&bar[XB_TOPGEN]) == tg, bar);
            __builtin_amdgcn_fence(__ATOMIC_ACQUIRE, "agent");
            xb_add(&bar[XB_XGEN(b.x)], 1u);
            asm volatile("s_waitcnt vmcnt(0)" ::: "memory");
        } else {
            XB_SPIN(xb_ld(&bar[XB_XGEN(b.x)]) == gen, bar);
            __builtin_amdgcn_fence(__ATOMIC_ACQUIRE, "agent");
            asm volatile("s_waitcnt vmcnt(0)" ::: "memory");
        }
    }
    __syncthreads();
}

constexpr int LDS_BYTES = 147456;
constexpr int LDS_TB = LDS_BYTES - 1024;
constexpr int LDS_MISC = LDS_BYTES - 512;

__device__ __forceinline__ void phase_p0a(const P& p, LAS unsigned char* lds, int bid, int G, int tid, int wave, int lane) {
    { float* POS = (float*)(p.ws + WS_POS);
      for (int i = bid * 512 + tid; i < 64 * 512; i += G * 512) {
          const int n = i / 512, j = i % 512, q = j % 256;
          const float omega = 1.0f / powf(10000.0f, (float)q / 256.0f);
          const float ang = (float)n * omega;
          POS[i] = j < 256 ? sinf(ang) : cosf(ang);
      } }
    { bf16* RWT = (bf16*)(p.ws + WS_RWT);
      for (int i = bid * 512 + tid; i < DEPTH * NE * 128; i += G * 512) {
          const int kc = i % 128, e = (i / 128) % NE, l = i / (128 * NE);
          const float* s = p.in[I_RW] + (size_t)l * D * NE + (size_t)(8 * kc) * NE + e;
          u32x4 o; o.x = pk2(s[0], s[NE]); o.y = pk2(s[2 * NE], s[3 * NE]); o.z = pk2(s[4 * NE], s[5 * NE]); o.w = pk2(s[6 * NE], s[7 * NE]);
          *(u32x4*)(RWT + ((size_t)l * NE + e) * D + 8 * kc) = o;
      } }
    { float* SP = (float*)(p.ws + WS_SP);
      const int gt = bid * 512 + tid, gn = G * 512;
      for (int l = 0; l < DEPTH; ++l) {
          float* o = SP + (size_t)l * SP_STRIDE;
          for (int i = gt; i < 2048; i += gn) o[SP_CW + i] = p.in[I_CONVW][(size_t)l * 2048 + i];
          for (int i = gt; i < 512; i += gn) { o[SP_CB + i] = p.in[I_CONVB][(size_t)l * 512 + i]; o[SP_PB + i] = p.in[I_POOLB][(size_t)l * 512 + i]; o[SP_PS + i] = p.in[I_POOLS][(size_t)l * 512 + i]; }
          for (int i = gt; i < 1024; i += gn) { o[SP_GAB + i] = p.in[I_GAB][(size_t)l * 1024 + i]; o[SP_GXB + i] = p.in[I_GXB][(size_t)l * 1024 + i];
              const float nl = -p.in[I_LAM][(size_t)l * 1024 + i]; o[SP_CC + i] = 8.0f * (nl > 20.f ? nl : log1pf(expf(nl)));
              o[SP_L1G + i] = p.in[I_LN1G][(size_t)l * 1024 + i]; o[SP_L1B + i] = p.in[I_LN1B][(size_t)l * 1024 + i];
              o[SP_L2G + i] = p.in[I_LN2G][(size_t)l * 1024 + i]; o[SP_L2B + i] = p.in[I_LN2B][(size_t)l * 1024 + i]; }
          for (int i = gt; i < 32; i += gn) o[SP_RB + i] = p.in[I_RB][(size_t)l * 32 + i];
          for (int i = gt; i < 32 * 2048; i += gn) o[SP_B1 + i] = p.in[I_B1][(size_t)l * 32 * 2048 + i];
          for (int i = gt; i < 32 * 1024; i += gn) o[SP_B2 + i] = p.in[I_B2][(size_t)l * 32 * 1024 + i];
      } }
    { LAS float* sl = (LAS float*)lds; LAS float* part = sl + 9 * 1024;
      const float* c = p.in[I_C]; const float* cc = p.in[I_CCTX];
      for (int i = tid; i < 9 * 1024; i += 512) { const float v = i < 8192 ? c[i] : cc[i - 8192]; sl[i] = v / (1.0f + __expf(-v)); }
      __syncthreads();
      float* MOD = (float*)(p.ws + WS_MOD);
      for (int u = bid; u < 2 * 96; u += G) {
          const int l = u / 96, n0 = (u % 96) * 64;
          const float* W = p.in[I_WMOD] + (size_t)l * 1024 * 6144 + n0;
          const int c4 = (tid & 15) * 4, ks = tid >> 4;
          f32x4 acc[9];
#pragma unroll
          for (int r = 0; r < 9; ++r) acc[r] = (f32x4){0.f, 0.f, 0.f, 0.f};
#pragma unroll
          for (int half = 0; half < 2; ++half) {
              f32x4 w[16];
#pragma unroll
              for (int kk = 0; kk < 16; ++kk) w[kk] = __builtin_nontemporal_load((const f32x4*)(W + (size_t)(ks * 32 + half * 16 + kk) * 6144 + c4));
#pragma unroll
              for (int kk = 0; kk < 16; ++kk) {
                  const int k = ks * 32 + half * 16 + kk;
#pragma unroll
                  for (int r = 0; r < 9; ++r) acc[r] += w[kk] * sl[r * 1024 + k];
              }
          }
#pragma unroll
          for (int r = 0; r < 9; ++r) *(LAS f32x4*)(part + (ks * 9 + r) * 64 + c4) = acc[r];
          __syncthreads();
          for (int o = tid; o < 9 * 64; o += 512) {
              const int r = o / 64, cl = o % 64; float sum = 0.f;
#pragma unroll
              for (int q = 0; q < 32; ++q) sum += part[(q * 9 + r) * 64 + cl];
              MOD[((size_t)l * 9 + r) * 6144 + n0 + cl] = sum + p.in[I_BMOD][(size_t)l * 6144 + n0 + cl];
          }
          __syncthreads();
      } }
    __syncthreads();
    convert_weights(p, lds, bid * 8 + wave, G * 8, wave, lane);
}

__device__ __forceinline__ void phase_entry(const P& p, int gw, int ngw, int lane) {
    const float* POS = (const float*)(p.ws + WS_POS);
    const float* MOD = (const float*)(p.ws + WS_MOD);
    float* XL = (float*)(p.ws + WS_XL); bf16* H = (bf16*)(p.ws + WS_H);
    for (int tok = gw; tok < TT; tok += ngw) {
        const float* src = tok < TL ? p.in[I_X] + (size_t)tok * D : p.in[I_CTX] + (size_t)(tok - TL) * D;
        f32x4 v[4];
#pragma unroll
        for (int j = 0; j < 4; ++j) v[j] = ((const f32x4*)src)[lane + 64 * j];
        if (tok < TL) {
            const int s = tok & (SEQ - 1), pr = s / GRIDW, pc = s % GRIDW;
#pragma unroll
            for (int j = 0; j < 4; ++j) {
                const float* ps = POS + (size_t)(j < 2 ? pr : pc) * 512 + (4 * lane + 256 * (j & 1));
                v[j] += *(const f32x4*)ps;
            }
        }
        float mean, rstd; ln_stats(v, mean, rstd);
        const float* m = MOD + (size_t)mod_row(tok) * 6144;
        f32x4 h[4];
#pragma unroll
        for (int j = 0; j < 4; ++j) {
            v[j] = (v[j] - mean) * rstd;
            ((f32x4*)(XL + (size_t)tok * D))[lane + 64 * j] = v[j];
            const f32x4 sh = ((const f32x4*)m)[lane + 64 * j], sc = ((const f32x4*)(m + 1024))[lane + 64 * j];
            h[j] = v[j] * (sc + 1.0f) + sh;
        }
        store_bf16_row(H + (size_t)tok * D, lane, h);
    }
}

constexpr float LOG2E = 1.4426950408889634f;
__device__ __forceinline__ float fast_sigmoid(float x) { return __builtin_amdgcn_rcpf(1.0f + __builtin_amdgcn_exp2f(-LOG2E * x)); }
__device__ __forceinline__ int lru_item(int b, int grp, int h, int cb, int wave) { return ((((b * NGRP + grp) * NH + h) * 2 + cb) * 8 + wave); }

template <bool FINAL>
__device__ __forceinline__ void tile_scan(const f32x16& ar, const f32x16& ai, int d, int hh, float cin, float& aggP, float& aggH, float (&hsum)[16]) {
    float oP[4], oH[4];
#pragma unroll
    for (int q = 0; q < 4; ++q) {
        float Pp = 1.f, Hh = 0.f;
#pragma unroll
        for (int jj = 0; jj < 4; ++jj) { const int j = d ? 3 - jj : jj; Hh = ar[4 * q + j] * Hh + ai[4 * q + j]; Pp *= ar[4 * q + j]; }
        oP[q] = Pp; oH[q] = Hh;
    }
    float eP[4], eH[4], xP[4], xH[4];
#pragma unroll
    for (int q = 0; q < 4; ++q) { const float pP = __shfl_xor(oP[q], 32), pH = __shfl_xor(oH[q], 32);
        eP[q] = hh ? pP : oP[q]; eH[q] = hh ? pH : oH[q]; xP[q] = hh ? oP[q] : pP; xH[q] = hh ? oH[q] : pH; }
    float c = cin, pall = 1.f;
    float mine[4];
    if (d == 0) {
#pragma unroll
        for (int q = 0; q < 4; ++q) { const float cE = c; c = eP[q] * c + eH[q]; const float cO = c; c = xP[q] * c + xH[q]; mine[q] = hh ? cO : cE; pall *= eP[q] * xP[q]; }
    } else {
#pragma unroll
        for (int q = 3; q >= 0; --q) { const float cO = c; c = xP[q] * c + xH[q]; const float cE = c; c = eP[q] * c + eH[q]; mine[q] = hh ? cO : cE; pall *= eP[q] * xP[q]; }
    }
    aggP = pall; aggH = c;
    if (FINAL) {
#pragma unroll
        for (int q = 0; q < 4; ++q) { float Hh = mine[q];
#pragma unroll
            for (int jj = 0; jj < 4; ++jj) { const int j = d ? 3 - jj : jj; Hh = ar[4 * q + j] * Hh + ai[4 * q + j]; if (d == 0) hsum[4 * q + j] = Hh; else hsum[4 * q + j] += Hh; } }
    }
}

__device__ __forceinline__ void lru_agg_unit(unsigned char* ws, int l, LAS unsigned char* lds, int b, int grp, int h, int cb, int wave, int lane) {
    asm volatile("" : "+s"(wave)); asm volatile("" : "+v"(lane));
    const bf16* Z = (const bf16*)(ws + WS_Z);
    const int r = lane & 31, hh = lane >> 5;
    int seqbase, len, t0;
    if (grp == 0) { seqbase = TL + b * CTXL; len = CTXL; t0 = wave * 32; } else { seqbase = b * SEQ; len = SEQ; t0 = (grp - 1) * 256 + wave * 32; }
    const int t = t0 + r;
    const float* SP = (const float*)(ws + WS_SP) + (size_t)l * SP_STRIDE;
    const float* cw = SP + SP_CW; const float* cbias = SP + SP_CB;
    bf16x8 Af[4];
#pragma unroll
    for (int s = 0; s < 4; ++s) {
        const int c0 = 64 * h + 16 * s + 8 * hh;
        const f32x4 b0 = *(const f32x4*)(cbias + c0), b1 = *(const f32x4*)(cbias + c0 + 4);
        float u[8] = {b0.x, b0.y, b0.z, b0.w, b1.x, b1.y, b1.z, b1.w};
#pragma unroll
        for (int k = 0; k < 4; ++k) {
            const int tt = t + k - 2;
            u32x4 raw = (u32x4){0u, 0u, 0u, 0u};
            if (tt >= 0 && tt < len) raw = *(const u32x4*)(Z + (size_t)(seqbase + tt) * DIN + c0);
            const f32x4 w0 = *(const f32x4*)(cw + k * DLRU + c0), w1 = *(const f32x4*)(cw + k * DLRU + c0 + 4);
            u[0] += w0.x * bflo(raw.x); u[1] += w0.y * bfhi(raw.x); u[2] += w0.z * bflo(raw.y); u[3] += w0.w * bfhi(raw.y);
            u[4] += w1.x * bflo(raw.z); u[5] += w1.y * bfhi(raw.z); u[6] += w1.z * bflo(raw.w); u[7] += w1.w * bfhi(raw.w);
        }
        u32x4 pk; pk.x = pg8::cvt_pk_bf16(u[0], u[1]); pk.y = pg8::cvt_pk_bf16(u[2], u[3]); pk.z = pg8::cvt_pk_bf16(u[4], u[5]); pk.w = pg8::cvt_pk_bf16(u[6], u[7]);
        Af[s] = __builtin_bit_cast(bf16x8, pk);
        asm volatile("" ::: "memory");
    }
    const bf16* WG = (const bf16*)(ws + WS_WG) + (size_t)(l * NH + h) * 256 * HD;
    f32x16 accu;
#pragma unroll
    for (int i = 0; i < 16; ++i) accu[i] = 0.f;
    { const int nn = 32 * cb + r;
#pragma unroll
      for (int s = 0; s < 4; ++s) {
          u32x4 w = (u32x4){0u, 0u, 0u, 0u};
          if ((nn >> 4) == s && ((nn >> 3) & 1) == hh) { const unsigned one = 0x3F80u << (16 * (nn & 1)); const int wi = (nn & 7) >> 1;
              w.x = wi == 0 ? one : 0u; w.y = wi == 1 ? one : 0u; w.z = wi == 2 ? one : 0u; w.w = wi == 3 ? one : 0u; }
          accu = __builtin_amdgcn_mfma_f32_32x32x16_bf16(Af[s], __builtin_bit_cast(bf16x8, w), accu, 0, 0, 0);
      } }
    const int ch = 64 * h + 32 * cb + r;
    u32x4* YB = (u32x4*)(ws + WS_YB) + (size_t)lru_item(b, grp, h, cb, wave) * 8 * 64 + lane;
    float aggP[2], aggH[2];
    float hdummy[16];
#pragma unroll
    for (int d = 0; d < 2; ++d) {
        f32x16 ar, ai;
#pragma unroll
        for (int i = 0; i < 16; ++i) { ar[i] = 0.f; ai[i] = 0.f; }
        { const bf16* wr_ = WG + (size_t)((2 * d) * 64 + 32 * cb + r) * HD + 8 * hh; const bf16* wi_ = wr_ + 64 * HD;
#pragma unroll
          for (int s = 0; s < 4; ++s) { const bf16x8 Bf = *(const bf16x8*)(wr_ + 16 * s); ar = __builtin_amdgcn_mfma_f32_32x32x16_bf16(Af[s], Bf, ar, 0, 0, 0); }
#pragma unroll
          for (int s = 0; s < 4; ++s) { const bf16x8 Bf = *(const bf16x8*)(wi_ + 16 * s); ai = __builtin_amdgcn_mfma_f32_32x32x16_bf16(Af[s], Bf, ai, 0, 0, 0); } }
        const float ba = SP[SP_GAB + d * DLRU + ch], bx = SP[SP_GXB + d * DLRU + ch], cc = SP[SP_CC + d * DLRU + ch];
#pragma unroll
        for (int q = 0; q < 4; ++q) {
            u32x4 wq;
#pragma unroll
            for (int j = 0; j < 4; ++j) { const int i = 4 * q + j;
                const float rr = fast_sigmoid(ar[i] + ba), ig = fast_sigmoid(ai[i] + bx);
                const float y = cc * rr;
                const float a0 = __builtin_amdgcn_exp2f(-LOG2E * y);
                const float bt = __builtin_amdgcn_sqrtf(fmaf(-a0, a0, 1.0f)) * (ig * accu[i]);
                const unsigned w = pg8::cvt_pk_bf16(y, bt);
                wq[j] = w;
                ar[i] = __builtin_amdgcn_exp2f(-LOG2E * bflo(w)); ai[i] = bfhi(w);
            }
            YB[(d * 4 + q) * 64] = wq;
            __builtin_amdgcn_sched_barrier(0);
        }
        tile_scan<false>(ar, ai, d, hh, 0.f, aggP[d], aggH[d], hdummy);
        __builtin_amdgcn_sched_barrier(0);
    }
    f32x2* AT = (f32x2*)(ws + WS_AGGT); f32x2* AG = (f32x2*)(ws + WS_AGGG);
    LAS f32x2* la = (LAS f32x2*)lds;
    if (hh == 0) {
#pragma unroll
        for (int d = 0; d < 2; ++d) { const f32x2 v = (f32x2){aggP[d], aggH[d]};
            AT[((size_t)(b * NTILE + grp * 8 + wave) * 2 + d) * DLRU + ch] = v; la[(wave * 2 + d) * 32 + r] = v; }
    }
    __syncthreads();
    if (wave == 0) {
        const int d = hh; float Pp = 1.f, Hh = 0.f;
#pragma unroll
        for (int i = 0; i < 8; ++i) { const int w = d ? 7 - i : i; const f32x2 v = la[(w * 2 + d) * 32 + r]; Hh = v.x * Hh + v.y; Pp *= v.x; }
        AG[((size_t)(b * NGRP + grp) * 2 + d) * DLRU + ch] = (f32x2){Pp, Hh};
    }
    __syncthreads();
}

__device__ __forceinline__ void lru_final_unit(unsigned char* ws, int l, int b, int grp, int h, int cb, int wave, int lane) {
    asm volatile("" : "+s"(wave)); asm volatile("" : "+v"(lane));
    const bf16* Z = (const bf16*)(ws + WS_Z);
    const int r = lane & 31, hh = lane >> 5;
    int seqbase, t0;
    if (grp == 0) { seqbase = TL + b * CTXL; t0 = wave * 32; } else { seqbase = b * SEQ; t0 = (grp - 1) * 256 + wave * 32; }
    const int ch = 64 * h + 32 * cb + r;
    const u32x4* YB = (const u32x4*)(ws + WS_YB) + (size_t)lru_item(b, grp, h, cb, wave) * 8 * 64 + lane;
    u32x4 W[8];
#pragma unroll
    for (int j = 0; j < 8; ++j) W[j] = YB[j * 64];
    unsigned short yg[16];
#pragma unroll
    for (int i = 0; i < 16; ++i) { const int row = (i & 3) + 8 * (i >> 2) + 4 * hh; yg[i] = Z[(size_t)(seqbase + t0 + row) * DIN + DLRU + ch]; }
    float C0, C1;
    {
        const f32x2* AGGT = (const f32x2*)(ws + WS_AGGT); const f32x2* AGGG = (const f32x2*)(ws + WS_AGGG);
        float c = 0.f;
        const int d = hh;
        if (grp > 0) {
            { const f32x2 g0 = AGGG[((size_t)(b * NGRP + 0) * 2 + d) * DLRU + ch]; c = g0.y; }
            f32x2 gv[7];
#pragma unroll
            for (int i = 0; i < 7; ++i) { const int g = d ? 8 - i : 1 + i; const bool valid = d ? (i < 8 - grp) : (i < grp - 1);
                gv[i] = valid ? AGGG[((size_t)(b * NGRP + g) * 2 + d) * DLRU + ch] : (f32x2){1.f, 0.f}; }
#pragma unroll
            for (int i = 0; i < 7; ++i) c = gv[i].x * c + gv[i].y;
        }
        f32x2 tv[7];
#pragma unroll
        for (int i = 0; i < 7; ++i) { const int tw = d ? 7 - i : i; const bool valid = d ? (i < 7 - wave) : (i < wave);
            tv[i] = valid ? AGGT[((size_t)(b * NTILE + grp * 8 + tw) * 2 + d) * DLRU + ch] : (f32x2){1.f, 0.f}; }
#pragma unroll
        for (int i = 0; i < 7; ++i) c = tv[i].x * c + tv[i].y;
        C0 = __shfl(c, r); C1 = __shfl(c, 32 + r);
    }
    float hsum[16];
#pragma unroll
    for (int d = 0; d < 2; ++d) {
        f32x16 ar, ai;
#pragma unroll
        for (int q = 0; q < 4; ++q)
#pragma unroll
            for (int j = 0; j < 4; ++j) { const unsigned w = W[d * 4 + q][j]; ar[4 * q + j] = __builtin_amdgcn_exp2f(-LOG2E * bflo(w)); ai[4 * q + j] = bfhi(w); }
        float aP, aH;
        tile_scan<true>(ar, ai, d, hh, d ? C1 : C0, aP, aH, hsum);
    }
    bf16* MIX = (bf16*)(ws + WS_MIX);
#pragma unroll
    for (int i = 0; i < 16; ++i) {
        const int row = (i & 3) + 8 * (i >> 2) + 4 * hh;
        MIX[(size_t)(seqbase + t0 + row) * D + ch] = (bf16)f2bf(hsum[i] * gelu_tanh(bf2f(yg[i])));
    }
}

constexpr int PX_PITCH = 528, PD_PITCH = 528;
constexpr int PX_OFF = 0, PD_OFF = 80 * PX_PITCH;
__device__ __forceinline__ void pool_unit(unsigned char* ws, int l, LAS unsigned char* lds, int c, int gp, int tid, int wave, int lane) {
    asm volatile("" : "+s"(wave)); asm volatile("" : "+v"(lane)); asm volatile("" : "+v"(tid));
    const bf16* Z = (const bf16*)(ws + WS_Z); bf16* MIX = (bf16*)(ws + WS_MIX);
    int seqbase, t0, seg_lo, seg_hi;
    if (c < 256) { seqbase = (c >> 5) * SEQ; t0 = (c & 31) * 64; seg_lo = t0; seg_hi = t0 + 64; }
    else { const int cc = c - 256; seqbase = TL + (cc >> 2) * CTXL; t0 = (cc & 3) * 64; seg_lo = 0; seg_hi = CTXL; }
    const int r_lo = max(t0 - 8, seg_lo), r_hi = min(t0 + 72, seg_hi);
    { const int sub = tid >> 5, l32 = tid & 31;
      for (int t = r_lo + sub; t < r_hi; t += 16) {
          const u32x4 v = *(const u32x4*)(Z + (size_t)(seqbase + t) * DIN + 2 * DLRU + 256 * gp + 8 * l32);
          *(LAS u32x4*)(lds + PX_OFF + (t - (t0 - 8)) * PX_PITCH + 16 * l32) = v;
      } }
    __syncthreads();
    { const int cp = tid & 127, tq = tid >> 7;
      const int g = 2 * gp + (cp >> 6);
      const int half = 1 << g;
      const LAS unsigned char* xb = lds + PX_OFF + 4 * cp - (t0 - 8) * PX_PITCH;
      int t = t0 + 16 * tq;
      int lo = max(t - half, seg_lo), hi = min(t + half, seg_hi);
      float s0 = 0.f, s1 = 0.f;
      for (int j = lo; j < hi; ++j) { const unsigned w = *(const LAS unsigned*)(xb + j * PX_PITCH); s0 += bflo(w); s1 += bfhi(w); }
#pragma unroll 4
      for (int i = 0; i < 16; ++i, ++t) {
          const unsigned wx = *(const LAS unsigned*)(xb + t * PX_PITCH);
          const float inv = 1.0f / (float)(hi - lo);
          const float d0 = s0 * inv - bflo(wx), d1 = s1 * inv - bfhi(wx);
          *(LAS unsigned*)(lds + PD_OFF + (t - t0) * PD_PITCH + 4 * cp) = pk2(d0, d1);
          const int nlo = max(t + 1 - half, seg_lo), nhi = min(t + 1 + half, seg_hi);
          if (nhi > hi) { const unsigned w = *(const LAS unsigned*)(xb + hi * PX_PITCH); s0 += bflo(w); s1 += bfhi(w); }
          if (nlo > lo) { const unsigned w = *(const LAS unsigned*)(xb + lo * PX_PITCH); s0 -= bflo(w); s1 -= bfhi(w); }
          lo = nlo; hi = nhi;
      } }
    __syncthreads();
    { const int gl = wave >> 2, th = (wave >> 1) & 1, nh = wave & 1, r = lane & 31, hh = lane >> 5;
      const int g = 2 * gp + gl;
      const bf16* WP = (const bf16*)(ws + WS_WP) + (size_t)(l * 4 + g) * 128 * 128;
      f32x16 acc[2];
#pragma unroll
      for (int q = 0; q < 2; ++q)
#pragma unroll
          for (int i = 0; i < 16; ++i) acc[q][i] = 0.f;
      const LAS unsigned char* arow = lds + PD_OFF + (th * 32 + r) * PD_PITCH + (gl * 128 + 8 * hh) * 2;
#pragma unroll
      for (int s = 0; s < 8; ++s) {
          const bf16x8 Af = *(const LAS bf16x8*)(arow + 32 * s);
#pragma unroll
          for (int nt = 0; nt < 2; ++nt) { const bf16x8 Bf = *(const bf16x8*)(WP + (size_t)(nh * 64 + nt * 32 + r) * 128 + 16 * s + 8 * hh);
              acc[nt] = __builtin_amdgcn_mfma_f32_32x32x16_bf16(Af, Bf, acc[nt], 0, 0, 0); }
      }
#pragma unroll
      for (int nt = 0; nt < 2; ++nt) {
          const int co = 128 * g + 64 * nh + 32 * nt + r;
          const float* SP = (const float*)(ws + WS_SP) + (size_t)l * SP_STRIDE; const float pb = SP[SP_PB + co], ps = SP[SP_PS + co];
#pragma unroll
          for (int i = 0; i < 16; ++i) {
              const int row = (i & 3) + 8 * (i >> 2) + 4 * hh;
              MIX[(size_t)(seqbase + t0 + th * 32 + row) * D + DLRU + co] = (bf16)f2bf((acc[nt][i] + pb) * ps);
          }
      } }
    __syncthreads();
}

constexpr int L1_PITCH = 2064;
constexpr int L1_PART = 16 * L1_PITCH;
constexpr int L1_MAXB = 5;
constexpr int L1_ROWS = L1_PART + 16384 + 256 + L1_MAXB * 64 * 16;
static_assert(L1_ROWS + L1_MAXB * 16 * 1024 <= LDS_TB, "LN1 LDS map");
__device__ __forceinline__ void phase_ln1(unsigned char* ws, int l, LAS unsigned char* lds, int bid, int G, int tid, int wave, int lane) {
    const float* MOD = (const float*)(ws + WS_MOD) + (size_t)l * 9 * 6144;
    float* XL = (float*)(ws + WS_XL); fp8* H8S = (fp8*)(ws + WS_H8S); const bf16* Y1 = (const bf16*)(ws + WS_Y1);
    const float* SP = (const float*)(ws + WS_SP) + (size_t)l * SP_STRIDE;
    const float* lg = SP + SP_L1G; const float* lb = SP + SP_L1B; const float* rb = SP + SP_RB;
    int* cnt = (int*)(ws + WS_CTL) + CW_CNT + 32 * l;
    float* TOPG = (float*)(ws + WS_TOPG); int* ROWDST = (int*)(ws + WS_ROWDST);
    const int ntok = (l == DEPTH - 1) ? TL : TT;
    const bf16* RWT = (const bf16*)(ws + WS_RWT) + (size_t)l * NE * D;
    bf16x8 Bf[4][2];
#pragma unroll
    for (int s = 0; s < 4; ++s)
#pragma unroll
        for (int nt = 0; nt < 2; ++nt) Bf[s][nt] = *(const bf16x8*)(RWT + (size_t)(16 * nt + (lane & 15)) * D + 128 * wave + 32 * s + 8 * (lane >> 4));
    LAS float* part = (LAS float*)(lds + L1_PART);
    LAS int* lcnt = (LAS int*)(lds + L1_PART + 16384);
    LAS int* lbase = lcnt + 32;
    LAS u32x4* ent = (LAS u32x4*)(lds + L1_PART + 16384 + 256);
    if (tid < 32) lcnt[tid] = 0;
    int nb_local = 0;
    __syncthreads();
    for (int batch = bid; batch < ntok / 16 && nb_local < L1_MAXB; batch += G) {
#pragma unroll
        for (int rr = 0; rr < 2; ++rr) {
            const int trow = 2 * wave + rr, tok = batch * 16 + trow;
            const float* m = MOD + (size_t)mod_row(tok) * 6144;
            f32x4 v[4], h[4];
#pragma unroll
            for (int j = 0; j < 4; ++j) {
                const f32x4 x = ((const f32x4*)(XL + (size_t)tok * D))[lane + 64 * j];
                const u32x2 yr = ((const u32x2*)(Y1 + (size_t)tok * D))[lane + 64 * j];
                const f32x4 g1 = ((const f32x4*)(m + 2048))[lane + 64 * j];
                f32x4 y; y.x = bflo(yr.x); y.y = bfhi(yr.x); y.z = bflo(yr.y); y.w = bfhi(yr.y);
                v[j] = x * ALPHA + g1 * y;
            }
            float mean, rstd; ln_stats(v, mean, rstd);
#pragma unroll
            for (int j = 0; j < 4; ++j) {
                const f32x4 gg = ((const f32x4*)lg)[lane + 64 * j], bb = ((const f32x4*)lb)[lane + 64 * j];
                v[j] = (v[j] - mean) * rstd * gg + bb;
                ((f32x4*)(XL + (size_t)tok * D))[lane + 64 * j] = v[j];
                const f32x4 sh = ((const f32x4*)(m + 3072))[lane + 64 * j], sc = ((const f32x4*)(m + 4096))[lane + 64 * j];
                h[j] = v[j] * (sc + 1.0f) + sh;
                u32x2 w; w.x = pk2(h[j].x, h[j].y); w.y = pk2(h[j].z, h[j].w);
                int w8 = 0; w8 = __builtin_amdgcn_cvt_pk_fp8_f32(h[j].x, h[j].y, w8, false); w8 = __builtin_amdgcn_cvt_pk_fp8_f32(h[j].z, h[j].w, w8, true);
                *(LAS unsigned*)(lds + L1_ROWS + (nb_local * 16 + trow) * 1024 + (4 * lane + 256 * j)) = (unsigned)w8;
                *(LAS u32x2*)(lds + trow * L1_PITCH + (4 * lane + 256 * j) * 2) = w;
            }
        }
        __syncthreads();
        {
            f32x4 a2[2] = {(f32x4){0.f, 0.f, 0.f, 0.f}, (f32x4){0.f, 0.f, 0.f, 0.f}};
            const LAS unsigned char* arow = lds + (lane & 15) * L1_PITCH + (128 * wave + 8 * (lane >> 4)) * 2;
#pragma unroll
            for (int s = 0; s < 4; ++s) { const bf16x8 Af = *(const LAS bf16x8*)(arow + 64 * s);
#pragma unroll
                for (int nt = 0; nt < 2; ++nt) a2[nt] = __builtin_amdgcn_mfma_f32_16x16x32_bf16(Af, Bf[s][nt], a2[nt], 0, 0, 0); }
#pragma unroll
            for (int nt = 0; nt < 2; ++nt)
#pragma unroll
                for (int i = 0; i < 4; ++i) part[(wave * 16 + 4 * (lane >> 4) + i) * 32 + 16 * nt + (lane & 15)] = a2[nt][i];
        }
        __syncthreads();
        {
            const int trow = tid >> 5, e = tid & 31, tok = batch * 16 + trow;
            float lgt = rb[e];
#pragma unroll
            for (int w = 0; w < 8; ++w) lgt += part[(w * 16 + trow) * 32 + e];
            float tv[4]; int ti[4];
            float cur = lgt;
#pragma unroll
            for (int k = 0; k < 4; ++k) {
                float bv = cur; int bi = e;
#pragma unroll
                for (int o = 1; o < 32; o <<= 1) { const float ov = __shfl_xor(bv, o); const int oi = __shfl_xor(bi, o); if (ov > bv || (ov == bv && oi < bi)) { bv = ov; bi = oi; } }
                tv[k] = bv; ti[k] = bi;
                if (e == bi) cur = -INFINITY;
            }
            const float e1 = __expf(tv[1] - tv[0]), e2 = __expf(tv[2] - tv[0]), e3 = __expf(tv[3] - tv[0]);
            const float inv = 1.0f / (1.0f + e1 + e2 + e3);
            if (e < 4) {
                const int ex = e == 0 ? ti[0] : e == 1 ? ti[1] : e == 2 ? ti[2] : ti[3];
                const float pg = (e == 0 ? 1.0f : e == 1 ? e1 : e == 2 ? e2 : e3) * inv;
                const int ls = __hip_atomic_fetch_add(lcnt + ex, 1, __ATOMIC_RELAXED, __HIP_MEMORY_SCOPE_WORKGROUP);
                const int idx = (nb_local * 16 + trow) * 4 + e;
                ent[idx] = (u32x4){(unsigned)tok, (unsigned)ex, (unsigned)ls, __float_as_uint(pg)};
            }
        }
        ++nb_local;
        __syncthreads();
    }
    if (tid < 32) { const int c = lcnt[tid]; lbase[tid] = c > 0 ? atomicAdd(&cnt[tid], c) : 0; }
    __syncthreads();
    for (int i = wave; i < nb_local * 64; i += 8) {
        const u32x4 en = ent[i]; const int tok = (int)en.x, ex = (int)en.y, slot = lbase[ex] + (int)en.z;
        if (lane == 0) { TOPG[tok * 4 + (i & 3)] = __uint_as_float(en.w); ROWDST[(size_t)ex * TT + slot] = tok * 4 + (i & 3); }
        const u32x4 v = *(const LAS u32x4*)(lds + L1_ROWS + (i >> 2) * 1024 + 16 * lane);
        *(u32x4*)(H8S + ((size_t)ex * TT + slot) * D + 16 * lane) = v;
    }
    __syncthreads();
}

__device__ __forceinline__ void phase_ln2(unsigned char* ws, float* out, int l, int gw, int ngw, int lane) {
    const float* MOD = (const float*)(ws + WS_MOD) + (size_t)l * 9 * 6144;
    float* XL = (float*)(ws + WS_XL); bf16* H = (bf16*)(ws + WS_H); const bf16* Y2 = (const bf16*)(ws + WS_Y2); const f32x4* TOPG = (const f32x4*)(ws + WS_TOPG);
    const float* SP = (const float*)(ws + WS_SP) + (size_t)l * SP_STRIDE;
    const float* lg = SP + SP_L2G; const float* lb = SP + SP_L2B;
    const bool last = (l == DEPTH - 1);
    const int ntok = last ? TL : TT;
    for (int tok0 = gw * 2; tok0 < ntok; tok0 += ngw * 2) {
        f32x4 v[2][4]; u32x2 yr[2][4][4]; f32x4 g2[2][4]; f32x4 gk[2];
#pragma unroll
        for (int t = 0; t < 2; ++t) {
            const int tok = tok0 + t;
            const float* m = MOD + (size_t)mod_row(tok) * 6144;
            gk[t] = TOPG[tok];
#pragma unroll
            for (int j = 0; j < 4; ++j) {
                v[t][j] = ((const f32x4*)(XL + (size_t)tok * D))[lane + 64 * j];
                g2[t][j] = ((const f32x4*)(m + 5120))[lane + 64 * j];
#pragma unroll
                for (int k = 0; k < 4; ++k) yr[t][k][j] = ((const u32x2*)(Y2 + ((size_t)tok * 4 + k) * D))[lane + 64 * j];
            }
        }
#pragma unroll
        for (int t = 0; t < 2; ++t) {
            const int tok = tok0 + t;
#pragma unroll
            for (int j = 0; j < 4; ++j) {
                f32x4 f = (f32x4){0.f, 0.f, 0.f, 0.f};
#pragma unroll
                for (int k = 0; k < 4; ++k) { const u32x2 r = yr[t][k][j]; const float g = gk[t][k]; f.x += g * bflo(r.x); f.y += g * bfhi(r.x); f.z += g * bflo(r.y); f.w += g * bfhi(r.y); }
                v[t][j] = v[t][j] * ALPHA + g2[t][j] * f;
            }
            float mean, rstd; ln_stats(v[t], mean, rstd);
            f32x4 h[4];
            const float* mn = MOD + (size_t)9 * 6144 + (size_t)mod_row(tok) * 6144;
#pragma unroll
            for (int j = 0; j < 4; ++j) {
                const f32x4 gg = ((const f32x4*)lg)[lane + 64 * j], bb = ((const f32x4*)lb)[lane + 64 * j];
                const f32x4 o = (v[t][j] - mean) * rstd * gg + bb;
                if (last) ((f32x4*)(out + (size_t)tok * D))[lane + 64 * j] = o;
                else {
                    ((f32x4*)(XL + (size_t)tok * D))[lane + 64 * j] = o;
                    const f32x4 sh = ((const f32x4*)mn)[lane + 64 * j], sc = ((const f32x4*)(mn + 1024))[lane + 64 * j];
                    h[j] = o * (sc + 1.0f) + sh;
                }
            }
            if (!last) store_bf16_row(H + (size_t)tok * D, lane, h);
        }
    }
}

constexpr int NPHASE = 2 + 8 * DEPTH;
#ifndef PHMASK
#define PHMASK 0xFFFF
#endif
#define PH_ON(k) (((PHMASK) >> (k)) & 1)
#ifndef MK_PER_PHASE
#define MK_PER_PHASE 0
#endif
__global__ void __launch_bounds__(512, 2) mk_fwd(P p) {
    extern __shared__ __attribute__((aligned(16))) unsigned char lds_[];
    LAS unsigned char* lds = (LAS unsigned char*)lds_;
    const int tid = threadIdx.x, lane = tid & 63, wave = __builtin_amdgcn_readfirstlane(tid >> 6);
    const int G = gridDim.x, bid = blockIdx.x;
    volatile LAS unsigned* MISC = (volatile LAS unsigned*)(lds + LDS_MISC);
    if (tid < 4) MISC[tid] = 0u;
    __syncthreads();
    unsigned* barw = (unsigned*)(p.ws + WS_CTL) + CW_BAR;
    XcdBarrier bar; bar.bar = barw; bar.x = 0; bar.st = MISC;
    if (!MK_PER_PHASE) bar = xcd_barrier_post(barw, MISC);
    const int lo = p.ph_lo, hi = p.ph_hi;
#define IN(k) (lo <= (k) && (k) < hi)
#define SEAM(k) do { if (IN(k) && IN((k) + 1)) xcd_barrier(bar, wave == 0 && (int)__lane_id() == 0); } while (0)
    if (PH_ON(0) && IN(0)) { phase_p0a(p, lds, bid, G, tid, wave, lane); }
    SEAM(0);
    if (PH_ON(1) && IN(1)) { phase_entry(p, bid * 8 + wave, G * 8, lane); }
    SEAM(1);
#pragma unroll 1
    for (int l = 0; l < DEPTH; ++l) {
        const int pb = 2 + 8 * l;
#define FRESH() int tid_ = wave * 64 + (int)__lane_id(); asm volatile("" : "+v"(tid_)); const int lane_ = tid_ & 63; const int wave_ = __builtin_amdgcn_readfirstlane(tid_ >> 6); \
                size_t wz_ = 0; asm volatile("" : "+s"(wz_)); unsigned char* ws = p.ws + wz_; (void)lane_; (void)wave_
        if (PH_ON(2) && IN(pb + 0)) {
            FRESH();
            pg8::DenseOrder S; S.init(TT / 256, DIN / 256, G, bid);
            pg8::EpiStore E{(bf16*)(ws + WS_Z), DIN};
            pg8::gemm_phase<false>(lds, tid_, ws + WS_H, (const bf16*)(ws + WS_WIN) + (size_t)l * DIN * D, S, E);
        }
        SEAM(pb + 0);
        if (PH_ON(3) && IN(pb + 1)) {
            FRESH();
            for (int u = bid; u < NB * NGRP * NH * 2; u += G) { const int cb = u & 1, h = (u >> 1) & 7, bg = u >> 4; lru_agg_unit(ws, l, lds, bg / NGRP, bg % NGRP, h, cb, wave_, lane_); }
        }
        SEAM(pb + 1);
        if (PH_ON(4) && IN(pb + 2)) {
            FRESH();
            const int g0 = (l == DEPTH - 1) ? 1 : 0, ng = NGRP - g0;
            const int nlru = NB * ng * NH * 2, npool = ((l == DEPTH - 1) ? 256 : 288) * 2;
            for (int u = bid; u < nlru + npool; u += G) {
                if (u < nlru) { const int cb = u & 1, h = (u >> 1) & 7, bg = u >> 4; lru_final_unit(ws, l, bg / ng, g0 + bg % ng, h, cb, wave_, lane_); }
                else { const int q = u - nlru; pool_unit(ws, l, lds, q >> 1, q & 1, tid_, wave_, lane_); }
            }
        }
        SEAM(pb + 2);
        if (PH_ON(5) && IN(pb + 3)) {
            FRESH();
            pg8::DenseOrder S; S.init((l == DEPTH - 1 ? TL : TT) / 256, D / 256, G, bid);
            pg8::EpiStore E{(bf16*)(ws + WS_Y1), D};
            pg8::gemm_phase<false>(lds, tid_, ws + WS_MIX, (const bf16*)(ws + WS_WOUT) + (size_t)l * D * D, S, E);
        }
        SEAM(pb + 3);
        if (PH_ON(6) && IN(pb + 4)) { FRESH(); phase_ln1(ws, l, lds, bid, G, tid_, wave_, lane_); }
        SEAM(pb + 4);
        if (IN(pb + 5) || IN(pb + 6)) {
            FRESH();
            const int* cnt = (const int*)(ws + WS_CTL) + CW_CNT + 32 * l;
            LAS int* tb = (LAS int*)(lds + LDS_TB);
            if (tid_ < 64) { const int c = lane_ < 32 ? (cnt[lane_] + 255) >> 8 : 0; int s = c;
#pragma unroll
                for (int o = 1; o < 32; o <<= 1) { const int t = __shfl_up(s, o); if (lane_ >= o) s += t; }
                if (lane_ < 32) tb[lane_ + 1] = s; if (lane_ == 0) tb[0] = 0; }
            __syncthreads();
        }
        if (PH_ON(7) && IN(pb + 5)) {
            FRESH();
            const int* cnt = (const int*)(ws + WS_CTL) + CW_CNT + 32 * l;
            pg8::MoeOrder<8, true> S{(const LAS int*)(lds + LDS_TB), cnt, G, bid};
            pg8::EpiSwiglu E{(fp8*)(ws + WS_ACT), (const float*)(ws + WS_SP) + (size_t)l * SP_STRIDE + SP_B1};
            pg8::gemm_phase<true>(lds, tid_, ws + WS_H8S, ws + WS_W1T + (size_t)l * NE * 2 * DF * D, S, E);
        }
        SEAM(pb + 5);
        if (PH_ON(8) && IN(pb + 6)) {
            FRESH();
            const int* cnt = (const int*)(ws + WS_CTL) + CW_CNT + 32 * l;
            pg8::MoeOrder<4, false> S{(const LAS int*)(lds + LDS_TB), cnt, G, bid};
            pg8::EpiDown E{(bf16*)(ws + WS_Y2), (const float*)(ws + WS_SP) + (size_t)l * SP_STRIDE + SP_B2, (const int*)(ws + WS_ROWDST)};
            pg8::gemm_phase<true>(lds, tid_, ws + WS_ACT, ws + WS_W2T + (size_t)l * NE * D * DF, S, E);
        }
        SEAM(pb + 6);
        if (PH_ON(9) && IN(pb + 7)) { FRESH(); phase_ln2(ws, p.out, l, bid * 8 + wave_, G * 8, lane_); }
        SEAM(pb + 7);
#undef FRESH
    }
#undef IN
#undef SEAM
}

extern "C" void kernel_launch(void* const* d_in, const int* in_sizes, int n_in, void* d_out, int out_size, void* d_ws, size_t ws_size, hipStream_t stream) {
    static int grid = 0;
    if (grid == 0) {
        if (n_in != N_IN || ws_size < WS_END || out_size != TL * D) { fprintf(stderr, "kernel_launch: unexpected shapes (n_in %d, out %d, ws %zu)\n", n_in, out_size, ws_size); grid = -1; return; }
        int dev = 0, cus = 0, per_cu = 0;
        if (hipGetDevice(&dev) != hipSuccess || hipDeviceGetAttribute(&cus, hipDeviceAttributeMultiprocessorCount, dev) != hipSuccess) { grid = -1; return; }
        if (hipFuncSetAttribute((const void*)mk_fwd, hipFuncAttributeMaxDynamicSharedMemorySize, LDS_BYTES) != hipSuccess) { fprintf(stderr, "kernel_launch: hipFuncSetAttribute failed\n"); grid = -1; return; }
        if (hipOccupancyMaxActiveBlocksPerMultiprocessor(&per_cu, (const void*)mk_fwd, 512, LDS_BYTES) != hipSuccess || per_cu < 1) { fprintf(stderr, "kernel_launch: occupancy query says %d\n", per_cu); }
        (void)hipGetLastError();
        grid = cus & ~7;
        if (grid < 231) { fprintf(stderr, "kernel_launch: this build needs at least 231 CUs (has %d)\n", cus); grid = -1; return; }
    }
    if (grid < 0) return;
    (void)hipMemsetAsync((char*)d_ws + WS_CTL, 0, CTL_BYTES, stream);
    P p{};
    for (int i = 0; i < N_IN; ++i) p.in[i] = (const float*)d_in[i];
    p.out = (float*)d_out; p.ws = (unsigned char*)d_ws;
#if MK_PER_PHASE
    for (int ph = 0; ph < NPHASE; ++ph) { p.ph_lo = ph; p.ph_hi = ph + 1; hipLaunchKernelGGL(mk_fwd, dim3(grid), dim3(512), LDS_BYTES, stream, p);
#ifdef EXTRA_PHASE
        if (ph == EXTRA_PHASE) for (int r = 0; r < EXTRA_REPS; ++r) hipLaunchKernelGGL(mk_fwd, dim3(grid), dim3(512), LDS_BYTES, stream, p);
#endif
    }
#else
    p.ph_lo = 0; p.ph_hi = NPHASE;
    hipLaunchKernelGGL(mk_fwd, dim3(grid), dim3(512), LDS_BYTES, stream, p);
#endif
}
```

```cpp
#include <hip/hip_runtime.h>
#include <cstdio>
#include <cstdint>

constexpr int NB = 8, SEQ = 2048, D = 1024, CTXL = 256, DEPTH = 2;
constexpr int TL = NB * SEQ;
constexpr int TC = NB * CTXL;
constexpr int TT = TL + TC;
constexpr int DLRU = 512, DPOOL = 512, DIN = 1536, NH = 8, HD = 64;
constexpr int NE = 32, TOPK = 4, DF = 1024;
constexpr int GRIDW = 64;
constexpr float LN_EPS = 1e-5f;
constexpr float ALPHA = 1.41421356237309515f;
constexpr int MAXROWS = 81920;
constexpr int NTILE = 72, NGRP = 9;

enum { I_X = 0, I_C, I_CTX, I_CCTX, I_WMOD, I_BMOD, I_WIN, I_CONVW, I_CONVB, I_GAW, I_GAB, I_GXW, I_GXB, I_LAM, I_POOLW, I_POOLB, I_POOLS,
       I_WOUT, I_LN1G, I_LN1B, I_RW, I_RB, I_W1, I_B1, I_W2, I_B2, I_LN2G, I_LN2B, N_IN };

constexpr size_t MiB = 1u << 20;
constexpr size_t WS_CTL = 0, CTL_BYTES = 1 * MiB;
constexpr size_t WS_MOD = 1 * MiB;
constexpr size_t WS_POS = 2 * MiB;
constexpr size_t WS_RWT = 2 * MiB + 512 * 1024;
constexpr size_t WS_TOPG = 7 * MiB;
constexpr size_t WS_AGGT = 10 * MiB;
constexpr size_t WS_AGGG = 15 * MiB;
constexpr size_t WS_WIN = 16 * MiB, WS_WOUT = 23 * MiB, WS_WG = 28 * MiB, WS_WP = 29 * MiB;
constexpr size_t WS_SP = 30 * MiB;
constexpr size_t WS_W1T = 32 * MiB, WS_W2T = 160 * MiB;
constexpr size_t WS_H8S = 1052 * MiB;
constexpr int W1_SH = 6, W2_SH = 7;
constexpr int SP_CW = 0, SP_CB = 2048, SP_GAB = 2560, SP_GXB = 3584, SP_CC = 4608, SP_PB = 5632, SP_PS = 6144, SP_L1G = 6656, SP_L1B = 7680, SP_L2G = 8704, SP_L2B = 9728, SP_RB = 10752,
              SP_B1 = 12288, SP_B2 = SP_B1 + 32 * 2048, SP_STRIDE = SP_B2 + 32 * 1024;
constexpr size_t WS_XL = 416 * MiB;
constexpr size_t WS_H = 488 * MiB;
constexpr size_t WS_Z = 524 * MiB;
constexpr size_t WS_MIX = 578 * MiB;
constexpr size_t WS_Y1 = 614 * MiB;
constexpr size_t WS_ACT = 650 * MiB;
constexpr size_t WS_Y2 = 810 * MiB;
constexpr size_t WS_YB = 970 * MiB;
constexpr size_t WS_ROWDST = 1046 * MiB;
constexpr size_t WS_END = 1628 * MiB;
constexpr int CW_CNT = 64;
constexpr int CW_BAR = 4096;

typedef unsigned short bf16;
typedef float f32x4 __attribute__((ext_vector_type(4)));
typedef float f32x2 __attribute__((ext_vector_type(2)));
typedef float f32x16 __attribute__((ext_vector_type(16)));
typedef unsigned u32x2 __attribute__((ext_vector_type(2)));
typedef unsigned u32x4 __attribute__((ext_vector_type(4)));
typedef short bf16x8 __attribute__((ext_vector_type(8)));
typedef int i32x8 __attribute__((ext_vector_type(8)));
typedef unsigned char fp8;

__device__ __forceinline__ float bf2f(bf16 v) { return __uint_as_float(((unsigned)v) << 16); }
__device__ __forceinline__ float bflo(unsigned w) { return __uint_as_float(w << 16); }
__device__ __forceinline__ float bfhi(unsigned w) { return __uint_as_float(w & 0xffff0000u); }
__device__ __forceinline__ unsigned f2bf(float f) { unsigned u = __float_as_uint(f); return (u + 0x7fffu + ((u >> 16) & 1u)) >> 16; }
__device__ __forceinline__ unsigned pk2(float lo, float hi) { return f2bf(lo) | (f2bf(hi) << 16); }
__device__ __forceinline__ float wave_sum(float v) {
#pragma unroll
    for (int o = 1; o < 64; o <<= 1) v += __shfl_xor(v, o);
    return v;
}
__device__ __forceinline__ float fsigmoid(float x) { return __builtin_amdgcn_rcpf(1.0f + __expf(-x)); }
__device__ __forceinline__ float gelu_tanh(float x) {
    const float u = 0.7978845608028654f * (x + 0.044715f * x * x * x);
    const float t = 1.0f - 2.0f * __builtin_amdgcn_rcpf(__expf(2.0f * u) + 1.0f);
    return 0.5f * x * (1.0f + t);
}

struct P {
    const float* in[N_IN];
    float* out;
    unsigned char* ws;
    int ph_lo, ph_hi;
};

__device__ __forceinline__ int mod_row(int tok) { return tok < TL ? (tok >> 11) : NB; }
__device__ __forceinline__ int pad256(int c) { return (c + 255) & ~255; }

__device__ __forceinline__ void ln_stats(const f32x4 (&v)[4], float& mean, float& rstd) {
    float s = 0.f;
#pragma unroll
    for (int j = 0; j < 4; ++j) s += (v[j].x + v[j].y) + (v[j].z + v[j].w);
    mean = wave_sum(s) * (1.f / D);
    float s2 = 0.f;
#pragma unroll
    for (int j = 0; j < 4; ++j) { const f32x4 d = v[j] - mean; s2 += (d.x * d.x + d.y * d.y) + (d.z * d.z + d.w * d.w); }
    rstd = 1.0f / sqrtf(wave_sum(s2) * (1.f / D) + LN_EPS);
}
__device__ __forceinline__ void store_bf16_row(bf16* row, int lane, const f32x4 (&h)[4]) {
    u32x2* o = (u32x2*)row + lane;
#pragma unroll
    for (int j = 0; j < 4; ++j) { u32x2 w; w.x = pk2(h[j].x, h[j].y); w.y = pk2(h[j].z, h[j].w); o[64 * j] = w; }
}


#define LAS __attribute__((address_space(3)))
struct CvtItem { const float* src; unsigned char* dst; int N, Kp, f8; float scale; };
__device__ __forceinline__ void tile_load(const CvtItem& it, int lane, f32x4 (&v)[16]) {
#pragma unroll
    for (int i = 0; i < 16; ++i) { const int k = 4 * i + (lane >> 4); v[i] = __builtin_nontemporal_load((const f32x4*)(it.src + (size_t)k * it.N + 4 * (lane & 15))); }
}
__device__ __forceinline__ void tile_store(const CvtItem& it, const f32x4 (&v)[16], LAS float* scr, int lane) {
#pragma unroll
    for (int i = 0; i < 16; ++i) { const int k = 4 * i + (lane >> 4); const int nn = (4 * (lane & 15)) ^ (((k >> 3) & 3) << 3); *(LAS f32x4*)(scr + k * 64 + nn) = v[i]; }
    asm volatile("s_waitcnt lgkmcnt(0)" ::: "memory");
    const int c = lane & 7, sw = (c & 3) << 3;
    if (it.f8) {
#pragma unroll
        for (int j = 0; j < 8; ++j) {
            const int n = (lane >> 3) + 8 * j;
            const LAS float* s = scr + (8 * c) * 64 + (n ^ sw);
            const float sc = it.scale;
            int w0 = 0, w1 = 0;
            w0 = __builtin_amdgcn_cvt_pk_fp8_f32(s[0] * sc, s[64] * sc, w0, false); w0 = __builtin_amdgcn_cvt_pk_fp8_f32(s[128] * sc, s[192] * sc, w0, true);
            w1 = __builtin_amdgcn_cvt_pk_fp8_f32(s[256] * sc, s[320] * sc, w1, false); w1 = __builtin_amdgcn_cvt_pk_fp8_f32(s[384] * sc, s[448] * sc, w1, true);
            *(u32x2*)(it.dst + (size_t)n * it.Kp + 8 * c) = (u32x2){(unsigned)w0, (unsigned)w1};
        }
    } else {
#pragma unroll
        for (int j = 0; j < 8; ++j) {
            const int n = (lane >> 3) + 8 * j;
            const LAS float* s = scr + (8 * c) * 64 + (n ^ sw);
            u32x4 o; o.x = pk2(s[0], s[64]); o.y = pk2(s[128], s[192]); o.z = pk2(s[256], s[320]); o.w = pk2(s[384], s[448]);
            *(u32x4*)(it.dst + ((size_t)n * it.Kp + 8 * c) * 2) = o;
        }
    }
    asm volatile("s_waitcnt lgkmcnt(0)" ::: "memory");
}
constexpr int CV_IN = DEPTH * 16 * 24, CV_OUT = DEPTH * 16 * 16, CV_G = DEPTH * 2 * 2 * NH, CV_P = DEPTH * 4 * 4, CV_1 = DEPTH * NE * 16 * 32, CV_2 = DEPTH * NE * 16 * 16;
constexpr int CV_ITEMS = CV_IN + CV_OUT + CV_G + CV_P + CV_1 + CV_2;
__device__ __forceinline__ CvtItem cvt_decode(const P& p, int r) {
    CvtItem it; it.f8 = 0; it.scale = 1.0f;
    if (r < CV_IN) { const int l = r / 384, q = r % 384, kb = q / 24, nb = q % 24;
        it.src = p.in[I_WIN] + (size_t)l * D * DIN + (size_t)(64 * kb) * DIN + 64 * nb; it.N = DIN; it.Kp = D; it.dst = p.ws + WS_WIN + (((size_t)l * DIN + 64 * nb) * D + 64 * kb) * 2; return it; }
    r -= CV_IN;
    if (r < CV_OUT) { const int l = r / 256, q = r % 256, kb = q / 16, nb = q % 16;
        it.src = p.in[I_WOUT] + (size_t)l * D * D + (size_t)(64 * kb) * D + 64 * nb; it.N = D; it.Kp = D; it.dst = p.ws + WS_WOUT + (((size_t)l * D + 64 * nb) * D + 64 * kb) * 2; return it; }
    r -= CV_OUT;
    if (r < CV_G) {
        const int h = r % NH, gt = (r / NH) % 2, d = (r / (NH * 2)) % 2, l = r / (NH * 4);
        it.src = (gt ? p.in[I_GXW] : p.in[I_GAW]) + ((size_t)(l * 2 + d) * NH + h) * HD * HD; it.N = HD; it.Kp = HD;
        it.dst = p.ws + WS_WG + (((size_t)(l * NH + h) * 256 + (d * 2 + gt) * 64) * HD) * 2; return it; }
    r -= CV_G;
    if (r < CV_P) {
        const int nb = r % 2, kb = (r / 2) % 2, lg = r / 4;
        it.src = p.in[I_POOLW] + (size_t)lg * 128 * 128 + (size_t)(64 * kb) * 128 + 64 * nb; it.N = 128; it.Kp = 128; it.dst = p.ws + WS_WP + (((size_t)lg * 128 + 64 * nb) * 128 + 64 * kb) * 2; return it; }
    r -= CV_P;
    it.f8 = 1;
    if (r < CV_1) {
        const int le = r / 512, q = r % 512, kb = q / 32, nb = q % 32;
        const int n0 = 64 * nb, j0 = n0 % DF, half = n0 / DF, row0 = (j0 / 128) * 256 + half * 128 + (j0 % 128);
        it.src = p.in[I_W1] + (size_t)le * D * 2 * DF + (size_t)(64 * kb) * (2 * DF) + n0; it.N = 2 * DF; it.Kp = D; it.scale = (float)(1 << W1_SH);
        it.dst = p.ws + WS_W1T + ((size_t)le * 2 * DF + row0) * D + 64 * kb; return it; }
    r -= CV_1;
    { const int le = r / 256, q = r % 256, kb = q / 16, nb = q % 16;
      it.src = p.in[I_W2] + (size_t)le * DF * D + (size_t)(64 * kb) * D + 64 * nb; it.N = D; it.Kp = DF; it.scale = (float)(1 << W2_SH);
      it.dst = p.ws + WS_W2T + ((size_t)le * D + 64 * nb) * DF + 64 * kb; }
    return it;
}
__device__ __forceinline__ void convert_weights(const P& p, LAS unsigned char* lds, int gw, int ngw, int wave, int lane) {
    LAS float* scr = (LAS float*)(lds + wave * 16384);
    int r = gw;
    if (r >= CV_ITEMS) return;
    CvtItem cur = cvt_decode(p, r);
    f32x4 v[16], vn[16];
    tile_load(cur, lane, v);
    for (;;) {
        const int rn = r + ngw; const bool more = rn < CV_ITEMS;
        CvtItem nxt = cur;
        if (more) { nxt = cvt_decode(p, rn); tile_load(nxt, lane, vn); }
        tile_store(cur, v, scr, lane);
        if (!more) break;
#pragma unroll
        for (int i = 0; i < 16; ++i) v[i] = vn[i];
        cur = nxt; r = rn;
    }
}

namespace pg8 {
typedef short bf16x8 __attribute__((ext_vector_type(8)));
constexpr int BM = 256, BK = 64, HALF = 128, HTB = HALF * BK * 2, STAGE_BYTES = 8 * HTB;
template <int XB> __host__ __device__ __forceinline__ int lds_byte(int r, int c) { const int st = (r >> 4) * 2 + (c >> 5), rr = r & 15, cc = c & 31, ob = rr * 64 + cc * 2; return st * 1024 + (ob ^ (((ob >> 9) & 1) << XB)); }
template <int XB> __host__ __device__ __forceinline__ void stage_rc(int b, int& R, int& C) { const int st = b / 1024, sb = b % 1024, swz = sb ^ (((sb >> 9) & 1) << XB); R = (st >> 1) * 16 + swz / 64; C = (st & 1) * 32 + (swz % 64) / 2; }
__host__ __device__ __forceinline__ int perm32(int rho) { const int n = rho >> 4, i = rho & 15; return 8 * (i >> 2) + 4 * n + (i & 3); }
__device__ __forceinline__ unsigned cvt_pk_bf16(float lo, float hi) { unsigned r; asm volatile("v_cvt_pk_bf16_f32 %0, %1, %2" : "=v"(r) : "v"(lo), "v"(hi)); return r; }

struct Unit { int a0, nvalid, b0, o0, pn, e, g0; };

template <bool F8, class Sched, class Epi>
__device__ __forceinline__ void gemm_phase(LAS unsigned char* lds, int tid, const void* Abase_, const void* Bt_, const Sched& S, const Epi& E) {
    constexpr int RP = F8 ? 1024 : 2048, nt = F8 ? 8 : 16;
    const int wid = __builtin_amdgcn_readfirstlane(tid >> 6), lane = tid & 63, wr = wid >> 2, wc = wid & 3, fr = lane & 15, fq = lane >> 4;
    unsigned voffA, voffB;
    { int R, C; stage_rc<F8 ? 4 : 5>(tid * 16, R, C); const int Rb = (R & ~31) + perm32(R & 31); voffA = (unsigned)(R * RP + 2 * C); voffB = (unsigned)(Rb * RP + 2 * C); }
    constexpr size_t kstep = (size_t)(BK * 2);
    constexpr size_t hstep = (size_t)HALF * RP;
    const unsigned ldsw = (unsigned)wid * 1024u;
    const int aoff = F8 ? lds_byte<4>(wr * 64 + fr, fq * 16) : lds_byte<5>(wr * 64 + fr, fq * 8), boff = F8 ? lds_byte<4>(wc * 32 + fr, fq * 16) : lds_byte<5>(wc * 32 + fr, fq * 8);
    const int one_scale = 0x7F7F7F7F;
#define PG8_SA(b, h) (((b) * 2 + (h)) * HTB)
#define PG8_SB(b, h) ((4 + (b) * 2 + (h)) * HTB)
#define PG8_STAGE(bufoff, gbase, voff) do { _Pragma("unroll") for (int _i = 0; _i < 2; ++_i) { unsigned _vo = (voff); asm volatile("" : "+v"(_vo)); \
        __builtin_amdgcn_global_load_lds((const unsigned*)((const char*)(gbase) + (size_t)_i * (64 * RP) + _vo), (LAS unsigned*)(lds + (bufoff) + ldsw + _i * 8192), 16, 0, 0); } } while (0)
#define PG8_LD8(base, off) __builtin_bit_cast(i32x8, __builtin_shufflevector(*(const LAS u32x4*)((base) + (off)), *(const LAS u32x4*)((base) + ((off) ^ 16)), 0, 1, 2, 3, 4, 5, 6, 7))
#define PG8_LDA(dst, b, h) do { _Pragma("unroll") for (int m = 0; m < 4; ++m) { \
        if constexpr (F8) dst##8[m] = PG8_LD8(lds + PG8_SA(b, h) + m * 2048, aoff); \
        else { _Pragma("unroll") for (int k = 0; k < 2; ++k) dst[m][k] = *(const LAS bf16x8*)(lds + PG8_SA(b, h) + aoff + m * 2048 + k * 1024); } } } while (0)
#define PG8_LDB(dst, b, h) do { _Pragma("unroll") for (int n = 0; n < 2; ++n) { \
        if constexpr (F8) dst##8[n] = PG8_LD8(lds + PG8_SB(b, h) + n * 2048, boff); \
        else { _Pragma("unroll") for (int k = 0; k < 2; ++k) dst[n][k] = *(const LAS bf16x8*)(lds + PG8_SB(b, h) + boff + n * 2048 + k * 1024); } } } while (0)
#define PG8_MMA(ai, bj, At, Bt) do { __builtin_amdgcn_s_setprio(1); _Pragma("unroll") for (int m = 0; m < 4; ++m) _Pragma("unroll") for (int n = 0; n < 2; ++n) { \
        if constexpr (F8) acc[ai][bj][m][n] = __builtin_amdgcn_mfma_scale_f32_16x16x128_f8f6f4(Bt##8[n], At##8[m], acc[ai][bj][m][n], 0, 0, 0, one_scale, 0, one_scale); \
        else { _Pragma("unroll") for (int k = 0; k < 2; ++k) acc[ai][bj][m][n] = __builtin_amdgcn_mfma_f32_16x16x32_bf16(Bt[n][k], At[m][k], acc[ai][bj][m][n], 0, 0, 0); } } \
        __builtin_amdgcn_s_setprio(0); } while (0)
#define PG8_WAIT_V(n) asm volatile("s_waitcnt vmcnt(" #n ")" ::: "memory")
#define PG8_WAIT_L(n) asm volatile("s_waitcnt lgkmcnt(" #n ")" ::: "memory")
#define PG8_BAR __builtin_amdgcn_s_barrier()
#define PG8_SCHED __builtin_amdgcn_sched_barrier(0)
    Unit cur, nxt; int ui = 0;
    if (!S.next(0, cur)) return;
    f32x4 acc[2][2][4][2];
#pragma unroll
    for (int a = 0; a < 2; ++a)
#pragma unroll
        for (int b = 0; b < 2; ++b)
#pragma unroll
            for (int m = 0; m < 4; ++m)
#pragma unroll
                for (int n = 0; n < 2; ++n) acc[a][b][m][n] = (f32x4){0.f, 0.f, 0.f, 0.f};
    bf16x8 At[4][2], B0[2][2], B1[2][2];
    i32x8 At8[4], B08[2], B18[2];
    const char* cA = (const char*)Abase_ + (size_t)cur.a0 * RP; const char* cB = (const char*)Bt_ + (size_t)cur.b0 * RP;
    PG8_STAGE(PG8_SB(0, 0), cB, voffB); PG8_STAGE(PG8_SB(0, 1), cB + hstep, voffB); PG8_STAGE(PG8_SA(0, 0), cA, voffA); PG8_STAGE(PG8_SA(0, 1), cA + hstep, voffA);
    if (wr == 1) PG8_BAR;
    PG8_WAIT_V(2); PG8_BAR;
    PG8_STAGE(PG8_SB(1, 0), cB + kstep, voffB); PG8_STAGE(PG8_SA(1, 0), cA + kstep, voffA); PG8_STAGE(PG8_SB(1, 1), cB + hstep + kstep, voffB);
    PG8_WAIT_V(6); PG8_BAR;
    for (;;) {
        const bool has_next = S.next(ui + 1, nxt);
        const char* nA = has_next ? (const char*)Abase_ + (size_t)nxt.a0 * RP : cA; const char* nB = has_next ? (const char*)Bt_ + (size_t)nxt.b0 * RP : cB;
#pragma unroll 1
        for (int t = 0; t < nt; t += 2) {
            const bool last = (t == nt - 2);
            const char* a1 = cA + (size_t)(t + 1) * kstep;
            const char* a2 = last ? nA : cA + (size_t)(t + 2) * kstep; const char* b2 = last ? nB : cB + (size_t)(t + 2) * kstep;
            const char* a3 = a2 + kstep; const char* b3 = b2 + kstep;
            PG8_LDB(B0, 0, 0); PG8_LDB(B1, 0, 1); PG8_SCHED; PG8_LDA(At, 0, 0); PG8_STAGE(PG8_SA(1, 1), a1 + hstep, voffA);
            PG8_WAIT_V(8); PG8_WAIT_L(0); PG8_BAR; PG8_MMA(0, 0, At, B0); PG8_MMA(0, 1, At, B1); PG8_BAR; PG8_SCHED;
            PG8_LDA(At, 0, 1); PG8_STAGE(PG8_SB(0, 0), b2, voffB); PG8_STAGE(PG8_SB(0, 1), b2 + hstep, voffB); PG8_STAGE(PG8_SA(0, 0), a2, voffA);
            PG8_WAIT_V(8); PG8_WAIT_L(0); PG8_BAR; PG8_MMA(1, 0, At, B0); PG8_MMA(1, 1, At, B1); PG8_BAR; PG8_SCHED;
            PG8_LDB(B0, 1, 0); PG8_LDB(B1, 1, 1); PG8_SCHED; PG8_LDA(At, 1, 0); PG8_STAGE(PG8_SA(0, 1), a2 + hstep, voffA);
            PG8_WAIT_V(8); PG8_WAIT_L(0); PG8_BAR; PG8_MMA(0, 0, At, B0); PG8_MMA(0, 1, At, B1); PG8_BAR; PG8_SCHED;
            PG8_LDA(At, 1, 1); PG8_STAGE(PG8_SB(1, 0), b3, voffB); PG8_STAGE(PG8_SB(1, 1), b3 + hstep, voffB); PG8_STAGE(PG8_SA(1, 0), a3, voffA);
            PG8_WAIT_V(8); PG8_WAIT_L(0); PG8_BAR; PG8_MMA(1, 0, At, B0); PG8_MMA(1, 1, At, B1); PG8_BAR; PG8_SCHED;
        }
        if (wr == 0) PG8_BAR;
        PG8_SCHED; { int fr_ = fr, fq_ = fq; asm volatile("" : "+v"(fr_), "+v"(fq_)); E(acc, cur, wr, wc, fr_, fq_); } PG8_SCHED;
        if (!has_next) break;
#pragma unroll
        for (int a = 0; a < 2; ++a)
#pragma unroll
            for (int b = 0; b < 2; ++b)
#pragma unroll
                for (int m = 0; m < 4; ++m)
#pragma unroll
                    for (int n = 0; n < 2; ++n) acc[a][b][m][n] = (f32x4){0.f, 0.f, 0.f, 0.f};
        cur = nxt; cA = nA; cB = nB; ++ui;
        if (wr == 1) PG8_BAR;
    }
    PG8_WAIT_V(0);
    PG8_BAR;
#undef PG8_SA
#undef PG8_SB
#undef PG8_STAGE
#undef PG8_LDA
#undef PG8_LDB
#undef PG8_MMA
#undef PG8_LD8
#undef PG8_WAIT_V
#undef PG8_WAIT_L
#undef PG8_BAR
#undef PG8_SCHED
}

struct DenseOrder {
    int nM, nN, nwg, G, c;
    __device__ void init(int nM_, int nN_, int G_, int c_) { nM = nM_; nN = nN_; nwg = nM * nN; G = G_; c = c_; }
    __device__ bool next(int i, Unit& u) const {
        const long L = (long)i * G + c; if (L >= nwg) return false;
        int wgid = (int)L; { const int q = nwg / 8, r = nwg % 8, xcd = wgid % 8, off = wgid / 8; wgid = (xcd < r ? xcd * (q + 1) : r * (q + 1) + (xcd - r) * q) + off; }
        const int nig = 8 * nN, gid = wgid / nig, fm = gid * 8, gsz = (nM - fm) < 8 ? (nM - fm) : 8;
        const int pm = fm + ((wgid % nig) % gsz), pn = (wgid % nig) / gsz;
        u.a0 = pm * 256; u.nvalid = 256; u.b0 = pn * 256; u.o0 = pm * 256; u.pn = pn; u.e = 0; u.g0 = 0; return true;
    }
};
template <int NPN, bool UP> struct MoeOrder {
    const LAS int* tb; const int* cnt; int G, c;
    __device__ bool next(int i, Unit& u) const {
        const int L = i * G + c; const int total = tb[32] * NPN; if (L >= total) return false;
        int e = 0;
#pragma unroll 1
        for (int q = 16; q >= 1; q >>= 1) if (tb[e + q] * NPN <= L) e += q;
        const int te = tb[e + 1] - tb[e], j = L - tb[e] * NPN, pn = j / te, mt = j % te;
        const int ce = cnt[e];
        u.e = e; u.pn = pn; u.o0 = (tb[e] + mt) * 256; u.nvalid = min(256, ce - mt * 256);
        u.g0 = e * TT + mt * 256;
        u.a0 = UP ? u.g0 : u.o0;
        u.b0 = e * (UP ? 2 * DF : D) + pn * 256;
        return true;
    }
};

struct EpiStore {
    bf16* C; int ldc;
    __device__ __forceinline__ void operator()(const f32x4 (&acc)[2][2][4][2], const Unit& u, int wr, int wc, int fr, int fq) const {
        const int row0 = u.o0 + wr * 64 + fr, col0 = u.pn * 256 + wc * 32 + 8 * fq;
#pragma unroll
        for (int ai = 0; ai < 2; ++ai)
#pragma unroll
            for (int m = 0; m < 4; ++m) { bf16* rowp = C + (size_t)(row0 + ai * HALF + m * 16) * ldc + col0;
#pragma unroll
                for (int bj = 0; bj < 2; ++bj) { const f32x4 v0 = acc[ai][bj][m][0], v1 = acc[ai][bj][m][1];
                    u32x4 w; w.x = cvt_pk_bf16(v0[0], v0[1]); w.y = cvt_pk_bf16(v0[2], v0[3]); w.z = cvt_pk_bf16(v1[0], v1[1]); w.w = cvt_pk_bf16(v1[2], v1[3]);
                    *(u32x4*)(rowp + bj * HALF) = w; } }
    }
};
struct EpiSwiglu {
    fp8* C; const float* b1;
    __device__ __forceinline__ void operator()(const f32x4 (&acc)[2][2][4][2], const Unit& u, int wr, int wc, int fr, int fq) const {
        const int row0 = u.o0 + wr * 64 + fr, j0 = u.pn * 128 + wc * 32 + 8 * fq;
        const float* bb = b1 + (size_t)u.e * 2 * DF + j0;
        const f32x4 bg0 = *(const f32x4*)bb, bg1 = *(const f32x4*)(bb + 4), bl0 = *(const f32x4*)(bb + DF), bl1 = *(const f32x4*)(bb + DF + 4);
#pragma unroll
        for (int ai = 0; ai < 2; ++ai)
#pragma unroll
            for (int m = 0; m < 4; ++m) {
                float o[8];
#pragma unroll
                for (int n = 0; n < 2; ++n)
#pragma unroll
                    for (int q = 0; q < 4; ++q) {
                        constexpr float ws = 1.0f / (float)(1 << W1_SH);
                        const float gl = fminf(fmaf(acc[ai][0][m][n][q], ws, n ? bg1[q] : bg0[q]), 7.0f);
                        const float li = fminf(fmaxf(fmaf(acc[ai][1][m][n][q], ws, n ? bl1[q] : bl0[q]), -7.0f), 7.0f);
                        o[4 * n + q] = gl * __builtin_amdgcn_rcpf(1.0f + __expf(-1.702f * gl)) * (li + 1.0f);
                    }
                int w0 = 0, w1 = 0;
                w0 = __builtin_amdgcn_cvt_pk_fp8_f32(o[0], o[1], w0, false); w0 = __builtin_amdgcn_cvt_pk_fp8_f32(o[2], o[3], w0, true);
                w1 = __builtin_amdgcn_cvt_pk_fp8_f32(o[4], o[5], w1, false); w1 = __builtin_amdgcn_cvt_pk_fp8_f32(o[6], o[7], w1, true);
                *(u32x2*)(C + (size_t)(row0 + ai * HALF + m * 16) * DF + j0) = (u32x2){(unsigned)w0, (unsigned)w1};
            }
    }
};
struct EpiDown {
    bf16* C; const float* b2; const int* rowdst;
    __device__ __forceinline__ void operator()(const f32x4 (&acc)[2][2][4][2], const Unit& u, int wr, int wc, int fr, int fq) const {
        const int rt0 = wr * 64 + fr, col0 = u.pn * 256 + wc * 32 + 8 * fq;
        const float* bp = b2 + (size_t)u.e * D + col0;
        int dst[2][4];
#pragma unroll
        for (int ai = 0; ai < 2; ++ai)
#pragma unroll
            for (int m = 0; m < 4; ++m) { const int rt = rt0 + ai * HALF + m * 16; dst[ai][m] = rowdst[u.g0 + min(rt, u.nvalid - 1)]; if (rt >= u.nvalid) dst[ai][m] = -1; }
        constexpr float ws = 1.0f / (float)(1 << W2_SH);
#pragma unroll
        for (int bj = 0; bj < 2; ++bj) {
            const f32x4 bv0 = *(const f32x4*)(bp + bj * HALF), bv1 = *(const f32x4*)(bp + bj * HALF + 4);
#pragma unroll
            for (int ai = 0; ai < 2; ++ai)
#pragma unroll
                for (int m = 0; m < 4; ++m) {
                    const f32x4 v0 = acc[ai][bj][m][0] * ws + bv0, v1 = acc[ai][bj][m][1] * ws + bv1;
                    u32x4 w; w.x = cvt_pk_bf16(v0[0], v0[1]); w.y = cvt_pk_bf16(v0[2], v0[3]); w.z = cvt_pk_bf16(v1[0], v1[1]); w.w = cvt_pk_bf16(v1[2], v1[3]);
                    if (dst[ai][m] >= 0) *(u32x4*)(C + (size_t)dst[ai][m] * D + col0 + bj * HALF) = w;
                }
        }
    }
};
}

#define XB_TMO      128
#define XB_XCNT(j)  (256  + 64 * (j))
#define XB_XSUB(j)  (1280 + 64 * (j))
#define XB_XGEN(j)  (2304 + 64 * (j))
#define XB_TOP      3328
#define XB_TOPGEN   3392
#define XCD_BAR_WORDS 3456
#define XB_SPIN_CAP (1u << 18)
__device__ __forceinline__ unsigned xb_ld(unsigned* p)              { return __hip_atomic_load(p, __ATOMIC_RELAXED, __HIP_MEMORY_SCOPE_AGENT); }
__device__ __forceinline__ unsigned xb_add(unsigned* p, unsigned v) { return __hip_atomic_fetch_add(p, v, __ATOMIC_RELAXED, __HIP_MEMORY_SCOPE_AGENT); }
__device__ __forceinline__ unsigned xb_xcc_id() { return (unsigned)__builtin_amdgcn_s_getreg((3 << 11) | 20) & 0xFu; }
#define XB_SPIN(cond, bar) do { unsigned _sp = 0; while (cond) { __builtin_amdgcn_s_sleep(1); \
    if ((++_sp & 255u) == 0u) { if (xb_ld(&(bar)[XB_TMO])) break; if (_sp > XB_SPIN_CAP) { atomicAdd(&(bar)[XB_TMO], 1u); break; } } } } while (0)
struct XcdBarrier { unsigned* bar; unsigned x; volatile LAS unsigned* st; };
__device__ __forceinline__ XcdBarrier xcd_barrier_post(unsigned* bar, volatile LAS unsigned* st) {
    XcdBarrier b; b.bar = bar; b.x = xb_xcc_id(); b.st = st;
    if (threadIdx.x == 0) (void)xb_add(&bar[XB_XCNT(b.x)], 1u);
    return b;
}
__device__ __forceinline__ void xcd_barrier_complete(unsigned* bar, unsigned x, unsigned& nloc, unsigned& nx) {
    const unsigned G = gridDim.x * gridDim.y * gridDim.z;
    unsigned sum, cnt, mine, sp = 0u;
    for (;;) {
        sum = 0u; cnt = 0u; mine = 0u;
#pragma unroll
        for (unsigned j = 0; j < 16; ++j) { const unsigned c = xb_ld(&bar[XB_XCNT(j)]); sum += c; cnt += (c > 0u) ? 1u : 0u; mine = (j == x) ? c : mine; }
        if (sum == G) break;
        __builtin_amdgcn_s_sleep(1);
        if ((++sp & 255u) == 0u) { if (xb_ld(&bar[XB_TMO])) break; if (sp > XB_SPIN_CAP) { atomicAdd(&bar[XB_TMO], 1u); break; } }
    }
    nloc = mine > 0u ? mine : 1u; nx = cnt > 0u ? cnt : 1u;
}
__device__ __forceinline__ void xcd_barrier(const XcdBarrier& b, bool leader) {
    asm volatile("s_waitcnt vmcnt(0)" ::: "memory");
    __syncthreads();
    if (leader) {
        unsigned* bar = b.bar;
        __builtin_amdgcn_s_waitcnt(0);
        unsigned nloc = b.st[0], nx = b.st[1];
        if (nloc == 0u) { xcd_barrier_complete(bar, b.x, nloc, nx); b.st[0] = nloc; b.st[1] = nx; }
        const unsigned old = xb_add(&bar[XB_XSUB(b.x)], 1u);
        const unsigned gen = old / nloc;
        if (old + 1u == (gen + 1u) * nloc) {
            __builtin_amdgcn_fence(__ATOMIC_RELEASE, "agent");
            asm volatile("s_waitcnt vmcnt(0)" ::: "memory");
            const unsigned og = xb_add(&bar[XB_TOP], 1u);
            const unsigned tg = og / nx;
            if (og + 1u == (tg + 1u) * nx) xb_add(&bar[XB_TOPGEN], 1u);
            else XB_SPIN(xb_ld(&bar[XB_TOPGEN]) == tg, bar);
            __builtin_amdgcn_fence(__ATOMIC_ACQUIRE, "agent");
            xb_add(&bar[XB_XGEN(b.x)], 1u);
            asm volatile("s_waitcnt vmcnt(0)" ::: "memory");
        } else {
            XB_SPIN(xb_ld(&bar[XB_XGEN(b.x)]) == gen, bar);
            __builtin_amdgcn_fence(__ATOMIC_ACQUIRE, "agent");
            asm volatile("s_waitcnt vmcnt(0)" ::: "memory");
        }
    }
    __syncthreads();
}

constexpr int LDS_BYTES = 147456;
constexpr int LDS_TB = LDS_BYTES - 1024;
constexpr int LDS_MISC = LDS_BYTES - 512;

__device__ __forceinline__ void phase_p0a(const P& p, LAS unsigned char* lds, int bid, int G, int tid, int wave, int lane) {
    { float* POS = (float*)(p.ws + WS_POS);
      for (int i = bid * 512 + tid; i < 64 * 512; i += G * 512) {
          const int n = i / 512, j = i % 512, q = j % 256;
          const float omega = 1.0f / powf(10000.0f, (float)q / 256.0f);
          const float ang = (float)n * omega;
          POS[i] = j < 256 ? sinf(ang) : cosf(ang);
      } }
    { bf16* RWT = (bf16*)(p.ws + WS_RWT);
      for (int i = bid * 512 + tid; i < DEPTH * NE * 128; i += G * 512) {
          const int kc = i % 128, e = (i / 128) % NE, l = i / (128 * NE);
          const float* s = p.in[I_RW] + (size_t)l * D * NE + (size_t)(8 * kc) * NE + e;
          u32x4 o; o.x = pk2(s[0], s[NE]); o.y = pk2(s[2 * NE], s[3 * NE]); o.z = pk2(s[4 * NE], s[5 * NE]); o.w = pk2(s[6 * NE], s[7 * NE]);
          *(u32x4*)(RWT + ((size_t)l * NE + e) * D + 8 * kc) = o;
      } }
    { float* SP = (float*)(p.ws + WS_SP);
      const int gt = bid * 512 + tid, gn = G * 512;
      for (int l = 0; l < DEPTH; ++l) {
          float* o = SP + (size_t)l * SP_STRIDE;
          for (int i = gt; i < 2048; i += gn) o[SP_CW + i] = p.in[I_CONVW][(size_t)l * 2048 + i];
          for (int i = gt; i < 512; i += gn) { o[SP_CB + i] = p.in[I_CONVB][(size_t)l * 512 + i]; o[SP_PB + i] = p.in[I_POOLB][(size_t)l * 512 + i]; o[SP_PS + i] = p.in[I_POOLS][(size_t)l * 512 + i]; }
          for (int i = gt; i < 1024; i += gn) { o[SP_GAB + i] = p.in[I_GAB][(size_t)l * 1024 + i]; o[SP_GXB + i] = p.in[I_GXB][(size_t)l * 1024 + i];
              const float nl = -p.in[I_LAM][(size_t)l * 1024 + i]; o[SP_CC + i] = 8.0f * (nl > 20.f ? nl : log1pf(expf(nl)));
              o[SP_L1G + i] = p.in[I_LN1G][(size_t)l * 1024 + i]; o[SP_L1B + i] = p.in[I_LN1B][(size_t)l * 1024 + i];
              o[SP_L2G + i] = p.in[I_LN2G][(size_t)l * 1024 + i]; o[SP_L2B + i] = p.in[I_LN2B][(size_t)l * 1024 + i]; }
          for (int i = gt; i < 32; i += gn) o[SP_RB + i] = p.in[I_RB][(size_t)l * 32 + i];
          for (int i = gt; i < 32 * 2048; i += gn) o[SP_B1 + i] = p.in[I_B1][(size_t)l * 32 * 2048 + i];
          for (int i = gt; i < 32 * 1024; i += gn) o[SP_B2 + i] = p.in[I_B2][(size_t)l * 32 * 1024 + i];
      } }
    { LAS float* sl = (LAS float*)lds; LAS float* part = sl + 9 * 1024;
      const float* c = p.in[I_C]; const float* cc = p.in[I_CCTX];
      for (int i = tid; i < 9 * 1024; i += 512) { const float v = i < 8192 ? c[i] : cc[i - 8192]; sl[i] = v / (1.0f + __expf(-v)); }
      __syncthreads();
      float* MOD = (float*)(p.ws + WS_MOD);
      for (int u = bid; u < 2 * 96; u += G) {
          const int l = u / 96, n0 = (u % 96) * 64;
          const float* W = p.in[I_WMOD] + (size_t)l * 1024 * 6144 + n0;
          const int c4 = (tid & 15) * 4, ks = tid >> 4;
          f32x4 acc[9];
#pragma unroll
          for (int r = 0; r < 9; ++r) acc[r] = (f32x4){0.f, 0.f, 0.f, 0.f};
#pragma unroll
          for (int half = 0; half < 2; ++half) {
              f32x4 w[16];
#pragma unroll
              for (int kk = 0; kk < 16; ++kk) w[kk] = __builtin_nontemporal_load((const f32x4*)(W + (size_t)(ks * 32 + half * 16 + kk) * 6144 + c4));
#pragma unroll
              for (int kk = 0; kk < 16; ++kk) {
                  const int k = ks * 32 + half * 16 + kk;
#pragma unroll
                  for (int r = 0; r < 9; ++r) acc[r] += w[kk] * sl[r * 1024 + k];
              }
          }
#pragma unroll
          for (int r = 0; r < 9; ++r) *(LAS f32x4*)(part + (ks * 9 + r) * 64 + c4) = acc[r];
          __syncthreads();
          for (int o = tid; o < 9 * 64; o += 512) {
              const int r = o / 64, cl = o % 64; float sum = 0.f;
#pragma unroll
              for (int q = 0; q < 32; ++q) sum += part[(q * 9 + r) * 64 + cl];
              MOD[((size_t)l * 9 + r) * 6144 + n0 + cl] = sum + p.in[I_BMOD][(size_t)l * 6144 + n0 + cl];
          }
          __syncthreads();
      } }
    __syncthreads();
    convert_weights(p, lds, bid * 8 + wave, G * 8, wave, lane);
}

__device__ __forceinline__ void phase_entry(const P& p, int gw, int ngw, int lane) {
    const float* POS = (const float*)(p.ws + WS_POS);
    const float* MOD = (const float*)(p.ws + WS_MOD);
    float* XL = (float*)(p.ws + WS_XL); bf16* H = (bf16*)(p.ws + WS_H);
    for (int tok = gw; tok < TT; tok += ngw) {
        const float* src = tok < TL ? p.in[I_X] + (size_t)tok * D : p.in[I_CTX] + (size_t)(tok - TL) * D;
        f32x4 v[4];
#pragma unroll
        for (int j = 0; j < 4; ++j) v[j] = ((const f32x4*)src)[lane + 64 * j];
        if (tok < TL) {
            const int s = tok & (SEQ - 1), pr = s / GRIDW, pc = s % GRIDW;
#pragma unroll
            for (int j = 0; j < 4; ++j) {
                const float* ps = POS + (size_t)(j < 2 ? pr : pc) * 512 + (4 * lane + 256 * (j & 1));
                v[j] += *(const f32x4*)ps;
            }
        }
        float mean, rstd; ln_stats(v, mean, rstd);
        const float* m = MOD + (size_t)mod_row(tok) * 6144;
        f32x4 h[4];
#pragma unroll
        for (int j = 0; j < 4; ++j) {
            v[j] = (v[j] - mean) * rstd;
            ((f32x4*)(XL + (size_t)tok * D))[lane + 64 * j] = v[j];
            const f32x4 sh = ((const f32x4*)m)[lane + 64 * j], sc = ((const f32x4*)(m + 1024))[lane + 64 * j];
            h[j] = v[j] * (sc + 1.0f) + sh;
        }
        store_bf16_row(H + (size_t)tok * D, lane, h);
    }
}

constexpr float LOG2E = 1.4426950408889634f;
__device__ __forceinline__ float fast_sigmoid(float x) { return __builtin_amdgcn_rcpf(1.0f + __builtin_amdgcn_exp2f(-LOG2E * x)); }
__device__ __forceinline__ int lru_item(int b, int grp, int h, int cb, int wave) { return ((((b * NGRP + grp) * NH + h) * 2 + cb) * 8 + wave); }

template <bool FINAL>
__device__ __forceinline__ void tile_scan(const f32x16& ar, const f32x16& ai, int d, int hh, float cin, float& aggP, float& aggH, float (&hsum)[16]) {
    float oP[4], oH[4];
#pragma unroll
    for (int q = 0; q < 4; ++q) {
        float Pp = 1.f, Hh = 0.f;
#pragma unroll
        for (int jj = 0; jj < 4; ++jj) { const int j = d ? 3 - jj : jj; Hh = ar[4 * q + j] * Hh + ai[4 * q + j]; Pp *= ar[4 * q + j]; }
        oP[q] = Pp; oH[q] = Hh;
    }
    float eP[4], eH[4], xP[4], xH[4];
#pragma unroll
    for (int q = 0; q < 4; ++q) { const float pP = __shfl_xor(oP[q], 32), pH = __shfl_xor(oH[q], 32);
        eP[q] = hh ? pP : oP[q]; eH[q] = hh ? pH : oH[q]; xP[q] = hh ? oP[q] : pP; xH[q] = hh ? oH[q] : pH; }
    float c = cin, pall = 1.f;
    float mine[4];
    if (d == 0) {
#pragma unroll
        for (int q = 0; q < 4; ++q) { const float cE = c; c = eP[q] * c + eH[q]; const float cO = c; c = xP[q] * c + xH[q]; mine[q] = hh ? cO : cE; pall *= eP[q] * xP[q]; }
    } else {
#pragma unroll
        for (int q = 3; q >= 0; --q) { const float cO = c; c = xP[q] * c + xH[q]; const float cE = c; c = eP[q] * c + eH[q]; mine[q] = hh ? cO : cE; pall *= eP[q] * xP[q]; }
    }
    aggP = pall; aggH = c;
    if (FINAL) {
#pragma unroll
        for (int q = 0; q < 4; ++q) { float Hh = mine[q];
#pragma unroll
            for (int jj = 0; jj < 4; ++jj) { const int j = d ? 3 - jj : jj; Hh = ar[4 * q + j] * Hh + ai[4 * q + j]; if (d == 0) hsum[4 * q + j] = Hh; else hsum[4 * q + j] += Hh; } }
    }
}

__device__ __forceinline__ void lru_agg_unit(unsigned char* ws, int l, LAS unsigned char* lds, int b, int grp, int h, int cb, int wave, int lane) {
    asm volatile("" : "+s"(wave)); asm volatile("" : "+v"(lane));
    const bf16* Z = (const bf16*)(ws + WS_Z);
    const int r = lane & 31, hh = lane >> 5;
    int seqbase, len, t0;
    if (grp == 0) { seqbase = TL + b * CTXL; len = CTXL; t0 = wave * 32; } else { seqbase = b * SEQ; len = SEQ; t0 = (grp - 1) * 256 + wave * 32; }
    const int t = t0 + r;
    const float* SP = (const float*)(ws + WS_SP) + (size_t)l * SP_STRIDE;
    const float* cw = SP + SP_CW; const float* cbias = SP + SP_CB;
    bf16x8 Af[4];
#pragma unroll
    for (int s = 0; s < 4; ++s) {
        const int c0 = 64 * h + 16 * s + 8 * hh;
        const f32x4 b0 = *(const f32x4*)(cbias + c0), b1 = *(const f32x4*)(cbias + c0 + 4);
        float u[8] = {b0.x, b0.y, b0.z, b0.w, b1.x, b1.y, b1.z, b1.w};
#pragma unroll
        for (int k = 0; k < 4; ++k) {
            const int tt = t + k - 2;
            u32x4 raw = (u32x4){0u, 0u, 0u, 0u};
            if (tt >= 0 && tt < len) raw = *(const u32x4*)(Z + (size_t)(seqbase + tt) * DIN + c0);
            const f32x4 w0 = *(const f32x4*)(cw + k * DLRU + c0), w1 = *(const f32x4*)(cw + k * DLRU + c0 + 4);
            u[0] += w0.x * bflo(raw.x); u[1] += w0.y * bfhi(raw.x); u[2] += w0.z * bflo(raw.y); u[3] += w0.w * bfhi(raw.y);
            u[4] += w1.x * bflo(raw.z); u[5] += w1.y * bfhi(raw.z); u[6] += w1.z * bflo(raw.w); u[7] += w1.w * bfhi(raw.w);
        }
        u32x4 pk; pk.x = pg8::cvt_pk_bf16(u[0], u[1]); pk.y = pg8::cvt_pk_bf16(u[2], u[3]); pk.z = pg8::cvt_pk_bf16(u[4], u[5]); pk.w = pg8::cvt_pk_bf16(u[6], u[7]);
        Af[s] = __builtin_bit_cast(bf16x8, pk);
        asm volatile("" ::: "memory");
    }
    const bf16* WG = (const bf16*)(ws + WS_WG) + (size_t)(l * NH + h) * 256 * HD;
    f32x16 accu;
#pragma unroll
    for (int i = 0; i < 16; ++i) accu[i] = 0.f;
    { const int nn = 32 * cb + r;
#pragma unroll
      for (int s = 0; s < 4; ++s) {
          u32x4 w = (u32x4){0u, 0u, 0u, 0u};
          if ((nn >> 4) == s && ((nn >> 3) & 1) == hh) { const unsigned one = 0x3F80u << (16 * (nn & 1)); const int wi = (nn & 7) >> 1;
              w.x = wi == 0 ? one : 0u; w.y = wi == 1 ? one : 0u; w.z = wi == 2 ? one : 0u; w.w = wi == 3 ? one : 0u; }
          accu = __builtin_amdgcn_mfma_f32_32x32x16_bf16(Af[s], __builtin_bit_cast(bf16x8, w), accu, 0, 0, 0);
      } }
    const int ch = 64 * h + 32 * cb + r;
    u32x4* YB = (u32x4*)(ws + WS_YB) + (size_t)lru_item(b, grp, h, cb, wave) * 8 * 64 + lane;
    float aggP[2], aggH[2];
    float hdummy[16];
#pragma unroll
    for (int d = 0; d < 2; ++d) {
        f32x16 ar, ai;
#pragma unroll
        for (int i = 0; i < 16; ++i) { ar[i] = 0.f; ai[i] = 0.f; }
        { const bf16* wr_ = WG + (size_t)((2 * d) * 64 + 32 * cb + r) * HD + 8 * hh; const bf16* wi_ = wr_ + 64 * HD;
#pragma unroll
          for (int s = 0; s < 4; ++s) { const bf16x8 Bf = *(const bf16x8*)(wr_ + 16 * s); ar = __builtin_amdgcn_mfma_f32_32x32x16_bf16(Af[s], Bf, ar, 0, 0, 0); }
#pragma unroll
          for (int s = 0; s < 4; ++s) { const bf16x8 Bf = *(const bf16x8*)(wi_ + 16 * s); ai = __builtin_amdgcn_mfma_f32_32x32x16_bf16(Af[s], Bf, ai, 0, 0, 0); } }
        const float ba = SP[SP_GAB + d * DLRU + ch], bx = SP[SP_GXB + d * DLRU + ch], cc = SP[SP_CC + d * DLRU + ch];
#pragma unroll
        for (int q = 0; q < 4; ++q) {
            u32x4 wq;
#pragma unroll
            for (int j = 0; j < 4; ++j) { const int i = 4 * q + j;
                const float rr = fast_sigmoid(ar[i] + ba), ig = fast_sigmoid(ai[i] + bx);
                const float y = cc * rr;
                const float a0 = __builtin_amdgcn_exp2f(-LOG2E * y);
                const float bt = __builtin_amdgcn_sqrtf(fmaf(-a0, a0, 1.0f)) * (ig * accu[i]);
                const unsigned w = pg8::cvt_pk_bf16(y, bt);
                wq[j] = w;
                ar[i] = __builtin_amdgcn_exp2f(-LOG2E * bflo(w)); ai[i] = bfhi(w);
            }
            YB[(d * 4 + q) * 64] = wq;
            __builtin_amdgcn_sched_barrier(0);
        }
        tile_scan<false>(ar, ai, d, hh, 0.f, aggP[d], aggH[d], hdummy);
        __builtin_amdgcn_sched_barrier(0);
    }
    f32x2* AT = (f32x2*)(ws + WS_AGGT); f32x2* AG = (f32x2*)(ws + WS_AGGG);
    LAS f32x2* la = (LAS f32x2*)lds;
    if (hh == 0) {
#pragma unroll
        for (int d = 0; d < 2; ++d) { const f32x2 v = (f32x2){aggP[d], aggH[d]};
            AT[((size_t)(b * NTILE + grp * 8 + wave) * 2 + d) * DLRU + ch] = v; la[(wave * 2 + d) * 32 + r] = v; }
    }
    __syncthreads();
    if (wave == 0) {
        const int d = hh; float Pp = 1.f, Hh = 0.f;
#pragma unroll
        for (int i = 0; i < 8; ++i) { const int w = d ? 7 - i : i; const f32x2 v = la[(w * 2 + d) * 32 + r]; Hh = v.x * Hh + v.y; Pp *= v.x; }
        AG[((size_t)(b * NGRP + grp) * 2 + d) * DLRU + ch] = (f32x2){Pp, Hh};
    }
    __syncthreads();
}

__device__ __forceinline__ void lru_final_unit(unsigned char* ws, int l, int b, int grp, int h, int cb, int wave, int lane) {
    asm volatile("" : "+s"(wave)); asm volatile("" : "+v"(lane));
    const bf16* Z = (const bf16*)(ws + WS_Z);
    const int r = lane & 31, hh = lane >> 5;
    int seqbase, t0;
    if (grp == 0) { seqbase = TL + b * CTXL; t0 = wave * 32; } else { seqbase = b * SEQ; t0 = (grp - 1) * 256 + wave * 32; }
    const int ch = 64 * h + 32 * cb + r;
    const u32x4* YB = (const u32x4*)(ws + WS_YB) + (size_t)lru_item(b, grp, h, cb, wave) * 8 * 64 + lane;
    u32x4 W[8];
#pragma unroll
    for (int j = 0; j < 8; ++j) W[j] = YB[j * 64];
    unsigned short yg[16];
#pragma unroll
    for (int i = 0; i < 16; ++i) { const int row = (i & 3) + 8 * (i >> 2) + 4 * hh; yg[i] = Z[(size_t)(seqbase + t0 + row) * DIN + DLRU + ch]; }
    float C0, C1;
    {
        const f32x2* AGGT = (const f32x2*)(ws + WS_AGGT); const f32x2* AGGG = (const f32x2*)(ws + WS_AGGG);
        float c = 0.f;
        const int d = hh;
        if (grp > 0) {
            { const f32x2 g0 = AGGG[((size_t)(b * NGRP + 0) * 2 + d) * DLRU + ch]; c = g0.y; }
            f32x2 gv[7];
#pragma unroll
            for (int i = 0; i < 7; ++i) { const int g = d ? 8 - i : 1 + i; const bool valid = d ? (i < 8 - grp) : (i < grp - 1);
                gv[i] = valid ? AGGG[((size_t)(b * NGRP + g) * 2 + d) * DLRU + ch] : (f32x2){1.f, 0.f}; }
#pragma unroll
            for (int i = 0; i < 7; ++i) c = gv[i].x * c + gv[i].y;
        }
        f32x2 tv[7];
#pragma unroll
        for (int i = 0; i < 7; ++i) { const int tw = d ? 7 - i : i; const bool valid = d ? (i < 7 - wave) : (i < wave);
            tv[i] = valid ? AGGT[((size_t)(b * NTILE + grp * 8 + tw) * 2 + d) * DLRU + ch] : (f32x2){1.f, 0.f}; }
#pragma unroll
        for (int i = 0; i < 7; ++i) c = tv[i].x * c + tv[i].y;
        C0 = __shfl(c, r); C1 = __shfl(c, 32 + r);
    }
    float hsum[16];
#pragma unroll
    for (int d = 0; d < 2; ++d) {
        f32x16 ar, ai;
#pragma unroll
        for (int q = 0; q < 4; ++q)
#pragma unroll
            for (int j = 0; j < 4; ++j) { const unsigned w = W[d * 4 + q][j]; ar[4 * q + j] = __builtin_amdgcn_exp2f(-LOG2E * bflo(w)); ai[4 * q + j] = bfhi(w); }
        float aP, aH;
        tile_scan<true>(ar, ai, d, hh, d ? C1 : C0, aP, aH, hsum);
    }
    bf16* MIX = (bf16*)(ws + WS_MIX);
#pragma unroll
    for (int i = 0; i < 16; ++i) {
        const int row = (i & 3) + 8 * (i >> 2) + 4 * hh;
        MIX[(size_t)(seqbase + t0 + row) * D + ch] = (bf16)f2bf(hsum[i] * gelu_tanh(bf2f(yg[i])));
    }
}

constexpr int PX_PITCH = 528, PD_PITCH = 528;
constexpr int PX_OFF = 0, PD_OFF = 80 * PX_PITCH;
__device__ __forceinline__ void pool_unit(unsigned char* ws, int l, LAS unsigned char* lds, int c, int gp, int tid, int wave, int lane) {
    asm volatile("" : "+s"(wave)); asm volatile("" : "+v"(lane)); asm volatile("" : "+v"(tid));
    const bf16* Z = (const bf16*)(ws + WS_Z); bf16* MIX = (bf16*)(ws + WS_MIX);
    int seqbase, t0, seg_lo, seg_hi;
    if (c < 256) { seqbase = (c >> 5) * SEQ; t0 = (c & 31) * 64; seg_lo = t0; seg_hi = t0 + 64; }
    else { const int cc = c - 256; seqbase = TL + (cc >> 2) * CTXL; t0 = (cc & 3) * 64; seg_lo = 0; seg_hi = CTXL; }
    const int r_lo = max(t0 - 8, seg_lo), r_hi = min(t0 + 72, seg_hi);
    { const int sub = tid >> 5, l32 = tid & 31;
      for (int t = r_lo + sub; t < r_hi; t += 16) {
          const u32x4 v = *(const u32x4*)(Z + (size_t)(seqbase + t) * DIN + 2 * DLRU + 256 * gp + 8 * l32);
          *(LAS u32x4*)(lds + PX_OFF + (t - (t0 - 8)) * PX_PITCH + 16 * l32) = v;
      } }
    __syncthreads();
    { const int cp = tid & 127, tq = tid >> 7;
      const int g = 2 * gp + (cp >> 6);
      const int half = 1 << g;
      const LAS unsigned char* xb = lds + PX_OFF + 4 * cp - (t0 - 8) * PX_PITCH;
      int t = t0 + 16 * tq;
      int lo = max(t - half, seg_lo), hi = min(t + half, seg_hi);
      float s0 = 0.f, s1 = 0.f;
      for (int j = lo; j < hi; ++j) { const unsigned w = *(const LAS unsigned*)(xb + j * PX_PITCH); s0 += bflo(w); s1 += bfhi(w); }
#pragma unroll 4
      for (int i = 0; i < 16; ++i, ++t) {
          const unsigned wx = *(const LAS unsigned*)(xb + t * PX_PITCH);
          const float inv = 1.0f / (float)(hi - lo);
          const float d0 = s0 * inv - bflo(wx), d1 = s1 * inv - bfhi(wx);
          *(LAS unsigned*)(lds + PD_OFF + (t - t0) * PD_PITCH + 4 * cp) = pk2(d0, d1);
          const int nlo = max(t + 1 - half, seg_lo), nhi = min(t + 1 + half, seg_hi);
          if (nhi > hi) { const unsigned w = *(const LAS unsigned*)(xb + hi * PX_PITCH); s0 += bflo(w); s1 += bfhi(w); }
          if (nlo > lo) { const unsigned w = *(const LAS unsigned*)(xb + lo * PX_PITCH); s0 -= bflo(w); s1 -= bfhi(w); }
          lo = nlo; hi = nhi;
      } }
    __syncthreads();
    { const int gl = wave >> 2, th = (wave >> 1) & 1, nh = wave & 1, r = lane & 31, hh = lane >> 5;
      const int g = 2 * gp + gl;
      const bf16* WP = (const bf16*)(ws + WS_WP) + (size_t)(l * 4 + g) * 128 * 128;
      f32x16 acc[2];
#pragma unroll
      for (int q = 0; q < 2; ++q)
#pragma unroll
          for (int i = 0; i < 16; ++i) acc[q][i] = 0.f;
      const LAS unsigned char* arow = lds + PD_OFF + (th * 32 + r) * PD_PITCH + (gl * 128 + 8 * hh) * 2;
#pragma unroll
      for (int s = 0; s < 8; ++s) {
          const bf16x8 Af = *(const LAS bf16x8*)(arow + 32 * s);
#pragma unroll
          for (int nt = 0; nt < 2; ++nt) { const bf16x8 Bf = *(const bf16x8*)(WP + (size_t)(nh * 64 + nt * 32 + r) * 128 + 16 * s + 8 * hh);
              acc[nt] = __builtin_amdgcn_mfma_f32_32x32x16_bf16(Af, Bf, acc[nt], 0, 0, 0); }
      }
#pragma unroll
      for (int nt = 0; nt < 2; ++nt) {
          const int co = 128 * g + 64 * nh + 32 * nt + r;
          const float* SP = (const float*)(ws + WS_SP) + (size_t)l * SP_STRIDE; const float pb = SP[SP_PB + co], ps = SP[SP_PS + co];
#pragma unroll
          for (int i = 0; i < 16; ++i) {
              const int row = (i & 3) + 8 * (i >> 2) + 4 * hh;
              MIX[(size_t)(seqbase + t0 + th * 32 + row) * D + DLRU + co] = (bf16)f2bf((acc[nt][i] + pb) * ps);
          }
      } }
    __syncthreads();
}

constexpr int L1_PITCH = 2064;
constexpr int L1_PART = 16 * L1_PITCH;
constexpr int L1_MAXB = 5;
constexpr int L1_ROWS = L1_PART + 16384 + 256 + L1_MAXB * 64 * 16;
static_assert(L1_ROWS + L1_MAXB * 16 * 1024 <= LDS_TB, "LN1 LDS map");
__device__ __forceinline__ void phase_ln1(unsigned char* ws, int l, LAS unsigned char* lds, int bid, int G, int tid, int wave, int lane) {
    const float* MOD = (const float*)(ws + WS_MOD) + (size_t)l * 9 * 6144;
    float* XL = (float*)(ws + WS_XL); fp8* H8S = (fp8*)(ws + WS_H8S); const bf16* Y1 = (const bf16*)(ws + WS_Y1);
    const float* SP = (const float*)(ws + WS_SP) + (size_t)l * SP_STRIDE;
    const float* lg = SP + SP_L1G; const float* lb = SP + SP_L1B; const float* rb = SP + SP_RB;
    int* cnt = (int*)(ws + WS_CTL) + CW_CNT + 32 * l;
    float* TOPG = (float*)(ws + WS_TOPG); int* ROWDST = (int*)(ws + WS_ROWDST);
    const int ntok = (l == DEPTH - 1) ? TL : TT;
    const bf16* RWT = (const bf16*)(ws + WS_RWT) + (size_t)l * NE * D;
    bf16x8 Bf[4][2];
#pragma unroll
    for (int s = 0; s < 4; ++s)
#pragma unroll
        for (int nt = 0; nt < 2; ++nt) Bf[s][nt] = *(const bf16x8*)(RWT + (size_t)(16 * nt + (lane & 15)) * D + 128 * wave + 32 * s + 8 * (lane >> 4));
    LAS float* part = (LAS float*)(lds + L1_PART);
    LAS int* lcnt = (LAS int*)(lds + L1_PART + 16384);
    LAS int* lbase = lcnt + 32;
    LAS u32x4* ent = (LAS u32x4*)(lds + L1_PART + 16384 + 256);
    if (tid < 32) lcnt[tid] = 0;
    int nb_local = 0;
    __syncthreads();
    f32x4 px[2][4]; u32x2 py[2][4];
#define L1_LOAD(batch_) do { _Pragma("unroll") for (int rr = 0; rr < 2; ++rr) { const int tok_ = (batch_) * 16 + 2 * wave + rr; _Pragma("unroll") for (int j = 0; j < 4; ++j) { \
        px[rr][j] = ((const f32x4*)(XL + (size_t)tok_ * D))[lane + 64 * j]; py[rr][j] = ((const u32x2*)(Y1 + (size_t)tok_ * D))[lane + 64 * j]; } } } while (0)
    if (bid < ntok / 16) L1_LOAD(bid);
    for (int batch = bid; batch < ntok / 16 && nb_local < L1_MAXB; batch += G) {
        f32x4 v[2][4];
#pragma unroll
        for (int rr = 0; rr < 2; ++rr) {
            const int tok = batch * 16 + 2 * wave + rr;
            const float* m = MOD + (size_t)mod_row(tok) * 6144;
#pragma unroll
            for (int j = 0; j < 4; ++j) {
                const f32x4 g1 = ((const f32x4*)(m + 2048))[lane + 64 * j];
                const u32x2 yr = py[rr][j];
                f32x4 y; y.x = bflo(yr.x); y.y = bfhi(yr.x); y.z = bflo(yr.y); y.w = bfhi(yr.y);
                v[rr][j] = px[rr][j] * ALPHA + g1 * y;
            }
        }
        if (batch + G < ntok / 16 && nb_local + 1 < L1_MAXB) L1_LOAD(batch + G);
#pragma unroll
        for (int rr = 0; rr < 2; ++rr) {
            const int trow = 2 * wave + rr, tok = batch * 16 + trow;
            const float* m = MOD + (size_t)mod_row(tok) * 6144;
            f32x4 h[4];
            float mean, rstd; ln_stats(v[rr], mean, rstd);
#pragma unroll
            for (int j = 0; j < 4; ++j) {
                const f32x4 gg = ((const f32x4*)lg)[lane + 64 * j], bb = ((const f32x4*)lb)[lane + 64 * j];
                const f32x4 o = (v[rr][j] - mean) * rstd * gg + bb;
                ((f32x4*)(XL + (size_t)tok * D))[lane + 64 * j] = o;
                const f32x4 sh = ((const f32x4*)(m + 3072))[lane + 64 * j], sc = ((const f32x4*)(m + 4096))[lane + 64 * j];
                h[j] = o * (sc + 1.0f) + sh;
                u32x2 w; w.x = pk2(h[j].x, h[j].y); w.y = pk2(h[j].z, h[j].w);
                int w8 = 0; w8 = __builtin_amdgcn_cvt_pk_fp8_f32(h[j].x, h[j].y, w8, false); w8 = __builtin_amdgcn_cvt_pk_fp8_f32(h[j].z, h[j].w, w8, true);
                *(LAS unsigned*)(lds + L1_ROWS + (nb_local * 16 + trow) * 1024 + (4 * lane + 256 * j)) = (unsigned)w8;
                *(LAS u32x2*)(lds + trow * L1_PITCH + (4 * lane + 256 * j) * 2) = w;
            }
        }
        __syncthreads();
        {
            f32x4 a2[2] = {(f32x4){0.f, 0.f, 0.f, 0.f}, (f32x4){0.f, 0.f, 0.f, 0.f}};
            const LAS unsigned char* arow = lds + (lane & 15) * L1_PITCH + (128 * wave + 8 * (lane >> 4)) * 2;
#pragma unroll
            for (int s = 0; s < 4; ++s) { const bf16x8 Af = *(const LAS bf16x8*)(arow + 64 * s);
#pragma unroll
                for (int nt = 0; nt < 2; ++nt) a2[nt] = __builtin_amdgcn_mfma_f32_16x16x32_bf16(Af, Bf[s][nt], a2[nt], 0, 0, 0); }
#pragma unroll
            for (int nt = 0; nt < 2; ++nt)
#pragma unroll
                for (int i = 0; i < 4; ++i) part[(wave * 16 + 4 * (lane >> 4) + i) * 32 + 16 * nt + (lane & 15)] = a2[nt][i];
        }
        __syncthreads();
        {
            const int trow = tid >> 5, e = tid & 31, tok = batch * 16 + trow;
            float lgt = rb[e];
#pragma unroll
            for (int w = 0; w < 8; ++w) lgt += part[(w * 16 + trow) * 32 + e];
            float tv[4]; int ti[4];
            float cur = lgt;
#pragma unroll
            for (int k = 0; k < 4; ++k) {
                float bv = cur; int bi = e;
#pragma unroll
                for (int o = 1; o < 32; o <<= 1) { const float ov = __shfl_xor(bv, o); const int oi = __shfl_xor(bi, o); if (ov > bv || (ov == bv && oi < bi)) { bv = ov; bi = oi; } }
                tv[k] = bv; ti[k] = bi;
                if (e == bi) cur = -INFINITY;
            }
            const float e1 = __expf(tv[1] - tv[0]), e2 = __expf(tv[2] - tv[0]), e3 = __expf(tv[3] - tv[0]);
            const float inv = 1.0f / (1.0f + e1 + e2 + e3);
            if (e < 4) {
                const int ex = e == 0 ? ti[0] : e == 1 ? ti[1] : e == 2 ? ti[2] : ti[3];
                const float pg = (e == 0 ? 1.0f : e == 1 ? e1 : e == 2 ? e2 : e3) * inv;
                const int ls = __hip_atomic_fetch_add(lcnt + ex, 1, __ATOMIC_RELAXED, __HIP_MEMORY_SCOPE_WORKGROUP);
                const int idx = (nb_local * 16 + trow) * 4 + e;
                ent[idx] = (u32x4){(unsigned)tok, (unsigned)ex, (unsigned)ls, __float_as_uint(pg)};
            }
        }
        ++nb_local;
        __syncthreads();
    }
    if (tid < 32) { const int c = lcnt[tid]; lbase[tid] = c > 0 ? atomicAdd(&cnt[tid], c) : 0; }
    __syncthreads();
    for (int i = wave; i < nb_local * 64; i += 8) {
        const u32x4 en = ent[i]; const int tok = (int)en.x, ex = (int)en.y, slot = lbase[ex] + (int)en.z;
        if (lane == 0) { TOPG[tok * 4 + (i & 3)] = __uint_as_float(en.w); ROWDST[(size_t)ex * TT + slot] = tok * 4 + (i & 3); }
        const u32x4 v = *(const LAS u32x4*)(lds + L1_ROWS + (i >> 2) * 1024 + 16 * lane);
        *(u32x4*)(H8S + ((size_t)ex * TT + slot) * D + 16 * lane) = v;
    }
    __syncthreads();
#undef L1_LOAD
}

__device__ __forceinline__ void phase_ln2(unsigned char* ws, float* out, int l, int gw, int ngw, int lane) {
    const float* MOD = (const float*)(ws + WS_MOD) + (size_t)l * 9 * 6144;
    float* XL = (float*)(ws + WS_XL); bf16* H = (bf16*)(ws + WS_H); const bf16* Y2 = (const bf16*)(ws + WS_Y2); const f32x4* TOPG = (const f32x4*)(ws + WS_TOPG);
    const float* SP = (const float*)(ws + WS_SP) + (size_t)l * SP_STRIDE;
    const float* lg = SP + SP_L2G; const float* lb = SP + SP_L2B;
    const bool last = (l == DEPTH - 1);
    const int ntok = last ? TL : TT;
    for (int tok0 = gw * 2; tok0 < ntok; tok0 += ngw * 2) {
        f32x4 v[2][4]; u32x2 yr[2][4][4]; f32x4 g2[2][4]; f32x4 gk[2];
#pragma unroll
        for (int t = 0; t < 2; ++t) {
            const int tok = tok0 + t;
            const float* m = MOD + (size_t)mod_row(tok) * 6144;
            gk[t] = TOPG[tok];
#pragma unroll
            for (int j = 0; j < 4; ++j) {
                v[t][j] = ((const f32x4*)(XL + (size_t)tok * D))[lane + 64 * j];
                g2[t][j] = ((const f32x4*)(m + 5120))[lane + 64 * j];
#pragma unroll
                for (int k = 0; k < 4; ++k) yr[t][k][j] = ((const u32x2*)(Y2 + ((size_t)tok * 4 + k) * D))[lane + 64 * j];
            }
        }
#pragma unroll
        for (int t = 0; t < 2; ++t) {
            const int tok = tok0 + t;
#pragma unroll
            for (int j = 0; j < 4; ++j) {
                f32x4 f = (f32x4){0.f, 0.f, 0.f, 0.f};
#pragma unroll
                for (int k = 0; k < 4; ++k) { const u32x2 r = yr[t][k][j]; const float g = gk[t][k]; f.x += g * bflo(r.x); f.y += g * bfhi(r.x); f.z += g * bflo(r.y); f.w += g * bfhi(r.y); }
                v[t][j] = v[t][j] * ALPHA + g2[t][j] * f;
            }
            float mean, rstd; ln_stats(v[t], mean, rstd);
            f32x4 h[4];
            const float* mn = MOD + (size_t)9 * 6144 + (size_t)mod_row(tok) * 6144;
#pragma unroll
            for (int j = 0; j < 4; ++j) {
                const f32x4 gg = ((const f32x4*)lg)[lane + 64 * j], bb = ((const f32x4*)lb)[lane + 64 * j];
                const f32x4 o = (v[t][j] - mean) * rstd * gg + bb;
                if (last) ((f32x4*)(out + (size_t)tok * D))[lane + 64 * j] = o;
                else {
                    ((f32x4*)(XL + (size_t)tok * D))[lane + 64 * j] = o;
                    const f32x4 sh = ((const f32x4*)mn)[lane + 64 * j], sc = ((const f32x4*)(mn + 1024))[lane + 64 * j];
                    h[j] = o * (sc + 1.0f) + sh;
                }
            }
            if (!last) store_bf16_row(H + (size_t)tok * D, lane, h);
        }
    }
}

constexpr int NPHASE = 2 + 8 * DEPTH;
#ifndef PHMASK
#define PHMASK 0xFFFF
#endif
#define PH_ON(k) (((PHMASK) >> (k)) & 1)
#ifndef MK_PER_PHASE
#define MK_PER_PHASE 0
#endif
__global__ void __launch_bounds__(512, 2) mk_fwd(P p) {
    extern __shared__ __attribute__((aligned(16))) unsigned char lds_[];
    LAS unsigned char* lds = (LAS unsigned char*)lds_;
    const int tid = threadIdx.x, lane = tid & 63, wave = __builtin_amdgcn_readfirstlane(tid >> 6);
    const int G = gridDim.x, bid = blockIdx.x;
    volatile LAS unsigned* MISC = (volatile LAS unsigned*)(lds + LDS_MISC);
    if (tid < 4) MISC[tid] = 0u;
    __syncthreads();
    unsigned* barw = (unsigned*)(p.ws + WS_CTL) + CW_BAR;
    XcdBarrier bar; bar.bar = barw; bar.x = 0; bar.st = MISC;
    if (!MK_PER_PHASE) bar = xcd_barrier_post(barw, MISC);
    const int lo = p.ph_lo, hi = p.ph_hi;
#define IN(k) (lo <= (k) && (k) < hi)
#define SEAM(k) do { if (IN(k) && IN((k) + 1)) xcd_barrier(bar, wave == 0 && (int)__lane_id() == 0); } while (0)
    if (PH_ON(0) && IN(0)) { phase_p0a(p, lds, bid, G, tid, wave, lane); }
    SEAM(0);
    if (PH_ON(1) && IN(1)) { phase_entry(p, bid * 8 + wave, G * 8, lane); }
    SEAM(1);
#pragma unroll 1
    for (int l = 0; l < DEPTH; ++l) {
        const int pb = 2 + 8 * l;
#define FRESH() int tid_ = wave * 64 + (int)__lane_id(); asm volatile("" : "+v"(tid_)); const int lane_ = tid_ & 63; const int wave_ = __builtin_amdgcn_readfirstlane(tid_ >> 6); \
                size_t wz_ = 0; asm volatile("" : "+s"(wz_)); unsigned char* ws = p.ws + wz_; (void)lane_; (void)wave_
        if (PH_ON(2) && IN(pb + 0)) {
            FRESH();
            pg8::DenseOrder S; S.init(TT / 256, DIN / 256, G, bid);
            pg8::EpiStore E{(bf16*)(ws + WS_Z), DIN};
            pg8::gemm_phase<false>(lds, tid_, ws + WS_H, (const bf16*)(ws + WS_WIN) + (size_t)l * DIN * D, S, E);
        }
        SEAM(pb + 0);
        if (PH_ON(3) && IN(pb + 1)) {
            FRESH();
            for (int u = bid; u < NB * NGRP * NH * 2; u += G) { const int cb = u & 1, h = (u >> 1) & 7, bg = u >> 4; lru_agg_unit(ws, l, lds, bg / NGRP, bg % NGRP, h, cb, wave_, lane_); }
        }
        SEAM(pb + 1);
        if (PH_ON(4) && IN(pb + 2)) {
            FRESH();
            const int g0 = (l == DEPTH - 1) ? 1 : 0, ng = NGRP - g0;
            const int nlru = NB * ng * NH * 2, npool = ((l == DEPTH - 1) ? 256 : 288) * 2;
            for (int u = bid; u < nlru + npool; u += G) {
                if (u < nlru) { const int cb = u & 1, h = (u >> 1) & 7, bg = u >> 4; lru_final_unit(ws, l, bg / ng, g0 + bg % ng, h, cb, wave_, lane_); }
                else { const int q = u - nlru; pool_unit(ws, l, lds, q >> 1, q & 1, tid_, wave_, lane_); }
            }
        }
        SEAM(pb + 2);
        if (PH_ON(5) && IN(pb + 3)) {
            FRESH();
            pg8::DenseOrder S; S.init((l == DEPTH - 1 ? TL : TT) / 256, D / 256, G, bid);
            pg8::EpiStore E{(bf16*)(ws + WS_Y1), D};
            pg8::gemm_phase<false>(lds, tid_, ws + WS_MIX, (const bf16*)(ws + WS_WOUT) + (size_t)l * D * D, S, E);
        }
        SEAM(pb + 3);
        if (PH_ON(6) && IN(pb + 4)) { FRESH(); phase_ln1(ws, l, lds, bid, G, tid_, wave_, lane_); }
        SEAM(pb + 4);
        if (IN(pb + 5) || IN(pb + 6)) {
            FRESH();
            const int* cnt = (const int*)(ws + WS_CTL) + CW_CNT + 32 * l;
            LAS int* tb = (LAS int*)(lds + LDS_TB);
            if (tid_ < 64) { const int c = lane_ < 32 ? (cnt[lane_] + 255) >> 8 : 0; int s = c;
#pragma unroll
                for (int o = 1; o < 32; o <<= 1) { const int t = __shfl_up(s, o); if (lane_ >= o) s += t; }
                if (lane_ < 32) tb[lane_ + 1] = s; if (lane_ == 0) tb[0] = 0; }
            __syncthreads();
        }
        if (PH_ON(7) && IN(pb + 5)) {
            FRESH();
            const int* cnt = (const int*)(ws + WS_CTL) + CW_CNT + 32 * l;
            pg8::MoeOrder<8, true> S{(const LAS int*)(lds + LDS_TB), cnt, G, bid};
            pg8::EpiSwiglu E{(fp8*)(ws + WS_ACT), (const float*)(ws + WS_SP) + (size_t)l * SP_STRIDE + SP_B1};
            pg8::gemm_phase<true>(lds, tid_, ws + WS_H8S, ws + WS_W1T + (size_t)l * NE * 2 * DF * D, S, E);
        }
        SEAM(pb + 5);
        if (PH_ON(8) && IN(pb + 6)) {
            FRESH();
            const int* cnt = (const int*)(ws + WS_CTL) + CW_CNT + 32 * l;
            pg8::MoeOrder<4, false> S{(const LAS int*)(lds + LDS_TB), cnt, G, bid};
            pg8::EpiDown E{(bf16*)(ws + WS_Y2), (const float*)(ws + WS_SP) + (size_t)l * SP_STRIDE + SP_B2, (const int*)(ws + WS_ROWDST)};
            pg8::gemm_phase<true>(lds, tid_, ws + WS_ACT, ws + WS_W2T + (size_t)l * NE * D * DF, S, E);
        }
        SEAM(pb + 6);
        if (PH_ON(9) && IN(pb + 7)) { FRESH(); phase_ln2(ws, p.out, l, bid * 8 + wave_, G * 8, lane_); }
        SEAM(pb + 7);
#undef FRESH
    }
#undef IN
#undef SEAM
}

extern "C" void kernel_launch(void* const* d_in, const int* in_sizes, int n_in, void* d_out, int out_size, void* d_ws, size_t ws_size, hipStream_t stream) {
    static int grid = 0;
    if (grid == 0) {
        if (n_in != N_IN || ws_size < WS_END || out_size != TL * D) { fprintf(stderr, "kernel_launch: unexpected shapes (n_in %d, out %d, ws %zu)\n", n_in, out_size, ws_size); grid = -1; return; }
        int dev = 0, cus = 0, per_cu = 0;
        if (hipGetDevice(&dev) != hipSuccess || hipDeviceGetAttribute(&cus, hipDeviceAttributeMultiprocessorCount, dev) != hipSuccess) { grid = -1; return; }
        if (hipFuncSetAttribute((const void*)mk_fwd, hipFuncAttributeMaxDynamicSharedMemorySize, LDS_BYTES) != hipSuccess) { fprintf(stderr, "kernel_launch: hipFuncSetAttribute failed\n"); grid = -1; return; }
        if (hipOccupancyMaxActiveBlocksPerMultiprocessor(&per_cu, (const void*)mk_fwd, 512, LDS_BYTES) != hipSuccess || per_cu < 1) { fprintf(stderr, "kernel_launch: occupancy query says %d\n", per_cu); }
        (void)hipGetLastError();
        grid = cus & ~7;
        if (grid < 231) { fprintf(stderr, "kernel_launch: this build needs at least 231 CUs (has %d)\n", cus); grid = -1; return; }
    }
    if (grid < 0) return;
    (void)hipMemsetAsync((char*)d_ws + WS_CTL, 0, CTL_BYTES, stream);
    P p{};
    for (int i = 0; i < N_IN; ++i) p.in[i] = (const float*)d_in[i];
    p.out = (float*)d_out; p.ws = (unsigned char*)d_ws;
#if MK_PER_PHASE
    for (int ph = 0; ph < NPHASE; ++ph) { p.ph_lo = ph; p.ph_hi = ph + 1; hipLaunchKernelGGL(mk_fwd, dim3(grid), dim3(512), LDS_BYTES, stream, p);
#ifdef EXTRA_PHASE
        if (ph == EXTRA_PHASE) for (int r = 0; r < EXTRA_REPS; ++r) hipLaunchKernelGGL(mk_fwd, dim3(grid), dim3(512), LDS_BYTES, stream, p);
#endif
    }
#else
    p.ph_lo = 0; p.ph_hi = NPHASE;
    hipLaunchKernelGGL(mk_fwd, dim3(grid), dim3(512), LDS_BYTES, stream, p);
#endif
}
```

```cpp
#include <hip/hip_runtime.h>
#include <cstdio>
#include <cstdint>

constexpr int NB = 8, SEQ = 2048, D = 1024, CTXL = 256, DEPTH = 2;
constexpr int TL = NB * SEQ;
constexpr int TC = NB * CTXL;
constexpr int TT = TL + TC;
constexpr int DLRU = 512, DPOOL = 512, DIN = 1536, NH = 8, HD = 64;
constexpr int NE = 32, TOPK = 4, DF = 1024;
constexpr int GRIDW = 64;
constexpr float LN_EPS = 1e-5f;
constexpr float ALPHA = 1.41421356237309515f;
constexpr int MAXROWS = 81920;
constexpr int NTILE = 72, NGRP = 9;

enum { I_X = 0, I_C, I_CTX, I_CCTX, I_WMOD, I_BMOD, I_WIN, I_CONVW, I_CONVB, I_GAW, I_GAB, I_GXW, I_GXB, I_LAM, I_POOLW, I_POOLB, I_POOLS,
       I_WOUT, I_LN1G, I_LN1B, I_RW, I_RB, I_W1, I_B1, I_W2, I_B2, I_LN2G, I_LN2B, N_IN };

constexpr size_t MiB = 1u << 20;
constexpr size_t WS_CTL = 0, CTL_BYTES = 1 * MiB;
constexpr size_t WS_MOD = 1 * MiB;
constexpr size_t WS_POS = 2 * MiB;
constexpr size_t WS_RWT = 2 * MiB + 512 * 1024;
constexpr size_t WS_TOPG = 7 * MiB;
constexpr size_t WS_AGGT = 10 * MiB;
constexpr size_t WS_AGGG = 15 * MiB;
constexpr size_t WS_WIN = 16 * MiB, WS_WOUT = 23 * MiB, WS_WG = 28 * MiB, WS_WP = 29 * MiB;
constexpr size_t WS_SP = 30 * MiB;
constexpr size_t WS_W1T = 32 * MiB, WS_W2T = 160 * MiB;
constexpr size_t WS_H8S = 1052 * MiB;
constexpr int W1_SH = 6, W2_SH = 7;
constexpr int SP_CW = 0, SP_CB = 2048, SP_GAB = 2560, SP_GXB = 3584, SP_CC = 4608, SP_PB = 5632, SP_PS = 6144, SP_L1G = 6656, SP_L1B = 7680, SP_L2G = 8704, SP_L2B = 9728, SP_RB = 10752,
              SP_B1 = 12288, SP_B2 = SP_B1 + 32 * 2048, SP_STRIDE = SP_B2 + 32 * 1024;
constexpr size_t WS_XL = 416 * MiB;
constexpr size_t WS_H = 488 * MiB;
constexpr size_t WS_Z = 524 * MiB;
constexpr size_t WS_MIX = 578 * MiB;
constexpr size_t WS_Y1 = 614 * MiB;
constexpr size_t WS_ACT = 650 * MiB;
constexpr size_t WS_Y2 = 810 * MiB;
constexpr size_t WS_YB = 970 * MiB;
constexpr size_t WS_ROWDST = 1046 * MiB;
constexpr size_t WS_END = 1628 * MiB;
constexpr int CW_CNT = 64;
constexpr int CW_BAR = 4096;

typedef unsigned short bf16;
typedef float f32x4 __attribute__((ext_vector_type(4)));
typedef float f32x2 __attribute__((ext_vector_type(2)));
typedef float f32x16 __attribute__((ext_vector_type(16)));
typedef unsigned u32x2 __attribute__((ext_vector_type(2)));
typedef unsigned u32x4 __attribute__((ext_vector_type(4)));
typedef short bf16x8 __attribute__((ext_vector_type(8)));
typedef int i32x8 __attribute__((ext_vector_type(8)));
typedef unsigned char fp8;

__device__ __forceinline__ float bf2f(bf16 v) { return __uint_as_float(((unsigned)v) << 16); }
__device__ __forceinline__ float bflo(unsigned w) { return __uint_as_float(w << 16); }
__device__ __forceinline__ float bfhi(unsigned w) { return __uint_as_float(w & 0xffff0000u); }
__device__ __forceinline__ unsigned f2bf(float f) { unsigned u = __float_as_uint(f); return (u + 0x7fffu + ((u >> 16) & 1u)) >> 16; }
__device__ __forceinline__ unsigned pk2(float lo, float hi) { return f2bf(lo) | (f2bf(hi) << 16); }
__device__ __forceinline__ float wave_sum(float v) {
#pragma unroll
    for (int o = 1; o < 64; o <<= 1) v += __shfl_xor(v, o);
    return v;
}
__device__ __forceinline__ float fsigmoid(float x) { return __builtin_amdgcn_rcpf(1.0f + __expf(-x)); }
__device__ __forceinline__ float gelu_tanh(float x) {
    const float u = 0.7978845608028654f * (x + 0.044715f * x * x * x);
    const float t = 1.0f - 2.0f * __builtin_amdgcn_rcpf(__expf(2.0f * u) + 1.0f);
    return 0.5f * x * (1.0f + t);
}

struct P {
    const float* in[N_IN];
    float* out;
    unsigned char* ws;
    int ph_lo, ph_hi;
};

__device__ __forceinline__ int mod_row(int tok) { return tok < TL ? (tok >> 11) : NB; }
__device__ __forceinline__ int pad256(int c) { return (c + 255) & ~255; }

__device__ __forceinline__ void ln_stats(const f32x4 (&v)[4], float& mean, float& rstd) {
    float s = 0.f;
#pragma unroll
    for (int j = 0; j < 4; ++j) s += (v[j].x + v[j].y) + (v[j].z + v[j].w);
    mean = wave_sum(s) * (1.f / D);
    float s2 = 0.f;
#pragma unroll
    for (int j = 0; j < 4; ++j) { const f32x4 d = v[j] - mean; s2 += (d.x * d.x + d.y * d.y) + (d.z * d.z + d.w * d.w); }
    rstd = 1.0f / sqrtf(wave_sum(s2) * (1.f / D) + LN_EPS);
}
__device__ __forceinline__ void store_bf16_row(bf16* row, int lane, const f32x4 (&h)[4]) {
    u32x2* o = (u32x2*)row + lane;
#pragma unroll
    for (int j = 0; j < 4; ++j) { u32x2 w; w.x = pk2(h[j].x, h[j].y); w.y = pk2(h[j].z, h[j].w); o[64 * j] = w; }
}


#define LAS __attribute__((address_space(3)))
struct CvtItem { const float* src; unsigned char* dst; int N, Kp, f8; float scale; };
__device__ __forceinline__ void tile_load(const CvtItem& it, int lane, f32x4 (&v)[16]) {
#pragma unroll
    for (int i = 0; i < 16; ++i) { const int k = 4 * i + (lane >> 4); v[i] = __builtin_nontemporal_load((const f32x4*)(it.src + (size_t)k * it.N + 4 * (lane & 15))); }
}
__device__ __forceinline__ void tile_store(const CvtItem& it, const f32x4 (&v)[16], LAS float* scr, int lane) {
#pragma unroll
    for (int i = 0; i < 16; ++i) { const int k = 4 * i + (lane >> 4); const int nn = (4 * (lane & 15)) ^ (((k >> 3) & 3) << 3); *(LAS f32x4*)(scr + k * 64 + nn) = v[i]; }
    asm volatile("s_waitcnt lgkmcnt(0)" ::: "memory");
    const int c = lane & 7, sw = (c & 3) << 3;
    if (it.f8) {
#pragma unroll
        for (int j = 0; j < 8; ++j) {
            const int n = (lane >> 3) + 8 * j;
            const LAS float* s = scr + (8 * c) * 64 + (n ^ sw);
            const float sc = it.scale;
            int w0 = 0, w1 = 0;
            w0 = __builtin_amdgcn_cvt_pk_fp8_f32(s[0] * sc, s[64] * sc, w0, false); w0 = __builtin_amdgcn_cvt_pk_fp8_f32(s[128] * sc, s[192] * sc, w0, true);
            w1 = __builtin_amdgcn_cvt_pk_fp8_f32(s[256] * sc, s[320] * sc, w1, false); w1 = __builtin_amdgcn_cvt_pk_fp8_f32(s[384] * sc, s[448] * sc, w1, true);
            *(u32x2*)(it.dst + (size_t)n * it.Kp + 8 * c) = (u32x2){(unsigned)w0, (unsigned)w1};
        }
    } else {
#pragma unroll
        for (int j = 0; j < 8; ++j) {
            const int n = (lane >> 3) + 8 * j;
            const LAS float* s = scr + (8 * c) * 64 + (n ^ sw);
            u32x4 o; o.x = pk2(s[0], s[64]); o.y = pk2(s[128], s[192]); o.z = pk2(s[256], s[320]); o.w = pk2(s[384], s[448]);
            *(u32x4*)(it.dst + ((size_t)n * it.Kp + 8 * c) * 2) = o;
        }
    }
    asm volatile("s_waitcnt lgkmcnt(0)" ::: "memory");
}
constexpr int CV_IN = DEPTH * 16 * 24, CV_OUT = DEPTH * 16 * 16, CV_G = DEPTH * 2 * 2 * NH, CV_P = DEPTH * 4 * 4, CV_1 = DEPTH * NE * 16 * 32, CV_2 = DEPTH * NE * 16 * 16;
constexpr int CV_ITEMS = CV_IN + CV_OUT + CV_G + CV_P + CV_1 + CV_2;
__device__ __forceinline__ CvtItem cvt_decode(const P& p, int r) {
    CvtItem it; it.f8 = 0; it.scale = 1.0f;
    if (r < CV_IN) { const int l = r / 384, q = r % 384, kb = q / 24, nb = q % 24;
        it.src = p.in[I_WIN] + (size_t)l * D * DIN + (size_t)(64 * kb) * DIN + 64 * nb; it.N = DIN; it.Kp = D; it.dst = p.ws + WS_WIN + (((size_t)l * DIN + 64 * nb) * D + 64 * kb) * 2; return it; }
    r -= CV_IN;
    if (r < CV_OUT) { const int l = r / 256, q = r % 256, kb = q / 16, nb = q % 16;
        it.src = p.in[I_WOUT] + (size_t)l * D * D + (size_t)(64 * kb) * D + 64 * nb; it.N = D; it.Kp = D; it.dst = p.ws + WS_WOUT + (((size_t)l * D + 64 * nb) * D + 64 * kb) * 2; return it; }
    r -= CV_OUT;
    if (r < CV_G) {
        const int h = r % NH, gt = (r / NH) % 2, d = (r / (NH * 2)) % 2, l = r / (NH * 4);
        it.src = (gt ? p.in[I_GXW] : p.in[I_GAW]) + ((size_t)(l * 2 + d) * NH + h) * HD * HD; it.N = HD; it.Kp = HD;
        it.dst = p.ws + WS_WG + (((size_t)(l * NH + h) * 256 + (d * 2 + gt) * 64) * HD) * 2; return it; }
    r -= CV_G;
    if (r < CV_P) {
        const int nb = r % 2, kb = (r / 2) % 2, lg = r / 4;
        it.src = p.in[I_POOLW] + (size_t)lg * 128 * 128 + (size_t)(64 * kb) * 128 + 64 * nb; it.N = 128; it.Kp = 128; it.dst = p.ws + WS_WP + (((size_t)lg * 128 + 64 * nb) * 128 + 64 * kb) * 2; return it; }
    r -= CV_P;
    it.f8 = 1;
    if (r < CV_1) {
        const int le = r / 512, q = r % 512, kb = q / 32, nb = q % 32;
        const int n0 = 64 * nb, j0 = n0 % DF, half = n0 / DF, row0 = (j0 / 128) * 256 + half * 128 + (j0 % 128);
        it.src = p.in[I_W1] + (size_t)le * D * 2 * DF + (size_t)(64 * kb) * (2 * DF) + n0; it.N = 2 * DF; it.Kp = D; it.scale = (float)(1 << W1_SH);
        it.dst = p.ws + WS_W1T + ((size_t)le * 2 * DF + row0) * D + 64 * kb; return it; }
    r -= CV_1;
    { const int le = r / 256, q = r % 256, kb = q / 16, nb = q % 16;
      it.src = p.in[I_W2] + (size_t)le * DF * D + (size_t)(64 * kb) * D + 64 * nb; it.N = D; it.Kp = DF; it.scale = (float)(1 << W2_SH);
      it.dst = p.ws + WS_W2T + ((size_t)le * D + 64 * nb) * DF + 64 * kb; }
    return it;
}
__device__ __forceinline__ void convert_weights(const P& p, LAS unsigned char* lds, int gw, int ngw, int wave, int lane) {
    LAS float* scr = (LAS float*)(lds + wave * 16384);
    int r = gw;
    if (r >= CV_ITEMS) return;
    CvtItem cur = cvt_decode(p, r);
    f32x4 v[16], vn[16];
    tile_load(cur, lane, v);
    for (;;) {
        const int rn = r + ngw; const bool more = rn < CV_ITEMS;
        CvtItem nxt = cur;
        if (more) { nxt = cvt_decode(p, rn); tile_load(nxt, lane, vn); }
        tile_store(cur, v, scr, lane);
        if (!more) break;
#pragma unroll
        for (int i = 0; i < 16; ++i) v[i] = vn[i];
        cur = nxt; r = rn;
    }
}

namespace pg8 {
typedef short bf16x8 __attribute__((ext_vector_type(8)));
constexpr int BM = 256, BK = 64, HALF = 128, HTB = HALF * BK * 2, STAGE_BYTES = 8 * HTB;
template <int XB> __host__ __device__ __forceinline__ int lds_byte(int r, int c) { const int st = (r >> 4) * 2 + (c >> 5), rr = r & 15, cc = c & 31, ob = rr * 64 + cc * 2; return st * 1024 + (ob ^ (((ob >> 9) & 1) << XB)); }
template <int XB> __host__ __device__ __forceinline__ void stage_rc(int b, int& R, int& C) { const int st = b / 1024, sb = b % 1024, swz = sb ^ (((sb >> 9) & 1) << XB); R = (st >> 1) * 16 + swz / 64; C = (st & 1) * 32 + (swz % 64) / 2; }
__host__ __device__ __forceinline__ int perm32(int rho) { const int n = rho >> 4, i = rho & 15; return 8 * (i >> 2) + 4 * n + (i & 3); }
__device__ __forceinline__ unsigned cvt_pk_bf16(float lo, float hi) { unsigned r; asm volatile("v_cvt_pk_bf16_f32 %0, %1, %2" : "=v"(r) : "v"(lo), "v"(hi)); return r; }

struct Unit { int a0, nvalid, b0, o0, pn, e, g0; };

template <bool F8, class Sched, class Epi>
__device__ __forceinline__ void gemm_phase(LAS unsigned char* lds, int tid, const void* Abase_, const void* Bt_, const Sched& S, const Epi& E) {
    constexpr int RP = F8 ? 1024 : 2048, nt = F8 ? 8 : 16;
    const int wid = __builtin_amdgcn_readfirstlane(tid >> 6), lane = tid & 63, wr = wid >> 2, wc = wid & 3, fr = lane & 15, fq = lane >> 4;
    unsigned voffA, voffB;
    { int R, C; stage_rc<F8 ? 4 : 5>(tid * 16, R, C); const int Rb = (R & ~31) + perm32(R & 31); voffA = (unsigned)(R * RP + 2 * C); voffB = (unsigned)(Rb * RP + 2 * C); }
    constexpr size_t kstep = (size_t)(BK * 2);
    constexpr size_t hstep = (size_t)HALF * RP;
    const unsigned ldsw = (unsigned)wid * 1024u;
    const int aoff = F8 ? lds_byte<4>(wr * 64 + fr, fq * 16) : lds_byte<5>(wr * 64 + fr, fq * 8), boff = F8 ? lds_byte<4>(wc * 32 + fr, fq * 16) : lds_byte<5>(wc * 32 + fr, fq * 8);
    const int one_scale = 0x7F7F7F7F;
#define PG8_SA(b, h) (((b) * 2 + (h)) * HTB)
#define PG8_SB(b, h) ((4 + (b) * 2 + (h)) * HTB)
#define PG8_STAGE(bufoff, gbase, voff) do { _Pragma("unroll") for (int _i = 0; _i < 2; ++_i) { unsigned _vo = (voff); asm volatile("" : "+v"(_vo)); \
        __builtin_amdgcn_global_load_lds((const unsigned*)((const char*)(gbase) + (size_t)_i * (64 * RP) + _vo), (LAS unsigned*)(lds + (bufoff) + ldsw + _i * 8192), 16, 0, 0); } } while (0)
#define PG8_LD8(base, off) __builtin_bit_cast(i32x8, __builtin_shufflevector(*(const LAS u32x4*)((base) + (off)), *(const LAS u32x4*)((base) + ((off) ^ 16)), 0, 1, 2, 3, 4, 5, 6, 7))
#define PG8_LDA(dst, b, h) do { _Pragma("unroll") for (int m = 0; m < 4; ++m) { \
        if constexpr (F8) dst##8[m] = PG8_LD8(lds + PG8_SA(b, h) + m * 2048, aoff); \
        else { _Pragma("unroll") for (int k = 0; k < 2; ++k) dst[m][k] = *(const LAS bf16x8*)(lds + PG8_SA(b, h) + aoff + m * 2048 + k * 1024); } } } while (0)
#define PG8_LDB(dst, b, h) do { _Pragma("unroll") for (int n = 0; n < 2; ++n) { \
        if constexpr (F8) dst##8[n] = PG8_LD8(lds + PG8_SB(b, h) + n * 2048, boff); \
        else { _Pragma("unroll") for (int k = 0; k < 2; ++k) dst[n][k] = *(const LAS bf16x8*)(lds + PG8_SB(b, h) + boff + n * 2048 + k * 1024); } } } while (0)
#define PG8_MMA(ai, bj, At, Bt) do { __builtin_amdgcn_s_setprio(1); _Pragma("unroll") for (int m = 0; m < 4; ++m) _Pragma("unroll") for (int n = 0; n < 2; ++n) { \
        if constexpr (F8) acc[ai][bj][m][n] = __builtin_amdgcn_mfma_scale_f32_16x16x128_f8f6f4(Bt##8[n], At##8[m], acc[ai][bj][m][n], 0, 0, 0, one_scale, 0, one_scale); \
        else { _Pragma("unroll") for (int k = 0; k < 2; ++k) acc[ai][bj][m][n] = __builtin_amdgcn_mfma_f32_16x16x32_bf16(Bt[n][k], At[m][k], acc[ai][bj][m][n], 0, 0, 0); } } \
        __builtin_amdgcn_s_setprio(0); } while (0)
#define PG8_WAIT_V(n) asm volatile("s_waitcnt vmcnt(" #n ")" ::: "memory")
#define PG8_WAIT_L(n) asm volatile("s_waitcnt lgkmcnt(" #n ")" ::: "memory")
#define PG8_BAR __builtin_amdgcn_s_barrier()
#define PG8_SCHED __builtin_amdgcn_sched_barrier(0)
    Unit cur, nxt; int ui = 0;
    if (!S.next(0, cur)) return;
    f32x4 acc[2][2][4][2];
#pragma unroll
    for (int a = 0; a < 2; ++a)
#pragma unroll
        for (int b = 0; b < 2; ++b)
#pragma unroll
            for (int m = 0; m < 4; ++m)
#pragma unroll
                for (int n = 0; n < 2; ++n) acc[a][b][m][n] = (f32x4){0.f, 0.f, 0.f, 0.f};
    bf16x8 At[4][2], B0[2][2], B1[2][2];
    i32x8 At8[4], B08[2], B18[2];
    const char* cA = (const char*)Abase_ + (size_t)cur.a0 * RP; const char* cB = (const char*)Bt_ + (size_t)cur.b0 * RP;
    PG8_STAGE(PG8_SB(0, 0), cB, voffB); PG8_STAGE(PG8_SB(0, 1), cB + hstep, voffB); PG8_STAGE(PG8_SA(0, 0), cA, voffA); PG8_STAGE(PG8_SA(0, 1), cA + hstep, voffA);
    if (wr == 1) PG8_BAR;
    PG8_WAIT_V(2); PG8_BAR;
    PG8_STAGE(PG8_SB(1, 0), cB + kstep, voffB); PG8_STAGE(PG8_SA(1, 0), cA + kstep, voffA); PG8_STAGE(PG8_SB(1, 1), cB + hstep + kstep, voffB);
    PG8_WAIT_V(6); PG8_BAR;
    for (;;) {
        const bool has_next = S.next(ui + 1, nxt);
        const char* nA = has_next ? (const char*)Abase_ + (size_t)nxt.a0 * RP : cA; const char* nB = has_next ? (const char*)Bt_ + (size_t)nxt.b0 * RP : cB;
#pragma unroll 1
        for (int t = 0; t < nt; t += 2) {
            const bool last = (t == nt - 2);
            const char* a1 = cA + (size_t)(t + 1) * kstep;
            const char* a2 = last ? nA : cA + (size_t)(t + 2) * kstep; const char* b2 = last ? nB : cB + (size_t)(t + 2) * kstep;
            const char* a3 = a2 + kstep; const char* b3 = b2 + kstep;
            PG8_LDB(B0, 0, 0); PG8_LDB(B1, 0, 1); PG8_SCHED; PG8_LDA(At, 0, 0); PG8_STAGE(PG8_SA(1, 1), a1 + hstep, voffA);
            PG8_WAIT_V(8); PG8_WAIT_L(0); PG8_BAR; PG8_MMA(0, 0, At, B0); PG8_MMA(0, 1, At, B1); PG8_BAR; PG8_SCHED;
            PG8_LDA(At, 0, 1); PG8_STAGE(PG8_SB(0, 0), b2, voffB); PG8_STAGE(PG8_SB(0, 1), b2 + hstep, voffB); PG8_STAGE(PG8_SA(0, 0), a2, voffA);
            PG8_WAIT_V(8); PG8_WAIT_L(0); PG8_BAR; PG8_MMA(1, 0, At, B0); PG8_MMA(1, 1, At, B1); PG8_BAR; PG8_SCHED;
            PG8_LDB(B0, 1, 0); PG8_LDB(B1, 1, 1); PG8_SCHED; PG8_LDA(At, 1, 0); PG8_STAGE(PG8_SA(0, 1), a2 + hstep, voffA);
            PG8_WAIT_V(8); PG8_WAIT_L(0); PG8_BAR; PG8_MMA(0, 0, At, B0); PG8_MMA(0, 1, At, B1); PG8_BAR; PG8_SCHED;
            PG8_LDA(At, 1, 1); PG8_STAGE(PG8_SB(1, 0), b3, voffB); PG8_STAGE(PG8_SB(1, 1), b3 + hstep, voffB); PG8_STAGE(PG8_SA(1, 0), a3, voffA);
            PG8_WAIT_V(8); PG8_WAIT_L(0); PG8_BAR; PG8_MMA(1, 0, At, B0); PG8_MMA(1, 1, At, B1); PG8_BAR; PG8_SCHED;
        }
        if (wr == 0) PG8_BAR;
        PG8_SCHED; { int fr_ = fr, fq_ = fq; asm volatile("" : "+v"(fr_), "+v"(fq_)); E(acc, cur, wr, wc, fr_, fq_); } PG8_SCHED;
        if (!has_next) break;
#pragma unroll
        for (int a = 0; a < 2; ++a)
#pragma unroll
            for (int b = 0; b < 2; ++b)
#pragma unroll
                for (int m = 0; m < 4; ++m)
#pragma unroll
                    for (int n = 0; n < 2; ++n) acc[a][b][m][n] = (f32x4){0.f, 0.f, 0.f, 0.f};
        cur = nxt; cA = nA; cB = nB; ++ui;
        if (wr == 1) PG8_BAR;
    }
    PG8_WAIT_V(0);
    PG8_BAR;
#undef PG8_SA
#undef PG8_SB
#undef PG8_STAGE
#undef PG8_LDA
#undef PG8_LDB
#undef PG8_MMA
#undef PG8_LD8
#undef PG8_WAIT_V
#undef PG8_WAIT_L
#undef PG8_BAR
#undef PG8_SCHED
}

struct DenseOrder {
    int nM, nN, nwg, G, c;
    __device__ void init(int nM_, int nN_, int G_, int c_) { nM = nM_; nN = nN_; nwg = nM * nN; G = G_; c = c_; }
    __device__ bool next(int i, Unit& u) const {
        const long L = (long)i * G + c; if (L >= nwg) return false;
        int wgid = (int)L; { const int q = nwg / 8, r = nwg % 8, xcd = wgid % 8, off = wgid / 8; wgid = (xcd < r ? xcd * (q + 1) : r * (q + 1) + (xcd - r) * q) + off; }
        const int nig = 8 * nN, gid = wgid / nig, fm = gid * 8, gsz = (nM - fm) < 8 ? (nM - fm) : 8;
        const int pm = fm + ((wgid % nig) % gsz), pn = (wgid % nig) / gsz;
        u.a0 = pm * 256; u.nvalid = 256; u.b0 = pn * 256; u.o0 = pm * 256; u.pn = pn; u.e = 0; u.g0 = 0; return true;
    }
};
template <int NPN, bool UP> struct MoeOrder {
    const LAS int* tb; const int* cnt; int G, c;
    __device__ bool next(int i, Unit& u) const {
        const int L = i * G + c; const int total = tb[32] * NPN; if (L >= total) return false;
        int e = 0;
#pragma unroll 1
        for (int q = 16; q >= 1; q >>= 1) if (tb[e + q] * NPN <= L) e += q;
        const int te = tb[e + 1] - tb[e], j = L - tb[e] * NPN, pn = j / te, mt = j % te;
        const int ce = cnt[e];
        u.e = e; u.pn = pn; u.o0 = (tb[e] + mt) * 256; u.nvalid = min(256, ce - mt * 256);
        u.g0 = e * TT + mt * 256;
        u.a0 = UP ? u.g0 : u.o0;
        u.b0 = e * (UP ? 2 * DF : D) + pn * 256;
        return true;
    }
};

struct EpiStore {
    bf16* C; int ldc;
    __device__ __forceinline__ void operator()(const f32x4 (&acc)[2][2][4][2], const Unit& u, int wr, int wc, int fr, int fq) const {
        const int row0 = u.o0 + wr * 64 + fr, col0 = u.pn * 256 + wc * 32 + 8 * fq;
#pragma unroll
        for (int ai = 0; ai < 2; ++ai)
#pragma unroll
            for (int m = 0; m < 4; ++m) { bf16* rowp = C + (size_t)(row0 + ai * HALF + m * 16) * ldc + col0;
#pragma unroll
                for (int bj = 0; bj < 2; ++bj) { const f32x4 v0 = acc[ai][bj][m][0], v1 = acc[ai][bj][m][1];
                    u32x4 w; w.x = cvt_pk_bf16(v0[0], v0[1]); w.y = cvt_pk_bf16(v0[2], v0[3]); w.z = cvt_pk_bf16(v1[0], v1[1]); w.w = cvt_pk_bf16(v1[2], v1[3]);
                    *(u32x4*)(rowp + bj * HALF) = w; } }
    }
};
struct EpiSwiglu {
    fp8* C; const float* b1;
    __device__ __forceinline__ void operator()(const f32x4 (&acc)[2][2][4][2], const Unit& u, int wr, int wc, int fr, int fq) const {
        const int row0 = u.o0 + wr * 64 + fr, j0 = u.pn * 128 + wc * 32 + 8 * fq;
        const float* bb = b1 + (size_t)u.e * 2 * DF + j0;
        const f32x4 bg0 = *(const f32x4*)bb, bg1 = *(const f32x4*)(bb + 4), bl0 = *(const f32x4*)(bb + DF), bl1 = *(const f32x4*)(bb + DF + 4);
#pragma unroll
        for (int ai = 0; ai < 2; ++ai)
#pragma unroll
            for (int m = 0; m < 4; ++m) {
                float o[8];
#pragma unroll
                for (int n = 0; n < 2; ++n)
#pragma unroll
                    for (int q = 0; q < 4; ++q) {
                        constexpr float ws = 1.0f / (float)(1 << W1_SH);
                        const float gl = fminf(fmaf(acc[ai][0][m][n][q], ws, n ? bg1[q] : bg0[q]), 7.0f);
                        const float li = fminf(fmaxf(fmaf(acc[ai][1][m][n][q], ws, n ? bl1[q] : bl0[q]), -7.0f), 7.0f);
                        o[4 * n + q] = gl * __builtin_amdgcn_rcpf(1.0f + __expf(-1.702f * gl)) * (li + 1.0f);
                    }
                int w0 = 0, w1 = 0;
                w0 = __builtin_amdgcn_cvt_pk_fp8_f32(o[0], o[1], w0, false); w0 = __builtin_amdgcn_cvt_pk_fp8_f32(o[2], o[3], w0, true);
                w1 = __builtin_amdgcn_cvt_pk_fp8_f32(o[4], o[5], w1, false); w1 = __builtin_amdgcn_cvt_pk_fp8_f32(o[6], o[7], w1, true);
                *(u32x2*)(C + (size_t)(row0 + ai * HALF + m * 16) * DF + j0) = (u32x2){(unsigned)w0, (unsigned)w1};
            }
    }
};
struct EpiDown {
    bf16* C; const float* b2; const int* rowdst;
    __device__ __forceinline__ void operator()(const f32x4 (&acc)[2][2][4][2], const Unit& u, int wr, int wc, int fr, int fq) const {
        const int rt0 = wr * 64 + fr, col0 = u.pn * 256 + wc * 32 + 8 * fq;
        const float* bp = b2 + (size_t)u.e * D + col0;
        int dst[2][4];
#pragma unroll
        for (int ai = 0; ai < 2; ++ai)
#pragma unroll
            for (int m = 0; m < 4; ++m) { const int rt = rt0 + ai * HALF + m * 16; dst[ai][m] = rowdst[u.g0 + min(rt, u.nvalid - 1)]; if (rt >= u.nvalid) dst[ai][m] = -1; }
        constexpr float ws = 1.0f / (float)(1 << W2_SH);
#pragma unroll
        for (int bj = 0; bj < 2; ++bj) {
            const f32x4 bv0 = *(const f32x4*)(bp + bj * HALF), bv1 = *(const f32x4*)(bp + bj * HALF + 4);
#pragma unroll
            for (int ai = 0; ai < 2; ++ai)
#pragma unroll
                for (int m = 0; m < 4; ++m) {
                    const f32x4 v0 = acc[ai][bj][m][0] * ws + bv0, v1 = acc[ai][bj][m][1] * ws + bv1;
                    u32x4 w; w.x = cvt_pk_bf16(v0[0], v0[1]); w.y = cvt_pk_bf16(v0[2], v0[3]); w.z = cvt_pk_bf16(v1[0], v1[1]); w.w = cvt_pk_bf16(v1[2], v1[3]);
                    if (dst[ai][m] >= 0) *(u32x4*)(C + (size_t)dst[ai][m] * D + col0 + bj * HALF) = w;
                }
        }
    }
};
}

#define XB_TMO      128
#define XB_XCNT(j)  (256  + 64 * (j))
#define XB_XSUB(j)  (1280 + 64 * (j))
#define XB_XGEN(j)  (2304 + 64 * (j))
#define XB_TOP      3328
#define XB_TOPGEN   3392
#define XCD_BAR_WORDS 3456
#define XB_SPIN_CAP (1u << 18)
__device__ __forceinline__ unsigned xb_ld(unsigned* p)              { return __hip_atomic_load(p, __ATOMIC_RELAXED, __HIP_MEMORY_SCOPE_AGENT); }
__device__ __forceinline__ unsigned xb_add(unsigned* p, unsigned v) { return __hip_atomic_fetch_add(p, v, __ATOMIC_RELAXED, __HIP_MEMORY_SCOPE_AGENT); }
__device__ __forceinline__ unsigned xb_xcc_id() { return (unsigned)__builtin_amdgcn_s_getreg((3 << 11) | 20) & 0xFu; }
#define XB_SPIN(cond, bar) do { unsigned _sp = 0; while (cond) { __builtin_amdgcn_s_sleep(1); \
    if ((++_sp & 255u) == 0u) { if (xb_ld(&(bar)[XB_TMO])) break; if (_sp > XB_SPIN_CAP) { atomicAdd(&(bar)[XB_TMO], 1u); break; } } } } while (0)
struct XcdBarrier { unsigned* bar; unsigned x; volatile LAS unsigned* st; };
__device__ __forceinline__ XcdBarrier xcd_barrier_post(unsigned* bar, volatile LAS unsigned* st) {
    XcdBarrier b; b.bar = bar; b.x = xb_xcc_id(); b.st = st;
    if (threadIdx.x == 0) (void)xb_add(&bar[XB_XCNT(b.x)], 1u);
    return b;
}
__device__ __forceinline__ void xcd_barrier_complete(unsigned* bar, unsigned x, unsigned& nloc, unsigned& nx) {
    const unsigned G = gridDim.x * gridDim.y * gridDim.z;
    unsigned sum, cnt, mine, sp = 0u;
    for (;;) {
        sum = 0u; cnt = 0u; mine = 0u;
#pragma unroll
        for (unsigned j = 0; j < 16; ++j) { const unsigned c = xb_ld(&bar[XB_XCNT(j)]); sum += c; cnt += (c > 0u) ? 1u : 0u; mine = (j == x) ? c : mine; }
        if (sum == G) break;
        __builtin_amdgcn_s_sleep(1);
        if ((++sp & 255u) == 0u) { if (xb_ld(&bar[XB_TMO])) break; if (sp > XB_SPIN_CAP) { atomicAdd(&bar[XB_TMO], 1u); break; } }
    }
    nloc = mine > 0u ? mine : 1u; nx = cnt > 0u ? cnt : 1u;
}
__device__ __forceinline__ void xcd_barrier(const XcdBarrier& b, bool leader) {
    asm volatile("s_waitcnt vmcnt(0)" ::: "memory");
    __syncthreads();
    if (leader) {
        unsigned* bar = b.bar;
        __builtin_amdgcn_s_waitcnt(0);
        unsigned nloc = b.st[0], nx = b.st[1];
        if (nloc == 0u) { xcd_barrier_complete(bar, b.x, nloc, nx); b.st[0] = nloc; b.st[1] = nx; }
        const unsigned old = xb_add(&bar[XB_XSUB(b.x)], 1u);
        const unsigned gen = old / nloc;
        if (old + 1u == (gen + 1u) * nloc) {
            __builtin_amdgcn_fence(__ATOMIC_RELEASE, "agent");
            asm volatile("s_waitcnt vmcnt(0)" ::: "memory");
            const unsigned og = xb_add(&bar[XB_TOP], 1u);
            const unsigned tg = og / nx;
            if (og + 1u == (tg + 1u) * nx) xb_add(&bar[XB_TOPGEN], 1u);
            else XB_SPIN(xb_ld(&bar[XB_TOPGEN]) == tg, bar);
            __builtin_amdgcn_fence(__ATOMIC_ACQUIRE, "agent");
            xb_add(&bar[XB_XGEN(b.x)], 1u);
            asm volatile("s_waitcnt vmcnt(0)" ::: "memory");
        } else {
            XB_SPIN(xb_ld(&bar[XB_XGEN(b.x)]) == gen, bar);
            __builtin_amdgcn_fence(__ATOMIC_ACQUIRE, "agent");
            asm volatile("s_waitcnt vmcnt(0)" ::: "memory");
        }
    }
    __syncthreads();
}

constexpr int LDS_BYTES = 147456;
constexpr int LDS_TB = LDS_BYTES - 1024;
constexpr int LDS_MISC = LDS_BYTES - 512;

__device__ __forceinline__ void phase_p0a(const P& p, LAS unsigned char* lds, int bid, int G, int tid, int wave, int lane) {
    { float* POS = (float*)(p.ws + WS_POS);
      for (int i = bid * 512 + tid; i < 64 * 512; i += G * 512) {
          const int n = i / 512, j = i % 512, q = j % 256;
          const float omega = 1.0f / powf(10000.0f, (float)q / 256.0f);
          const float ang = (float)n * omega;
          POS[i] = j < 256 ? sinf(ang) : cosf(ang);
      } }
    { bf16* RWT = (bf16*)(p.ws + WS_RWT);
      for (int i = bid * 512 + tid; i < DEPTH * NE * 128; i += G * 512) {
          const int kc = i % 128, e = (i / 128) % NE, l = i / (128 * NE);
          const float* s = p.in[I_RW] + (size_t)l * D * NE + (size_t)(8 * kc) * NE + e;
          u32x4 o; o.x = pk2(s[0], s[NE]); o.y = pk2(s[2 * NE], s[3 * NE]); o.z = pk2(s[4 * NE], s[5 * NE]); o.w = pk2(s[6 * NE], s[7 * NE]);
          *(u32x4*)(RWT + ((size_t)l * NE + e) * D + 8 * kc) = o;
      } }
    { float* SP = (float*)(p.ws + WS_SP);
      const int gt = bid * 512 + tid, gn = G * 512;
      for (int l = 0; l < DEPTH; ++l) {
          float* o = SP + (size_t)l * SP_STRIDE;
          for (int i = gt; i < 2048; i += gn) o[SP_CW + i] = p.in[I_CONVW][(size_t)l * 2048 + i];
          for (int i = gt; i < 512; i += gn) { o[SP_CB + i] = p.in[I_CONVB][(size_t)l * 512 + i]; o[SP_PB + i] = p.in[I_POOLB][(size_t)l * 512 + i]; o[SP_PS + i] = p.in[I_POOLS][(size_t)l * 512 + i]; }
          for (int i = gt; i < 1024; i += gn) { o[SP_GAB + i] = p.in[I_GAB][(size_t)l * 1024 + i]; o[SP_GXB + i] = p.in[I_GXB][(size_t)l * 1024 + i];
              const float nl = -p.in[I_LAM][(size_t)l * 1024 + i]; o[SP_CC + i] = 8.0f * (nl > 20.f ? nl : log1pf(expf(nl)));
              o[SP_L1G + i] = p.in[I_LN1G][(size_t)l * 1024 + i]; o[SP_L1B + i] = p.in[I_LN1B][(size_t)l * 1024 + i];
              o[SP_L2G + i] = p.in[I_LN2G][(size_t)l * 1024 + i]; o[SP_L2B + i] = p.in[I_LN2B][(size_t)l * 1024 + i]; }
          for (int i = gt; i < 32; i += gn) o[SP_RB + i] = p.in[I_RB][(size_t)l * 32 + i];
          for (int i = gt; i < 32 * 2048; i += gn) o[SP_B1 + i] = p.in[I_B1][(size_t)l * 32 * 2048 + i];
          for (int i = gt; i < 32 * 1024; i += gn) o[SP_B2 + i] = p.in[I_B2][(size_t)l * 32 * 1024 + i];
      } }
    { LAS float* sl = (LAS float*)lds; LAS float* part = sl + 9 * 1024;
      const float* c = p.in[I_C]; const float* cc = p.in[I_CCTX];
      for (int i = tid; i < 9 * 1024; i += 512) { const float v = i < 8192 ? c[i] : cc[i - 8192]; sl[i] = v / (1.0f + __expf(-v)); }
      __syncthreads();
      float* MOD = (float*)(p.ws + WS_MOD);
      for (int u = bid; u < 2 * 96; u += G) {
          const int l = u / 96, n0 = (u % 96) * 64;
          const float* W = p.in[I_WMOD] + (size_t)l * 1024 * 6144 + n0;
          const int c4 = (tid & 15) * 4, ks = tid >> 4;
          f32x4 acc[9];
#pragma unroll
          for (int r = 0; r < 9; ++r) acc[r] = (f32x4){0.f, 0.f, 0.f, 0.f};
#pragma unroll
          for (int half = 0; half < 2; ++half) {
              f32x4 w[16];
#pragma unroll
              for (int kk = 0; kk < 16; ++kk) w[kk] = __builtin_nontemporal_load((const f32x4*)(W + (size_t)(ks * 32 + half * 16 + kk) * 6144 + c4));
#pragma unroll
              for (int kk = 0; kk < 16; ++kk) {
                  const int k = ks * 32 + half * 16 + kk;
#pragma unroll
                  for (int r = 0; r < 9; ++r) acc[r] += w[kk] * sl[r * 1024 + k];
              }
          }
#pragma unroll
          for (int r = 0; r < 9; ++r) *(LAS f32x4*)(part + (ks * 9 + r) * 64 + c4) = acc[r];
          __syncthreads();
          for (int o = tid; o < 9 * 64; o += 512) {
              const int r = o / 64, cl = o % 64; float sum = 0.f;
#pragma unroll
              for (int q = 0; q < 32; ++q) sum += part[(q * 9 + r) * 64 + cl];
              MOD[((size_t)l * 9 + r) * 6144 + n0 + cl] = sum + p.in[I_BMOD][(size_t)l * 6144 + n0 + cl];
          }
          __syncthreads();
      } }
    __syncthreads();
    convert_weights(p, lds, bid * 8 + wave, G * 8, wave, lane);
}

__device__ __forceinline__ void phase_entry(const P& p, int gw, int ngw, int lane) {
    const float* POS = (const float*)(p.ws + WS_POS);
    const float* MOD = (const float*)(p.ws + WS_MOD);
    float* XL = (float*)(p.ws + WS_XL); bf16* H = (bf16*)(p.ws + WS_H);
    for (int tok = gw; tok < TT; tok += ngw) {
        const float* src = tok < TL ? p.in[I_X] + (size_t)tok * D : p.in[I_CTX] + (size_t)(tok - TL) * D;
        f32x4 v[4];
#pragma unroll
        for (int j = 0; j < 4; ++j) v[j] = ((const f32x4*)src)[lane + 64 * j];
        if (tok < TL) {
            const int s = tok & (SEQ - 1), pr = s / GRIDW, pc = s % GRIDW;
#pragma unroll
            for (int j = 0; j < 4; ++j) {
                const float* ps = POS + (size_t)(j < 2 ? pr : pc) * 512 + (4 * lane + 256 * (j & 1));
                v[j] += *(const f32x4*)ps;
            }
        }
        float mean, rstd; ln_stats(v, mean, rstd);
        const float* m = MOD + (size_t)mod_row(tok) * 6144;
        f32x4 h[4];
#pragma unroll
        for (int j = 0; j < 4; ++j) {
            v[j] = (v[j] - mean) * rstd;
            ((f32x4*)(XL + (size_t)tok * D))[lane + 64 * j] = v[j];
            const f32x4 sh = ((const f32x4*)m)[lane + 64 * j], sc = ((const f32x4*)(m + 1024))[lane + 64 * j];
            h[j] = v[j] * (sc + 1.0f) + sh;
        }
        store_bf16_row(H + (size_t)tok * D, lane, h);
    }
}

constexpr float LOG2E = 1.4426950408889634f;
__device__ __forceinline__ float fast_sigmoid(float x) { return __builtin_amdgcn_rcpf(1.0f + __builtin_amdgcn_exp2f(-LOG2E * x)); }
__device__ __forceinline__ int lru_item(int b, int grp, int h, int cb, int wave) { return ((((b * NGRP + grp) * NH + h) * 2 + cb) * 8 + wave); }

template <bool FINAL>
__device__ __forceinline__ void tile_scan(const f32x16& ar, const f32x16& ai, int d, int hh, float cin, float& aggP, float& aggH, float (&hsum)[16]) {
    float oP[4], oH[4];
#pragma unroll
    for (int q = 0; q < 4; ++q) {
        float Pp = 1.f, Hh = 0.f;
#pragma unroll
        for (int jj = 0; jj < 4; ++jj) { const int j = d ? 3 - jj : jj; Hh = ar[4 * q + j] * Hh + ai[4 * q + j]; Pp *= ar[4 * q + j]; }
        oP[q] = Pp; oH[q] = Hh;
    }
    float eP[4], eH[4], xP[4], xH[4];
#pragma unroll
    for (int q = 0; q < 4; ++q) { const float pP = __shfl_xor(oP[q], 32), pH = __shfl_xor(oH[q], 32);
        eP[q] = hh ? pP : oP[q]; eH[q] = hh ? pH : oH[q]; xP[q] = hh ? oP[q] : pP; xH[q] = hh ? oH[q] : pH; }
    float c = cin, pall = 1.f;
    float mine[4];
    if (d == 0) {
#pragma unroll
        for (int q = 0; q < 4; ++q) { const float cE = c; c = eP[q] * c + eH[q]; const float cO = c; c = xP[q] * c + xH[q]; mine[q] = hh ? cO : cE; pall *= eP[q] * xP[q]; }
    } else {
#pragma unroll
        for (int q = 3; q >= 0; --q) { const float cO = c; c = xP[q] * c + xH[q]; const float cE = c; c = eP[q] * c + eH[q]; mine[q] = hh ? cO : cE; pall *= eP[q] * xP[q]; }
    }
    aggP = pall; aggH = c;
    if (FINAL) {
#pragma unroll
        for (int q = 0; q < 4; ++q) { float Hh = mine[q];
#pragma unroll
            for (int jj = 0; jj < 4; ++jj) { const int j = d ? 3 - jj : jj; Hh = ar[4 * q + j] * Hh + ai[4 * q + j]; if (d == 0) hsum[4 * q + j] = Hh; else hsum[4 * q + j] += Hh; } }
    }
}

constexpr int LW_OFF = 4096, LW_PITCH = 144;
__device__ __forceinline__ void lru_load_w(unsigned char* ws, int l, int h, int cb, int tid, LAS unsigned char* lds) {
    const bf16* WG = (const bf16*)(ws + WS_WG) + (size_t)(l * NH + h) * 256 * HD;
    __syncthreads();
    for (int i = tid; i < 128 * 8; i += 512) { const int row = i >> 3, c = i & 7, q = row >> 5, r = row & 31;
        *(LAS u32x4*)(lds + LW_OFF + row * LW_PITCH + 16 * c) = *(const u32x4*)(WG + (size_t)(q * 64 + 32 * cb + r) * HD + 8 * c); }
    __syncthreads();
}
__device__ __forceinline__ void lru_agg_unit(unsigned char* ws, int l, LAS unsigned char* lds, int b, int grp, int h, int cb, int wave, int lane) {
    asm volatile("" : "+s"(wave)); asm volatile("" : "+v"(lane));
    const bf16* Z = (const bf16*)(ws + WS_Z);
    const int r = lane & 31, hh = lane >> 5;
    int seqbase, len, t0;
    if (grp == 0) { seqbase = TL + b * CTXL; len = CTXL; t0 = wave * 32; } else { seqbase = b * SEQ; len = SEQ; t0 = (grp - 1) * 256 + wave * 32; }
    const int t = t0 + r;
    const float* SP = (const float*)(ws + WS_SP) + (size_t)l * SP_STRIDE;
    const float* cw = SP + SP_CW; const float* cbias = SP + SP_CB;
    bf16x8 Af[4];
#pragma unroll
    for (int s = 0; s < 4; ++s) {
        const int c0 = 64 * h + 16 * s + 8 * hh;
        const f32x4 b0 = *(const f32x4*)(cbias + c0), b1 = *(const f32x4*)(cbias + c0 + 4);
        float u[8] = {b0.x, b0.y, b0.z, b0.w, b1.x, b1.y, b1.z, b1.w};
#pragma unroll
        for (int k = 0; k < 4; ++k) {
            const int tt = t + k - 2;
            u32x4 raw = (u32x4){0u, 0u, 0u, 0u};
            if (tt >= 0 && tt < len) raw = *(const u32x4*)(Z + (size_t)(seqbase + tt) * DIN + c0);
            const f32x4 w0 = *(const f32x4*)(cw + k * DLRU + c0), w1 = *(const f32x4*)(cw + k * DLRU + c0 + 4);
            u[0] += w0.x * bflo(raw.x); u[1] += w0.y * bfhi(raw.x); u[2] += w0.z * bflo(raw.y); u[3] += w0.w * bfhi(raw.y);
            u[4] += w1.x * bflo(raw.z); u[5] += w1.y * bfhi(raw.z); u[6] += w1.z * bflo(raw.w); u[7] += w1.w * bfhi(raw.w);
        }
        u32x4 pk; pk.x = pg8::cvt_pk_bf16(u[0], u[1]); pk.y = pg8::cvt_pk_bf16(u[2], u[3]); pk.z = pg8::cvt_pk_bf16(u[4], u[5]); pk.w = pg8::cvt_pk_bf16(u[6], u[7]);
        Af[s] = __builtin_bit_cast(bf16x8, pk);
        asm volatile("" ::: "memory");
    }
    f32x16 accu;
#pragma unroll
    for (int i = 0; i < 16; ++i) accu[i] = 0.f;
    { const int nn = 32 * cb + r;
#pragma unroll
      for (int s = 0; s < 4; ++s) {
          u32x4 w = (u32x4){0u, 0u, 0u, 0u};
          if ((nn >> 4) == s && ((nn >> 3) & 1) == hh) { const unsigned one = 0x3F80u << (16 * (nn & 1)); const int wi = (nn & 7) >> 1;
              w.x = wi == 0 ? one : 0u; w.y = wi == 1 ? one : 0u; w.z = wi == 2 ? one : 0u; w.w = wi == 3 ? one : 0u; }
          accu = __builtin_amdgcn_mfma_f32_32x32x16_bf16(Af[s], __builtin_bit_cast(bf16x8, w), accu, 0, 0, 0);
      } }
    const int ch = 64 * h + 32 * cb + r;
    u32x4* YB = (u32x4*)(ws + WS_YB) + (size_t)lru_item(b, grp, h, cb, wave) * 8 * 64 + lane;
    float aggP[2], aggH[2];
    float hdummy[16];
#pragma unroll
    for (int d = 0; d < 2; ++d) {
        f32x16 ar, ai;
#pragma unroll
        for (int i = 0; i < 16; ++i) { ar[i] = 0.f; ai[i] = 0.f; }
        { const LAS unsigned char* wr_ = lds + LW_OFF + ((2 * d) * 32 + r) * LW_PITCH + 16 * hh; const LAS unsigned char* wi_ = wr_ + 32 * LW_PITCH;
#pragma unroll
          for (int s = 0; s < 4; ++s) ar = __builtin_amdgcn_mfma_f32_32x32x16_bf16(Af[s], *(const LAS bf16x8*)(wr_ + 32 * s), ar, 0, 0, 0);
#pragma unroll
          for (int s = 0; s < 4; ++s) ai = __builtin_amdgcn_mfma_f32_32x32x16_bf16(Af[s], *(const LAS bf16x8*)(wi_ + 32 * s), ai, 0, 0, 0); }
        const float ba = SP[SP_GAB + d * DLRU + ch], bx = SP[SP_GXB + d * DLRU + ch], cc = SP[SP_CC + d * DLRU + ch];
#pragma unroll
        for (int q = 0; q < 4; ++q) {
            u32x4 wq;
#pragma unroll
            for (int j = 0; j < 4; ++j) { const int i = 4 * q + j;
                const float rr = fast_sigmoid(ar[i] + ba), ig = fast_sigmoid(ai[i] + bx);
                const float y = cc * rr;
                const float a0 = __builtin_amdgcn_exp2f(-LOG2E * y);
                const float bt = __builtin_amdgcn_sqrtf(fmaf(-a0, a0, 1.0f)) * (ig * accu[i]);
                const unsigned w = pg8::cvt_pk_bf16(y, bt);
                wq[j] = w;
                ar[i] = __builtin_amdgcn_exp2f(-LOG2E * bflo(w)); ai[i] = bfhi(w);
            }
            YB[(d * 4 + q) * 64] = wq;
            __builtin_amdgcn_sched_barrier(0);
        }
        tile_scan<false>(ar, ai, d, hh, 0.f, aggP[d], aggH[d], hdummy);
        __builtin_amdgcn_sched_barrier(0);
    }
    f32x2* AT = (f32x2*)(ws + WS_AGGT); f32x2* AG = (f32x2*)(ws + WS_AGGG);
    LAS f32x2* la = (LAS f32x2*)lds;
    if (hh == 0) {
#pragma unroll
        for (int d = 0; d < 2; ++d) { const f32x2 v = (f32x2){aggP[d], aggH[d]};
            AT[((size_t)(b * NTILE + grp * 8 + wave) * 2 + d) * DLRU + ch] = v; la[(wave * 2 + d) * 32 + r] = v; }
    }
    __syncthreads();
    if (wave == 0) {
        const int d = hh; float Pp = 1.f, Hh = 0.f;
#pragma unroll
        for (int i = 0; i < 8; ++i) { const int w = d ? 7 - i : i; const f32x2 v = la[(w * 2 + d) * 32 + r]; Hh = v.x * Hh + v.y; Pp *= v.x; }
        AG[((size_t)(b * NGRP + grp) * 2 + d) * DLRU + ch] = (f32x2){Pp, Hh};
    }
    __syncthreads();
}

__device__ __forceinline__ void lru_final_unit(unsigned char* ws, int l, int b, int grp, int h, int cb, int wave, int lane) {
    asm volatile("" : "+s"(wave)); asm volatile("" : "+v"(lane));
    const bf16* Z = (const bf16*)(ws + WS_Z);
    const int r = lane & 31, hh = lane >> 5;
    int seqbase, t0;
    if (grp == 0) { seqbase = TL + b * CTXL; t0 = wave * 32; } else { seqbase = b * SEQ; t0 = (grp - 1) * 256 + wave * 32; }
    const int ch = 64 * h + 32 * cb + r;
    const u32x4* YB = (const u32x4*)(ws + WS_YB) + (size_t)lru_item(b, grp, h, cb, wave) * 8 * 64 + lane;
    u32x4 W[8];
#pragma unroll
    for (int j = 0; j < 8; ++j) W[j] = YB[j * 64];
    unsigned short yg[16];
#pragma unroll
    for (int i = 0; i < 16; ++i) { const int row = (i & 3) + 8 * (i >> 2) + 4 * hh; yg[i] = Z[(size_t)(seqbase + t0 + row) * DIN + DLRU + ch]; }
    float C0, C1;
    {
        const f32x2* AGGT = (const f32x2*)(ws + WS_AGGT); const f32x2* AGGG = (const f32x2*)(ws + WS_AGGG);
        float c = 0.f;
        const int d = hh;
        if (grp > 0) {
            { const f32x2 g0 = AGGG[((size_t)(b * NGRP + 0) * 2 + d) * DLRU + ch]; c = g0.y; }
            f32x2 gv[7];
#pragma unroll
            for (int i = 0; i < 7; ++i) { const int g = d ? 8 - i : 1 + i; const bool valid = d ? (i < 8 - grp) : (i < grp - 1);
                gv[i] = valid ? AGGG[((size_t)(b * NGRP + g) * 2 + d) * DLRU + ch] : (f32x2){1.f, 0.f}; }
#pragma unroll
            for (int i = 0; i < 7; ++i) c = gv[i].x * c + gv[i].y;
        }
        f32x2 tv[7];
#pragma unroll
        for (int i = 0; i < 7; ++i) { const int tw = d ? 7 - i : i; const bool valid = d ? (i < 7 - wave) : (i < wave);
            tv[i] = valid ? AGGT[((size_t)(b * NTILE + grp * 8 + tw) * 2 + d) * DLRU + ch] : (f32x2){1.f, 0.f}; }
#pragma unroll
        for (int i = 0; i < 7; ++i) c = tv[i].x * c + tv[i].y;
        C0 = __shfl(c, r); C1 = __shfl(c, 32 + r);
    }
    float hsum[16];
#pragma unroll
    for (int d = 0; d < 2; ++d) {
        f32x16 ar, ai;
#pragma unroll
        for (int q = 0; q < 4; ++q)
#pragma unroll
            for (int j = 0; j < 4; ++j) { const unsigned w = W[d * 4 + q][j]; ar[4 * q + j] = __builtin_amdgcn_exp2f(-LOG2E * bflo(w)); ai[4 * q + j] = bfhi(w); }
        float aP, aH;
        tile_scan<true>(ar, ai, d, hh, d ? C1 : C0, aP, aH, hsum);
    }
    bf16* MIX = (bf16*)(ws + WS_MIX);
#pragma unroll
    for (int i = 0; i < 16; ++i) {
        const int row = (i & 3) + 8 * (i >> 2) + 4 * hh;
        MIX[(size_t)(seqbase + t0 + row) * D + ch] = (bf16)f2bf(hsum[i] * gelu_tanh(bf2f(yg[i])));
    }
}

constexpr int PX_PITCH = 528, PD_PITCH = 528;
constexpr int PX_OFF = 0, PD_OFF = 80 * PX_PITCH;
__device__ __forceinline__ void pool_unit(unsigned char* ws, int l, LAS unsigned char* lds, int c, int gp, int tid, int wave, int lane) {
    asm volatile("" : "+s"(wave)); asm volatile("" : "+v"(lane)); asm volatile("" : "+v"(tid));
    const bf16* Z = (const bf16*)(ws + WS_Z); bf16* MIX = (bf16*)(ws + WS_MIX);
    int seqbase, t0, seg_lo, seg_hi;
    if (c < 256) { seqbase = (c >> 5) * SEQ; t0 = (c & 31) * 64; seg_lo = t0; seg_hi = t0 + 64; }
    else { const int cc = c - 256; seqbase = TL + (cc >> 2) * CTXL; t0 = (cc & 3) * 64; seg_lo = 0; seg_hi = CTXL; }
    const int r_lo = max(t0 - 8, seg_lo), r_hi = min(t0 + 72, seg_hi);
    { const int sub = tid >> 5, l32 = tid & 31;
      for (int t = r_lo + sub; t < r_hi; t += 16) {
          const u32x4 v = *(const u32x4*)(Z + (size_t)(seqbase + t) * DIN + 2 * DLRU + 256 * gp + 8 * l32);
          *(LAS u32x4*)(lds + PX_OFF + (t - (t0 - 8)) * PX_PITCH + 16 * l32) = v;
      } }
    __syncthreads();
    { const int cp = tid & 127, tq = tid >> 7;
      const int g = 2 * gp + (cp >> 6);
      const int half = 1 << g;
      const LAS unsigned char* xb = lds + PX_OFF + 4 * cp - (t0 - 8) * PX_PITCH;
      int t = t0 + 16 * tq;
      int lo = max(t - half, seg_lo), hi = min(t + half, seg_hi);
      float s0 = 0.f, s1 = 0.f;
      for (int j = lo; j < hi; ++j) { const unsigned w = *(const LAS unsigned*)(xb + j * PX_PITCH); s0 += bflo(w); s1 += bfhi(w); }
#pragma unroll 4
      for (int i = 0; i < 16; ++i, ++t) {
          const unsigned wx = *(const LAS unsigned*)(xb + t * PX_PITCH);
          const float inv = 1.0f / (float)(hi - lo);
          const float d0 = s0 * inv - bflo(wx), d1 = s1 * inv - bfhi(wx);
          *(LAS unsigned*)(lds + PD_OFF + (t - t0) * PD_PITCH + 4 * cp) = pk2(d0, d1);
          const int nlo = max(t + 1 - half, seg_lo), nhi = min(t + 1 + half, seg_hi);
          if (nhi > hi) { const unsigned w = *(const LAS unsigned*)(xb + hi * PX_PITCH); s0 += bflo(w); s1 += bfhi(w); }
          if (nlo > lo) { const unsigned w = *(const LAS unsigned*)(xb + lo * PX_PITCH); s0 -= bflo(w); s1 -= bfhi(w); }
          lo = nlo; hi = nhi;
      } }
    __syncthreads();
    { const int gl = wave >> 2, th = (wave >> 1) & 1, nh = wave & 1, r = lane & 31, hh = lane >> 5;
      const int g = 2 * gp + gl;
      const bf16* WP = (const bf16*)(ws + WS_WP) + (size_t)(l * 4 + g) * 128 * 128;
      f32x16 acc[2];
#pragma unroll
      for (int q = 0; q < 2; ++q)
#pragma unroll
          for (int i = 0; i < 16; ++i) acc[q][i] = 0.f;
      const LAS unsigned char* arow = lds + PD_OFF + (th * 32 + r) * PD_PITCH + (gl * 128 + 8 * hh) * 2;
#pragma unroll
      for (int s = 0; s < 8; ++s) {
          const bf16x8 Af = *(const LAS bf16x8*)(arow + 32 * s);
#pragma unroll
          for (int nt = 0; nt < 2; ++nt) { const bf16x8 Bf = *(const bf16x8*)(WP + (size_t)(nh * 64 + nt * 32 + r) * 128 + 16 * s + 8 * hh);
              acc[nt] = __builtin_amdgcn_mfma_f32_32x32x16_bf16(Af, Bf, acc[nt], 0, 0, 0); }
      }
#pragma unroll
      for (int nt = 0; nt < 2; ++nt) {
          const int co = 128 * g + 64 * nh + 32 * nt + r;
          const float* SP = (const float*)(ws + WS_SP) + (size_t)l * SP_STRIDE; const float pb = SP[SP_PB + co], ps = SP[SP_PS + co];
#pragma unroll
          for (int i = 0; i < 16; ++i) {
              const int row = (i & 3) + 8 * (i >> 2) + 4 * hh;
              MIX[(size_t)(seqbase + t0 + th * 32 + row) * D + DLRU + co] = (bf16)f2bf((acc[nt][i] + pb) * ps);
          }
      } }
    __syncthreads();
}

constexpr int L1_PITCH = 2064;
constexpr int L1_PART = 16 * L1_PITCH;
constexpr int L1_MAXB = 5;
constexpr int L1_ROWS = L1_PART + 16384 + 256 + L1_MAXB * 64 * 16;
static_assert(L1_ROWS + L1_MAXB * 16 * 1024 <= LDS_TB, "LN1 LDS map");
__device__ __forceinline__ void phase_ln1(unsigned char* ws, int l, LAS unsigned char* lds, int bid, int G, int tid, int wave, int lane) {
    const float* MOD = (const float*)(ws + WS_MOD) + (size_t)l * 9 * 6144;
    float* XL = (float*)(ws + WS_XL); fp8* H8S = (fp8*)(ws + WS_H8S); const bf16* Y1 = (const bf16*)(ws + WS_Y1);
    const float* SP = (const float*)(ws + WS_SP) + (size_t)l * SP_STRIDE;
    const float* lg = SP + SP_L1G; const float* lb = SP + SP_L1B; const float* rb = SP + SP_RB;
    int* cnt = (int*)(ws + WS_CTL) + CW_CNT + 32 * l;
    float* TOPG = (float*)(ws + WS_TOPG); int* ROWDST = (int*)(ws + WS_ROWDST);
    const int ntok = (l == DEPTH - 1) ? TL : TT;
    const bf16* RWT = (const bf16*)(ws + WS_RWT) + (size_t)l * NE * D;
    bf16x8 Bf[4][2];
#pragma unroll
    for (int s = 0; s < 4; ++s)
#pragma unroll
        for (int nt = 0; nt < 2; ++nt) Bf[s][nt] = *(const bf16x8*)(RWT + (size_t)(16 * nt + (lane & 15)) * D + 128 * wave + 32 * s + 8 * (lane >> 4));
    LAS float* part = (LAS float*)(lds + L1_PART);
    LAS int* lcnt = (LAS int*)(lds + L1_PART + 16384);
    LAS int* lbase = lcnt + 32;
    LAS u32x4* ent = (LAS u32x4*)(lds + L1_PART + 16384 + 256);
    if (tid < 32) lcnt[tid] = 0;
    int nb_local = 0;
    __syncthreads();
    f32x4 px[2][4]; u32x2 py[2][4];
#define L1_LOAD(batch_) do { _Pragma("unroll") for (int rr = 0; rr < 2; ++rr) { const int tok_ = (batch_) * 16 + 2 * wave + rr; _Pragma("unroll") for (int j = 0; j < 4; ++j) { \
        px[rr][j] = ((const f32x4*)(XL + (size_t)tok_ * D))[lane + 64 * j]; py[rr][j] = ((const u32x2*)(Y1 + (size_t)tok_ * D))[lane + 64 * j]; } } } while (0)
    if (bid < ntok / 16) L1_LOAD(bid);
    for (int batch = bid; batch < ntok / 16 && nb_local < L1_MAXB; batch += G) {
        f32x4 v[2][4];
#pragma unroll
        for (int rr = 0; rr < 2; ++rr) {
            const int tok = batch * 16 + 2 * wave + rr;
            const float* m = MOD + (size_t)mod_row(tok) * 6144;
#pragma unroll
            for (int j = 0; j < 4; ++j) {
                const f32x4 g1 = ((const f32x4*)(m + 2048))[lane + 64 * j];
                const u32x2 yr = py[rr][j];
                f32x4 y; y.x = bflo(yr.x); y.y = bfhi(yr.x); y.z = bflo(yr.y); y.w = bfhi(yr.y);
                v[rr][j] = px[rr][j] * ALPHA + g1 * y;
            }
        }
        if (batch + G < ntok / 16 && nb_local + 1 < L1_MAXB) L1_LOAD(batch + G);
#pragma unroll
        for (int rr = 0; rr < 2; ++rr) {
            const int trow = 2 * wave + rr, tok = batch * 16 + trow;
            const float* m = MOD + (size_t)mod_row(tok) * 6144;
            f32x4 h[4];
            float mean, rstd; ln_stats(v[rr], mean, rstd);
#pragma unroll
            for (int j = 0; j < 4; ++j) {
                const f32x4 gg = ((const f32x4*)lg)[lane + 64 * j], bb = ((const f32x4*)lb)[lane + 64 * j];
                const f32x4 o = (v[rr][j] - mean) * rstd * gg + bb;
                ((f32x4*)(XL + (size_t)tok * D))[lane + 64 * j] = o;
                const f32x4 sh = ((const f32x4*)(m + 3072))[lane + 64 * j], sc = ((const f32x4*)(m + 4096))[lane + 64 * j];
                h[j] = o * (sc + 1.0f) + sh;
                u32x2 w; w.x = pk2(h[j].x, h[j].y); w.y = pk2(h[j].z, h[j].w);
                int w8 = 0; w8 = __builtin_amdgcn_cvt_pk_fp8_f32(h[j].x, h[j].y, w8, false); w8 = __builtin_amdgcn_cvt_pk_fp8_f32(h[j].z, h[j].w, w8, true);
                *(LAS unsigned*)(lds + L1_ROWS + (nb_local * 16 + trow) * 1024 + (4 * lane + 256 * j)) = (unsigned)w8;
                *(LAS u32x2*)(lds + trow * L1_PITCH + (4 * lane + 256 * j) * 2) = w;
            }
        }
        __syncthreads();
        {
            f32x4 a2[2] = {(f32x4){0.f, 0.f, 0.f, 0.f}, (f32x4){0.f, 0.f, 0.f, 0.f}};
            const LAS unsigned char* arow = lds + (lane & 15) * L1_PITCH + (128 * wave + 8 * (lane >> 4)) * 2;
#pragma unroll
            for (int s = 0; s < 4; ++s) { const bf16x8 Af = *(const LAS bf16x8*)(arow + 64 * s);
#pragma unroll
                for (int nt = 0; nt < 2; ++nt) a2[nt] = __builtin_amdgcn_mfma_f32_16x16x32_bf16(Af, Bf[s][nt], a2[nt], 0, 0, 0); }
#pragma unroll
            for (int nt = 0; nt < 2; ++nt)
#pragma unroll
                for (int i = 0; i < 4; ++i) part[(wave * 16 + 4 * (lane >> 4) + i) * 32 + 16 * nt + (lane & 15)] = a2[nt][i];
        }
        __syncthreads();
        {
            const int trow = tid >> 5, e = tid & 31, tok = batch * 16 + trow;
            float lgt = rb[e];
#pragma unroll
            for (int w = 0; w < 8; ++w) lgt += part[(w * 16 + trow) * 32 + e];
            float tv[4]; int ti[4];
            float cur = lgt;
#pragma unroll
            for (int k = 0; k < 4; ++k) {
                float bv = cur; int bi = e;
#pragma unroll
                for (int o = 1; o < 32; o <<= 1) { const float ov = __shfl_xor(bv, o); const int oi = __shfl_xor(bi, o); if (ov > bv || (ov == bv && oi < bi)) { bv = ov; bi = oi; } }
                tv[k] = bv; ti[k] = bi;
                if (e == bi) cur = -INFINITY;
            }
            const float e1 = __expf(tv[1] - tv[0]), e2 = __expf(tv[2] - tv[0]), e3 = __expf(tv[3] - tv[0]);
            const float inv = 1.0f / (1.0f + e1 + e2 + e3);
            if (e < 4) {
                const int ex = e == 0 ? ti[0] : e == 1 ? ti[1] : e == 2 ? ti[2] : ti[3];
                const float pg = (e == 0 ? 1.0f : e == 1 ? e1 : e == 2 ? e2 : e3) * inv;
                const int ls = __hip_atomic_fetch_add(lcnt + ex, 1, __ATOMIC_RELAXED, __HIP_MEMORY_SCOPE_WORKGROUP);
                const int idx = (nb_local * 16 + trow) * 4 + e;
                ent[idx] = (u32x4){(unsigned)tok, (unsigned)ex, (unsigned)ls, __float_as_uint(pg)};
            }
        }
        ++nb_local;
        __syncthreads();
    }
    if (tid < 32) { const int c = lcnt[tid]; lbase[tid] = c > 0 ? atomicAdd(&cnt[tid], c) : 0; }
    __syncthreads();
    for (int i = wave; i < nb_local * 64; i += 8) {
        const u32x4 en = ent[i]; const int tok = (int)en.x, ex = (int)en.y, slot = lbase[ex] + (int)en.z;
        if (lane == 0) { TOPG[tok * 4 + (i & 3)] = __uint_as_float(en.w); ROWDST[(size_t)ex * TT + slot] = tok * 4 + (i & 3); }
        const u32x4 v = *(const LAS u32x4*)(lds + L1_ROWS + (i >> 2) * 1024 + 16 * lane);
        *(u32x4*)(H8S + ((size_t)ex * TT + slot) * D + 16 * lane) = v;
    }
    __syncthreads();
#undef L1_LOAD
}

__device__ __forceinline__ void phase_ln2(unsigned char* ws, float* out, int l, int gw, int ngw, int lane) {
    const float* MOD = (const float*)(ws + WS_MOD) + (size_t)l * 9 * 6144;
    float* XL = (float*)(ws + WS_XL); bf16* H = (bf16*)(ws + WS_H); const bf16* Y2 = (const bf16*)(ws + WS_Y2); const f32x4* TOPG = (const f32x4*)(ws + WS_TOPG);
    const float* SP = (const float*)(ws + WS_SP) + (size_t)l * SP_STRIDE;
    const float* lg = SP + SP_L2G; const float* lb = SP + SP_L2B;
    const bool last = (l == DEPTH - 1);
    const int ntok = last ? TL : TT;
    for (int tok0 = gw * 2; tok0 < ntok; tok0 += ngw * 2) {
        f32x4 v[2][4]; u32x2 yr[2][4][4]; f32x4 g2[2][4]; f32x4 gk[2];
#pragma unroll
        for (int t = 0; t < 2; ++t) {
            const int tok = tok0 + t;
            const float* m = MOD + (size_t)mod_row(tok) * 6144;
            gk[t] = TOPG[tok];
#pragma unroll
            for (int j = 0; j < 4; ++j) {
                v[t][j] = ((const f32x4*)(XL + (size_t)tok * D))[lane + 64 * j];
                g2[t][j] = ((const f32x4*)(m + 5120))[lane + 64 * j];
#pragma unroll
                for (int k = 0; k < 4; ++k) yr[t][k][j] = ((const u32x2*)(Y2 + ((size_t)tok * 4 + k) * D))[lane + 64 * j];
            }
        }
#pragma unroll
        for (int t = 0; t < 2; ++t) {
            const int tok = tok0 + t;
#pragma unroll
            for (int j = 0; j < 4; ++j) {
                f32x4 f = (f32x4){0.f, 0.f, 0.f, 0.f};
#pragma unroll
                for (int k = 0; k < 4; ++k) { const u32x2 r = yr[t][k][j]; const float g = gk[t][k]; f.x += g * bflo(r.x); f.y += g * bfhi(r.x); f.z += g * bflo(r.y); f.w += g * bfhi(r.y); }
                v[t][j] = v[t][j] * ALPHA + g2[t][j] * f;
            }
            float mean, rstd; ln_stats(v[t], mean, rstd);
            f32x4 h[4];
            const float* mn = MOD + (size_t)9 * 6144 + (size_t)mod_row(tok) * 6144;
#pragma unroll
            for (int j = 0; j < 4; ++j) {
                const f32x4 gg = ((const f32x4*)lg)[lane + 64 * j], bb = ((const f32x4*)lb)[lane + 64 * j];
                const f32x4 o = (v[t][j] - mean) * rstd * gg + bb;
                if (last) ((f32x4*)(out + (size_t)tok * D))[lane + 64 * j] = o;
                else {
                    ((f32x4*)(XL + (size_t)tok * D))[lane + 64 * j] = o;
                    const f32x4 sh = ((const f32x4*)mn)[lane + 64 * j], sc = ((const f32x4*)(mn + 1024))[lane + 64 * j];
                    h[j] = o * (sc + 1.0f) + sh;
                }
            }
            if (!last) store_bf16_row(H + (size_t)tok * D, lane, h);
        }
    }
}

constexpr int NPHASE = 2 + 8 * DEPTH;
#ifndef PHMASK
#define PHMASK 0xFFFF
#endif
#define PH_ON(k) (((PHMASK) >> (k)) & 1)
#ifndef MK_PER_PHASE
#define MK_PER_PHASE 0
#endif
__global__ void __launch_bounds__(512, 2) mk_fwd(P p) {
    extern __shared__ __attribute__((aligned(16))) unsigned char lds_[];
    LAS unsigned char* lds = (LAS unsigned char*)lds_;
    const int tid = threadIdx.x, lane = tid & 63, wave = __builtin_amdgcn_readfirstlane(tid >> 6);
    const int G = gridDim.x, bid = blockIdx.x;
    volatile LAS unsigned* MISC = (volatile LAS unsigned*)(lds + LDS_MISC);
    if (tid < 4) MISC[tid] = 0u;
    __syncthreads();
    unsigned* barw = (unsigned*)(p.ws + WS_CTL) + CW_BAR;
    XcdBarrier bar; bar.bar = barw; bar.x = 0; bar.st = MISC;
    if (!MK_PER_PHASE) bar = xcd_barrier_post(barw, MISC);
    const int lo = p.ph_lo, hi = p.ph_hi;
#define IN(k) (lo <= (k) && (k) < hi)
#define SEAM(k) do { if (IN(k) && IN((k) + 1)) xcd_barrier(bar, wave == 0 && (int)__lane_id() == 0); } while (0)
    if (PH_ON(0) && IN(0)) { phase_p0a(p, lds, bid, G, tid, wave, lane); }
    SEAM(0);
    if (PH_ON(1) && IN(1)) { phase_entry(p, bid * 8 + wave, G * 8, lane); }
    SEAM(1);
#pragma unroll 1
    for (int l = 0; l < DEPTH; ++l) {
        const int pb = 2 + 8 * l;
#define FRESH() int tid_ = wave * 64 + (int)__lane_id(); asm volatile("" : "+v"(tid_)); const int lane_ = tid_ & 63; const int wave_ = __builtin_amdgcn_readfirstlane(tid_ >> 6); \
                size_t wz_ = 0; asm volatile("" : "+s"(wz_)); unsigned char* ws = p.ws + wz_; (void)lane_; (void)wave_
        if (PH_ON(2) && IN(pb + 0)) {
            FRESH();
            pg8::DenseOrder S; S.init(TT / 256, DIN / 256, G, bid);
            pg8::EpiStore E{(bf16*)(ws + WS_Z), DIN};
            pg8::gemm_phase<false>(lds, tid_, ws + WS_H, (const bf16*)(ws + WS_WIN) + (size_t)l * DIN * D, S, E);
        }
        SEAM(pb + 0);
        if (PH_ON(3) && IN(pb + 1)) {
            FRESH();
            int key = -1;
            for (int u = bid; u < NB * NGRP * NH * 2; u += G) { const int cb = u & 1, h = (u >> 1) & 7, bg = u >> 4;
                if ((u & 15) != key) { key = u & 15; lru_load_w(ws, l, h, cb, tid_, lds); }
                lru_agg_unit(ws, l, lds, bg / NGRP, bg % NGRP, h, cb, wave_, lane_); }
        }
        SEAM(pb + 1);
        if (PH_ON(4) && IN(pb + 2)) {
            FRESH();
            const int g0 = (l == DEPTH - 1) ? 1 : 0, ng = NGRP - g0;
            const int nlru = NB * ng * NH * 2, npool = ((l == DEPTH - 1) ? 256 : 288) * 2;
            for (int u = bid; u < nlru + npool; u += G) {
                if (u < nlru) { const int cb = u & 1, h = (u >> 1) & 7, bg = u >> 4; lru_final_unit(ws, l, bg / ng, g0 + bg % ng, h, cb, wave_, lane_); }
                else { const int q = u - nlru; pool_unit(ws, l, lds, q >> 1, q & 1, tid_, wave_, lane_); }
            }
        }
        SEAM(pb + 2);
        if (PH_ON(5) && IN(pb + 3)) {
            FRESH();
            pg8::DenseOrder S; S.init((l == DEPTH - 1 ? TL : TT) / 256, D / 256, G, bid);
            pg8::EpiStore E{(bf16*)(ws + WS_Y1), D};
            pg8::gemm_phase<false>(lds, tid_, ws + WS_MIX, (const bf16*)(ws + WS_WOUT) + (size_t)l * D * D, S, E);
        }
        SEAM(pb + 3);
        if (PH_ON(6) && IN(pb + 4)) { FRESH(); phase_ln1(ws, l, lds, bid, G, tid_, wave_, lane_); }
        SEAM(pb + 4);
        if (IN(pb + 5) || IN(pb + 6)) {
            FRESH();
            const int* cnt = (const int*)(ws + WS_CTL) + CW_CNT + 32 * l;
            LAS int* tb = (LAS int*)(lds + LDS_TB);
            if (tid_ < 64) { const int c = lane_ < 32 ? (cnt[lane_] + 255) >> 8 : 0; int s = c;
#pragma unroll
                for (int o = 1; o < 32; o <<= 1) { const int t = __shfl_up(s, o); if (lane_ >= o) s += t; }
                if (lane_ < 32) tb[lane_ + 1] = s; if (lane_ == 0) tb[0] = 0; }
            __syncthreads();
        }
        if (PH_ON(7) && IN(pb + 5)) {
            FRESH();
            const int* cnt = (const int*)(ws + WS_CTL) + CW_CNT + 32 * l;
            pg8::MoeOrder<8, true> S{(const LAS int*)(lds + LDS_TB), cnt, G, bid};
            pg8::EpiSwiglu E{(fp8*)(ws + WS_ACT), (const float*)(ws + WS_SP) + (size_t)l * SP_STRIDE + SP_B1};
            pg8::gemm_phase<true>(lds, tid_, ws + WS_H8S, ws + WS_W1T + (size_t)l * NE * 2 * DF * D, S, E);
        }
        SEAM(pb + 5);
        if (PH_ON(8) && IN(pb + 6)) {
            FRESH();
            const int* cnt = (const int*)(ws + WS_CTL) + CW_CNT + 32 * l;
            pg8::MoeOrder<4, false> S{(const LAS int*)(lds + LDS_TB), cnt, G, bid};
            pg8::EpiDown E{(bf16*)(ws + WS_Y2), (const float*)(ws + WS_SP) + (size_t)l * SP_STRIDE + SP_B2, (const int*)(ws + WS_ROWDST)};
            pg8::gemm_phase<true>(lds, tid_, ws + WS_ACT, ws + WS_W2T + (size_t)l * NE * D * DF, S, E);
        }
        SEAM(pb + 6);
        if (PH_ON(9) && IN(pb + 7)) { FRESH(); phase_ln2(ws, p.out, l, bid * 8 + wave_, G * 8, lane_); }
        SEAM(pb + 7);
#undef FRESH
    }
#undef IN
#undef SEAM
}

extern "C" void kernel_launch(void* const* d_in, const int* in_sizes, int n_in, void* d_out, int out_size, void* d_ws, size_t ws_size, hipStream_t stream) {
    static int grid = 0;
    if (grid == 0) {
        if (n_in != N_IN || ws_size < WS_END || out_size != TL * D) { fprintf(stderr, "kernel_launch: unexpected shapes (n_in %d, out %d, ws %zu)\n", n_in, out_size, ws_size); grid = -1; return; }
        int dev = 0, cus = 0, per_cu = 0;
        if (hipGetDevice(&dev) != hipSuccess || hipDeviceGetAttribute(&cus, hipDeviceAttributeMultiprocessorCount, dev) != hipSuccess) { grid = -1; return; }
        if (hipFuncSetAttribute((const void*)mk_fwd, hipFuncAttributeMaxDynamicSharedMemorySize, LDS_BYTES) != hipSuccess) { fprintf(stderr, "kernel_launch: hipFuncSetAttribute failed\n"); grid = -1; return; }
        if (hipOccupancyMaxActiveBlocksPerMultiprocessor(&per_cu, (const void*)mk_fwd, 512, LDS_BYTES) != hipSuccess || per_cu < 1) { fprintf(stderr, "kernel_launch: occupancy query says %d\n", per_cu); }
        (void)hipGetLastError();
        grid = cus & ~7;
        if (grid < 231) { fprintf(stderr, "kernel_launch: this build needs at least 231 CUs (has %d)\n", cus); grid = -1; return; }
    }
    if (grid < 0) return;
    (void)hipMemsetAsync((char*)d_ws + WS_CTL, 0, CTL_BYTES, stream);
    P p{};
    for (int i = 0; i < N_IN; ++i) p.in[i] = (const float*)d_in[i];
    p.out = (float*)d_out; p.ws = (unsigned char*)d_ws;
#if MK_PER_PHASE
    for (int ph = 0; ph < NPHASE; ++ph) { p.ph_lo = ph; p.ph_hi = ph + 1; hipLaunchKernelGGL(mk_fwd, dim3(grid), dim3(512), LDS_BYTES, stream, p);
#ifdef EXTRA_PHASE
        if (ph == EXTRA_PHASE) for (int r = 0; r < EXTRA_REPS; ++r) hipLaunchKernelGGL(mk_fwd, dim3(grid), dim3(512), LDS_BYTES, stream, p);
#endif
    }
#else
    p.ph_lo = 0; p.ph_hi = NPHASE;
    hipLaunchKernelGGL(mk_fwd, dim3(grid), dim3(512), LDS_BYTES, stream, p);
#endif
}
```

```cpp
#include <hip/hip_runtime.h>
#include <cstdio>
#include <cstdint>

constexpr int NB = 8, SEQ = 2048, D = 1024, CTXL = 256, DEPTH = 2;
constexpr int TL = NB * SEQ;
constexpr int TC = NB * CTXL;
constexpr int TT = TL + TC;
constexpr int DLRU = 512, DPOOL = 512, DIN = 1536, NH = 8, HD = 64;
constexpr int NE = 32, TOPK = 4, DF = 1024;
constexpr int GRIDW = 64;
constexpr float LN_EPS = 1e-5f;
constexpr float ALPHA = 1.41421356237309515f;
constexpr int MAXROWS = 81920;
constexpr int NTILE = 72, NGRP = 9;

enum { I_X = 0, I_C, I_CTX, I_CCTX, I_WMOD, I_BMOD, I_WIN, I_CONVW, I_CONVB, I_GAW, I_GAB, I_GXW, I_GXB, I_LAM, I_POOLW, I_POOLB, I_POOLS,
       I_WOUT, I_LN1G, I_LN1B, I_RW, I_RB, I_W1, I_B1, I_W2, I_B2, I_LN2G, I_LN2B, N_IN };

constexpr size_t MiB = 1u << 20;
constexpr size_t WS_CTL = 0, CTL_BYTES = 1 * MiB;
constexpr size_t WS_MOD = 1 * MiB;
constexpr size_t WS_POS = 2 * MiB;
constexpr size_t WS_RWT = 2 * MiB + 512 * 1024;
constexpr size_t WS_TOPG = 7 * MiB;
constexpr size_t WS_AGGT = 10 * MiB;
constexpr size_t WS_AGGG = 15 * MiB;
constexpr size_t WS_WIN = 16 * MiB, WS_WOUT = 23 * MiB, WS_WG = 28 * MiB, WS_WP = 29 * MiB;
constexpr size_t WS_SP = 30 * MiB;
constexpr size_t WS_W1T = 32 * MiB, WS_W2T = 160 * MiB;
constexpr size_t WS_H8S = 1052 * MiB;
constexpr int W1_SH = 6, W2_SH = 7;
constexpr int SP_CW = 0, SP_CB = 2048, SP_GAB = 2560, SP_GXB = 3584, SP_CC = 4608, SP_PB = 5632, SP_PS = 6144, SP_L1G = 6656, SP_L1B = 7680, SP_L2G = 8704, SP_L2B = 9728, SP_RB = 10752,
              SP_B1 = 12288, SP_B2 = SP_B1 + 32 * 2048, SP_STRIDE = SP_B2 + 32 * 1024;
constexpr size_t WS_XL = 416 * MiB;
constexpr size_t WS_H = 488 * MiB;
constexpr size_t WS_Z = 524 * MiB;
constexpr size_t WS_MIX = 578 * MiB;
constexpr size_t WS_Y1 = 614 * MiB;
constexpr size_t WS_ACT = 650 * MiB;
constexpr size_t WS_Y2 = 810 * MiB;
constexpr size_t WS_YB = 970 * MiB;
constexpr size_t WS_ROWDST = 1046 * MiB;
constexpr size_t WS_END = 1628 * MiB;
constexpr int CW_CNT = 64;
constexpr int CW_BAR = 4096;

typedef unsigned short bf16;
typedef float f32x4 __attribute__((ext_vector_type(4)));
typedef float f32x2 __attribute__((ext_vector_type(2)));
typedef float f32x16 __attribute__((ext_vector_type(16)));
typedef unsigned u32x2 __attribute__((ext_vector_type(2)));
typedef unsigned u32x4 __attribute__((ext_vector_type(4)));
typedef short bf16x8 __attribute__((ext_vector_type(8)));
typedef int i32x8 __attribute__((ext_vector_type(8)));
typedef unsigned char fp8;

__device__ __forceinline__ float bf2f(bf16 v) { return __uint_as_float(((unsigned)v) << 16); }
__device__ __forceinline__ float bflo(unsigned w) { return __uint_as_float(w << 16); }
__device__ __forceinline__ float bfhi(unsigned w) { return __uint_as_float(w & 0xffff0000u); }
__device__ __forceinline__ unsigned f2bf(float f) { unsigned u = __float_as_uint(f); return (u + 0x7fffu + ((u >> 16) & 1u)) >> 16; }
__device__ __forceinline__ unsigned pk2(float lo, float hi) { return f2bf(lo) | (f2bf(hi) << 16); }
__device__ __forceinline__ float wave_sum(float v) {
#pragma unroll
    for (int o = 1; o < 64; o <<= 1) v += __shfl_xor(v, o);
    return v;
}
__device__ __forceinline__ float fsigmoid(float x) { return __builtin_amdgcn_rcpf(1.0f + __expf(-x)); }
__device__ __forceinline__ float gelu_tanh(float x) {
    const float u = 0.7978845608028654f * (x + 0.044715f * x * x * x);
    const float t = 1.0f - 2.0f * __builtin_amdgcn_rcpf(__expf(2.0f * u) + 1.0f);
    return 0.5f * x * (1.0f + t);
}

struct P {
    const float* in[N_IN];
    float* out;
    unsigned char* ws;
    int ph_lo, ph_hi;
};

__device__ __forceinline__ int mod_row(int tok) { return tok < TL ? (tok >> 11) : NB; }
__device__ __forceinline__ int pad256(int c) { return (c + 255) & ~255; }

__device__ __forceinline__ void ln_stats(const f32x4 (&v)[4], float& mean, float& rstd) {
    float s = 0.f;
#pragma unroll
    for (int j = 0; j < 4; ++j) s += (v[j].x + v[j].y) + (v[j].z + v[j].w);
    mean = wave_sum(s) * (1.f / D);
    float s2 = 0.f;
#pragma unroll
    for (int j = 0; j < 4; ++j) { const f32x4 d = v[j] - mean; s2 += (d.x * d.x + d.y * d.y) + (d.z * d.z + d.w * d.w); }
    rstd = 1.0f / sqrtf(wave_sum(s2) * (1.f / D) + LN_EPS);
}
__device__ __forceinline__ void store_bf16_row(bf16* row, int lane, const f32x4 (&h)[4]) {
    u32x2* o = (u32x2*)row + lane;
#pragma unroll
    for (int j = 0; j < 4; ++j) { u32x2 w; w.x = pk2(h[j].x, h[j].y); w.y = pk2(h[j].z, h[j].w); o[64 * j] = w; }
}


#define LAS __attribute__((address_space(3)))
struct CvtItem { const float* src; unsigned char* dst; int N, Kp, f8; float scale; };
__device__ __forceinline__ void tile_load(const CvtItem& it, int lane, f32x4 (&v)[16]) {
#pragma unroll
    for (int i = 0; i < 16; ++i) { const int k = 4 * i + (lane >> 4); v[i] = __builtin_nontemporal_load((const f32x4*)(it.src + (size_t)k * it.N + 4 * (lane & 15))); }
}
__device__ __forceinline__ void tile_store(const CvtItem& it, const f32x4 (&v)[16], LAS float* scr, int lane) {
#pragma unroll
    for (int i = 0; i < 16; ++i) { const int k = 4 * i + (lane >> 4); const int nn = (4 * (lane & 15)) ^ (((k >> 3) & 3) << 3); *(LAS f32x4*)(scr + k * 64 + nn) = v[i]; }
    asm volatile("s_waitcnt lgkmcnt(0)" ::: "memory");
    const int c = lane & 7, sw = (c & 3) << 3;
    if (it.f8) {
#pragma unroll
        for (int j = 0; j < 8; ++j) {
            const int n = (lane >> 3) + 8 * j;
            const LAS float* s = scr + (8 * c) * 64 + (n ^ sw);
            const float sc = it.scale;
            int w0 = 0, w1 = 0;
            w0 = __builtin_amdgcn_cvt_pk_fp8_f32(s[0] * sc, s[64] * sc, w0, false); w0 = __builtin_amdgcn_cvt_pk_fp8_f32(s[128] * sc, s[192] * sc, w0, true);
            w1 = __builtin_amdgcn_cvt_pk_fp8_f32(s[256] * sc, s[320] * sc, w1, false); w1 = __builtin_amdgcn_cvt_pk_fp8_f32(s[384] * sc, s[448] * sc, w1, true);
            *(u32x2*)(it.dst + (size_t)n * it.Kp + 8 * c) = (u32x2){(unsigned)w0, (unsigned)w1};
        }
    } else {
#pragma unroll
        for (int j = 0; j < 8; ++j) {
            const int n = (lane >> 3) + 8 * j;
            const LAS float* s = scr + (8 * c) * 64 + (n ^ sw);
            u32x4 o; o.x = pk2(s[0], s[64]); o.y = pk2(s[128], s[192]); o.z = pk2(s[256], s[320]); o.w = pk2(s[384], s[448]);
            *(u32x4*)(it.dst + ((size_t)n * it.Kp + 8 * c) * 2) = o;
        }
    }
    asm volatile("s_waitcnt lgkmcnt(0)" ::: "memory");
}
constexpr int CV_IN = DEPTH * 16 * 24, CV_OUT = DEPTH * 16 * 16, CV_G = DEPTH * 2 * 2 * NH, CV_P = DEPTH * 4 * 4, CV_1 = DEPTH * NE * 16 * 32, CV_2 = DEPTH * NE * 16 * 16;
constexpr int CV_ITEMS = CV_IN + CV_OUT + CV_G + CV_P + CV_1 + CV_2;
__device__ __forceinline__ CvtItem cvt_decode(const P& p, int r) {
    CvtItem it; it.f8 = 0; it.scale = 1.0f;
    if (r < CV_IN) { const int l = r / 384, q = r % 384, kb = q / 24, nb = q % 24;
        it.src = p.in[I_WIN] + (size_t)l * D * DIN + (size_t)(64 * kb) * DIN + 64 * nb; it.N = DIN; it.Kp = D; it.dst = p.ws + WS_WIN + (((size_t)l * DIN + 64 * nb) * D + 64 * kb) * 2; return it; }
    r -= CV_IN;
    if (r < CV_OUT) { const int l = r / 256, q = r % 256, kb = q / 16, nb = q % 16;
        it.src = p.in[I_WOUT] + (size_t)l * D * D + (size_t)(64 * kb) * D + 64 * nb; it.N = D; it.Kp = D; it.dst = p.ws + WS_WOUT + (((size_t)l * D + 64 * nb) * D + 64 * kb) * 2; return it; }
    r -= CV_OUT;
    if (r < CV_G) {
        const int h = r % NH, gt = (r / NH) % 2, d = (r / (NH * 2)) % 2, l = r / (NH * 4);
        it.src = (gt ? p.in[I_GXW] : p.in[I_GAW]) + ((size_t)(l * 2 + d) * NH + h) * HD * HD; it.N = HD; it.Kp = HD;
        it.dst = p.ws + WS_WG + (((size_t)(l * NH + h) * 256 + (d * 2 + gt) * 64) * HD) * 2; return it; }
    r -= CV_G;
    if (r < CV_P) {
        const int nb = r % 2, kb = (r / 2) % 2, lg = r / 4;
        it.src = p.in[I_POOLW] + (size_t)lg * 128 * 128 + (size_t)(64 * kb) * 128 + 64 * nb; it.N = 128; it.Kp = 128; it.dst = p.ws + WS_WP + (((size_t)lg * 128 + 64 * nb) * 128 + 64 * kb) * 2; return it; }
    r -= CV_P;
    it.f8 = 1;
    if (r < CV_1) {
        const int le = r / 512, q = r % 512, kb = q / 32, nb = q % 32;
        const int n0 = 64 * nb, j0 = n0 % DF, half = n0 / DF, row0 = (j0 / 128) * 256 + half * 128 + (j0 % 128);
        it.src = p.in[I_W1] + (size_t)le * D * 2 * DF + (size_t)(64 * kb) * (2 * DF) + n0; it.N = 2 * DF; it.Kp = D; it.scale = (float)(1 << W1_SH);
        it.dst = p.ws + WS_W1T + ((size_t)le * 2 * DF + row0) * D + 64 * kb; return it; }
    r -= CV_1;
    { const int le = r / 256, q = r % 256, kb = q / 16, nb = q % 16;
      it.src = p.in[I_W2] + (size_t)le * DF * D + (size_t)(64 * kb) * D + 64 * nb; it.N = D; it.Kp = DF; it.scale = (float)(1 << W2_SH);
      it.dst = p.ws + WS_W2T + ((size_t)le * D + 64 * nb) * DF + 64 * kb; }
    return it;
}
__device__ __forceinline__ void convert_weights(const P& p, LAS unsigned char* lds, int gw, int ngw, int wave, int lane) {
    LAS float* scr = (LAS float*)(lds + wave * 16384);
    int r = gw;
    if (r >= CV_ITEMS) return;
    CvtItem cur = cvt_decode(p, r);
    f32x4 v[16], vn[16];
    tile_load(cur, lane, v);
    for (;;) {
        const int rn = r + ngw; const bool more = rn < CV_ITEMS;
        CvtItem nxt = cur;
        if (more) { nxt = cvt_decode(p, rn); tile_load(nxt, lane, vn); }
        tile_store(cur, v, scr, lane);
        if (!more) break;
#pragma unroll
        for (int i = 0; i < 16; ++i) v[i] = vn[i];
        cur = nxt; r = rn;
    }
}

namespace pg8 {
typedef short bf16x8 __attribute__((ext_vector_type(8)));
constexpr int BM = 256, BK = 64, HALF = 128, HTB = HALF * BK * 2, STAGE_BYTES = 8 * HTB;
template <int XB> __host__ __device__ __forceinline__ int lds_byte(int r, int c) { const int st = (r >> 4) * 2 + (c >> 5), rr = r & 15, cc = c & 31, ob = rr * 64 + cc * 2; return st * 1024 + (ob ^ (((ob >> 9) & 1) << XB)); }
template <int XB> __host__ __device__ __forceinline__ void stage_rc(int b, int& R, int& C) { const int st = b / 1024, sb = b % 1024, swz = sb ^ (((sb >> 9) & 1) << XB); R = (st >> 1) * 16 + swz / 64; C = (st & 1) * 32 + (swz % 64) / 2; }
__host__ __device__ __forceinline__ int perm32(int rho) { const int n = rho >> 4, i = rho & 15; return 8 * (i >> 2) + 4 * n + (i & 3); }
__device__ __forceinline__ unsigned cvt_pk_bf16(float lo, float hi) { unsigned r; asm volatile("v_cvt_pk_bf16_f32 %0, %1, %2" : "=v"(r) : "v"(lo), "v"(hi)); return r; }

struct Unit { int a0, nvalid, b0, o0, pn, e, g0; };

template <bool F8, class Sched, class Epi>
__device__ __forceinline__ void gemm_phase(LAS unsigned char* lds, int tid, const void* Abase_, const void* Bt_, const Sched& S, const Epi& E) {
    constexpr int RP = F8 ? 1024 : 2048, nt = F8 ? 8 : 16;
    const int wid = __builtin_amdgcn_readfirstlane(tid >> 6), lane = tid & 63, wr = wid >> 2, wc = wid & 3, fr = lane & 15, fq = lane >> 4;
    unsigned voffA, voffB;
    { int R, C; stage_rc<F8 ? 4 : 5>(tid * 16, R, C); const int Rb = (R & ~31) + perm32(R & 31); voffA = (unsigned)(R * RP + 2 * C); voffB = (unsigned)(Rb * RP + 2 * C); }
    constexpr size_t kstep = (size_t)(BK * 2);
    constexpr size_t hstep = (size_t)HALF * RP;
    const unsigned ldsw = (unsigned)wid * 1024u;
    const int aoff = F8 ? lds_byte<4>(wr * 64 + fr, fq * 16) : lds_byte<5>(wr * 64 + fr, fq * 8), boff = F8 ? lds_byte<4>(wc * 32 + fr, fq * 16) : lds_byte<5>(wc * 32 + fr, fq * 8);
    const int one_scale = 0x7F7F7F7F;
#define PG8_SA(b, h) (((b) * 2 + (h)) * HTB)
#define PG8_SB(b, h) ((4 + (b) * 2 + (h)) * HTB)
#define PG8_STAGE(bufoff, gbase, voff) do { _Pragma("unroll") for (int _i = 0; _i < 2; ++_i) { unsigned _vo = (voff); asm volatile("" : "+v"(_vo)); \
        __builtin_amdgcn_global_load_lds((const unsigned*)((const char*)(gbase) + (size_t)_i * (64 * RP) + _vo), (LAS unsigned*)(lds + (bufoff) + ldsw + _i * 8192), 16, 0, 0); } } while (0)
#define PG8_LD8(base, off) __builtin_bit_cast(i32x8, __builtin_shufflevector(*(const LAS u32x4*)((base) + (off)), *(const LAS u32x4*)((base) + ((off) ^ 16)), 0, 1, 2, 3, 4, 5, 6, 7))
#define PG8_LDA(dst, b, h) do { _Pragma("unroll") for (int m = 0; m < 4; ++m) { \
        if constexpr (F8) dst##8[m] = PG8_LD8(lds + PG8_SA(b, h) + m * 2048, aoff); \
        else { _Pragma("unroll") for (int k = 0; k < 2; ++k) dst[m][k] = *(const LAS bf16x8*)(lds + PG8_SA(b, h) + aoff + m * 2048 + k * 1024); } } } while (0)
#define PG8_LDB(dst, b, h) do { _Pragma("unroll") for (int n = 0; n < 2; ++n) { \
        if constexpr (F8) dst##8[n] = PG8_LD8(lds + PG8_SB(b, h) + n * 2048, boff); \
        else { _Pragma("unroll") for (int k = 0; k < 2; ++k) dst[n][k] = *(const LAS bf16x8*)(lds + PG8_SB(b, h) + boff + n * 2048 + k * 1024); } } } while (0)
#define PG8_MMA(ai, bj, At, Bt) do { __builtin_amdgcn_s_setprio(1); _Pragma("unroll") for (int m = 0; m < 4; ++m) _Pragma("unroll") for (int n = 0; n < 2; ++n) { \
        if constexpr (F8) acc[ai][bj][m][n] = __builtin_amdgcn_mfma_scale_f32_16x16x128_f8f6f4(Bt##8[n], At##8[m], acc[ai][bj][m][n], 0, 0, 0, one_scale, 0, one_scale); \
        else { _Pragma("unroll") for (int k = 0; k < 2; ++k) acc[ai][bj][m][n] = __builtin_amdgcn_mfma_f32_16x16x32_bf16(Bt[n][k], At[m][k], acc[ai][bj][m][n], 0, 0, 0); } } \
        __builtin_amdgcn_s_setprio(0); } while (0)
#define PG8_WAIT_V(n) asm volatile("s_waitcnt vmcnt(" #n ")" ::: "memory")
#define PG8_WAIT_L(n) asm volatile("s_waitcnt lgkmcnt(" #n ")" ::: "memory")
#define PG8_BAR __builtin_amdgcn_s_barrier()
#define PG8_SCHED __builtin_amdgcn_sched_barrier(0)
    Unit cur, nxt; int ui = 0;
    if (!S.next(0, cur)) return;
    f32x4 acc[2][2][4][2];
#pragma unroll
    for (int a = 0; a < 2; ++a)
#pragma unroll
        for (int b = 0; b < 2; ++b)
#pragma unroll
            for (int m = 0; m < 4; ++m)
#pragma unroll
                for (int n = 0; n < 2; ++n) acc[a][b][m][n] = (f32x4){0.f, 0.f, 0.f, 0.f};
    bf16x8 At[4][2], B0[2][2], B1[2][2];
    i32x8 At8[4], B08[2], B18[2];
    const char* cA = (const char*)Abase_ + (size_t)cur.a0 * RP; const char* cB = (const char*)Bt_ + (size_t)cur.b0 * RP;
    PG8_STAGE(PG8_SB(0, 0), cB, voffB); PG8_STAGE(PG8_SB(0, 1), cB + hstep, voffB); PG8_STAGE(PG8_SA(0, 0), cA, voffA); PG8_STAGE(PG8_SA(0, 1), cA + hstep, voffA);
    if (wr == 1) PG8_BAR;
    PG8_WAIT_V(2); PG8_BAR;
    PG8_STAGE(PG8_SB(1, 0), cB + kstep, voffB); PG8_STAGE(PG8_SA(1, 0), cA + kstep, voffA); PG8_STAGE(PG8_SB(1, 1), cB + hstep + kstep, voffB);
    PG8_WAIT_V(6); PG8_BAR;
    for (;;) {
        const bool has_next = S.next(ui + 1, nxt);
        const char* nA = has_next ? (const char*)Abase_ + (size_t)nxt.a0 * RP : cA; const char* nB = has_next ? (const char*)Bt_ + (size_t)nxt.b0 * RP : cB;
#pragma unroll 1
        for (int t = 0; t < nt; t += 2) {
            const bool last = (t == nt - 2);
            const char* a1 = cA + (size_t)(t + 1) * kstep;
            const char* a2 = last ? nA : cA + (size_t)(t + 2) * kstep; const char* b2 = last ? nB : cB + (size_t)(t + 2) * kstep;
            const char* a3 = a2 + kstep; const char* b3 = b2 + kstep;
            PG8_LDB(B0, 0, 0); PG8_LDB(B1, 0, 1); PG8_SCHED; PG8_LDA(At, 0, 0); PG8_STAGE(PG8_SA(1, 1), a1 + hstep, voffA);
            PG8_WAIT_V(8); PG8_WAIT_L(0); PG8_BAR; PG8_MMA(0, 0, At, B0); PG8_MMA(0, 1, At, B1); PG8_BAR; PG8_SCHED;
            PG8_LDA(At, 0, 1); PG8_STAGE(PG8_SB(0, 0), b2, voffB); PG8_STAGE(PG8_SB(0, 1), b2 + hstep, voffB); PG8_STAGE(PG8_SA(0, 0), a2, voffA);
            PG8_WAIT_V(8); PG8_WAIT_L(0); PG8_BAR; PG8_MMA(1, 0, At, B0); PG8_MMA(1, 1, At, B1); PG8_BAR; PG8_SCHED;
            PG8_LDB(B0, 1, 0); PG8_LDB(B1, 1, 1); PG8_SCHED; PG8_LDA(At, 1, 0); PG8_STAGE(PG8_SA(0, 1), a2 + hstep, voffA);
            PG8_WAIT_V(8); PG8_WAIT_L(0); PG8_BAR; PG8_MMA(0, 0, At, B0); PG8_MMA(0, 1, At, B1); PG8_BAR; PG8_SCHED;
            PG8_LDA(At, 1, 1); PG8_STAGE(PG8_SB(1, 0), b3, voffB); PG8_STAGE(PG8_SB(1, 1), b3 + hstep, voffB); PG8_STAGE(PG8_SA(1, 0), a3, voffA);
            PG8_WAIT_V(8); PG8_WAIT_L(0); PG8_BAR; PG8_MMA(1, 0, At, B0); PG8_MMA(1, 1, At, B1); PG8_BAR; PG8_SCHED;
        }
        if (wr == 0) PG8_BAR;
        PG8_SCHED; { int fr_ = fr, fq_ = fq; asm volatile("" : "+v"(fr_), "+v"(fq_)); E(acc, cur, wr, wc, fr_, fq_); } PG8_SCHED;
        if (!has_next) break;
#pragma unroll
        for (int a = 0; a < 2; ++a)
#pragma unroll
            for (int b = 0; b < 2; ++b)
#pragma unroll
                for (int m = 0; m < 4; ++m)
#pragma unroll
                    for (int n = 0; n < 2; ++n) acc[a][b][m][n] = (f32x4){0.f, 0.f, 0.f, 0.f};
        cur = nxt; cA = nA; cB = nB; ++ui;
        if (wr == 1) PG8_BAR;
    }
    PG8_WAIT_V(0);
    PG8_BAR;
#undef PG8_SA
#undef PG8_SB
#undef PG8_STAGE
#undef PG8_LDA
#undef PG8_LDB
#undef PG8_MMA
#undef PG8_LD8
#undef PG8_WAIT_V
#undef PG8_WAIT_L
#undef PG8_BAR
#undef PG8_SCHED
}

struct DenseOrder {
    int nM, nN, nwg, G, c;
    __device__ void init(int nM_, int nN_, int G_, int c_) { nM = nM_; nN = nN_; nwg = nM * nN; G = G_; c = c_; }
    __device__ bool next(int i, Unit& u) const {
        const long L = (long)i * G + c; if (L >= nwg) return false;
        int wgid = (int)L; { const int q = nwg / 8, r = nwg % 8, xcd = wgid % 8, off = wgid / 8; wgid = (xcd < r ? xcd * (q + 1) : r * (q + 1) + (xcd - r) * q) + off; }
        const int nig = 8 * nN, gid = wgid / nig, fm = gid * 8, gsz = (nM - fm) < 8 ? (nM - fm) : 8;
        const int pm = fm + ((wgid % nig) % gsz), pn = (wgid % nig) / gsz;
        u.a0 = pm * 256; u.nvalid = 256; u.b0 = pn * 256; u.o0 = pm * 256; u.pn = pn; u.e = 0; u.g0 = 0; return true;
    }
};
template <int NPN, bool UP> struct MoeOrder {
    const LAS int* tb; const int* cnt; int G, c;
    __device__ bool next(int i, Unit& u) const {
        const int L = i * G + c; const int total = tb[32] * NPN; if (L >= total) return false;
        int e = 0;
#pragma unroll 1
        for (int q = 16; q >= 1; q >>= 1) if (tb[e + q] * NPN <= L) e += q;
        const int te = tb[e + 1] - tb[e], j = L - tb[e] * NPN, pn = j / te, mt = j % te;
        const int ce = cnt[e];
        u.e = e; u.pn = pn; u.o0 = (tb[e] + mt) * 256; u.nvalid = min(256, ce - mt * 256);
        u.g0 = e * TT + mt * 256;
        u.a0 = UP ? u.g0 : u.o0;
        u.b0 = e * (UP ? 2 * DF : D) + pn * 256;
        return true;
    }
};

struct EpiStore {
    bf16* C; int ldc;
    __device__ __forceinline__ void operator()(const f32x4 (&acc)[2][2][4][2], const Unit& u, int wr, int wc, int fr, int fq) const {
        const int row0 = u.o0 + wr * 64 + fr, col0 = u.pn * 256 + wc * 32 + 8 * fq;
#pragma unroll
        for (int ai = 0; ai < 2; ++ai)
#pragma unroll
            for (int m = 0; m < 4; ++m) { bf16* rowp = C + (size_t)(row0 + ai * HALF + m * 16) * ldc + col0;
#pragma unroll
                for (int bj = 0; bj < 2; ++bj) { const f32x4 v0 = acc[ai][bj][m][0], v1 = acc[ai][bj][m][1];
                    u32x4 w; w.x = cvt_pk_bf16(v0[0], v0[1]); w.y = cvt_pk_bf16(v0[2], v0[3]); w.z = cvt_pk_bf16(v1[0], v1[1]); w.w = cvt_pk_bf16(v1[2], v1[3]);
                    *(u32x4*)(rowp + bj * HALF) = w; } }
    }
};
struct EpiSwiglu {
    fp8* C; const float* b1;
    __device__ __forceinline__ void operator()(const f32x4 (&acc)[2][2][4][2], const Unit& u, int wr, int wc, int fr, int fq) const {
        const int row0 = u.o0 + wr * 64 + fr, j0 = u.pn * 128 + wc * 32 + 8 * fq;
        const float* bb = b1 + (size_t)u.e * 2 * DF + j0;
        const f32x4 bg0 = *(const f32x4*)bb, bg1 = *(const f32x4*)(bb + 4), bl0 = *(const f32x4*)(bb + DF), bl1 = *(const f32x4*)(bb + DF + 4);
#pragma unroll
        for (int ai = 0; ai < 2; ++ai)
#pragma unroll
            for (int m = 0; m < 4; ++m) {
                float o[8];
#pragma unroll
                for (int n = 0; n < 2; ++n)
#pragma unroll
                    for (int q = 0; q < 4; ++q) {
                        constexpr float ws = 1.0f / (float)(1 << W1_SH);
                        const float gl = fminf(fmaf(acc[ai][0][m][n][q], ws, n ? bg1[q] : bg0[q]), 7.0f);
                        const float li = fminf(fmaxf(fmaf(acc[ai][1][m][n][q], ws, n ? bl1[q] : bl0[q]), -7.0f), 7.0f);
                        o[4 * n + q] = gl * __builtin_amdgcn_rcpf(1.0f + __expf(-1.702f * gl)) * (li + 1.0f);
                    }
                int w0 = 0, w1 = 0;
                w0 = __builtin_amdgcn_cvt_pk_fp8_f32(o[0], o[1], w0, false); w0 = __builtin_amdgcn_cvt_pk_fp8_f32(o[2], o[3], w0, true);
                w1 = __builtin_amdgcn_cvt_pk_fp8_f32(o[4], o[5], w1, false); w1 = __builtin_amdgcn_cvt_pk_fp8_f32(o[6], o[7], w1, true);
                *(u32x2*)(C + (size_t)(row0 + ai * HALF + m * 16) * DF + j0) = (u32x2){(unsigned)w0, (unsigned)w1};
            }
    }
};
struct EpiDown {
    fp8* C; const float* b2; const int* rowdst;
    __device__ __forceinline__ void operator()(const f32x4 (&acc)[2][2][4][2], const Unit& u, int wr, int wc, int fr, int fq) const {
        const int rt0 = wr * 64 + fr, col0 = u.pn * 256 + wc * 32 + 8 * fq;
        const float* bp = b2 + (size_t)u.e * D + col0;
        int dst[2][4];
#pragma unroll
        for (int ai = 0; ai < 2; ++ai)
#pragma unroll
            for (int m = 0; m < 4; ++m) { const int rt = rt0 + ai * HALF + m * 16; dst[ai][m] = rowdst[u.g0 + min(rt, u.nvalid - 1)]; if (rt >= u.nvalid) dst[ai][m] = -1; }
        constexpr float ws = 1.0f / (float)(1 << W2_SH);
#pragma unroll
        for (int bj = 0; bj < 2; ++bj) {
            const f32x4 bv0 = *(const f32x4*)(bp + bj * HALF), bv1 = *(const f32x4*)(bp + bj * HALF + 4);
#pragma unroll
            for (int ai = 0; ai < 2; ++ai)
#pragma unroll
                for (int m = 0; m < 4; ++m) {
                    const f32x4 v0 = acc[ai][bj][m][0] * ws + bv0, v1 = acc[ai][bj][m][1] * ws + bv1;
                    int w0 = 0, w1 = 0;
                    w0 = __builtin_amdgcn_cvt_pk_fp8_f32(v0[0], v0[1], w0, false); w0 = __builtin_amdgcn_cvt_pk_fp8_f32(v0[2], v0[3], w0, true);
                    w1 = __builtin_amdgcn_cvt_pk_fp8_f32(v1[0], v1[1], w1, false); w1 = __builtin_amdgcn_cvt_pk_fp8_f32(v1[2], v1[3], w1, true);
                    if (dst[ai][m] >= 0) *(u32x2*)(C + (size_t)dst[ai][m] * D + col0 + bj * HALF) = (u32x2){(unsigned)w0, (unsigned)w1};
                }
        }
    }
};
}

#define XB_TMO      128
#define XB_XCNT(j)  (256  + 64 * (j))
#define XB_XSUB(j)  (1280 + 64 * (j))
#define XB_XGEN(j)  (2304 + 64 * (j))
#define XB_TOP      3328
#define XB_TOPGEN   3392
#define XCD_BAR_WORDS 3456
#define XB_SPIN_CAP (1u << 18)
__device__ __forceinline__ unsigned xb_ld(unsigned* p)              { return __hip_atomic_load(p, __ATOMIC_RELAXED, __HIP_MEMORY_SCOPE_AGENT); }
__device__ __forceinline__ unsigned xb_add(unsigned* p, unsigned v) { return __hip_atomic_fetch_add(p, v, __ATOMIC_RELAXED, __HIP_MEMORY_SCOPE_AGENT); }
__device__ __forceinline__ unsigned xb_xcc_id() { return (unsigned)__builtin_amdgcn_s_getreg((3 << 11) | 20) & 0xFu; }
#define XB_SPIN(cond, bar) do { unsigned _sp = 0; while (cond) { __builtin_amdgcn_s_sleep(1); \
    if ((++_sp & 255u) == 0u) { if (xb_ld(&(bar)[XB_TMO])) break; if (_sp > XB_SPIN_CAP) { atomicAdd(&(bar)[XB_TMO], 1u); break; } } } } while (0)
struct XcdBarrier { unsigned* bar; unsigned x; volatile LAS unsigned* st; };
__device__ __forceinline__ XcdBarrier xcd_barrier_post(unsigned* bar, volatile LAS unsigned* st) {
    XcdBarrier b; b.bar = bar; b.x = xb_xcc_id(); b.st = st;
    if (threadIdx.x == 0) (void)xb_add(&bar[XB_XCNT(b.x)], 1u);
    return b;
}
__device__ __forceinline__ void xcd_barrier_complete(unsigned* bar, unsigned x, unsigned& nloc, unsigned& nx) {
    const unsigned G = gridDim.x * gridDim.y * gridDim.z;
    unsigned sum, cnt, mine, sp = 0u;
    for (;;) {
        sum = 0u; cnt = 0u; mine = 0u;
#pragma unroll
        for (unsigned j = 0; j < 16; ++j) { const unsigned c = xb_ld(&bar[XB_XCNT(j)]); sum += c; cnt += (c > 0u) ? 1u : 0u; mine = (j == x) ? c : mine; }
        if (sum == G) break;
        __builtin_amdgcn_s_sleep(1);
        if ((++sp & 255u) == 0u) { if (xb_ld(&bar[XB_TMO])) break; if (sp > XB_SPIN_CAP) { atomicAdd(&bar[XB_TMO], 1u); break; } }
    }
    nloc = mine > 0u ? mine : 1u; nx = cnt > 0u ? cnt : 1u;
}
__device__ __forceinline__ void xcd_barrier(const XcdBarrier& b, bool leader) {
    asm volatile("s_waitcnt vmcnt(0)" ::: "memory");
    __syncthreads();
    if (leader) {
        unsigned* bar = b.bar;
        __builtin_amdgcn_s_waitcnt(0);
        unsigned nloc = b.st[0], nx = b.st[1];
        if (nloc == 0u) { xcd_barrier_complete(bar, b.x, nloc, nx); b.st[0] = nloc; b.st[1] = nx; }
        const unsigned old = xb_add(&bar[XB_XSUB(b.x)], 1u);
        const unsigned gen = old / nloc;
        if (old + 1u == (gen + 1u) * nloc) {
            __builtin_amdgcn_fence(__ATOMIC_RELEASE, "agent");
            asm volatile("s_waitcnt vmcnt(0)" ::: "memory");
            const unsigned og = xb_add(&bar[XB_TOP], 1u);
            const unsigned tg = og / nx;
            if (og + 1u == (tg + 1u) * nx) xb_add(&bar[XB_TOPGEN], 1u);
            else XB_SPIN(xb_ld(&bar[XB_TOPGEN]) == tg, bar);
            __builtin_amdgcn_fence(__ATOMIC_ACQUIRE, "agent");
            xb_add(&bar[XB_XGEN(b.x)], 1u);
            asm volatile("s_waitcnt vmcnt(0)" ::: "memory");
        } else {
            XB_SPIN(xb_ld(&bar[XB_XGEN(b.x)]) == gen, bar);
            __builtin_amdgcn_fence(__ATOMIC_ACQUIRE, "agent");
            asm volatile("s_waitcnt vmcnt(0)" ::: "memory");
        }
    }
    __syncthreads();
}

constexpr int LDS_BYTES = 147456;
constexpr int LDS_TB = LDS_BYTES - 1024;
constexpr int LDS_MISC = LDS_BYTES - 512;

__device__ __forceinline__ void phase_p0a(const P& p, LAS unsigned char* lds, int bid, int G, int tid, int wave, int lane) {
    { float* POS = (float*)(p.ws + WS_POS);
      for (int i = (G - 1 - bid) * 512 + tid; i < 64 * 512; i += G * 512) {
          const int n = i / 512, j = i % 512, q = j % 256;
          const float omega = 1.0f / powf(10000.0f, (float)q / 256.0f);
          const float ang = (float)n * omega;
          POS[i] = j < 256 ? sinf(ang) : cosf(ang);
      } }
    { bf16* RWT = (bf16*)(p.ws + WS_RWT);
      for (int i = bid * 512 + tid; i < DEPTH * NE * 128; i += G * 512) {
          const int kc = i % 128, e = (i / 128) % NE, l = i / (128 * NE);
          const float* s = p.in[I_RW] + (size_t)l * D * NE + (size_t)(8 * kc) * NE + e;
          u32x4 o; o.x = pk2(s[0], s[NE]); o.y = pk2(s[2 * NE], s[3 * NE]); o.z = pk2(s[4 * NE], s[5 * NE]); o.w = pk2(s[6 * NE], s[7 * NE]);
          *(u32x4*)(RWT + ((size_t)l * NE + e) * D + 8 * kc) = o;
      } }
    { float* SP = (float*)(p.ws + WS_SP);
      const int gt = bid * 512 + tid, gn = G * 512;
      if (gn >= 32 * 2048) {
#pragma unroll
          for (int l = 0; l < DEPTH; ++l) {
              float* o = SP + (size_t)l * SP_STRIDE;
              const bool p2048 = gt < 2048, p512 = gt < 512, p1024 = gt < 1024, p32 = gt < 32, pb1 = gt < 32 * 2048, pb2 = gt < 32 * 1024;
              float cwv = 0.f, cbv = 0.f, pbv = 0.f, psv = 0.f, gab = 0.f, gxb = 0.f, lam = 0.f, l1g = 0.f, l1b = 0.f, l2g = 0.f, l2b = 0.f, rbv = 0.f, b1v = 0.f, b2v = 0.f;
              if (p2048) cwv = p.in[I_CONVW][(size_t)l * 2048 + gt];
              if (p512) { cbv = p.in[I_CONVB][(size_t)l * 512 + gt]; pbv = p.in[I_POOLB][(size_t)l * 512 + gt]; psv = p.in[I_POOLS][(size_t)l * 512 + gt]; }
              if (p1024) { gab = p.in[I_GAB][(size_t)l * 1024 + gt]; gxb = p.in[I_GXB][(size_t)l * 1024 + gt]; lam = p.in[I_LAM][(size_t)l * 1024 + gt];
                  l1g = p.in[I_LN1G][(size_t)l * 1024 + gt]; l1b = p.in[I_LN1B][(size_t)l * 1024 + gt]; l2g = p.in[I_LN2G][(size_t)l * 1024 + gt]; l2b = p.in[I_LN2B][(size_t)l * 1024 + gt]; }
              if (p32) rbv = p.in[I_RB][(size_t)l * 32 + gt];
              if (pb1) b1v = p.in[I_B1][(size_t)l * 32 * 2048 + gt];
              if (pb2) b2v = p.in[I_B2][(size_t)l * 32 * 1024 + gt];
              if (p2048) o[SP_CW + gt] = cwv;
              if (p512) { o[SP_CB + gt] = cbv; o[SP_PB + gt] = pbv; o[SP_PS + gt] = psv; }
              if (p1024) { o[SP_GAB + gt] = gab; o[SP_GXB + gt] = gxb; const float nl = -lam; o[SP_CC + gt] = 8.0f * (nl > 20.f ? nl : log1pf(expf(nl)));
                  o[SP_L1G + gt] = l1g; o[SP_L1B + gt] = l1b; o[SP_L2G + gt] = l2g; o[SP_L2B + gt] = l2b; }
              if (p32) o[SP_RB + gt] = rbv;
              if (pb1) o[SP_B1 + gt] = b1v;
              if (pb2) o[SP_B2 + gt] = b2v;
          }
      } else {
      for (int l = 0; l < DEPTH; ++l) {
          float* o = SP + (size_t)l * SP_STRIDE;
          for (int i = gt; i < 2048; i += gn) o[SP_CW + i] = p.in[I_CONVW][(size_t)l * 2048 + i];
          for (int i = gt; i < 512; i += gn) { o[SP_CB + i] = p.in[I_CONVB][(size_t)l * 512 + i]; o[SP_PB + i] = p.in[I_POOLB][(size_t)l * 512 + i]; o[SP_PS + i] = p.in[I_POOLS][(size_t)l * 512 + i]; }
          for (int i = gt; i < 1024; i += gn) { o[SP_GAB + i] = p.in[I_GAB][(size_t)l * 1024 + i]; o[SP_GXB + i] = p.in[I_GXB][(size_t)l * 1024 + i];
              const float nl = -p.in[I_LAM][(size_t)l * 1024 + i]; o[SP_CC + i] = 8.0f * (nl > 20.f ? nl : log1pf(expf(nl)));
              o[SP_L1G + i] = p.in[I_LN1G][(size_t)l * 1024 + i]; o[SP_L1B + i] = p.in[I_LN1B][(size_t)l * 1024 + i];
              o[SP_L2G + i] = p.in[I_LN2G][(size_t)l * 1024 + i]; o[SP_L2B + i] = p.in[I_LN2B][(size_t)l * 1024 + i]; }
          for (int i = gt; i < 32; i += gn) o[SP_RB + i] = p.in[I_RB][(size_t)l * 32 + i];
          for (int i = gt; i < 32 * 2048; i += gn) o[SP_B1 + i] = p.in[I_B1][(size_t)l * 32 * 2048 + i];
          for (int i = gt; i < 32 * 1024; i += gn) o[SP_B2 + i] = p.in[I_B2][(size_t)l * 32 * 1024 + i];
      } } }
    { LAS float* sl = (LAS float*)lds; LAS float* part = sl + 9 * 1024;
      const float* c = p.in[I_C]; const float* cc = p.in[I_CCTX];
      for (int i = tid; i < 9 * 1024; i += 512) { const float v = i < 8192 ? c[i] : cc[i - 8192]; sl[i] = v / (1.0f + __expf(-v)); }
      __syncthreads();
      float* MOD = (float*)(p.ws + WS_MOD);
      for (int u = bid; u < 2 * 96; u += G) {
          const int l = u / 96, n0 = (u % 96) * 64;
          const float* W = p.in[I_WMOD] + (size_t)l * 1024 * 6144 + n0;
          const int c4 = (tid & 15) * 4, ks = tid >> 4;
          f32x4 acc[9];
#pragma unroll
          for (int r = 0; r < 9; ++r) acc[r] = (f32x4){0.f, 0.f, 0.f, 0.f};
#pragma unroll
          for (int half = 0; half < 2; ++half) {
              f32x4 w[16];
#pragma unroll
              for (int kk = 0; kk < 16; ++kk) w[kk] = __builtin_nontemporal_load((const f32x4*)(W + (size_t)(ks * 32 + half * 16 + kk) * 6144 + c4));
#pragma unroll
              for (int kk = 0; kk < 16; ++kk) {
                  const int k = ks * 32 + half * 16 + kk;
#pragma unroll
                  for (int r = 0; r < 9; ++r) acc[r] += w[kk] * sl[r * 1024 + k];
              }
          }
#pragma unroll
          for (int r = 0; r < 9; ++r) *(LAS f32x4*)(part + (ks * 9 + r) * 64 + c4) = acc[r];
          __syncthreads();
          for (int o = tid; o < 9 * 64; o += 512) {
              const int r = o / 64, cl = o % 64; float sum = 0.f;
#pragma unroll
              for (int q = 0; q < 32; ++q) sum += part[(q * 9 + r) * 64 + cl];
              MOD[((size_t)l * 9 + r) * 6144 + n0 + cl] = sum + p.in[I_BMOD][(size_t)l * 6144 + n0 + cl];
          }
          __syncthreads();
      } }
    __syncthreads();
    convert_weights(p, lds, bid * 8 + wave, G * 8, wave, lane);
}

__device__ __forceinline__ void phase_entry(const P& p, int gw, int ngw, int lane) {
    const float* POS = (const float*)(p.ws + WS_POS);
    const float* MOD = (const float*)(p.ws + WS_MOD);
    float* XL = (float*)(p.ws + WS_XL); bf16* H = (bf16*)(p.ws + WS_H);
    for (int tok = gw; tok < TT; tok += ngw) {
        const float* src = tok < TL ? p.in[I_X] + (size_t)tok * D : p.in[I_CTX] + (size_t)(tok - TL) * D;
        f32x4 v[4];
#pragma unroll
        for (int j = 0; j < 4; ++j) v[j] = ((const f32x4*)src)[lane + 64 * j];
        if (tok < TL) {
            const int s = tok & (SEQ - 1), pr = s / GRIDW, pc = s % GRIDW;
#pragma unroll
            for (int j = 0; j < 4; ++j) {
                const float* ps = POS + (size_t)(j < 2 ? pr : pc) * 512 + (4 * lane + 256 * (j & 1));
                v[j] += *(const f32x4*)ps;
            }
        }
        float mean, rstd; ln_stats(v, mean, rstd);
        const float* m = MOD + (size_t)mod_row(tok) * 6144;
        f32x4 h[4];
#pragma unroll
        for (int j = 0; j < 4; ++j) {
            v[j] = (v[j] - mean) * rstd;
            ((f32x4*)(XL + (size_t)tok * D))[lane + 64 * j] = v[j];
            const f32x4 sh = ((const f32x4*)m)[lane + 64 * j], sc = ((const f32x4*)(m + 1024))[lane + 64 * j];
            h[j] = v[j] * (sc + 1.0f) + sh;
        }
        store_bf16_row(H + (size_t)tok * D, lane, h);
    }
}

constexpr float LOG2E = 1.4426950408889634f;
__device__ __forceinline__ float fast_sigmoid(float x) { return __builtin_amdgcn_rcpf(1.0f + __builtin_amdgcn_exp2f(-LOG2E * x)); }
__device__ __forceinline__ int lru_item(int b, int grp, int h, int cb, int wave) { return ((((b * NGRP + grp) * NH + h) * 2 + cb) * 8 + wave); }

template <bool FINAL>
__device__ __forceinline__ void tile_scan(const f32x16& ar, const f32x16& ai, int d, int hh, float cin, float& aggP, float& aggH, float (&hsum)[16]) {
    float oP[4], oH[4];
#pragma unroll
    for (int q = 0; q < 4; ++q) {
        float Pp = 1.f, Hh = 0.f;
#pragma unroll
        for (int jj = 0; jj < 4; ++jj) { const int j = d ? 3 - jj : jj; Hh = ar[4 * q + j] * Hh + ai[4 * q + j]; Pp *= ar[4 * q + j]; }
        oP[q] = Pp; oH[q] = Hh;
    }
    float eP[4], eH[4], xP[4], xH[4];
#pragma unroll
    for (int q = 0; q < 4; ++q) { const float pP = __shfl_xor(oP[q], 32), pH = __shfl_xor(oH[q], 32);
        eP[q] = hh ? pP : oP[q]; eH[q] = hh ? pH : oH[q]; xP[q] = hh ? oP[q] : pP; xH[q] = hh ? oH[q] : pH; }
    float c = cin, pall = 1.f;
    float mine[4];
    if (d == 0) {
#pragma unroll
        for (int q = 0; q < 4; ++q) { const float cE = c; c = eP[q] * c + eH[q]; const float cO = c; c = xP[q] * c + xH[q]; mine[q] = hh ? cO : cE; pall *= eP[q] * xP[q]; }
    } else {
#pragma unroll
        for (int q = 3; q >= 0; --q) { const float cO = c; c = xP[q] * c + xH[q]; const float cE = c; c = eP[q] * c + eH[q]; mine[q] = hh ? cO : cE; pall *= eP[q] * xP[q]; }
    }
    aggP = pall; aggH = c;
    if (FINAL) {
#pragma unroll
        for (int q = 0; q < 4; ++q) { float Hh = mine[q];
#pragma unroll
            for (int jj = 0; jj < 4; ++jj) { const int j = d ? 3 - jj : jj; Hh = ar[4 * q + j] * Hh + ai[4 * q + j]; if (d == 0) hsum[4 * q + j] = Hh; else hsum[4 * q + j] += Hh; } }
    }
}

constexpr int LW_OFF = 4096, LW_PITCH = 144;
__device__ __forceinline__ void lru_load_w(unsigned char* ws, int l, int h, int cb, int tid, LAS unsigned char* lds) {
    const bf16* WG = (const bf16*)(ws + WS_WG) + (size_t)(l * NH + h) * 256 * HD;
    __syncthreads();
    for (int i = tid; i < 128 * 8; i += 512) { const int row = i >> 3, c = i & 7, q = row >> 5, r = row & 31;
        *(LAS u32x4*)(lds + LW_OFF + row * LW_PITCH + 16 * c) = *(const u32x4*)(WG + (size_t)(q * 64 + 32 * cb + r) * HD + 8 * c); }
    __syncthreads();
}
__device__ __forceinline__ void lru_agg_unit(unsigned char* ws, int l, LAS unsigned char* lds, int b, int grp, int h, int cb, int wave, int lane) {
    asm volatile("" : "+s"(wave)); asm volatile("" : "+v"(lane));
    const bf16* Z = (const bf16*)(ws + WS_Z);
    const int r = lane & 31, hh = lane >> 5;
    int seqbase, len, t0;
    if (grp == 0) { seqbase = TL + b * CTXL; len = CTXL; t0 = wave * 32; } else { seqbase = b * SEQ; len = SEQ; t0 = (grp - 1) * 256 + wave * 32; }
    const int t = t0 + r;
    const float* SP = (const float*)(ws + WS_SP) + (size_t)l * SP_STRIDE;
    const float* cw = SP + SP_CW; const float* cbias = SP + SP_CB;
    bf16x8 Af[4];
#pragma unroll
    for (int s = 0; s < 4; ++s) {
        const int c0 = 64 * h + 16 * s + 8 * hh;
        const f32x4 b0 = *(const f32x4*)(cbias + c0), b1 = *(const f32x4*)(cbias + c0 + 4);
        float u[8] = {b0.x, b0.y, b0.z, b0.w, b1.x, b1.y, b1.z, b1.w};
#pragma unroll
        for (int k = 0; k < 4; ++k) {
            const int tt = t + k - 2;
            u32x4 raw = (u32x4){0u, 0u, 0u, 0u};
            if (tt >= 0 && tt < len) raw = *(const u32x4*)(Z + (size_t)(seqbase + tt) * DIN + c0);
            const f32x4 w0 = *(const f32x4*)(cw + k * DLRU + c0), w1 = *(const f32x4*)(cw + k * DLRU + c0 + 4);
            u[0] += w0.x * bflo(raw.x); u[1] += w0.y * bfhi(raw.x); u[2] += w0.z * bflo(raw.y); u[3] += w0.w * bfhi(raw.y);
            u[4] += w1.x * bflo(raw.z); u[5] += w1.y * bfhi(raw.z); u[6] += w1.z * bflo(raw.w); u[7] += w1.w * bfhi(raw.w);
        }
        u32x4 pk; pk.x = pg8::cvt_pk_bf16(u[0], u[1]); pk.y = pg8::cvt_pk_bf16(u[2], u[3]); pk.z = pg8::cvt_pk_bf16(u[4], u[5]); pk.w = pg8::cvt_pk_bf16(u[6], u[7]);
        Af[s] = __builtin_bit_cast(bf16x8, pk);
        asm volatile("" ::: "memory");
    }
    f32x16 accu;
#pragma unroll
    for (int i = 0; i < 16; ++i) accu[i] = 0.f;
    { const int nn = 32 * cb + r;
#pragma unroll
      for (int s = 0; s < 4; ++s) {
          u32x4 w = (u32x4){0u, 0u, 0u, 0u};
          if ((nn >> 4) == s && ((nn >> 3) & 1) == hh) { const unsigned one = 0x3F80u << (16 * (nn & 1)); const int wi = (nn & 7) >> 1;
              w.x = wi == 0 ? one : 0u; w.y = wi == 1 ? one : 0u; w.z = wi == 2 ? one : 0u; w.w = wi == 3 ? one : 0u; }
          accu = __builtin_amdgcn_mfma_f32_32x32x16_bf16(Af[s], __builtin_bit_cast(bf16x8, w), accu, 0, 0, 0);
      } }
    const int ch = 64 * h + 32 * cb + r;
    u32x4* YB = (u32x4*)(ws + WS_YB) + (size_t)lru_item(b, grp, h, cb, wave) * 8 * 64 + lane;
    float aggP[2], aggH[2];
    float hdummy[16];
#pragma unroll
    for (int d = 0; d < 2; ++d) {
        f32x16 ar, ai;
#pragma unroll
        for (int i = 0; i < 16; ++i) { ar[i] = 0.f; ai[i] = 0.f; }
        { const LAS unsigned char* wr_ = lds + LW_OFF + ((2 * d) * 32 + r) * LW_PITCH + 16 * hh; const LAS unsigned char* wi_ = wr_ + 32 * LW_PITCH;
#pragma unroll
          for (int s = 0; s < 4; ++s) ar = __builtin_amdgcn_mfma_f32_32x32x16_bf16(Af[s], *(const LAS bf16x8*)(wr_ + 32 * s), ar, 0, 0, 0);
#pragma unroll
          for (int s = 0; s < 4; ++s) ai = __builtin_amdgcn_mfma_f32_32x32x16_bf16(Af[s], *(const LAS bf16x8*)(wi_ + 32 * s), ai, 0, 0, 0); }
        const float ba = SP[SP_GAB + d * DLRU + ch], bx = SP[SP_GXB + d * DLRU + ch], cc = SP[SP_CC + d * DLRU + ch];
#pragma unroll
        for (int q = 0; q < 4; ++q) {
            u32x4 wq;
#pragma unroll
            for (int j = 0; j < 4; ++j) { const int i = 4 * q + j;
                const float rr = fast_sigmoid(ar[i] + ba), ig = fast_sigmoid(ai[i] + bx);
                const float y = cc * rr;
                const float a0 = __builtin_amdgcn_exp2f(-LOG2E * y);
                const float bt = __builtin_amdgcn_sqrtf(fmaf(-a0, a0, 1.0f)) * (ig * accu[i]);
                const unsigned w = pg8::cvt_pk_bf16(y, bt);
                wq[j] = w;
                ar[i] = __builtin_amdgcn_exp2f(-LOG2E * bflo(w)); ai[i] = bfhi(w);
            }
            YB[(d * 4 + q) * 64] = wq;
            __builtin_amdgcn_sched_barrier(0);
        }
        tile_scan<false>(ar, ai, d, hh, 0.f, aggP[d], aggH[d], hdummy);
        __builtin_amdgcn_sched_barrier(0);
    }
    f32x2* AT = (f32x2*)(ws + WS_AGGT); f32x2* AG = (f32x2*)(ws + WS_AGGG);
    LAS f32x2* la = (LAS f32x2*)lds;
    if (hh == 0) {
#pragma unroll
        for (int d = 0; d < 2; ++d) { const f32x2 v = (f32x2){aggP[d], aggH[d]};
            AT[((size_t)(b * NTILE + grp * 8 + wave) * 2 + d) * DLRU + ch] = v; la[(wave * 2 + d) * 32 + r] = v; }
    }
    __syncthreads();
    if (wave == 0) {
        const int d = hh; float Pp = 1.f, Hh = 0.f;
#pragma unroll
        for (int i = 0; i < 8; ++i) { const int w = d ? 7 - i : i; const f32x2 v = la[(w * 2 + d) * 32 + r]; Hh = v.x * Hh + v.y; Pp *= v.x; }
        AG[((size_t)(b * NGRP + grp) * 2 + d) * DLRU + ch] = (f32x2){Pp, Hh};
    }
    __syncthreads();
}

__device__ __forceinline__ void lru_final_unit(unsigned char* ws, int l, int b, int grp, int h, int cb, int wave, int lane) {
    asm volatile("" : "+s"(wave)); asm volatile("" : "+v"(lane));
    const bf16* Z = (const bf16*)(ws + WS_Z);
    const int r = lane & 31, hh = lane >> 5;
    int seqbase, t0;
    if (grp == 0) { seqbase = TL + b * CTXL; t0 = wave * 32; } else { seqbase = b * SEQ; t0 = (grp - 1) * 256 + wave * 32; }
    const int ch = 64 * h + 32 * cb + r;
    const u32x4* YB = (const u32x4*)(ws + WS_YB) + (size_t)lru_item(b, grp, h, cb, wave) * 8 * 64 + lane;
    u32x4 W[8];
#pragma unroll
    for (int j = 0; j < 8; ++j) W[j] = YB[j * 64];
    unsigned short yg[16];
#pragma unroll
    for (int i = 0; i < 16; ++i) { const int row = (i & 3) + 8 * (i >> 2) + 4 * hh; yg[i] = Z[(size_t)(seqbase + t0 + row) * DIN + DLRU + ch]; }
    float C0, C1;
    {
        const f32x2* AGGT = (const f32x2*)(ws + WS_AGGT); const f32x2* AGGG = (const f32x2*)(ws + WS_AGGG);
        float c = 0.f;
        const int d = hh;
        if (grp > 0) {
            { const f32x2 g0 = AGGG[((size_t)(b * NGRP + 0) * 2 + d) * DLRU + ch]; c = g0.y; }
            f32x2 gv[7];
#pragma unroll
            for (int i = 0; i < 7; ++i) { const int g = d ? 8 - i : 1 + i; const bool valid = d ? (i < 8 - grp) : (i < grp - 1);
                gv[i] = valid ? AGGG[((size_t)(b * NGRP + g) * 2 + d) * DLRU + ch] : (f32x2){1.f, 0.f}; }
#pragma unroll
            for (int i = 0; i < 7; ++i) c = gv[i].x * c + gv[i].y;
        }
        f32x2 tv[7];
#pragma unroll
        for (int i = 0; i < 7; ++i) { const int tw = d ? 7 - i : i; const bool valid = d ? (i < 7 - wave) : (i < wave);
            tv[i] = valid ? AGGT[((size_t)(b * NTILE + grp * 8 + tw) * 2 + d) * DLRU + ch] : (f32x2){1.f, 0.f}; }
#pragma unroll
        for (int i = 0; i < 7; ++i) c = tv[i].x * c + tv[i].y;
        C0 = __shfl(c, r); C1 = __shfl(c, 32 + r);
    }
    float hsum[16];
#pragma unroll
    for (int d = 0; d < 2; ++d) {
        f32x16 ar, ai;
#pragma unroll
        for (int q = 0; q < 4; ++q)
#pragma unroll
            for (int j = 0; j < 4; ++j) { const unsigned w = W[d * 4 + q][j]; ar[4 * q + j] = __builtin_amdgcn_exp2f(-LOG2E * bflo(w)); ai[4 * q + j] = bfhi(w); }
        float aP, aH;
        tile_scan<true>(ar, ai, d, hh, d ? C1 : C0, aP, aH, hsum);
    }
    bf16* MIX = (bf16*)(ws + WS_MIX);
#pragma unroll
    for (int i = 0; i < 16; ++i) {
        const int row = (i & 3) + 8 * (i >> 2) + 4 * hh;
        MIX[(size_t)(seqbase + t0 + row) * D + ch] = (bf16)f2bf(hsum[i] * gelu_tanh(bf2f(yg[i])));
    }
}

constexpr int PX_PITCH = 528, PD_PITCH = 528;
constexpr int PX_OFF = 0, PD_OFF = 80 * PX_PITCH;
__device__ __forceinline__ void pool_unit(unsigned char* ws, int l, LAS unsigned char* lds, int c, int gp, int tid, int wave, int lane) {
    asm volatile("" : "+s"(wave)); asm volatile("" : "+v"(lane)); asm volatile("" : "+v"(tid));
    const bf16* Z = (const bf16*)(ws + WS_Z); bf16* MIX = (bf16*)(ws + WS_MIX);
    int seqbase, t0, seg_lo, seg_hi;
    if (c < 256) { seqbase = (c >> 5) * SEQ; t0 = (c & 31) * 64; seg_lo = t0; seg_hi = t0 + 64; }
    else { const int cc = c - 256; seqbase = TL + (cc >> 2) * CTXL; t0 = (cc & 3) * 64; seg_lo = 0; seg_hi = CTXL; }
    const int r_lo = max(t0 - 8, seg_lo), r_hi = min(t0 + 72, seg_hi);
    { const int sub = tid >> 5, l32 = tid & 31;
      for (int t = r_lo + sub; t < r_hi; t += 16) {
          const u32x4 v = *(const u32x4*)(Z + (size_t)(seqbase + t) * DIN + 2 * DLRU + 256 * gp + 8 * l32);
          *(LAS u32x4*)(lds + PX_OFF + (t - (t0 - 8)) * PX_PITCH + 16 * l32) = v;
      } }
    __syncthreads();
    { const int cp = tid & 127, tq = tid >> 7;
      const int g = 2 * gp + (cp >> 6);
      const int half = 1 << g;
      const LAS unsigned char* xb = lds + PX_OFF + 4 * cp - (t0 - 8) * PX_PITCH;
      int t = t0 + 16 * tq;
      int lo = max(t - half, seg_lo), hi = min(t + half, seg_hi);
      float s0 = 0.f, s1 = 0.f;
      for (int j = lo; j < hi; ++j) { const unsigned w = *(const LAS unsigned*)(xb + j * PX_PITCH); s0 += bflo(w); s1 += bfhi(w); }
#pragma unroll 4
      for (int i = 0; i < 16; ++i, ++t) {
          const unsigned wx = *(const LAS unsigned*)(xb + t * PX_PITCH);
          const float inv = 1.0f / (float)(hi - lo);
          const float d0 = s0 * inv - bflo(wx), d1 = s1 * inv - bfhi(wx);
          *(LAS unsigned*)(lds + PD_OFF + (t - t0) * PD_PITCH + 4 * cp) = pk2(d0, d1);
          const int nlo = max(t + 1 - half, seg_lo), nhi = min(t + 1 + half, seg_hi);
          if (nhi > hi) { const unsigned w = *(const LAS unsigned*)(xb + hi * PX_PITCH); s0 += bflo(w); s1 += bfhi(w); }
          if (nlo > lo) { const unsigned w = *(const LAS unsigned*)(xb + lo * PX_PITCH); s0 -= bflo(w); s1 -= bfhi(w); }
          lo = nlo; hi = nhi;
      } }
    __syncthreads();
    { const int gl = wave >> 2, th = (wave >> 1) & 1, nh = wave & 1, r = lane & 31, hh = lane >> 5;
      const int g = 2 * gp + gl;
      const bf16* WP = (const bf16*)(ws + WS_WP) + (size_t)(l * 4 + g) * 128 * 128;
      f32x16 acc[2];
#pragma unroll
      for (int q = 0; q < 2; ++q)
#pragma unroll
          for (int i = 0; i < 16; ++i) acc[q][i] = 0.f;
      const LAS unsigned char* arow = lds + PD_OFF + (th * 32 + r) * PD_PITCH + (gl * 128 + 8 * hh) * 2;
#pragma unroll
      for (int s = 0; s < 8; ++s) {
          const bf16x8 Af = *(const LAS bf16x8*)(arow + 32 * s);
#pragma unroll
          for (int nt = 0; nt < 2; ++nt) { const bf16x8 Bf = *(const bf16x8*)(WP + (size_t)(nh * 64 + nt * 32 + r) * 128 + 16 * s + 8 * hh);
              acc[nt] = __builtin_amdgcn_mfma_f32_32x32x16_bf16(Af, Bf, acc[nt], 0, 0, 0); }
      }
#pragma unroll
      for (int nt = 0; nt < 2; ++nt) {
          const int co = 128 * g + 64 * nh + 32 * nt + r;
          const float* SP = (const float*)(ws + WS_SP) + (size_t)l * SP_STRIDE; const float pb = SP[SP_PB + co], ps = SP[SP_PS + co];
#pragma unroll
          for (int i = 0; i < 16; ++i) {
              const int row = (i & 3) + 8 * (i >> 2) + 4 * hh;
              MIX[(size_t)(seqbase + t0 + th * 32 + row) * D + DLRU + co] = (bf16)f2bf((acc[nt][i] + pb) * ps);
          }
      } }
    __syncthreads();
}

constexpr int L1_PITCH = 2064;
constexpr int L1_PART = 16 * L1_PITCH;
constexpr int L1_MAXB = 5;
constexpr int L1_ROWS = L1_PART + 16384 + 256 + L1_MAXB * 64 * 16;
static_assert(L1_ROWS + L1_MAXB * 16 * 1024 <= LDS_TB, "LN1 LDS map");
__device__ __forceinline__ void phase_ln1(unsigned char* ws, int l, LAS unsigned char* lds, int bid, int G, int tid, int wave, int lane) {
    const float* MOD = (const float*)(ws + WS_MOD) + (size_t)l * 9 * 6144;
    float* XL = (float*)(ws + WS_XL); fp8* H8S = (fp8*)(ws + WS_H8S); const bf16* Y1 = (const bf16*)(ws + WS_Y1);
    const float* SP = (const float*)(ws + WS_SP) + (size_t)l * SP_STRIDE;
    const float* lg = SP + SP_L1G; const float* lb = SP + SP_L1B; const float* rb = SP + SP_RB;
    int* cnt = (int*)(ws + WS_CTL) + CW_CNT + 32 * l;
    float* TOPG = (float*)(ws + WS_TOPG); int* ROWDST = (int*)(ws + WS_ROWDST);
    const int ntok = (l == DEPTH - 1) ? TL : TT;
    const bf16* RWT = (const bf16*)(ws + WS_RWT) + (size_t)l * NE * D;
    bf16x8 Bf[4][2];
#pragma unroll
    for (int s = 0; s < 4; ++s)
#pragma unroll
        for (int nt = 0; nt < 2; ++nt) Bf[s][nt] = *(const bf16x8*)(RWT + (size_t)(16 * nt + (lane & 15)) * D + 128 * wave + 32 * s + 8 * (lane >> 4));
    LAS float* part = (LAS float*)(lds + L1_PART);
    LAS int* lcnt = (LAS int*)(lds + L1_PART + 16384);
    LAS int* lbase = lcnt + 32;
    LAS u32x4* ent = (LAS u32x4*)(lds + L1_PART + 16384 + 256);
    if (tid < 32) lcnt[tid] = 0;
    int nb_local = 0;
    __syncthreads();
    f32x4 px[2][4]; u32x2 py[2][4];
#define L1_LOAD(batch_) do { _Pragma("unroll") for (int rr = 0; rr < 2; ++rr) { const int tok_ = (batch_) * 16 + 2 * wave + rr; _Pragma("unroll") for (int j = 0; j < 4; ++j) { \
        px[rr][j] = ((const f32x4*)(XL + (size_t)tok_ * D))[lane + 64 * j]; py[rr][j] = ((const u32x2*)(Y1 + (size_t)tok_ * D))[lane + 64 * j]; } } } while (0)
    if (bid < ntok / 16) L1_LOAD(bid);
    for (int batch = bid; batch < ntok / 16 && nb_local < L1_MAXB; batch += G) {
        f32x4 v[2][4];
#pragma unroll
        for (int rr = 0; rr < 2; ++rr) {
            const int tok = batch * 16 + 2 * wave + rr;
            const float* m = MOD + (size_t)mod_row(tok) * 6144;
#pragma unroll
            for (int j = 0; j < 4; ++j) {
                const f32x4 g1 = ((const f32x4*)(m + 2048))[lane + 64 * j];
                const u32x2 yr = py[rr][j];
                f32x4 y; y.x = bflo(yr.x); y.y = bfhi(yr.x); y.z = bflo(yr.y); y.w = bfhi(yr.y);
                v[rr][j] = px[rr][j] * ALPHA + g1 * y;
            }
        }
        if (batch + G < ntok / 16 && nb_local + 1 < L1_MAXB) L1_LOAD(batch + G);
#pragma unroll
        for (int rr = 0; rr < 2; ++rr) {
            const int trow = 2 * wave + rr, tok = batch * 16 + trow;
            const float* m = MOD + (size_t)mod_row(tok) * 6144;
            f32x4 h[4];
            float mean, rstd; ln_stats(v[rr], mean, rstd);
#pragma unroll
            for (int j = 0; j < 4; ++j) {
                const f32x4 gg = ((const f32x4*)lg)[lane + 64 * j], bb = ((const f32x4*)lb)[lane + 64 * j];
                const f32x4 o = (v[rr][j] - mean) * rstd * gg + bb;
                ((f32x4*)(XL + (size_t)tok * D))[lane + 64 * j] = o;
                const f32x4 sh = ((const f32x4*)(m + 3072))[lane + 64 * j], sc = ((const f32x4*)(m + 4096))[lane + 64 * j];
                h[j] = o * (sc + 1.0f) + sh;
                u32x2 w; w.x = pk2(h[j].x, h[j].y); w.y = pk2(h[j].z, h[j].w);
                int w8 = 0; w8 = __builtin_amdgcn_cvt_pk_fp8_f32(h[j].x, h[j].y, w8, false); w8 = __builtin_amdgcn_cvt_pk_fp8_f32(h[j].z, h[j].w, w8, true);
                *(LAS unsigned*)(lds + L1_ROWS + (nb_local * 16 + trow) * 1024 + (4 * lane + 256 * j)) = (unsigned)w8;
                *(LAS u32x2*)(lds + trow * L1_PITCH + (4 * lane + 256 * j) * 2) = w;
            }
        }
        __syncthreads();
        {
            f32x4 a2[2] = {(f32x4){0.f, 0.f, 0.f, 0.f}, (f32x4){0.f, 0.f, 0.f, 0.f}};
            const LAS unsigned char* arow = lds + (lane & 15) * L1_PITCH + (128 * wave + 8 * (lane >> 4)) * 2;
#pragma unroll
            for (int s = 0; s < 4; ++s) { const bf16x8 Af = *(const LAS bf16x8*)(arow + 64 * s);
#pragma unroll
                for (int nt = 0; nt < 2; ++nt) a2[nt] = __builtin_amdgcn_mfma_f32_16x16x32_bf16(Af, Bf[s][nt], a2[nt], 0, 0, 0); }
#pragma unroll
            for (int nt = 0; nt < 2; ++nt)
#pragma unroll
                for (int i = 0; i < 4; ++i) part[(wave * 16 + 4 * (lane >> 4) + i) * 32 + 16 * nt + (lane & 15)] = a2[nt][i];
        }
        __syncthreads();
        {
            const int trow = tid >> 5, e = tid & 31, tok = batch * 16 + trow;
            float lgt = rb[e];
#pragma unroll
            for (int w = 0; w < 8; ++w) lgt += part[(w * 16 + trow) * 32 + e];
            float tv[4]; int ti[4];
            float cur = lgt;
#pragma unroll
            for (int k = 0; k < 4; ++k) {
                float bv = cur; int bi = e;
#pragma unroll
                for (int o = 1; o < 32; o <<= 1) { const float ov = __shfl_xor(bv, o); const int oi = __shfl_xor(bi, o); if (ov > bv || (ov == bv && oi < bi)) { bv = ov; bi = oi; } }
                tv[k] = bv; ti[k] = bi;
                if (e == bi) cur = -INFINITY;
            }
            const float e1 = __expf(tv[1] - tv[0]), e2 = __expf(tv[2] - tv[0]), e3 = __expf(tv[3] - tv[0]);
            const float inv = 1.0f / (1.0f + e1 + e2 + e3);
            if (e < 4) {
                const int ex = e == 0 ? ti[0] : e == 1 ? ti[1] : e == 2 ? ti[2] : ti[3];
                const float pg = (e == 0 ? 1.0f : e == 1 ? e1 : e == 2 ? e2 : e3) * inv;
                const int ls = __hip_atomic_fetch_add(lcnt + ex, 1, __ATOMIC_RELAXED, __HIP_MEMORY_SCOPE_WORKGROUP);
                const int idx = (nb_local * 16 + trow) * 4 + e;
                ent[idx] = (u32x4){(unsigned)tok, (unsigned)ex, (unsigned)ls, __float_as_uint(pg)};
            }
        }
        ++nb_local;
        __syncthreads();
    }
    if (tid < 32) { const int c = lcnt[tid]; lbase[tid] = c > 0 ? atomicAdd(&cnt[tid], c) : 0; }
    __syncthreads();
    for (int i = wave; i < nb_local * 64; i += 8) {
        const u32x4 en = ent[i]; const int tok = (int)en.x, ex = (int)en.y, slot = lbase[ex] + (int)en.z;
        if (lane == 0) { TOPG[tok * 4 + (i & 3)] = __uint_as_float(en.w); ROWDST[(size_t)ex * TT + slot] = tok * 4 + (i & 3); }
        const u32x4 v = *(const LAS u32x4*)(lds + L1_ROWS + (i >> 2) * 1024 + 16 * lane);
        *(u32x4*)(H8S + ((size_t)ex * TT + slot) * D + 16 * lane) = v;
    }
    __syncthreads();
#undef L1_LOAD
}

__device__ __forceinline__ void phase_ln2(unsigned char* ws, float* out, int l, int gw, int ngw, int lane) {
    const float* MOD = (const float*)(ws + WS_MOD) + (size_t)l * 9 * 6144;
    float* XL = (float*)(ws + WS_XL); bf16* H = (bf16*)(ws + WS_H); const fp8* Y2 = (const fp8*)(ws + WS_Y2); const f32x4* TOPG = (const f32x4*)(ws + WS_TOPG);
    const float* SP = (const float*)(ws + WS_SP) + (size_t)l * SP_STRIDE;
    const float* lg = SP + SP_L2G; const float* lb = SP + SP_L2B;
    const bool last = (l == DEPTH - 1);
    const int ntok = last ? TL : TT;
    for (int tok0 = gw * 2; tok0 < ntok; tok0 += ngw * 2) {
        f32x4 v[2][4]; unsigned yr[2][4][4]; f32x4 g2[2][4]; f32x4 gk[2];
#pragma unroll
        for (int t = 0; t < 2; ++t) {
            const int tok = tok0 + t;
            const float* m = MOD + (size_t)mod_row(tok) * 6144;
            gk[t] = TOPG[tok];
#pragma unroll
            for (int j = 0; j < 4; ++j) {
                v[t][j] = ((const f32x4*)(XL + (size_t)tok * D))[lane + 64 * j];
                g2[t][j] = ((const f32x4*)(m + 5120))[lane + 64 * j];
#pragma unroll
                for (int k = 0; k < 4; ++k) yr[t][k][j] = ((const unsigned*)(Y2 + ((size_t)tok * 4 + k) * D))[lane + 64 * j];
            }
        }
#pragma unroll
        for (int t = 0; t < 2; ++t) {
            const int tok = tok0 + t;
#pragma unroll
            for (int j = 0; j < 4; ++j) {
                f32x4 f = (f32x4){0.f, 0.f, 0.f, 0.f};
#pragma unroll
                for (int k = 0; k < 4; ++k) { const unsigned r = yr[t][k][j]; const float g = gk[t][k]; const f32x2 lo = __builtin_amdgcn_cvt_pk_f32_fp8((int)r, false), hi = __builtin_amdgcn_cvt_pk_f32_fp8((int)r, true);
                    f.x += g * lo.x; f.y += g * lo.y; f.z += g * hi.x; f.w += g * hi.y; }
                v[t][j] = v[t][j] * ALPHA + g2[t][j] * f;
            }
            float mean, rstd; ln_stats(v[t], mean, rstd);
            f32x4 h[4];
            const float* mn = MOD + (size_t)9 * 6144 + (size_t)mod_row(tok) * 6144;
#pragma unroll
            for (int j = 0; j < 4; ++j) {
                const f32x4 gg = ((const f32x4*)lg)[lane + 64 * j], bb = ((const f32x4*)lb)[lane + 64 * j];
                const f32x4 o = (v[t][j] - mean) * rstd * gg + bb;
                if (last) ((f32x4*)(out + (size_t)tok * D))[lane + 64 * j] = o;
                else {
                    ((f32x4*)(XL + (size_t)tok * D))[lane + 64 * j] = o;
                    const f32x4 sh = ((const f32x4*)mn)[lane + 64 * j], sc = ((const f32x4*)(mn + 1024))[lane + 64 * j];
                    h[j] = o * (sc + 1.0f) + sh;
                }
            }
            if (!last) store_bf16_row(H + (size_t)tok * D, lane, h);
        }
    }
}

constexpr int NPHASE = 2 + 8 * DEPTH;
#ifndef PHMASK
#define PHMASK 0xFFFF
#endif
#define PH_ON(k) (((PHMASK) >> (k)) & 1)
#ifndef MK_PER_PHASE
#define MK_PER_PHASE 0
#endif
__global__ void __launch_bounds__(512, 2) mk_fwd(P p) {
    extern __shared__ __attribute__((aligned(16))) unsigned char lds_[];
    LAS unsigned char* lds = (LAS unsigned char*)lds_;
    const int tid = threadIdx.x, lane = tid & 63, wave = __builtin_amdgcn_readfirstlane(tid >> 6);
    const int G = gridDim.x, bid = blockIdx.x;
    volatile LAS unsigned* MISC = (volatile LAS unsigned*)(lds + LDS_MISC);
    if (tid < 4) MISC[tid] = 0u;
    __syncthreads();
    unsigned* barw = (unsigned*)(p.ws + WS_CTL) + CW_BAR;
    XcdBarrier bar; bar.bar = barw; bar.x = 0; bar.st = MISC;
    if (!MK_PER_PHASE) bar = xcd_barrier_post(barw, MISC);
    const int lo = p.ph_lo, hi = p.ph_hi;
#define IN(k) (lo <= (k) && (k) < hi)
#define SEAM(k) do { if (IN(k) && IN((k) + 1)) xcd_barrier(bar, wave == 0 && (int)__lane_id() == 0); } while (0)
    if (PH_ON(0) && IN(0)) { phase_p0a(p, lds, bid, G, tid, wave, lane); }
    SEAM(0);
    if (PH_ON(1) && IN(1)) { phase_entry(p, bid * 8 + wave, G * 8, lane); }
    SEAM(1);
#pragma unroll 1
    for (int l = 0; l < DEPTH; ++l) {
        const int pb = 2 + 8 * l;
#define FRESH() int tid_ = wave * 64 + (int)__lane_id(); asm volatile("" : "+v"(tid_)); const int lane_ = tid_ & 63; const int wave_ = __builtin_amdgcn_readfirstlane(tid_ >> 6); \
                size_t wz_ = 0; asm volatile("" : "+s"(wz_)); unsigned char* ws = p.ws + wz_; (void)lane_; (void)wave_
        if (PH_ON(2) && IN(pb + 0)) {
            FRESH();
            pg8::DenseOrder S; S.init(TT / 256, DIN / 256, G, bid);
            pg8::EpiStore E{(bf16*)(ws + WS_Z), DIN};
            pg8::gemm_phase<false>(lds, tid_, ws + WS_H, (const bf16*)(ws + WS_WIN) + (size_t)l * DIN * D, S, E);
        }
        SEAM(pb + 0);
        if (PH_ON(3) && IN(pb + 1)) {
            FRESH();
            int key = -1;
            for (int u = bid; u < NB * NGRP * NH * 2; u += G) { const int cb = u & 1, h = (u >> 1) & 7, bg = u >> 4;
                if ((u & 15) != key) { key = u & 15; lru_load_w(ws, l, h, cb, tid_, lds); }
                lru_agg_unit(ws, l, lds, bg / NGRP, bg % NGRP, h, cb, wave_, lane_); }
        }
        SEAM(pb + 1);
        if (PH_ON(4) && IN(pb + 2)) {
            FRESH();
            const int g0 = (l == DEPTH - 1) ? 1 : 0, ng = NGRP - g0;
            const int nlru = NB * ng * NH * 2, npool = ((l == DEPTH - 1) ? 256 : 288) * 2;
            for (int u = bid; u < nlru + npool; u += G) {
                if (u < nlru) { const int cb = u & 1, h = (u >> 1) & 7, bg = u >> 4; lru_final_unit(ws, l, bg / ng, g0 + bg % ng, h, cb, wave_, lane_); }
                else { const int q = u - nlru; pool_unit(ws, l, lds, q >> 1, q & 1, tid_, wave_, lane_); }
            }
        }
        SEAM(pb + 2);
        if (PH_ON(5) && IN(pb + 3)) {
            FRESH();
            pg8::DenseOrder S; S.init((l == DEPTH - 1 ? TL : TT) / 256, D / 256, G, bid);
            pg8::EpiStore E{(bf16*)(ws + WS_Y1), D};
            pg8::gemm_phase<false>(lds, tid_, ws + WS_MIX, (const bf16*)(ws + WS_WOUT) + (size_t)l * D * D, S, E);
        }
        SEAM(pb + 3);
        if (PH_ON(6) && IN(pb + 4)) { FRESH(); phase_ln1(ws, l, lds, bid, G, tid_, wave_, lane_); }
        SEAM(pb + 4);
        if (IN(pb + 5) || IN(pb + 6)) {
            FRESH();
            const int* cnt = (const int*)(ws + WS_CTL) + CW_CNT + 32 * l;
            LAS int* tb = (LAS int*)(lds + LDS_TB);
            if (tid_ < 64) { const int c = lane_ < 32 ? (cnt[lane_] + 255) >> 8 : 0; int s = c;
#pragma unroll
                for (int o = 1; o < 32; o <<= 1) { const int t = __shfl_up(s, o); if (lane_ >= o) s += t; }
                if (lane_ < 32) tb[lane_ + 1] = s; if (lane_ == 0) tb[0] = 0; }
            __syncthreads();
        }
        if (PH_ON(7) && IN(pb + 5)) {
            FRESH();
            const int* cnt = (const int*)(ws + WS_CTL) + CW_CNT + 32 * l;
            pg8::MoeOrder<8, true> S{(const LAS int*)(lds + LDS_TB), cnt, G, bid};
            pg8::EpiSwiglu E{(fp8*)(ws + WS_ACT), (const float*)(ws + WS_SP) + (size_t)l * SP_STRIDE + SP_B1};
            pg8::gemm_phase<true>(lds, tid_, ws + WS_H8S, ws + WS_W1T + (size_t)l * NE * 2 * DF * D, S, E);
        }
        SEAM(pb + 5);
        if (PH_ON(8) && IN(pb + 6)) {
            FRESH();
            const int* cnt = (const int*)(ws + WS_CTL) + CW_CNT + 32 * l;
            pg8::MoeOrder<4, false> S{(const LAS int*)(lds + LDS_TB), cnt, G, bid};
            pg8::EpiDown E{(fp8*)(ws + WS_Y2), (const float*)(ws + WS_SP) + (size_t)l * SP_STRIDE + SP_B2, (const int*)(ws + WS_ROWDST)};
            pg8::gemm_phase<true>(lds, tid_, ws + WS_ACT, ws + WS_W2T + (size_t)l * NE * D * DF, S, E);
        }
        SEAM(pb + 6);
        if (PH_ON(9) && IN(pb + 7)) { FRESH(); phase_ln2(ws, p.out, l, bid * 8 + wave_, G * 8, lane_); }
        SEAM(pb + 7);
#undef FRESH
    }
#undef IN
#undef SEAM
}

extern "C" void kernel_launch(void* const* d_in, const int* in_sizes, int n_in, void* d_out, int out_size, void* d_ws, size_t ws_size, hipStream_t stream) {
    static int grid = 0;
    if (grid == 0) {
        if (n_in != N_IN || ws_size < WS_END || out_size != TL * D) { fprintf(stderr, "kernel_launch: unexpected shapes (n_in %d, out %d, ws %zu)\n", n_in, out_size, ws_size); grid = -1; return; }
        int dev = 0, cus = 0, per_cu = 0;
        if (hipGetDevice(&dev) != hipSuccess || hipDeviceGetAttribute(&cus, hipDeviceAttributeMultiprocessorCount, dev) != hipSuccess) { grid = -1; return; }
        if (hipFuncSetAttribute((const void*)mk_fwd, hipFuncAttributeMaxDynamicSharedMemorySize, LDS_BYTES) != hipSuccess) { fprintf(stderr, "kernel_launch: hipFuncSetAttribute failed\n"); grid = -1; return; }
        if (hipOccupancyMaxActiveBlocksPerMultiprocessor(&per_cu, (const void*)mk_fwd, 512, LDS_BYTES) != hipSuccess || per_cu < 1) { fprintf(stderr, "kernel_launch: occupancy query says %d\n", per_cu); }
        (void)hipGetLastError();
        grid = cus & ~7;
        if (grid < 231) { fprintf(stderr, "kernel_launch: this build needs at least 231 CUs (has %d)\n", cus); grid = -1; return; }
    }
    if (grid < 0) return;
    (void)hipMemsetAsync((char*)d_ws + WS_CTL, 0, CTL_BYTES, stream);
    P p{};
    for (int i = 0; i < N_IN; ++i) p.in[i] = (const float*)d_in[i];
    p.out = (float*)d_out; p.ws = (unsigned char*)d_ws;
#if MK_PER_PHASE
    for (int ph = 0; ph < NPHASE; ++ph) { p.ph_lo = ph; p.ph_hi = ph + 1; hipLaunchKernelGGL(mk_fwd, dim3(grid), dim3(512), LDS_BYTES, stream, p);
#ifdef EXTRA_PHASE
        if (ph == EXTRA_PHASE) for (int r = 0; r < EXTRA_REPS; ++r) hipLaunchKernelGGL(mk_fwd, dim3(grid), dim3(512), LDS_BYTES, stream, p);
#endif
    }
#else
    p.ph_lo = 0; p.ph_hi = NPHASE;
    hipLaunchKernelGGL(mk_fwd, dim3(grid), dim3(512), LDS_BYTES, stream, p);
#endif
}
```

```cpp
#include <hip/hip_runtime.h>
#include <cstdio>
#include <cstdint>

constexpr int NB = 8, SEQ = 2048, D = 1024, CTXL = 256, DEPTH = 2;
constexpr int TL = NB * SEQ;
constexpr int TC = NB * CTXL;
constexpr int TT = TL + TC;
constexpr int DLRU = 512, DPOOL = 512, DIN = 1536, NH = 8, HD = 64;
constexpr int NE = 32, TOPK = 4, DF = 1024;
constexpr int GRIDW = 64;
constexpr float LN_EPS = 1e-5f;
constexpr float ALPHA = 1.41421356237309515f;
constexpr int MAXROWS = 81920;
constexpr int NTILE = 72, NGRP = 9;

enum { I_X = 0, I_C, I_CTX, I_CCTX, I_WMOD, I_BMOD, I_WIN, I_CONVW, I_CONVB, I_GAW, I_GAB, I_GXW, I_GXB, I_LAM, I_POOLW, I_POOLB, I_POOLS,
       I_WOUT, I_LN1G, I_LN1B, I_RW, I_RB, I_W1, I_B1, I_W2, I_B2, I_LN2G, I_LN2B, N_IN };

constexpr size_t MiB = 1u << 20;
constexpr size_t WS_CTL = 0, CTL_BYTES = 1 * MiB;
constexpr size_t WS_MOD = 1 * MiB;
constexpr size_t WS_POS = 2 * MiB;
constexpr size_t WS_RWT = 2 * MiB + 512 * 1024;
constexpr size_t WS_TOPG = 7 * MiB;
constexpr size_t WS_AGGT = 10 * MiB;
constexpr size_t WS_AGGG = 15 * MiB;
constexpr size_t WS_WIN = 16 * MiB, WS_WOUT = 23 * MiB, WS_WG = 28 * MiB, WS_WP = 29 * MiB;
constexpr size_t WS_SP = 30 * MiB;
constexpr size_t WS_W1T = 32 * MiB, WS_W2T = 160 * MiB;
constexpr size_t WS_H8S = 1052 * MiB;
constexpr int W1_SH = 6, W2_SH = 7;
constexpr int SP_CW = 0, SP_CB = 2048, SP_GAB = 2560, SP_GXB = 3584, SP_CC = 4608, SP_PB = 5632, SP_PS = 6144, SP_L1G = 6656, SP_L1B = 7680, SP_L2G = 8704, SP_L2B = 9728, SP_RB = 10752,
              SP_B1 = 12288, SP_B2 = SP_B1 + 32 * 2048, SP_STRIDE = SP_B2 + 32 * 1024;
constexpr size_t WS_XL = 416 * MiB;
constexpr size_t WS_H = 488 * MiB;
constexpr size_t WS_Z = 524 * MiB;
constexpr size_t WS_MIX = 578 * MiB;
constexpr size_t WS_Y1 = 614 * MiB;
constexpr size_t WS_ACT = 650 * MiB;
constexpr size_t WS_Y2 = 810 * MiB;
constexpr size_t WS_YB = 970 * MiB;
constexpr size_t WS_ROWDST = 1046 * MiB;
constexpr size_t WS_END = 1628 * MiB;
constexpr int CW_CNT = 64;
constexpr int CW_BAR = 4096;

typedef unsigned short bf16;
typedef float f32x4 __attribute__((ext_vector_type(4)));
typedef float f32x2 __attribute__((ext_vector_type(2)));
typedef float f32x16 __attribute__((ext_vector_type(16)));
typedef unsigned u32x2 __attribute__((ext_vector_type(2)));
typedef unsigned u32x4 __attribute__((ext_vector_type(4)));
typedef short bf16x8 __attribute__((ext_vector_type(8)));
typedef int i32x8 __attribute__((ext_vector_type(8)));
typedef unsigned char fp8;

__device__ __forceinline__ float bf2f(bf16 v) { return __uint_as_float(((unsigned)v) << 16); }
__device__ __forceinline__ float bflo(unsigned w) { return __uint_as_float(w << 16); }
__device__ __forceinline__ float bfhi(unsigned w) { return __uint_as_float(w & 0xffff0000u); }
__device__ __forceinline__ unsigned f2bf(float f) { unsigned u = __float_as_uint(f); return (u + 0x7fffu + ((u >> 16) & 1u)) >> 16; }
__device__ __forceinline__ unsigned pk2(float lo, float hi) { return f2bf(lo) | (f2bf(hi) << 16); }
__device__ __forceinline__ float wave_sum(float v) {
#pragma unroll
    for (int o = 1; o < 64; o <<= 1) v += __shfl_xor(v, o);
    return v;
}
__device__ __forceinline__ float fsigmoid(float x) { return __builtin_amdgcn_rcpf(1.0f + __expf(-x)); }
__device__ __forceinline__ float gelu_tanh(float x) {
    const float u = 0.7978845608028654f * (x + 0.044715f * x * x * x);
    const float t = 1.0f - 2.0f * __builtin_amdgcn_rcpf(__expf(2.0f * u) + 1.0f);
    return 0.5f * x * (1.0f + t);
}

struct P {
    const float* in[N_IN];
    float* out;
    unsigned char* ws;
    int ph_lo, ph_hi;
};

__device__ __forceinline__ int mod_row(int tok) { return tok < TL ? (tok >> 11) : NB; }
__device__ __forceinline__ int pad256(int c) { return (c + 255) & ~255; }

__device__ __forceinline__ void ln_stats(const f32x4 (&v)[4], float& mean, float& rstd) {
    float s = 0.f;
#pragma unroll
    for (int j = 0; j < 4; ++j) s += (v[j].x + v[j].y) + (v[j].z + v[j].w);
    mean = wave_sum(s) * (1.f / D);
    float s2 = 0.f;
#pragma unroll
    for (int j = 0; j < 4; ++j) { const f32x4 d = v[j] - mean; s2 += (d.x * d.x + d.y * d.y) + (d.z * d.z + d.w * d.w); }
    rstd = 1.0f / sqrtf(wave_sum(s2) * (1.f / D) + LN_EPS);
}
__device__ __forceinline__ f32x4 bf4(u32x2 r) { f32x4 y; y.x = bflo(r.x); y.y = bfhi(r.x); y.z = bflo(r.y); y.w = bfhi(r.y); return y; }
__device__ __forceinline__ u32x2 pk4(f32x4 v) { u32x2 w; w.x = pk2(v.x, v.y); w.y = pk2(v.z, v.w); return w; }
__device__ __forceinline__ void store_bf16_row(bf16* row, int lane, const f32x4 (&h)[4]) {
    u32x2* o = (u32x2*)row + lane;
#pragma unroll
    for (int j = 0; j < 4; ++j) { u32x2 w; w.x = pk2(h[j].x, h[j].y); w.y = pk2(h[j].z, h[j].w); o[64 * j] = w; }
}


#define LAS __attribute__((address_space(3)))
struct CvtItem { const float* src; unsigned char* dst; int N, Kp, f8; float scale; };
__device__ __forceinline__ void tile_load(const CvtItem& it, int lane, f32x4 (&v)[16]) {
#pragma unroll
    for (int i = 0; i < 16; ++i) { const int k = 4 * i + (lane >> 4); v[i] = __builtin_nontemporal_load((const f32x4*)(it.src + (size_t)k * it.N + 4 * (lane & 15))); }
}
__device__ __forceinline__ void tile_store(const CvtItem& it, const f32x4 (&v)[16], LAS float* scr, int lane) {
#pragma unroll
    for (int i = 0; i < 16; ++i) { const int k = 4 * i + (lane >> 4); const int nn = (4 * (lane & 15)) ^ (((k >> 3) & 3) << 3); *(LAS f32x4*)(scr + k * 64 + nn) = v[i]; }
    asm volatile("s_waitcnt lgkmcnt(0)" ::: "memory");
    const int c = lane & 7, sw = (c & 3) << 3;
    if (it.f8) {
#pragma unroll
        for (int j = 0; j < 8; ++j) {
            const int n = (lane >> 3) + 8 * j;
            const LAS float* s = scr + (8 * c) * 64 + (n ^ sw);
            const float sc = it.scale;
            int w0 = 0, w1 = 0;
            w0 = __builtin_amdgcn_cvt_pk_fp8_f32(s[0] * sc, s[64] * sc, w0, false); w0 = __builtin_amdgcn_cvt_pk_fp8_f32(s[128] * sc, s[192] * sc, w0, true);
            w1 = __builtin_amdgcn_cvt_pk_fp8_f32(s[256] * sc, s[320] * sc, w1, false); w1 = __builtin_amdgcn_cvt_pk_fp8_f32(s[384] * sc, s[448] * sc, w1, true);
            *(u32x2*)(it.dst + (size_t)n * it.Kp + 8 * c) = (u32x2){(unsigned)w0, (unsigned)w1};
        }
    } else {
#pragma unroll
        for (int j = 0; j < 8; ++j) {
            const int n = (lane >> 3) + 8 * j;
            const LAS float* s = scr + (8 * c) * 64 + (n ^ sw);
            u32x4 o; o.x = pk2(s[0], s[64]); o.y = pk2(s[128], s[192]); o.z = pk2(s[256], s[320]); o.w = pk2(s[384], s[448]);
            *(u32x4*)(it.dst + ((size_t)n * it.Kp + 8 * c) * 2) = o;
        }
    }
    asm volatile("s_waitcnt lgkmcnt(0)" ::: "memory");
}
constexpr int CV_IN = DEPTH * 16 * 24, CV_OUT = DEPTH * 16 * 16, CV_G = DEPTH * 2 * 2 * NH, CV_P = DEPTH * 4 * 4, CV_1 = DEPTH * NE * 16 * 32, CV_2 = DEPTH * NE * 16 * 16;
constexpr int CV_ITEMS = CV_IN + CV_OUT + CV_G + CV_P + CV_1 + CV_2;
__device__ __forceinline__ CvtItem cvt_decode(const P& p, int r) {
    CvtItem it; it.f8 = 0; it.scale = 1.0f;
    if (r < CV_IN) { const int l = r / 384, q = r % 384, kb = q / 24, nb = q % 24;
        it.src = p.in[I_WIN] + (size_t)l * D * DIN + (size_t)(64 * kb) * DIN + 64 * nb; it.N = DIN; it.Kp = D; it.dst = p.ws + WS_WIN + (((size_t)l * DIN + 64 * nb) * D + 64 * kb) * 2; return it; }
    r -= CV_IN;
    if (r < CV_OUT) { const int l = r / 256, q = r % 256, kb = q / 16, nb = q % 16;
        it.src = p.in[I_WOUT] + (size_t)l * D * D + (size_t)(64 * kb) * D + 64 * nb; it.N = D; it.Kp = D; it.dst = p.ws + WS_WOUT + (((size_t)l * D + 64 * nb) * D + 64 * kb) * 2; return it; }
    r -= CV_OUT;
    if (r < CV_G) {
        const int h = r % NH, gt = (r / NH) % 2, d = (r / (NH * 2)) % 2, l = r / (NH * 4);
        it.src = (gt ? p.in[I_GXW] : p.in[I_GAW]) + ((size_t)(l * 2 + d) * NH + h) * HD * HD; it.N = HD; it.Kp = HD;
        it.dst = p.ws + WS_WG + (((size_t)(l * NH + h) * 256 + (d * 2 + gt) * 64) * HD) * 2; return it; }
    r -= CV_G;
    if (r < CV_P) {
        const int nb = r % 2, kb = (r / 2) % 2, lg = r / 4;
        it.src = p.in[I_POOLW] + (size_t)lg * 128 * 128 + (size_t)(64 * kb) * 128 + 64 * nb; it.N = 128; it.Kp = 128; it.dst = p.ws + WS_WP + (((size_t)lg * 128 + 64 * nb) * 128 + 64 * kb) * 2; return it; }
    r -= CV_P;
    it.f8 = 1;
    if (r < CV_1) {
        const int le = r / 512, q = r % 512, kb = q / 32, nb = q % 32;
        const int n0 = 64 * nb, j0 = n0 % DF, half = n0 / DF, row0 = (j0 / 128) * 256 + half * 128 + (j0 % 128);
        it.src = p.in[I_W1] + (size_t)le * D * 2 * DF + (size_t)(64 * kb) * (2 * DF) + n0; it.N = 2 * DF; it.Kp = D; it.scale = (float)(1 << W1_SH);
        it.dst = p.ws + WS_W1T + ((size_t)le * 2 * DF + row0) * D + 64 * kb; return it; }
    r -= CV_1;
    { const int le = r / 256, q = r % 256, kb = q / 16, nb = q % 16;
      it.src = p.in[I_W2] + (size_t)le * DF * D + (size_t)(64 * kb) * D + 64 * nb; it.N = D; it.Kp = DF; it.scale = (float)(1 << W2_SH);
      it.dst = p.ws + WS_W2T + ((size_t)le * D + 64 * nb) * DF + 64 * kb; }
    return it;
}
__device__ __forceinline__ void convert_weights(const P& p, LAS unsigned char* lds, int gw, int ngw, int wave, int lane) {
    LAS float* scr = (LAS float*)(lds + wave * 16384);
    int r = gw;
    if (r >= CV_ITEMS) return;
    CvtItem cur = cvt_decode(p, r);
    f32x4 v[16], vn[16];
    tile_load(cur, lane, v);
    for (;;) {
        const int rn = r + ngw; const bool more = rn < CV_ITEMS;
        CvtItem nxt = cur;
        if (more) { nxt = cvt_decode(p, rn); tile_load(nxt, lane, vn); }
        tile_store(cur, v, scr, lane);
        if (!more) break;
#pragma unroll
        for (int i = 0; i < 16; ++i) v[i] = vn[i];
        cur = nxt; r = rn;
    }
}

namespace pg8 {
typedef short bf16x8 __attribute__((ext_vector_type(8)));
constexpr int BM = 256, BK = 64, HALF = 128, HTB = HALF * BK * 2, STAGE_BYTES = 8 * HTB;
template <int XB> __host__ __device__ __forceinline__ int lds_byte(int r, int c) { const int st = (r >> 4) * 2 + (c >> 5), rr = r & 15, cc = c & 31, ob = rr * 64 + cc * 2; return st * 1024 + (ob ^ (((ob >> 9) & 1) << XB)); }
template <int XB> __host__ __device__ __forceinline__ void stage_rc(int b, int& R, int& C) { const int st = b / 1024, sb = b % 1024, swz = sb ^ (((sb >> 9) & 1) << XB); R = (st >> 1) * 16 + swz / 64; C = (st & 1) * 32 + (swz % 64) / 2; }
__host__ __device__ __forceinline__ int perm32(int rho) { const int n = rho >> 4, i = rho & 15; return 8 * (i >> 2) + 4 * n + (i & 3); }
__device__ __forceinline__ unsigned cvt_pk_bf16(float lo, float hi) { unsigned r; asm volatile("v_cvt_pk_bf16_f32 %0, %1, %2" : "=v"(r) : "v"(lo), "v"(hi)); return r; }

struct Unit { int a0, nvalid, b0, o0, pn, e, g0; };

template <bool F8, class Sched, class Epi>
__device__ __forceinline__ void gemm_phase(LAS unsigned char* lds, int tid, const void* Abase_, const void* Bt_, const Sched& S, const Epi& E) {
    constexpr int RP = F8 ? 1024 : 2048, nt = F8 ? 8 : 16;
    const int wid = __builtin_amdgcn_readfirstlane(tid >> 6), lane = tid & 63, wr = wid >> 2, wc = wid & 3, fr = lane & 15, fq = lane >> 4;
    unsigned voffA, voffB;
    { int R, C; stage_rc<F8 ? 4 : 5>(tid * 16, R, C); const int Rb = (R & ~31) + perm32(R & 31); voffA = (unsigned)(R * RP + 2 * C); voffB = (unsigned)(Rb * RP + 2 * C); }
    constexpr size_t kstep = (size_t)(BK * 2);
    constexpr size_t hstep = (size_t)HALF * RP;
    const unsigned ldsw = (unsigned)wid * 1024u;
    const int aoff = F8 ? lds_byte<4>(wr * 64 + fr, fq * 16) : lds_byte<5>(wr * 64 + fr, fq * 8), boff = F8 ? lds_byte<4>(wc * 32 + fr, fq * 16) : lds_byte<5>(wc * 32 + fr, fq * 8);
    const int one_scale = 0x7F7F7F7F;
#define PG8_SA(b, h) (((b) * 2 + (h)) * HTB)
#define PG8_SB(b, h) ((4 + (b) * 2 + (h)) * HTB)
#define PG8_STAGE(bufoff, gbase, voff) do { _Pragma("unroll") for (int _i = 0; _i < 2; ++_i) { unsigned _vo = (voff); asm volatile("" : "+v"(_vo)); \
        __builtin_amdgcn_global_load_lds((const unsigned*)((const char*)(gbase) + (size_t)_i * (64 * RP) + _vo), (LAS unsigned*)(lds + (bufoff) + ldsw + _i * 8192), 16, 0, 0); } } while (0)
#define PG8_LD8(base, off) __builtin_bit_cast(i32x8, __builtin_shufflevector(*(const LAS u32x4*)((base) + (off)), *(const LAS u32x4*)((base) + ((off) ^ 16)), 0, 1, 2, 3, 4, 5, 6, 7))
#define PG8_LDA(dst, b, h) do { _Pragma("unroll") for (int m = 0; m < 4; ++m) { \
        if constexpr (F8) dst##8[m] = PG8_LD8(lds + PG8_SA(b, h) + m * 2048, aoff); \
        else { _Pragma("unroll") for (int k = 0; k < 2; ++k) dst[m][k] = *(const LAS bf16x8*)(lds + PG8_SA(b, h) + aoff + m * 2048 + k * 1024); } } } while (0)
#define PG8_LDB(dst, b, h) do { _Pragma("unroll") for (int n = 0; n < 2; ++n) { \
        if constexpr (F8) dst##8[n] = PG8_LD8(lds + PG8_SB(b, h) + n * 2048, boff); \
        else { _Pragma("unroll") for (int k = 0; k < 2; ++k) dst[n][k] = *(const LAS bf16x8*)(lds + PG8_SB(b, h) + boff + n * 2048 + k * 1024); } } } while (0)
#define PG8_MMA(ai, bj, At, Bt) do { __builtin_amdgcn_s_setprio(1); _Pragma("unroll") for (int m = 0; m < 4; ++m) _Pragma("unroll") for (int n = 0; n < 2; ++n) { \
        if constexpr (F8) acc[ai][bj][m][n] = __builtin_amdgcn_mfma_scale_f32_16x16x128_f8f6f4(Bt##8[n], At##8[m], acc[ai][bj][m][n], 0, 0, 0, one_scale, 0, one_scale); \
        else { _Pragma("unroll") for (int k = 0; k < 2; ++k) acc[ai][bj][m][n] = __builtin_amdgcn_mfma_f32_16x16x32_bf16(Bt[n][k], At[m][k], acc[ai][bj][m][n], 0, 0, 0); } } \
        __builtin_amdgcn_s_setprio(0); } while (0)
#define PG8_WAIT_V(n) asm volatile("s_waitcnt vmcnt(" #n ")" ::: "memory")
#define PG8_WAIT_L(n) asm volatile("s_waitcnt lgkmcnt(" #n ")" ::: "memory")
#define PG8_BAR __builtin_amdgcn_s_barrier()
#define PG8_SCHED __builtin_amdgcn_sched_barrier(0)
    Unit cur, nxt; int ui = 0;
    if (!S.next(0, cur)) return;
    f32x4 acc[2][2][4][2];
#pragma unroll
    for (int a = 0; a < 2; ++a)
#pragma unroll
        for (int b = 0; b < 2; ++b)
#pragma unroll
            for (int m = 0; m < 4; ++m)
#pragma unroll
                for (int n = 0; n < 2; ++n) acc[a][b][m][n] = (f32x4){0.f, 0.f, 0.f, 0.f};
    bf16x8 At[4][2], B0[2][2], B1[2][2];
    i32x8 At8[4], B08[2], B18[2];
    const char* cA = (const char*)Abase_ + (size_t)cur.a0 * RP; const char* cB = (const char*)Bt_ + (size_t)cur.b0 * RP;
    PG8_STAGE(PG8_SB(0, 0), cB, voffB); PG8_STAGE(PG8_SB(0, 1), cB + hstep, voffB); PG8_STAGE(PG8_SA(0, 0), cA, voffA); PG8_STAGE(PG8_SA(0, 1), cA + hstep, voffA);
    if (wr == 1) PG8_BAR;
    PG8_WAIT_V(2); PG8_BAR;
    PG8_STAGE(PG8_SB(1, 0), cB + kstep, voffB); PG8_STAGE(PG8_SA(1, 0), cA + kstep, voffA); PG8_STAGE(PG8_SB(1, 1), cB + hstep + kstep, voffB);
    PG8_WAIT_V(6); PG8_BAR;
    for (;;) {
        const bool has_next = S.next(ui + 1, nxt);
        const char* nA = has_next ? (const char*)Abase_ + (size_t)nxt.a0 * RP : cA; const char* nB = has_next ? (const char*)Bt_ + (size_t)nxt.b0 * RP : cB;
#pragma unroll 1
        for (int t = 0; t < nt; t += 2) {
            const bool last = (t == nt - 2);
            const char* a1 = cA + (size_t)(t + 1) * kstep;
            const char* a2 = last ? nA : cA + (size_t)(t + 2) * kstep; const char* b2 = last ? nB : cB + (size_t)(t + 2) * kstep;
            const char* a3 = a2 + kstep; const char* b3 = b2 + kstep;
            PG8_LDB(B0, 0, 0); PG8_LDB(B1, 0, 1); PG8_SCHED; PG8_LDA(At, 0, 0); PG8_STAGE(PG8_SA(1, 1), a1 + hstep, voffA);
            PG8_WAIT_V(8); PG8_WAIT_L(0); PG8_BAR; PG8_MMA(0, 0, At, B0); PG8_MMA(0, 1, At, B1); PG8_BAR; PG8_SCHED;
            PG8_LDA(At, 0, 1); PG8_STAGE(PG8_SB(0, 0), b2, voffB); PG8_STAGE(PG8_SB(0, 1), b2 + hstep, voffB); PG8_STAGE(PG8_SA(0, 0), a2, voffA);
            PG8_WAIT_V(8); PG8_WAIT_L(0); PG8_BAR; PG8_MMA(1, 0, At, B0); PG8_MMA(1, 1, At, B1); PG8_BAR; PG8_SCHED;
            PG8_LDB(B0, 1, 0); PG8_LDB(B1, 1, 1); PG8_SCHED; PG8_LDA(At, 1, 0); PG8_STAGE(PG8_SA(0, 1), a2 + hstep, voffA);
            PG8_WAIT_V(8); PG8_WAIT_L(0); PG8_BAR; PG8_MMA(0, 0, At, B0); PG8_MMA(0, 1, At, B1); PG8_BAR; PG8_SCHED;
            PG8_LDA(At, 1, 1); PG8_STAGE(PG8_SB(1, 0), b3, voffB); PG8_STAGE(PG8_SB(1, 1), b3 + hstep, voffB); PG8_STAGE(PG8_SA(1, 0), a3, voffA);
            PG8_WAIT_V(8); PG8_WAIT_L(0); PG8_BAR; PG8_MMA(1, 0, At, B0); PG8_MMA(1, 1, At, B1); PG8_BAR; PG8_SCHED;
        }
        if (wr == 0) PG8_BAR;
        PG8_SCHED; { int fr_ = fr, fq_ = fq; asm volatile("" : "+v"(fr_), "+v"(fq_)); E(acc, cur, wr, wc, fr_, fq_); } PG8_SCHED;
        if (!has_next) break;
#pragma unroll
        for (int a = 0; a < 2; ++a)
#pragma unroll
            for (int b = 0; b < 2; ++b)
#pragma unroll
                for (int m = 0; m < 4; ++m)
#pragma unroll
                    for (int n = 0; n < 2; ++n) acc[a][b][m][n] = (f32x4){0.f, 0.f, 0.f, 0.f};
        cur = nxt; cA = nA; cB = nB; ++ui;
        if (wr == 1) PG8_BAR;
    }
    PG8_WAIT_V(0);
    PG8_BAR;
#undef PG8_SA
#undef PG8_SB
#undef PG8_STAGE
#undef PG8_LDA
#undef PG8_LDB
#undef PG8_MMA
#undef PG8_LD8
#undef PG8_WAIT_V
#undef PG8_WAIT_L
#undef PG8_BAR
#undef PG8_SCHED
}

struct DenseOrder {
    int nM, nN, nwg, G, c;
    __device__ void init(int nM_, int nN_, int G_, int c_) { nM = nM_; nN = nN_; nwg = nM * nN; G = G_; c = c_; }
    __device__ bool next(int i, Unit& u) const {
        const long L = (long)i * G + c; if (L >= nwg) return false;
        int wgid = (int)L; { const int q = nwg / 8, r = nwg % 8, xcd = wgid % 8, off = wgid / 8; wgid = (xcd < r ? xcd * (q + 1) : r * (q + 1) + (xcd - r) * q) + off; }
        const int nig = 8 * nN, gid = wgid / nig, fm = gid * 8, gsz = (nM - fm) < 8 ? (nM - fm) : 8;
        const int pm = fm + ((wgid % nig) % gsz), pn = (wgid % nig) / gsz;
        u.a0 = pm * 256; u.nvalid = 256; u.b0 = pn * 256; u.o0 = pm * 256; u.pn = pn; u.e = 0; u.g0 = 0; return true;
    }
};
template <int NPN, bool UP> struct MoeOrder {
    const LAS int* tb; const int* cnt; int G, c;
    __device__ bool next(int i, Unit& u) const {
        const int L = i * G + c; const int total = tb[32] * NPN; if (L >= total) return false;
        int e = 0;
#pragma unroll 1
        for (int q = 16; q >= 1; q >>= 1) if (tb[e + q] * NPN <= L) e += q;
        const int te = tb[e + 1] - tb[e], j = L - tb[e] * NPN, pn = j / te, mt = j % te;
        const int ce = cnt[e];
        u.e = e; u.pn = pn; u.o0 = (tb[e] + mt) * 256; u.nvalid = min(256, ce - mt * 256);
        u.g0 = e * TT + mt * 256;
        u.a0 = UP ? u.g0 : u.o0;
        u.b0 = e * (UP ? 2 * DF : D) + pn * 256;
        return true;
    }
};

struct EpiStore {
    bf16* C; int ldc;
    __device__ __forceinline__ void operator()(const f32x4 (&acc)[2][2][4][2], const Unit& u, int wr, int wc, int fr, int fq) const {
        const int row0 = u.o0 + wr * 64 + fr, col0 = u.pn * 256 + wc * 32 + 8 * fq;
#pragma unroll
        for (int ai = 0; ai < 2; ++ai)
#pragma unroll
            for (int m = 0; m < 4; ++m) { bf16* rowp = C + (size_t)(row0 + ai * HALF + m * 16) * ldc + col0;
#pragma unroll
                for (int bj = 0; bj < 2; ++bj) { const f32x4 v0 = acc[ai][bj][m][0], v1 = acc[ai][bj][m][1];
                    u32x4 w; w.x = cvt_pk_bf16(v0[0], v0[1]); w.y = cvt_pk_bf16(v0[2], v0[3]); w.z = cvt_pk_bf16(v1[0], v1[1]); w.w = cvt_pk_bf16(v1[2], v1[3]);
                    *(u32x4*)(rowp + bj * HALF) = w; } }
    }
};
struct EpiSwiglu {
    fp8* C; const float* b1;
    __device__ __forceinline__ void operator()(const f32x4 (&acc)[2][2][4][2], const Unit& u, int wr, int wc, int fr, int fq) const {
        const int row0 = u.o0 + wr * 64 + fr, j0 = u.pn * 128 + wc * 32 + 8 * fq;
        const float* bb = b1 + (size_t)u.e * 2 * DF + j0;
        const f32x4 bg0 = *(const f32x4*)bb, bg1 = *(const f32x4*)(bb + 4), bl0 = *(const f32x4*)(bb + DF), bl1 = *(const f32x4*)(bb + DF + 4);
#pragma unroll
        for (int ai = 0; ai < 2; ++ai)
#pragma unroll
            for (int m = 0; m < 4; ++m) {
                float o[8];
#pragma unroll
                for (int n = 0; n < 2; ++n)
#pragma unroll
                    for (int q = 0; q < 4; ++q) {
                        constexpr float ws = 1.0f / (float)(1 << W1_SH);
                        const float gl = fminf(fmaf(acc[ai][0][m][n][q], ws, n ? bg1[q] : bg0[q]), 7.0f);
                        const float li = fminf(fmaxf(fmaf(acc[ai][1][m][n][q], ws, n ? bl1[q] : bl0[q]), -7.0f), 7.0f);
                        o[4 * n + q] = gl * __builtin_amdgcn_rcpf(1.0f + __expf(-1.702f * gl)) * (li + 1.0f);
                    }
                int w0 = 0, w1 = 0;
                w0 = __builtin_amdgcn_cvt_pk_fp8_f32(o[0], o[1], w0, false); w0 = __builtin_amdgcn_cvt_pk_fp8_f32(o[2], o[3], w0, true);
                w1 = __builtin_amdgcn_cvt_pk_fp8_f32(o[4], o[5], w1, false); w1 = __builtin_amdgcn_cvt_pk_fp8_f32(o[6], o[7], w1, true);
                *(u32x2*)(C + (size_t)(row0 + ai * HALF + m * 16) * DF + j0) = (u32x2){(unsigned)w0, (unsigned)w1};
            }
    }
};
struct EpiDown {
    fp8* C; const float* b2; const int* rowdst;
    __device__ __forceinline__ void operator()(const f32x4 (&acc)[2][2][4][2], const Unit& u, int wr, int wc, int fr, int fq) const {
        const int rt0 = wr * 64 + fr, col0 = u.pn * 256 + wc * 32 + 8 * fq;
        const float* bp = b2 + (size_t)u.e * D + col0;
        int dst[2][4];
#pragma unroll
        for (int ai = 0; ai < 2; ++ai)
#pragma unroll
            for (int m = 0; m < 4; ++m) { const int rt = rt0 + ai * HALF + m * 16; dst[ai][m] = rowdst[u.g0 + min(rt, u.nvalid - 1)]; if (rt >= u.nvalid) dst[ai][m] = -1; }
        constexpr float ws = 1.0f / (float)(1 << W2_SH);
#pragma unroll
        for (int bj = 0; bj < 2; ++bj) {
            const f32x4 bv0 = *(const f32x4*)(bp + bj * HALF), bv1 = *(const f32x4*)(bp + bj * HALF + 4);
#pragma unroll
            for (int ai = 0; ai < 2; ++ai)
#pragma unroll
                for (int m = 0; m < 4; ++m) {
                    const f32x4 v0 = acc[ai][bj][m][0] * ws + bv0, v1 = acc[ai][bj][m][1] * ws + bv1;
                    int w0 = 0, w1 = 0;
                    w0 = __builtin_amdgcn_cvt_pk_fp8_f32(v0[0], v0[1], w0, false); w0 = __builtin_amdgcn_cvt_pk_fp8_f32(v0[2], v0[3], w0, true);
                    w1 = __builtin_amdgcn_cvt_pk_fp8_f32(v1[0], v1[1], w1, false); w1 = __builtin_amdgcn_cvt_pk_fp8_f32(v1[2], v1[3], w1, true);
                    if (dst[ai][m] >= 0) *(u32x2*)(C + (size_t)dst[ai][m] * D + col0 + bj * HALF) = (u32x2){(unsigned)w0, (unsigned)w1};
                }
        }
    }
};
}

#define XB_TMO      128
#define XB_XCNT(j)  (256  + 64 * (j))
#define XB_XSUB(j)  (1280 + 64 * (j))
#define XB_XGEN(j)  (2304 + 64 * (j))
#define XB_TOP      3328
#define XB_TOPGEN   3392
#define XCD_BAR_WORDS 3456
#define XB_SPIN_CAP (1u << 18)
__device__ __forceinline__ unsigned xb_ld(unsigned* p)              { return __hip_atomic_load(p, __ATOMIC_RELAXED, __HIP_MEMORY_SCOPE_AGENT); }
__device__ __forceinline__ unsigned xb_add(unsigned* p, unsigned v) { return __hip_atomic_fetch_add(p, v, __ATOMIC_RELAXED, __HIP_MEMORY_SCOPE_AGENT); }
__device__ __forceinline__ unsigned xb_xcc_id() { return (unsigned)__builtin_amdgcn_s_getreg((3 << 11) | 20) & 0xFu; }
#define XB_SPIN(cond, bar) do { unsigned _sp = 0; while (cond) { __builtin_amdgcn_s_sleep(1); \
    if ((++_sp & 255u) == 0u) { if (xb_ld(&(bar)[XB_TMO])) break; if (_sp > XB_SPIN_CAP) { atomicAdd(&(bar)[XB_TMO], 1u); break; } } } } while (0)
struct XcdBarrier { unsigned* bar; unsigned x; volatile LAS unsigned* st; };
__device__ __forceinline__ XcdBarrier xcd_barrier_post(unsigned* bar, volatile LAS unsigned* st) {
    XcdBarrier b; b.bar = bar; b.x = xb_xcc_id(); b.st = st;
    if (threadIdx.x == 0) (void)xb_add(&bar[XB_XCNT(b.x)], 1u);
    return b;
}
__device__ __forceinline__ void xcd_barrier_complete(unsigned* bar, unsigned x, unsigned& nloc, unsigned& nx) {
    const unsigned G = gridDim.x * gridDim.y * gridDim.z;
    unsigned sum, cnt, mine, sp = 0u;
    for (;;) {
        sum = 0u; cnt = 0u; mine = 0u;
#pragma unroll
        for (unsigned j = 0; j < 16; ++j) { const unsigned c = xb_ld(&bar[XB_XCNT(j)]); sum += c; cnt += (c > 0u) ? 1u : 0u; mine = (j == x) ? c : mine; }
        if (sum == G) break;
        __builtin_amdgcn_s_sleep(1);
        if ((++sp & 255u) == 0u) { if (xb_ld(&bar[XB_TMO])) break; if (sp > XB_SPIN_CAP) { atomicAdd(&bar[XB_TMO], 1u); break; } }
    }
    nloc = mine > 0u ? mine : 1u; nx = cnt > 0u ? cnt : 1u;
}
__device__ __forceinline__ void xcd_barrier(const XcdBarrier& b, bool leader) {
    asm volatile("s_waitcnt vmcnt(0)" ::: "memory");
    __syncthreads();
    if (leader) {
        unsigned* bar = b.bar;
        __builtin_amdgcn_s_waitcnt(0);
        unsigned nloc = b.st[0], nx = b.st[1];
        if (nloc == 0u) { xcd_barrier_complete(bar, b.x, nloc, nx); b.st[0] = nloc; b.st[1] = nx; }
        const unsigned old = xb_add(&bar[XB_XSUB(b.x)], 1u);
        const unsigned gen = old / nloc;
        if (old + 1u == (gen + 1u) * nloc) {
            __builtin_amdgcn_fence(__ATOMIC_RELEASE, "agent");
            asm volatile("s_waitcnt vmcnt(0)" ::: "memory");
            const unsigned og = xb_add(&bar[XB_TOP], 1u);
            const unsigned tg = og / nx;
            if (og + 1u == (tg + 1u) * nx) xb_add(&bar[XB_TOPGEN], 1u);
            else XB_SPIN(xb_ld(&bar[XB_TOPGEN]) == tg, bar);
            __builtin_amdgcn_fence(__ATOMIC_ACQUIRE, "agent");
            xb_add(&bar[XB_XGEN(b.x)], 1u);
            asm volatile("s_waitcnt vmcnt(0)" ::: "memory");
        } else {
            XB_SPIN(xb_ld(&bar[XB_XGEN(b.x)]) == gen, bar);
            __builtin_amdgcn_fence(__ATOMIC_ACQUIRE, "agent");
            asm volatile("s_waitcnt vmcnt(0)" ::: "memory");
        }
    }
    __syncthreads();
}

constexpr int LDS_BYTES = 147456;
constexpr int LDS_TB = LDS_BYTES - 1024;
constexpr int LDS_MISC = LDS_BYTES - 512;

__device__ __forceinline__ void phase_p0a(const P& p, LAS unsigned char* lds, int bid, int G, int tid, int wave, int lane) {
    { float* POS = (float*)(p.ws + WS_POS);
      for (int i = (G - 1 - bid) * 512 + tid; i < 64 * 512; i += G * 512) {
          const int n = i / 512, j = i % 512, q = j % 256;
          const float omega = 1.0f / powf(10000.0f, (float)q / 256.0f);
          const float ang = (float)n * omega;
          POS[i] = j < 256 ? sinf(ang) : cosf(ang);
      } }
    { bf16* RWT = (bf16*)(p.ws + WS_RWT);
      for (int i = bid * 512 + tid; i < DEPTH * NE * 128; i += G * 512) {
          const int kc = i % 128, e = (i / 128) % NE, l = i / (128 * NE);
          const float* s = p.in[I_RW] + (size_t)l * D * NE + (size_t)(8 * kc) * NE + e;
          u32x4 o; o.x = pk2(s[0], s[NE]); o.y = pk2(s[2 * NE], s[3 * NE]); o.z = pk2(s[4 * NE], s[5 * NE]); o.w = pk2(s[6 * NE], s[7 * NE]);
          *(u32x4*)(RWT + ((size_t)l * NE + e) * D + 8 * kc) = o;
      } }
    { float* SP = (float*)(p.ws + WS_SP);
      const int gt = bid * 512 + tid, gn = G * 512;
      if (gn >= 32 * 2048) {
#pragma unroll
          for (int l = 0; l < DEPTH; ++l) {
              float* o = SP + (size_t)l * SP_STRIDE;
              const bool p2048 = gt < 2048, p512 = gt < 512, p1024 = gt < 1024, p32 = gt < 32, pb1 = gt < 32 * 2048, pb2 = gt < 32 * 1024;
              float cwv = 0.f, cbv = 0.f, pbv = 0.f, psv = 0.f, gab = 0.f, gxb = 0.f, lam = 0.f, l1g = 0.f, l1b = 0.f, l2g = 0.f, l2b = 0.f, rbv = 0.f, b1v = 0.f, b2v = 0.f;
              if (p2048) cwv = p.in[I_CONVW][(size_t)l * 2048 + gt];
              if (p512) { cbv = p.in[I_CONVB][(size_t)l * 512 + gt]; pbv = p.in[I_POOLB][(size_t)l * 512 + gt]; psv = p.in[I_POOLS][(size_t)l * 512 + gt]; }
              if (p1024) { gab = p.in[I_GAB][(size_t)l * 1024 + gt]; gxb = p.in[I_GXB][(size_t)l * 1024 + gt]; lam = p.in[I_LAM][(size_t)l * 1024 + gt];
                  l1g = p.in[I_LN1G][(size_t)l * 1024 + gt]; l1b = p.in[I_LN1B][(size_t)l * 1024 + gt]; l2g = p.in[I_LN2G][(size_t)l * 1024 + gt]; l2b = p.in[I_LN2B][(size_t)l * 1024 + gt]; }
              if (p32) rbv = p.in[I_RB][(size_t)l * 32 + gt];
              if (pb1) b1v = p.in[I_B1][(size_t)l * 32 * 2048 + gt];
              if (pb2) b2v = p.in[I_B2][(size_t)l * 32 * 1024 + gt];
              if (p2048) o[SP_CW + gt] = cwv;
              if (p512) { o[SP_CB + gt] = cbv; o[SP_PB + gt] = pbv; o[SP_PS + gt] = psv; }
              if (p1024) { o[SP_GAB + gt] = gab; o[SP_GXB + gt] = gxb; const float nl = -lam; o[SP_CC + gt] = 8.0f * (nl > 20.f ? nl : log1pf(expf(nl)));
                  o[SP_L1G + gt] = l1g; o[SP_L1B + gt] = l1b; o[SP_L2G + gt] = l2g; o[SP_L2B + gt] = l2b; }
              if (p32) o[SP_RB + gt] = rbv;
              if (pb1) o[SP_B1 + gt] = b1v;
              if (pb2) o[SP_B2 + gt] = b2v;
          }
      } else {
      for (int l = 0; l < DEPTH; ++l) {
          float* o = SP + (size_t)l * SP_STRIDE;
          for (int i = gt; i < 2048; i += gn) o[SP_CW + i] = p.in[I_CONVW][(size_t)l * 2048 + i];
          for (int i = gt; i < 512; i += gn) { o[SP_CB + i] = p.in[I_CONVB][(size_t)l * 512 + i]; o[SP_PB + i] = p.in[I_POOLB][(size_t)l * 512 + i]; o[SP_PS + i] = p.in[I_POOLS][(size_t)l * 512 + i]; }
          for (int i = gt; i < 1024; i += gn) { o[SP_GAB + i] = p.in[I_GAB][(size_t)l * 1024 + i]; o[SP_GXB + i] = p.in[I_GXB][(size_t)l * 1024 + i];
              const float nl = -p.in[I_LAM][(size_t)l * 1024 + i]; o[SP_CC + i] = 8.0f * (nl > 20.f ? nl : log1pf(expf(nl)));
              o[SP_L1G + i] = p.in[I_LN1G][(size_t)l * 1024 + i]; o[SP_L1B + i] = p.in[I_LN1B][(size_t)l * 1024 + i];
              o[SP_L2G + i] = p.in[I_LN2G][(size_t)l * 1024 + i]; o[SP_L2B + i] = p.in[I_LN2B][(size_t)l * 1024 + i]; }
          for (int i = gt; i < 32; i += gn) o[SP_RB + i] = p.in[I_RB][(size_t)l * 32 + i];
          for (int i = gt; i < 32 * 2048; i += gn) o[SP_B1 + i] = p.in[I_B1][(size_t)l * 32 * 2048 + i];
          for (int i = gt; i < 32 * 1024; i += gn) o[SP_B2 + i] = p.in[I_B2][(size_t)l * 32 * 1024 + i];
      } } }
    { LAS float* sl = (LAS float*)lds; LAS float* part = sl + 9 * 1024;
      const float* c = p.in[I_C]; const float* cc = p.in[I_CCTX];
      for (int i = tid; i < 9 * 1024; i += 512) { const float v = i < 8192 ? c[i] : cc[i - 8192]; sl[i] = v / (1.0f + __expf(-v)); }
      __syncthreads();
      float* MOD = (float*)(p.ws + WS_MOD);
      for (int u = bid; u < 2 * 96; u += G) {
          const int l = u / 96, n0 = (u % 96) * 64;
          const float* W = p.in[I_WMOD] + (size_t)l * 1024 * 6144 + n0;
          const int c4 = (tid & 15) * 4, ks = tid >> 4;
          f32x4 acc[9];
#pragma unroll
          for (int r = 0; r < 9; ++r) acc[r] = (f32x4){0.f, 0.f, 0.f, 0.f};
#pragma unroll
          for (int half = 0; half < 2; ++half) {
              f32x4 w[16];
#pragma unroll
              for (int kk = 0; kk < 16; ++kk) w[kk] = __builtin_nontemporal_load((const f32x4*)(W + (size_t)(ks * 32 + half * 16 + kk) * 6144 + c4));
#pragma unroll
              for (int kk = 0; kk < 16; ++kk) {
                  const int k = ks * 32 + half * 16 + kk;
#pragma unroll
                  for (int r = 0; r < 9; ++r) acc[r] += w[kk] * sl[r * 1024 + k];
              }
          }
#pragma unroll
          for (int r = 0; r < 9; ++r) *(LAS f32x4*)(part + (ks * 9 + r) * 64 + c4) = acc[r];
          __syncthreads();
          for (int o = tid; o < 9 * 64; o += 512) {
              const int r = o / 64, cl = o % 64; float sum = 0.f;
#pragma unroll
              for (int q = 0; q < 32; ++q) sum += part[(q * 9 + r) * 64 + cl];
              MOD[((size_t)l * 9 + r) * 6144 + n0 + cl] = sum + p.in[I_BMOD][(size_t)l * 6144 + n0 + cl];
          }
          __syncthreads();
      } }
    __syncthreads();
    convert_weights(p, lds, bid * 8 + wave, G * 8, wave, lane);
}

__device__ __forceinline__ void phase_entry(const P& p, int gw, int ngw, int lane) {
    const float* POS = (const float*)(p.ws + WS_POS);
    const float* MOD = (const float*)(p.ws + WS_MOD);
    bf16* XL = (bf16*)(p.ws + WS_XL); bf16* H = (bf16*)(p.ws + WS_H);
    for (int tok = gw; tok < TT; tok += ngw) {
        const float* src = tok < TL ? p.in[I_X] + (size_t)tok * D : p.in[I_CTX] + (size_t)(tok - TL) * D;
        f32x4 v[4];
#pragma unroll
        for (int j = 0; j < 4; ++j) v[j] = ((const f32x4*)src)[lane + 64 * j];
        if (tok < TL) {
            const int s = tok & (SEQ - 1), pr = s / GRIDW, pc = s % GRIDW;
#pragma unroll
            for (int j = 0; j < 4; ++j) {
                const float* ps = POS + (size_t)(j < 2 ? pr : pc) * 512 + (4 * lane + 256 * (j & 1));
                v[j] += *(const f32x4*)ps;
            }
        }
        float mean, rstd; ln_stats(v, mean, rstd);
        const float* m = MOD + (size_t)mod_row(tok) * 6144;
        f32x4 h[4];
#pragma unroll
        for (int j = 0; j < 4; ++j) {
            v[j] = (v[j] - mean) * rstd;
            ((u32x2*)(XL + (size_t)tok * D))[lane + 64 * j] = pk4(v[j]); v[j] = bf4(pk4(v[j]));
            const f32x4 sh = ((const f32x4*)m)[lane + 64 * j], sc = ((const f32x4*)(m + 1024))[lane + 64 * j];
            h[j] = v[j] * (sc + 1.0f) + sh;
        }
        store_bf16_row(H + (size_t)tok * D, lane, h);
    }
}

constexpr float LOG2E = 1.4426950408889634f;
__device__ __forceinline__ float fast_sigmoid(float x) { return __builtin_amdgcn_rcpf(1.0f + __builtin_amdgcn_exp2f(-LOG2E * x)); }
__device__ __forceinline__ int lru_item(int b, int grp, int h, int cb, int wave) { return ((((b * NGRP + grp) * NH + h) * 2 + cb) * 8 + wave); }

template <bool FINAL>
__device__ __forceinline__ void tile_scan(const f32x16& ar, const f32x16& ai, int d, int hh, float cin, float& aggP, float& aggH, float (&hsum)[16]) {
    float oP[4], oH[4];
#pragma unroll
    for (int q = 0; q < 4; ++q) {
        float Pp = 1.f, Hh = 0.f;
#pragma unroll
        for (int jj = 0; jj < 4; ++jj) { const int j = d ? 3 - jj : jj; Hh = ar[4 * q + j] * Hh + ai[4 * q + j]; Pp *= ar[4 * q + j]; }
        oP[q] = Pp; oH[q] = Hh;
    }
    float eP[4], eH[4], xP[4], xH[4];
#pragma unroll
    for (int q = 0; q < 4; ++q) { const float pP = __shfl_xor(oP[q], 32), pH = __shfl_xor(oH[q], 32);
        eP[q] = hh ? pP : oP[q]; eH[q] = hh ? pH : oH[q]; xP[q] = hh ? oP[q] : pP; xH[q] = hh ? oH[q] : pH; }
    float c = cin, pall = 1.f;
    float mine[4];
    if (d == 0) {
#pragma unroll
        for (int q = 0; q < 4; ++q) { const float cE = c; c = eP[q] * c + eH[q]; const float cO = c; c = xP[q] * c + xH[q]; mine[q] = hh ? cO : cE; pall *= eP[q] * xP[q]; }
    } else {
#pragma unroll
        for (int q = 3; q >= 0; --q) { const float cO = c; c = xP[q] * c + xH[q]; const float cE = c; c = eP[q] * c + eH[q]; mine[q] = hh ? cO : cE; pall *= eP[q] * xP[q]; }
    }
    aggP = pall; aggH = c;
    if (FINAL) {
#pragma unroll
        for (int q = 0; q < 4; ++q) { float Hh = mine[q];
#pragma unroll
            for (int jj = 0; jj < 4; ++jj) { const int j = d ? 3 - jj : jj; Hh = ar[4 * q + j] * Hh + ai[4 * q + j]; if (d == 0) hsum[4 * q + j] = Hh; else hsum[4 * q + j] += Hh; } }
    }
}

constexpr int LW_OFF = 4096, LW_PITCH = 144;
__device__ __forceinline__ void lru_load_w(unsigned char* ws, int l, int h, int cb, int tid, LAS unsigned char* lds) {
    const bf16* WG = (const bf16*)(ws + WS_WG) + (size_t)(l * NH + h) * 256 * HD;
    __syncthreads();
    for (int i = tid; i < 128 * 8; i += 512) { const int row = i >> 3, c = i & 7, q = row >> 5, r = row & 31;
        *(LAS u32x4*)(lds + LW_OFF + row * LW_PITCH + 16 * c) = *(const u32x4*)(WG + (size_t)(q * 64 + 32 * cb + r) * HD + 8 * c); }
    __syncthreads();
}
__device__ __forceinline__ void lru_agg_unit(unsigned char* ws, int l, LAS unsigned char* lds, int b, int grp, int h, int cb, int wave, int lane) {
    asm volatile("" : "+s"(wave)); asm volatile("" : "+v"(lane));
    const bf16* Z = (const bf16*)(ws + WS_Z);
    const int r = lane & 31, hh = lane >> 5;
    int seqbase, len, t0;
    if (grp == 0) { seqbase = TL + b * CTXL; len = CTXL; t0 = wave * 32; } else { seqbase = b * SEQ; len = SEQ; t0 = (grp - 1) * 256 + wave * 32; }
    const int t = t0 + r;
    const float* SP = (const float*)(ws + WS_SP) + (size_t)l * SP_STRIDE;
    const float* cw = SP + SP_CW; const float* cbias = SP + SP_CB;
    bf16x8 Af[4];
#pragma unroll
    for (int s = 0; s < 4; ++s) {
        const int c0 = 64 * h + 16 * s + 8 * hh;
        const f32x4 b0 = *(const f32x4*)(cbias + c0), b1 = *(const f32x4*)(cbias + c0 + 4);
        float u[8] = {b0.x, b0.y, b0.z, b0.w, b1.x, b1.y, b1.z, b1.w};
#pragma unroll
        for (int k = 0; k < 4; ++k) {
            const int tt = t + k - 2;
            u32x4 raw = (u32x4){0u, 0u, 0u, 0u};
            if (tt >= 0 && tt < len) raw = *(const u32x4*)(Z + (size_t)(seqbase + tt) * DIN + c0);
            const f32x4 w0 = *(const f32x4*)(cw + k * DLRU + c0), w1 = *(const f32x4*)(cw + k * DLRU + c0 + 4);
            u[0] += w0.x * bflo(raw.x); u[1] += w0.y * bfhi(raw.x); u[2] += w0.z * bflo(raw.y); u[3] += w0.w * bfhi(raw.y);
            u[4] += w1.x * bflo(raw.z); u[5] += w1.y * bfhi(raw.z); u[6] += w1.z * bflo(raw.w); u[7] += w1.w * bfhi(raw.w);
        }
        u32x4 pk; pk.x = pg8::cvt_pk_bf16(u[0], u[1]); pk.y = pg8::cvt_pk_bf16(u[2], u[3]); pk.z = pg8::cvt_pk_bf16(u[4], u[5]); pk.w = pg8::cvt_pk_bf16(u[6], u[7]);
        Af[s] = __builtin_bit_cast(bf16x8, pk);
        asm volatile("" ::: "memory");
    }
    f32x16 accu;
#pragma unroll
    for (int i = 0; i < 16; ++i) accu[i] = 0.f;
    { const int nn = 32 * cb + r;
#pragma unroll
      for (int s = 0; s < 4; ++s) {
          u32x4 w = (u32x4){0u, 0u, 0u, 0u};
          if ((nn >> 4) == s && ((nn >> 3) & 1) == hh) { const unsigned one = 0x3F80u << (16 * (nn & 1)); const int wi = (nn & 7) >> 1;
              w.x = wi == 0 ? one : 0u; w.y = wi == 1 ? one : 0u; w.z = wi == 2 ? one : 0u; w.w = wi == 3 ? one : 0u; }
          accu = __builtin_amdgcn_mfma_f32_32x32x16_bf16(Af[s], __builtin_bit_cast(bf16x8, w), accu, 0, 0, 0);
      } }
    const int ch = 64 * h + 32 * cb + r;
    u32x4* YB = (u32x4*)(ws + WS_YB) + (size_t)lru_item(b, grp, h, cb, wave) * 8 * 64 + lane;
    float aggP[2], aggH[2];
    float hdummy[16];
#pragma unroll
    for (int d = 0; d < 2; ++d) {
        f32x16 ar, ai;
#pragma unroll
        for (int i = 0; i < 16; ++i) { ar[i] = 0.f; ai[i] = 0.f; }
        { const LAS unsigned char* wr_ = lds + LW_OFF + ((2 * d) * 32 + r) * LW_PITCH + 16 * hh; const LAS unsigned char* wi_ = wr_ + 32 * LW_PITCH;
#pragma unroll
          for (int s = 0; s < 4; ++s) ar = __builtin_amdgcn_mfma_f32_32x32x16_bf16(Af[s], *(const LAS bf16x8*)(wr_ + 32 * s), ar, 0, 0, 0);
#pragma unroll
          for (int s = 0; s < 4; ++s) ai = __builtin_amdgcn_mfma_f32_32x32x16_bf16(Af[s], *(const LAS bf16x8*)(wi_ + 32 * s), ai, 0, 0, 0); }
        const float ba = SP[SP_GAB + d * DLRU + ch], bx = SP[SP_GXB + d * DLRU + ch], cc = SP[SP_CC + d * DLRU + ch];
#pragma unroll
        for (int q = 0; q < 4; ++q) {
            u32x4 wq;
#pragma unroll
            for (int j = 0; j < 4; ++j) { const int i = 4 * q + j;
                const float rr = fast_sigmoid(ar[i] + ba), ig = fast_sigmoid(ai[i] + bx);
                const float y = cc * rr;
                const float a0 = __builtin_amdgcn_exp2f(-LOG2E * y);
                const float bt = __builtin_amdgcn_sqrtf(fmaf(-a0, a0, 1.0f)) * (ig * accu[i]);
                const unsigned w = pg8::cvt_pk_bf16(y, bt);
                wq[j] = w;
                ar[i] = __builtin_amdgcn_exp2f(-LOG2E * bflo(w)); ai[i] = bfhi(w);
            }
            YB[(d * 4 + q) * 64] = wq;
            __builtin_amdgcn_sched_barrier(0);
        }
        tile_scan<false>(ar, ai, d, hh, 0.f, aggP[d], aggH[d], hdummy);
        __builtin_amdgcn_sched_barrier(0);
    }
    f32x2* AT = (f32x2*)(ws + WS_AGGT); f32x2* AG = (f32x2*)(ws + WS_AGGG);
    LAS f32x2* la = (LAS f32x2*)lds;
    if (hh == 0) {
#pragma unroll
        for (int d = 0; d < 2; ++d) { const f32x2 v = (f32x2){aggP[d], aggH[d]};
            AT[((size_t)(b * NTILE + grp * 8 + wave) * 2 + d) * DLRU + ch] = v; la[(wave * 2 + d) * 32 + r] = v; }
    }
    __syncthreads();
    if (wave == 0) {
        const int d = hh; float Pp = 1.f, Hh = 0.f;
#pragma unroll
        for (int i = 0; i < 8; ++i) { const int w = d ? 7 - i : i; const f32x2 v = la[(w * 2 + d) * 32 + r]; Hh = v.x * Hh + v.y; Pp *= v.x; }
        AG[((size_t)(b * NGRP + grp) * 2 + d) * DLRU + ch] = (f32x2){Pp, Hh};
    }
    __syncthreads();
}

__device__ __forceinline__ void lru_final_unit(unsigned char* ws, int l, int b, int grp, int h, int cb, int wave, int lane) {
    asm volatile("" : "+s"(wave)); asm volatile("" : "+v"(lane));
    const bf16* Z = (const bf16*)(ws + WS_Z);
    const int r = lane & 31, hh = lane >> 5;
    int seqbase, t0;
    if (grp == 0) { seqbase = TL + b * CTXL; t0 = wave * 32; } else { seqbase = b * SEQ; t0 = (grp - 1) * 256 + wave * 32; }
    const int ch = 64 * h + 32 * cb + r;
    const u32x4* YB = (const u32x4*)(ws + WS_YB) + (size_t)lru_item(b, grp, h, cb, wave) * 8 * 64 + lane;
    u32x4 W[8];
#pragma unroll
    for (int j = 0; j < 8; ++j) W[j] = YB[j * 64];
    unsigned short yg[16];
#pragma unroll
    for (int i = 0; i < 16; ++i) { const int row = (i & 3) + 8 * (i >> 2) + 4 * hh; yg[i] = Z[(size_t)(seqbase + t0 + row) * DIN + DLRU + ch]; }
    float C0, C1;
    {
        const f32x2* AGGT = (const f32x2*)(ws + WS_AGGT); const f32x2* AGGG = (const f32x2*)(ws + WS_AGGG);
        float c = 0.f;
        const int d = hh;
        if (grp > 0) {
            { const f32x2 g0 = AGGG[((size_t)(b * NGRP + 0) * 2 + d) * DLRU + ch]; c = g0.y; }
            f32x2 gv[7];
#pragma unroll
            for (int i = 0; i < 7; ++i) { const int g = d ? 8 - i : 1 + i; const bool valid = d ? (i < 8 - grp) : (i < grp - 1);
                gv[i] = valid ? AGGG[((size_t)(b * NGRP + g) * 2 + d) * DLRU + ch] : (f32x2){1.f, 0.f}; }
#pragma unroll
            for (int i = 0; i < 7; ++i) c = gv[i].x * c + gv[i].y;
        }
        f32x2 tv[7];
#pragma unroll
        for (int i = 0; i < 7; ++i) { const int tw = d ? 7 - i : i; const bool valid = d ? (i < 7 - wave) : (i < wave);
            tv[i] = valid ? AGGT[((size_t)(b * NTILE + grp * 8 + tw) * 2 + d) * DLRU + ch] : (f32x2){1.f, 0.f}; }
#pragma unroll
        for (int i = 0; i < 7; ++i) c = tv[i].x * c + tv[i].y;
        C0 = __shfl(c, r); C1 = __shfl(c, 32 + r);
    }
    float hsum[16];
#pragma unroll
    for (int d = 0; d < 2; ++d) {
        f32x16 ar, ai;
#pragma unroll
        for (int q = 0; q < 4; ++q)
#pragma unroll
            for (int j = 0; j < 4; ++j) { const unsigned w = W[d * 4 + q][j]; ar[4 * q + j] = __builtin_amdgcn_exp2f(-LOG2E * bflo(w)); ai[4 * q + j] = bfhi(w); }
        float aP, aH;
        tile_scan<true>(ar, ai, d, hh, d ? C1 : C0, aP, aH, hsum);
    }
    bf16* MIX = (bf16*)(ws + WS_MIX);
#pragma unroll
    for (int i = 0; i < 16; ++i) {
        const int row = (i & 3) + 8 * (i >> 2) + 4 * hh;
        MIX[(size_t)(seqbase + t0 + row) * D + ch] = (bf16)f2bf(hsum[i] * gelu_tanh(bf2f(yg[i])));
    }
}

constexpr int PX_PITCH = 528, PD_PITCH = 528;
constexpr int PX_OFF = 0, PD_OFF = 80 * PX_PITCH;
__device__ __forceinline__ void pool_unit(unsigned char* ws, int l, LAS unsigned char* lds, int c, int gp, int tid, int wave, int lane) {
    asm volatile("" : "+s"(wave)); asm volatile("" : "+v"(lane)); asm volatile("" : "+v"(tid));
    const bf16* Z = (const bf16*)(ws + WS_Z); bf16* MIX = (bf16*)(ws + WS_MIX);
    int seqbase, t0, seg_lo, seg_hi;
    if (c < 256) { seqbase = (c >> 5) * SEQ; t0 = (c & 31) * 64; seg_lo = t0; seg_hi = t0 + 64; }
    else { const int cc = c - 256; seqbase = TL + (cc >> 2) * CTXL; t0 = (cc & 3) * 64; seg_lo = 0; seg_hi = CTXL; }
    const int r_lo = max(t0 - 8, seg_lo), r_hi = min(t0 + 72, seg_hi);
    { const int sub = tid >> 5, l32 = tid & 31;
      for (int t = r_lo + sub; t < r_hi; t += 16) {
          const u32x4 v = *(const u32x4*)(Z + (size_t)(seqbase + t) * DIN + 2 * DLRU + 256 * gp + 8 * l32);
          *(LAS u32x4*)(lds + PX_OFF + (t - (t0 - 8)) * PX_PITCH + 16 * l32) = v;
      } }
    __syncthreads();
    { const int cp = tid & 127, tq = tid >> 7;
      const int g = 2 * gp + (cp >> 6);
      const int half = 1 << g;
      const LAS unsigned char* xb = lds + PX_OFF + 4 * cp - (t0 - 8) * PX_PITCH;
      int t = t0 + 16 * tq;
      int lo = max(t - half, seg_lo), hi = min(t + half, seg_hi);
      float s0 = 0.f, s1 = 0.f;
      for (int j = lo; j < hi; ++j) { const unsigned w = *(const LAS unsigned*)(xb + j * PX_PITCH); s0 += bflo(w); s1 += bfhi(w); }
#pragma unroll 4
      for (int i = 0; i < 16; ++i, ++t) {
          const unsigned wx = *(const LAS unsigned*)(xb + t * PX_PITCH);
          const float inv = 1.0f / (float)(hi - lo);
          const float d0 = s0 * inv - bflo(wx), d1 = s1 * inv - bfhi(wx);
          *(LAS unsigned*)(lds + PD_OFF + (t - t0) * PD_PITCH + 4 * cp) = pk2(d0, d1);
          const int nlo = max(t + 1 - half, seg_lo), nhi = min(t + 1 + half, seg_hi);
          if (nhi > hi) { const unsigned w = *(const LAS unsigned*)(xb + hi * PX_PITCH); s0 += bflo(w); s1 += bfhi(w); }
          if (nlo > lo) { const unsigned w = *(const LAS unsigned*)(xb + lo * PX_PITCH); s0 -= bflo(w); s1 -= bfhi(w); }
          lo = nlo; hi = nhi;
      } }
    __syncthreads();
    { const int gl = wave >> 2, th = (wave >> 1) & 1, nh = wave & 1, r = lane & 31, hh = lane >> 5;
      const int g = 2 * gp + gl;
      const bf16* WP = (const bf16*)(ws + WS_WP) + (size_t)(l * 4 + g) * 128 * 128;
      f32x16 acc[2];
#pragma unroll
      for (int q = 0; q < 2; ++q)
#pragma unroll
          for (int i = 0; i < 16; ++i) acc[q][i] = 0.f;
      const LAS unsigned char* arow = lds + PD_OFF + (th * 32 + r) * PD_PITCH + (gl * 128 + 8 * hh) * 2;
#pragma unroll
      for (int s = 0; s < 8; ++s) {
          const bf16x8 Af = *(const LAS bf16x8*)(arow + 32 * s);
#pragma unroll
          for (int nt = 0; nt < 2; ++nt) { const bf16x8 Bf = *(const bf16x8*)(WP + (size_t)(nh * 64 + nt * 32 + r) * 128 + 16 * s + 8 * hh);
              acc[nt] = __builtin_amdgcn_mfma_f32_32x32x16_bf16(Af, Bf, acc[nt], 0, 0, 0); }
      }
#pragma unroll
      for (int nt = 0; nt < 2; ++nt) {
          const int co = 128 * g + 64 * nh + 32 * nt + r;
          const float* SP = (const float*)(ws + WS_SP) + (size_t)l * SP_STRIDE; const float pb = SP[SP_PB + co], ps = SP[SP_PS + co];
#pragma unroll
          for (int i = 0; i < 16; ++i) {
              const int row = (i & 3) + 8 * (i >> 2) + 4 * hh;
              MIX[(size_t)(seqbase + t0 + th * 32 + row) * D + DLRU + co] = (bf16)f2bf((acc[nt][i] + pb) * ps);
          }
      } }
    __syncthreads();
}

constexpr int L1_PITCH = 2064;
constexpr int L1_PART = 16 * L1_PITCH;
constexpr int L1_MAXB = 5;
constexpr int L1_ROWS = L1_PART + 16384 + 256 + L1_MAXB * 64 * 16;
static_assert(L1_ROWS + L1_MAXB * 16 * 1024 <= LDS_TB, "LN1 LDS map");
__device__ __forceinline__ void phase_ln1(unsigned char* ws, int l, LAS unsigned char* lds, int bid, int G, int tid, int wave, int lane) {
    const float* MOD = (const float*)(ws + WS_MOD) + (size_t)l * 9 * 6144;
    bf16* XL = (bf16*)(ws + WS_XL); fp8* H8S = (fp8*)(ws + WS_H8S); const bf16* Y1 = (const bf16*)(ws + WS_Y1);
    const float* SP = (const float*)(ws + WS_SP) + (size_t)l * SP_STRIDE;
    const float* lg = SP + SP_L1G; const float* lb = SP + SP_L1B; const float* rb = SP + SP_RB;
    int* cnt = (int*)(ws + WS_CTL) + CW_CNT + 32 * l;
    float* TOPG = (float*)(ws + WS_TOPG); int* ROWDST = (int*)(ws + WS_ROWDST);
    const int ntok = (l == DEPTH - 1) ? TL : TT;
    const bf16* RWT = (const bf16*)(ws + WS_RWT) + (size_t)l * NE * D;
    bf16x8 Bf[4][2];
#pragma unroll
    for (int s = 0; s < 4; ++s)
#pragma unroll
        for (int nt = 0; nt < 2; ++nt) Bf[s][nt] = *(const bf16x8*)(RWT + (size_t)(16 * nt + (lane & 15)) * D + 128 * wave + 32 * s + 8 * (lane >> 4));
    LAS float* part = (LAS float*)(lds + L1_PART);
    LAS int* lcnt = (LAS int*)(lds + L1_PART + 16384);
    LAS int* lbase = lcnt + 32;
    LAS u32x4* ent = (LAS u32x4*)(lds + L1_PART + 16384 + 256);
    if (tid < 32) lcnt[tid] = 0;
    int nb_local = 0;
    __syncthreads();
    u32x2 px[2][4]; u32x2 py[2][4];
#define L1_LOAD(batch_) do { _Pragma("unroll") for (int rr = 0; rr < 2; ++rr) { const int tok_ = (batch_) * 16 + 2 * wave + rr; _Pragma("unroll") for (int j = 0; j < 4; ++j) { \
        px[rr][j] = ((const u32x2*)(XL + (size_t)tok_ * D))[lane + 64 * j]; py[rr][j] = ((const u32x2*)(Y1 + (size_t)tok_ * D))[lane + 64 * j]; } } } while (0)
    if (bid < ntok / 16) L1_LOAD(bid);
    for (int batch = bid; batch < ntok / 16 && nb_local < L1_MAXB; batch += G) {
        f32x4 v[2][4];
#pragma unroll
        for (int rr = 0; rr < 2; ++rr) {
            const int tok = batch * 16 + 2 * wave + rr;
            const float* m = MOD + (size_t)mod_row(tok) * 6144;
#pragma unroll
            for (int j = 0; j < 4; ++j) {
                const f32x4 g1 = ((const f32x4*)(m + 2048))[lane + 64 * j];
                const u32x2 yr = py[rr][j];
                f32x4 y; y.x = bflo(yr.x); y.y = bfhi(yr.x); y.z = bflo(yr.y); y.w = bfhi(yr.y);
                v[rr][j] = bf4(px[rr][j]) * ALPHA + g1 * y;
            }
        }
        if (batch + G < ntok / 16 && nb_local + 1 < L1_MAXB) L1_LOAD(batch + G);
#pragma unroll
        for (int rr = 0; rr < 2; ++rr) {
            const int trow = 2 * wave + rr, tok = batch * 16 + trow;
            const float* m = MOD + (size_t)mod_row(tok) * 6144;
            f32x4 h[4];
            float mean, rstd; ln_stats(v[rr], mean, rstd);
#pragma unroll
            for (int j = 0; j < 4; ++j) {
                const f32x4 gg = ((const f32x4*)lg)[lane + 64 * j], bb = ((const f32x4*)lb)[lane + 64 * j];
                const u32x2 ob = pk4((v[rr][j] - mean) * rstd * gg + bb);
                ((u32x2*)(XL + (size_t)tok * D))[lane + 64 * j] = ob; const f32x4 o = bf4(ob);
                const f32x4 sh = ((const f32x4*)(m + 3072))[lane + 64 * j], sc = ((const f32x4*)(m + 4096))[lane + 64 * j];
                h[j] = o * (sc + 1.0f) + sh;
                u32x2 w; w.x = pk2(h[j].x, h[j].y); w.y = pk2(h[j].z, h[j].w);
                int w8 = 0; w8 = __builtin_amdgcn_cvt_pk_fp8_f32(h[j].x, h[j].y, w8, false); w8 = __builtin_amdgcn_cvt_pk_fp8_f32(h[j].z, h[j].w, w8, true);
                *(LAS unsigned*)(lds + L1_ROWS + (nb_local * 16 + trow) * 1024 + (4 * lane + 256 * j)) = (unsigned)w8;
                *(LAS u32x2*)(lds + trow * L1_PITCH + (4 * lane + 256 * j) * 2) = w;
            }
        }
        __syncthreads();
        {
            f32x4 a2[2] = {(f32x4){0.f, 0.f, 0.f, 0.f}, (f32x4){0.f, 0.f, 0.f, 0.f}};
            const LAS unsigned char* arow = lds + (lane & 15) * L1_PITCH + (128 * wave + 8 * (lane >> 4)) * 2;
#pragma unroll
            for (int s = 0; s < 4; ++s) { const bf16x8 Af = *(const LAS bf16x8*)(arow + 64 * s);
#pragma unroll
                for (int nt = 0; nt < 2; ++nt) a2[nt] = __builtin_amdgcn_mfma_f32_16x16x32_bf16(Af, Bf[s][nt], a2[nt], 0, 0, 0); }
#pragma unroll
            for (int nt = 0; nt < 2; ++nt)
#pragma unroll
                for (int i = 0; i < 4; ++i) part[(wave * 16 + 4 * (lane >> 4) + i) * 32 + 16 * nt + (lane & 15)] = a2[nt][i];
        }
        __syncthreads();
        {
            const int trow = tid >> 5, e = tid & 31, tok = batch * 16 + trow;
            float lgt = rb[e];
#pragma unroll
            for (int w = 0; w < 8; ++w) lgt += part[(w * 16 + trow) * 32 + e];
            float tv[4]; int ti[4];
            float cur = lgt;
#pragma unroll
            for (int k = 0; k < 4; ++k) {
                float bv = cur; int bi = e;
#pragma unroll
                for (int o = 1; o < 32; o <<= 1) { const float ov = __shfl_xor(bv, o); const int oi = __shfl_xor(bi, o); if (ov > bv || (ov == bv && oi < bi)) { bv = ov; bi = oi; } }
                tv[k] = bv; ti[k] = bi;
                if (e == bi) cur = -INFINITY;
            }
            const float e1 = __expf(tv[1] - tv[0]), e2 = __expf(tv[2] - tv[0]), e3 = __expf(tv[3] - tv[0]);
            const float inv = 1.0f / (1.0f + e1 + e2 + e3);
            if (e < 4) {
                const int ex = e == 0 ? ti[0] : e == 1 ? ti[1] : e == 2 ? ti[2] : ti[3];
                const float pg = (e == 0 ? 1.0f : e == 1 ? e1 : e == 2 ? e2 : e3) * inv;
                const int ls = __hip_atomic_fetch_add(lcnt + ex, 1, __ATOMIC_RELAXED, __HIP_MEMORY_SCOPE_WORKGROUP);
                const int idx = (nb_local * 16 + trow) * 4 + e;
                ent[idx] = (u32x4){(unsigned)tok, (unsigned)ex, (unsigned)ls, __float_as_uint(pg)};
            }
        }
        ++nb_local;
        __syncthreads();
    }
    if (tid < 32) { const int c = lcnt[tid]; lbase[tid] = c > 0 ? atomicAdd(&cnt[tid], c) : 0; }
    __syncthreads();
    for (int i = wave; i < nb_local * 64; i += 8) {
        const u32x4 en = ent[i]; const int tok = (int)en.x, ex = (int)en.y, slot = lbase[ex] + (int)en.z;
        if (lane == 0) { TOPG[tok * 4 + (i & 3)] = __uint_as_float(en.w); ROWDST[(size_t)ex * TT + slot] = tok * 4 + (i & 3); }
        const u32x4 v = *(const LAS u32x4*)(lds + L1_ROWS + (i >> 2) * 1024 + 16 * lane);
        *(u32x4*)(H8S + ((size_t)ex * TT + slot) * D + 16 * lane) = v;
    }
    __syncthreads();
#undef L1_LOAD
}

__device__ __forceinline__ void phase_ln2(unsigned char* ws, float* out, int l, int gw, int ngw, int lane) {
    const float* MOD = (const float*)(ws + WS_MOD) + (size_t)l * 9 * 6144;
    bf16* XL = (bf16*)(ws + WS_XL); bf16* H = (bf16*)(ws + WS_H); const fp8* Y2 = (const fp8*)(ws + WS_Y2); const f32x4* TOPG = (const f32x4*)(ws + WS_TOPG);
    const float* SP = (const float*)(ws + WS_SP) + (size_t)l * SP_STRIDE;
    const float* lg = SP + SP_L2G; const float* lb = SP + SP_L2B;
    const bool last = (l == DEPTH - 1);
    const int ntok = last ? TL : TT;
    for (int tok0 = gw * 2; tok0 < ntok; tok0 += ngw * 2) {
        f32x4 v[2][4]; unsigned yr[2][4][4]; f32x4 g2[2][4]; f32x4 gk[2];
#pragma unroll
        for (int t = 0; t < 2; ++t) {
            const int tok = tok0 + t;
            const float* m = MOD + (size_t)mod_row(tok) * 6144;
            gk[t] = TOPG[tok];
#pragma unroll
            for (int j = 0; j < 4; ++j) {
                v[t][j] = bf4(((const u32x2*)(XL + (size_t)tok * D))[lane + 64 * j]);
                g2[t][j] = ((const f32x4*)(m + 5120))[lane + 64 * j];
#pragma unroll
                for (int k = 0; k < 4; ++k) yr[t][k][j] = ((const unsigned*)(Y2 + ((size_t)tok * 4 + k) * D))[lane + 64 * j];
            }
        }
#pragma unroll
        for (int t = 0; t < 2; ++t) {
            const int tok = tok0 + t;
#pragma unroll
            for (int j = 0; j < 4; ++j) {
                f32x4 f = (f32x4){0.f, 0.f, 0.f, 0.f};
#pragma unroll
                for (int k = 0; k < 4; ++k) { const unsigned r = yr[t][k][j]; const float g = gk[t][k]; const f32x2 lo = __builtin_amdgcn_cvt_pk_f32_fp8((int)r, false), hi = __builtin_amdgcn_cvt_pk_f32_fp8((int)r, true);
                    f.x += g * lo.x; f.y += g * lo.y; f.z += g * hi.x; f.w += g * hi.y; }
                v[t][j] = v[t][j] * ALPHA + g2[t][j] * f;
            }
            float mean, rstd; ln_stats(v[t], mean, rstd);
            f32x4 h[4];
            const float* mn = MOD + (size_t)9 * 6144 + (size_t)mod_row(tok) * 6144;
#pragma unroll
            for (int j = 0; j < 4; ++j) {
                const f32x4 gg = ((const f32x4*)lg)[lane + 64 * j], bb = ((const f32x4*)lb)[lane + 64 * j];
                const f32x4 o = (v[t][j] - mean) * rstd * gg + bb;
                if (last) ((f32x4*)(out + (size_t)tok * D))[lane + 64 * j] = o;
                else {
                    const u32x2 ob = pk4(o); ((u32x2*)(XL + (size_t)tok * D))[lane + 64 * j] = ob;
                    const f32x4 sh = ((const f32x4*)mn)[lane + 64 * j], sc = ((const f32x4*)(mn + 1024))[lane + 64 * j];
                    h[j] = bf4(ob) * (sc + 1.0f) + sh;
                }
            }
            if (!last) store_bf16_row(H + (size_t)tok * D, lane, h);
        }
    }
}

constexpr int NPHASE = 2 + 8 * DEPTH;
#ifndef PHMASK
#define PHMASK 0xFFFF
#endif
#define PH_ON(k) (((PHMASK) >> (k)) & 1)
#ifndef MK_PER_PHASE
#define MK_PER_PHASE 0
#endif
__global__ void __launch_bounds__(512, 2) mk_fwd(P p) {
    extern __shared__ __attribute__((aligned(16))) unsigned char lds_[];
    LAS unsigned char* lds = (LAS unsigned char*)lds_;
    const int tid = threadIdx.x, lane = tid & 63, wave = __builtin_amdgcn_readfirstlane(tid >> 6);
    const int G = gridDim.x, bid = blockIdx.x;
    volatile LAS unsigned* MISC = (volatile LAS unsigned*)(lds + LDS_MISC);
    if (tid < 4) MISC[tid] = 0u;
    __syncthreads();
    unsigned* barw = (unsigned*)(p.ws + WS_CTL) + CW_BAR;
    XcdBarrier bar; bar.bar = barw; bar.x = 0; bar.st = MISC;
    if (!MK_PER_PHASE) bar = xcd_barrier_post(barw, MISC);
    const int lo = p.ph_lo, hi = p.ph_hi;
#define IN(k) (lo <= (k) && (k) < hi)
#define SEAM(k) do { if (IN(k) && IN((k) + 1)) xcd_barrier(bar, wave == 0 && (int)__lane_id() == 0); } while (0)
    if (PH_ON(0) && IN(0)) { phase_p0a(p, lds, bid, G, tid, wave, lane); }
    SEAM(0);
    if (PH_ON(1) && IN(1)) { phase_entry(p, bid * 8 + wave, G * 8, lane); }
    SEAM(1);
#pragma unroll 1
    for (int l = 0; l < DEPTH; ++l) {
        const int pb = 2 + 8 * l;
#define FRESH() int tid_ = wave * 64 + (int)__lane_id(); asm volatile("" : "+v"(tid_)); const int lane_ = tid_ & 63; const int wave_ = __builtin_amdgcn_readfirstlane(tid_ >> 6); \
                size_t wz_ = 0; asm volatile("" : "+s"(wz_)); unsigned char* ws = p.ws + wz_; (void)lane_; (void)wave_
        if (PH_ON(2) && IN(pb + 0)) {
            FRESH();
            pg8::DenseOrder S; S.init(TT / 256, DIN / 256, G, bid);
            pg8::EpiStore E{(bf16*)(ws + WS_Z), DIN};
            pg8::gemm_phase<false>(lds, tid_, ws + WS_H, (const bf16*)(ws + WS_WIN) + (size_t)l * DIN * D, S, E);
        }
        SEAM(pb + 0);
        if (PH_ON(3) && IN(pb + 1)) {
            FRESH();
            int key = -1;
            for (int u = bid; u < NB * NGRP * NH * 2; u += G) { const int cb = u & 1, h = (u >> 1) & 7, bg = u >> 4;
                if ((u & 15) != key) { key = u & 15; lru_load_w(ws, l, h, cb, tid_, lds); }
                lru_agg_unit(ws, l, lds, bg / NGRP, bg % NGRP, h, cb, wave_, lane_); }
        }
        SEAM(pb + 1);
        if (PH_ON(4) && IN(pb + 2)) {
            FRESH();
            const int g0 = (l == DEPTH - 1) ? 1 : 0, ng = NGRP - g0;
            const int nlru = NB * ng * NH * 2, npool = ((l == DEPTH - 1) ? 256 : 288) * 2;
            for (int u = bid; u < nlru + npool; u += G) {
                if (u < nlru) { const int cb = u & 1, h = (u >> 1) & 7, bg = u >> 4; lru_final_unit(ws, l, bg / ng, g0 + bg % ng, h, cb, wave_, lane_); }
                else { const int q = u - nlru; pool_unit(ws, l, lds, q >> 1, q & 1, tid_, wave_, lane_); }
            }
        }
        SEAM(pb + 2);
        if (PH_ON(5) && IN(pb + 3)) {
            FRESH();
            pg8::DenseOrder S; S.init((l == DEPTH - 1 ? TL : TT) / 256, D / 256, G, bid);
            pg8::EpiStore E{(bf16*)(ws + WS_Y1), D};
            pg8::gemm_phase<false>(lds, tid_, ws + WS_MIX, (const bf16*)(ws + WS_WOUT) + (size_t)l * D * D, S, E);
        }
        SEAM(pb + 3);
        if (PH_ON(6) && IN(pb + 4)) { FRESH(); phase_ln1(ws, l, lds, bid, G, tid_, wave_, lane_); }
        SEAM(pb + 4);
        if (IN(pb + 5) || IN(pb + 6)) {
            FRESH();
            const int* cnt = (const int*)(ws + WS_CTL) + CW_CNT + 32 * l;
            LAS int* tb = (LAS int*)(lds + LDS_TB);
            if (tid_ < 64) { const int c = lane_ < 32 ? (cnt[lane_] + 255) >> 8 : 0; int s = c;
#pragma unroll
                for (int o = 1; o < 32; o <<= 1) { const int t = __shfl_up(s, o); if (lane_ >= o) s += t; }
                if (lane_ < 32) tb[lane_ + 1] = s; if (lane_ == 0) tb[0] = 0; }
            __syncthreads();
        }
        if (PH_ON(7) && IN(pb + 5)) {
            FRESH();
            const int* cnt = (const int*)(ws + WS_CTL) + CW_CNT + 32 * l;
            pg8::MoeOrder<8, true> S{(const LAS int*)(lds + LDS_TB), cnt, G, bid};
            pg8::EpiSwiglu E{(fp8*)(ws + WS_ACT), (const float*)(ws + WS_SP) + (size_t)l * SP_STRIDE + SP_B1};
            pg8::gemm_phase<true>(lds, tid_, ws + WS_H8S, ws + WS_W1T + (size_t)l * NE * 2 * DF * D, S, E);
        }
        SEAM(pb + 5);
        if (PH_ON(8) && IN(pb + 6)) {
            FRESH();
            const int* cnt = (const int*)(ws + WS_CTL) + CW_CNT + 32 * l;
            pg8::MoeOrder<4, false> S{(const LAS int*)(lds + LDS_TB), cnt, G, bid};
            pg8::EpiDown E{(fp8*)(ws + WS_Y2), (const float*)(ws + WS_SP) + (size_t)l * SP_STRIDE + SP_B2, (const int*)(ws + WS_ROWDST)};
            pg8::gemm_phase<true>(lds, tid_, ws + WS_ACT, ws + WS_W2T + (size_t)l * NE * D * DF, S, E);
        }
        SEAM(pb + 6);
        if (PH_ON(9) && IN(pb + 7)) { FRESH(); phase_ln2(ws, p.out, l, bid * 8 + wave_, G * 8, lane_); }
        SEAM(pb + 7);
#undef FRESH
    }
#undef IN
#undef SEAM
}

extern "C" void kernel_launch(void* const* d_in, const int* in_sizes, int n_in, void* d_out, int out_size, void* d_ws, size_t ws_size, hipStream_t stream) {
    static int grid = 0;
    if (grid == 0) {
        if (n_in != N_IN || ws_size < WS_END || out_size != TL * D) { fprintf(stderr, "kernel_launch: unexpected shapes (n_in %d, out %d, ws %zu)\n", n_in, out_size, ws_size); grid = -1; return; }
        int dev = 0, cus = 0, per_cu = 0;
        if (hipGetDevice(&dev) != hipSuccess || hipDeviceGetAttribute(&cus, hipDeviceAttributeMultiprocessorCount, dev) != hipSuccess) { grid = -1; return; }
        if (hipFuncSetAttribute((const void*)mk_fwd, hipFuncAttributeMaxDynamicSharedMemorySize, LDS_BYTES) != hipSuccess) { fprintf(stderr, "kernel_launch: hipFuncSetAttribute failed\n"); grid = -1; return; }
        if (hipOccupancyMaxActiveBlocksPerMultiprocessor(&per_cu, (const void*)mk_fwd, 512, LDS_BYTES) != hipSuccess || per_cu < 1) { fprintf(stderr, "kernel_launch: occupancy query says %d\n", per_cu); }
        (void)hipGetLastError();
        grid = cus & ~7;
        if (grid < 231) { fprintf(stderr, "kernel_launch: this build needs at least 231 CUs (has %d)\n", cus); grid = -1; return; }
    }
    if (grid < 0) return;
    (void)hipMemsetAsync((char*)d_ws + WS_CTL, 0, CTL_BYTES, stream);
    P p{};
    for (int i = 0; i < N_IN; ++i) p.in[i] = (const float*)d_in[i];
    p.out = (float*)d_out; p.ws = (unsigned char*)d_ws;
#if MK_PER_PHASE
    for (int ph = 0; ph < NPHASE; ++ph) { p.ph_lo = ph; p.ph_hi = ph + 1; hipLaunchKernelGGL(mk_fwd, dim3(grid), dim3(512), LDS_BYTES, stream, p);
#ifdef EXTRA_PHASE
        if (ph == EXTRA_PHASE) for (int r = 0; r < EXTRA_REPS; ++r) hipLaunchKernelGGL(mk_fwd, dim3(grid), dim3(512), LDS_BYTES, stream, p);
#endif
    }
#else
    p.ph_lo = 0; p.ph_hi = NPHASE;
    hipLaunchKernelGGL(mk_fwd, dim3(grid), dim3(512), LDS_BYTES, stream, p);
#endif
}
```
